# Optimizing an MI355X kernel written in HIP

```python
import jax, jax.numpy as jnp
from jax import lax
import numpy as np

D_MODEL = 1024
BATCH = 32
SEQ = 2048
DEPTH = 2

CHUNK = 64
N_MEM = 256
N_HEADS = 4
HEAD_DIM = 64
BRANCH_W = N_HEADS * HEAD_DIM
N_BRANCH = 4
Q_BLOCK = 128
ROPE_BASE = 10000.0
N_EXPERTS = 16
N_GROUPS = 4
EXPERTS_PER_GROUP = N_EXPERTS // N_GROUPS
TOP_K = 2
D_EXPERT = 512
DEEPNORM_ALPHA = (2.0 * DEPTH) ** 0.25
DEEPNORM_BETA = (8.0 * DEPTH) ** -0.25
LN_EPS = 1e-5
GN_EPS = 1e-6
MASK_VALUE = -1e30
FOX_FORGET_BIAS = 2.0

COL_SIZES = (
    BRANCH_W, BRANCH_W, BRANCH_W, N_HEADS,
    BRANCH_W, BRANCH_W, BRANCH_W, BRANCH_W,
    BRANCH_W, BRANCH_W, BRANCH_W, BRANCH_W,
    BRANCH_W,
    N_BRANCH * D_MODEL,
)
SPLIT_POINTS = tuple(int(v) for v in np.cumsum(COL_SIZES)[:-1])
N_IN = int(sum(COL_SIZES))
FOX_F_COL = 3 * BRANCH_W

kernel_name = 'hybrid_fox_retnet_hgrn2_mem_moe_deepnorm'


def _heads(t):
    return t.reshape(t.shape[:-1] + (N_HEADS, t.shape[-1] // N_HEADS))


def _layer_norm(x, g, b):
    xf = x.astype(jnp.float32)
    mu = jnp.mean(xf, axis=-1, keepdims=True)
    var = jnp.mean(jnp.square(xf - mu), axis=-1, keepdims=True)
    y = (xf - mu) * lax.rsqrt(var + LN_EPS)
    return (y * g + b).astype(x.dtype)


def _rope(t, pos):
    half = HEAD_DIM // 2
    inv = ROPE_BASE ** (-2.0 * jnp.arange(half, dtype=jnp.float32) / HEAD_DIM)
    ang = pos[:, None] * inv[None, :]
    cos = jnp.cos(ang)[:, None, :]
    sin = jnp.sin(ang)[:, None, :]
    t1, t2 = t[..., :half], t[..., half:]
    return jnp.concatenate([t1 * cos - t2 * sin, t1 * sin + t2 * cos], axis=-1)


def forgetting_attention(q, k, v, zf):
    S = q.shape[1]
    q = q.astype(jnp.float32)
    k = k.astype(jnp.float32)
    v = v.astype(jnp.float32)
    c = jnp.cumsum(jax.nn.log_sigmoid(zf.astype(jnp.float32)), axis=1).transpose(0, 2, 1)
    scale = HEAD_DIM ** -0.5
    pos = jnp.arange(S)
    outs = []
    for qs in range(0, S, Q_BLOCK):
        qe = qs + Q_BLOCK
        s = jnp.einsum('bqhd,bkhd->bhqk', q[:, qs:qe], k[:, :qe]) * scale
        s = s + c[:, :, qs:qe, None] - c[:, :, None, :qe]
        mask = pos[qs:qe, None] >= pos[None, :qe]
        p = jax.nn.softmax(jnp.where(mask, s, MASK_VALUE), axis=-1)
        outs.append(jnp.einsum('bhqk,bkhd->bqhd', p, v[:, :qe]))
    return jnp.concatenate(outs, axis=1)


def retention(q, k, v, g):
    B, S = q.shape[:2]
    n_chunks = S // CHUNK
    pos = jnp.arange(S, dtype=jnp.float32)
    q = _rope(q.astype(jnp.float32), pos)
    k = _rope(k.astype(jnp.float32), pos) * (HEAD_DIM ** -0.5)
    v = v.astype(jnp.float32)
    log_gamma = jnp.log1p(-jnp.exp2(-5.0 - jnp.arange(N_HEADS, dtype=jnp.float32)))
    idx = jnp.arange(CHUNK, dtype=jnp.float32)
    intra_decay = jnp.exp(log_gamma[:, None, None] * jnp.abs(idx[:, None] - idx[None, :]))
    key_decay = jnp.exp(log_gamma[:, None] * (CHUNK - 1.0 - idx[None, :]))
    query_decay = jnp.exp(log_gamma[:, None] * (idx[None, :] + 1.0))
    chunk_decay = jnp.exp(log_gamma * CHUNK)
    qc = q.reshape(B, n_chunks, CHUNK, N_HEADS, HEAD_DIM)
    kc = k.reshape(B, n_chunks, CHUNK, N_HEADS, HEAD_DIM)
    vc = v.reshape(B, n_chunks, CHUNK, N_HEADS, HEAD_DIM)
    scores = jnp.einsum('bnihd,bnjhd->bnhij', qc, kc) * intra_decay
    o = jnp.einsum('bnhij,bnjhv->bnihv', scores, vc)
    kv = jnp.einsum('bnjhd,hj,bnjhv->nbhdv', kc, key_decay, vc)

    def step(state, kv_n):
        return chunk_decay[None, :, None, None] * state + kv_n, state

    _, states = lax.scan(step, jnp.zeros((B, N_HEADS, HEAD_DIM, HEAD_DIM), jnp.float32), kv)
    o = o + jnp.einsum('bnihd,hi,nbhdv->bnihv', qc, query_decay, states)
    o = o.reshape(B, S, N_HEADS, HEAD_DIM)
    mu = jnp.mean(o, axis=-1, keepdims=True)
    var = jnp.mean(jnp.square(o - mu), axis=-1, keepdims=True)
    o = (o - mu) * lax.rsqrt(var + GN_EPS)
    return o * jax.nn.silu(g.astype(jnp.float32))


def _to_chunks(t):
    B, S, H, K = t.shape
    return t.reshape(B, S // CHUNK, CHUNK, H, K).transpose(1, 0, 3, 2, 4)


def hgrn2(q, i, zf, g, lb, norm_g):
    B, S = q.shape[:2]
    lb = lb.reshape(N_HEADS, HEAD_DIM)
    kf = (1.0 - lb) * jax.nn.sigmoid(-zf.astype(jnp.float32))
    logf = jnp.log1p(-kf)
    xs = (_to_chunks(q.astype(jnp.float32)), _to_chunks(kf), _to_chunks(i.astype(jnp.float32)), _to_chunks(logf))
    causal = jnp.tril(jnp.ones((CHUNK, CHUNK), dtype=bool))[:, :, None]

    def step(state, chunk):
        qn, kn, vn, lfn = chunk
        b = jnp.cumsum(lfn, axis=2)
        rel = b[:, :, :, None, :] - b[:, :, None, :, :]
        decay = jnp.where(causal, jnp.exp(jnp.where(causal, rel, 0.0)), 0.0)
        a = jnp.einsum('bhik,bhjk,bhijk->bhij', qn, kn, decay)
        o = jnp.einsum('bhij,bhjv->bhiv', a, vn) + jnp.einsum('bhik,bhkv->bhiv', qn * jnp.exp(b), state)
        b_last = b[:, :, -1:, :]
        new_state = jnp.exp(b_last[:, :, 0, :])[..., None] * state + jnp.einsum('bhjk,bhjv->bhkv', kn * jnp.exp(b_last - b), vn)
        return new_state, o

    _, o = lax.scan(step, jnp.zeros((B, N_HEADS, HEAD_DIM, HEAD_DIM), jnp.float32), xs)
    o = o.transpose(1, 0, 3, 2, 4).reshape(B, S, N_HEADS, HEAD_DIM)
    o = o * lax.rsqrt(jnp.mean(jnp.square(o), axis=-1, keepdims=True) + GN_EPS) * norm_g.astype(jnp.float32)
    return o * jax.nn.silu(g.astype(jnp.float32))


def memory_attention(q, mk, mv):
    s = jnp.einsum('bshd,bmhd->bhsm', q.astype(jnp.float32), mk.astype(jnp.float32)) * (HEAD_DIM ** -0.5)
    p = jax.nn.softmax(s, axis=-1)
    return jnp.einsum('bhsm,bmhd->bshd', p, mv.astype(jnp.float32))


def grouped_moe(x, w_router, b_router, w_e_in, w_e_out):
    B, S, D = x.shape
    T = B * S
    xt = x.reshape(T, D)
    probs = jax.nn.softmax((xt @ w_router + b_router).astype(jnp.float32), axis=-1)
    grouped = probs.reshape(T, N_GROUPS, EXPERTS_PER_GROUP)
    g_sel = jnp.argmax(jnp.max(grouped, axis=-1), axis=-1)
    in_group = jnp.take_along_axis(grouped, g_sel[:, None, None], axis=1)[:, 0]
    top_p, top_i = lax.top_k(in_group, TOP_K)
    expert = g_sel[:, None] * EXPERTS_PER_GROUP + top_i
    weight = top_p / jnp.sum(top_p, axis=-1, keepdims=True)
    flat_e = expert.reshape(-1)
    order = jnp.argsort(flat_e)
    tok = order // TOP_K
    xs = xt[tok]
    group_sizes = jnp.bincount(flat_e, length=N_EXPERTS).astype(jnp.int32)
    h = lax.ragged_dot(xs, w_e_in, group_sizes)
    h_gate, h_up = jnp.split(h, 2, axis=-1)
    y = lax.ragged_dot(jax.nn.silu(h_gate) * h_up, w_e_out, group_sizes)
    y = y * weight.reshape(-1)[order][:, None].astype(y.dtype)
    out = jnp.zeros_like(xt).at[tok].add(y.astype(xt.dtype))
    return out.reshape(B, S, D)


def setup_inputs(seed: int = 0) -> dict:
    key = jax.random.key(seed)
    ks = jax.random.split(key, 16)
    nrm = jax.random.normal
    f32 = jnp.float32
    x = nrm(ks[0], (BATCH, SEQ, D_MODEL), f32)
    mem = nrm(ks[1], (BATCH, N_MEM, D_MODEL), f32)
    w_in = nrm(ks[2], (DEPTH, D_MODEL, N_IN), f32) * D_MODEL ** -0.5
    b_in = 0.02 * nrm(ks[3], (DEPTH, N_IN), f32)
    b_in = b_in.at[:, FOX_F_COL:FOX_F_COL + N_HEADS].add(FOX_FORGET_BIAS)
    w_mem_kv = nrm(ks[4], (DEPTH, D_MODEL, 2 * BRANCH_W), f32) * D_MODEL ** -0.5
    hgrn_lb = 1.0 + 0.1 * nrm(ks[5], (DEPTH, BRANCH_W), f32)
    hgrn_norm_g = 1.0 + 0.1 * nrm(ks[6], (DEPTH, HEAD_DIM), f32)
    w_branch = nrm(ks[7], (DEPTH, N_BRANCH, BRANCH_W, D_MODEL), f32) * (BRANCH_W ** -0.5) * DEEPNORM_BETA
    w_out = nrm(ks[8], (DEPTH, D_MODEL, D_MODEL), f32) * (D_MODEL ** -0.5) * DEEPNORM_BETA
    ln_g = 1.0 + 0.1 * nrm(ks[9], (DEPTH, 2, D_MODEL), f32)
    ln_b = 0.02 * nrm(ks[10], (DEPTH, 2, D_MODEL), f32)
    w_router = nrm(ks[11], (D_MODEL, N_EXPERTS), f32) * D_MODEL ** -0.5
    b_router = 0.01 * nrm(ks[12], (N_EXPERTS,), f32)
    w_e_in = nrm(ks[13], (DEPTH, N_EXPERTS, D_MODEL, 2 * D_EXPERT), f32) * D_MODEL ** -0.5
    w_e_out = nrm(ks[14], (DEPTH, N_EXPERTS, D_EXPERT, D_MODEL), f32) * (D_EXPERT ** -0.5) * DEEPNORM_BETA
    return {'x': x, 'mem': mem, 'w_in': w_in, 'b_in': b_in, 'w_mem_kv': w_mem_kv,
            'hgrn_lb': hgrn_lb, 'hgrn_norm_g': hgrn_norm_g, 'w_branch': w_branch, 'w_out': w_out,
            'ln_g': ln_g, 'ln_b': ln_b, 'w_router': w_router, 'b_router': b_router,
            'w_e_in': w_e_in, 'w_e_out': w_e_out}


def reference(x, mem, w_in, b_in, w_mem_kv, hgrn_lb, hgrn_norm_g, w_branch, w_out,
              ln_g, ln_b, w_router, b_router, w_e_in, w_e_out):
    B, S, D = x.shape
    lb_all = jax.nn.softmax(hgrn_lb.astype(jnp.float32), axis=0)
    lb_all = jnp.cumsum(lb_all, axis=0) - lb_all[0:1]
    for l in range(DEPTH):
        proj = x @ w_in[l] + b_in[l]
        (fq, fk, fv, ff, rq, rk, rv, rg, hf, hi, hq, hg, mq, gate) = jnp.split(proj, SPLIT_POINTS, axis=-1)
        o_fox = forgetting_attention(_heads(fq), _heads(fk), _heads(fv), ff)
        o_ret = retention(_heads(rq), _heads(rk), _heads(rv), _heads(rg))
        o_hg = hgrn2(_heads(hq), _heads(hi), _heads(hf), _heads(hg), lb_all[l], hgrn_norm_g[l])
        mk, mv = jnp.split(mem @ w_mem_kv[l], 2, axis=-1)
        o_mem = memory_attention(_heads(mq), _heads(mk), _heads(mv))
        branches = jnp.stack([o_fox, o_ret, o_hg, o_mem], axis=2).reshape(B, S, N_BRANCH, BRANCH_W).astype(x.dtype)
        up = jnp.einsum('bsnc,ncd->bsnd', branches, w_branch[l])
        gates = jax.nn.sigmoid(gate.reshape(B, S, N_BRANCH, D))
        mixed = jnp.sum(gates * up, axis=2) @ w_out[l]
        x = _layer_norm(DEEPNORM_ALPHA * x + mixed, ln_g[l, 0], ln_b[l, 0])
        x = _layer_norm(DEEPNORM_ALPHA * x + grouped_moe(x, w_router, b_router, w_e_in[l], w_e_out[l]), ln_g[l, 1], ln_b[l, 1])
    return x
```

```cpp
#include <hip/hip_runtime.h>
#include <cstdio>
#include <cstdint>

namespace pg8 {
#define PG8_LAS __attribute__((address_space(3)))
typedef unsigned short bf16_t;
typedef short bf16x8 __attribute__((ext_vector_type(8)));
typedef float f32x4 __attribute__((ext_vector_type(4)));
typedef float f32x2 __attribute__((ext_vector_type(2)));
typedef unsigned u32x4 __attribute__((ext_vector_type(4)));
typedef unsigned u32x2 __attribute__((ext_vector_type(2)));
constexpr int BM = 256, BK = 64, HALF = 128, HTB = HALF * BK * 2  , STAGE_BYTES = 8 * HTB, NXCD = 8, WGM = 8;

__host__ __device__ __forceinline__ int lds_byte(int r, int c) { const int st = (r >> 4) * 2 + (c >> 5), rr = r & 15, cc = c & 31, ob = rr * 64 + cc * 2; return st * 1024 + (ob ^ (((ob >> 9) & 1) << 5)); }
__host__ __device__ __forceinline__ void stage_rc(int b, int& R, int& C) { const int st = b / 1024, sb = b % 1024, swz = sb ^ (((sb >> 9) & 1) << 5); R = (st >> 1) * 16 + swz / 64; C = (st & 1) * 32 + (swz % 64) / 2; }
__host__ __device__ __forceinline__ int perm32(int rho) { const int n = rho >> 4, i = rho & 15; return 8 * (i >> 2) + 4 * n + (i & 3); }

struct Unit { int pm, pn; };
struct Gemm { const bf16_t* A; const bf16_t* Bt; int lda, ldb, K; };

struct StaticOrder {
    int nM, nN, nwg, G, c, a_div, a_add;
    __device__ void init(int M, int N, int G_, int c_, int a_div_ = 0, int a_add_ = 0) { nM = M / BM; nN = N / BM; nwg = nM * nN; G = G_; c = c_; a_div = a_div_; a_add = a_add_; }
    __device__ bool next(int i, Unit& u) const {
        const long L = (long)i * G + c; if (L >= nwg) return false;
        int wgid = (int)L; { const int q = nwg / NXCD, r = nwg % NXCD, xcd = wgid % NXCD, off = wgid / NXCD; wgid = (xcd < r ? xcd * (q + 1) : r * (q + 1) + (xcd - r) * q) + off; }
        const int nig = WGM * nN, gid = wgid / nig, fm = gid * WGM, gsz = (nM - fm) < WGM ? (nM - fm) : WGM;
        u.pm = fm + ((wgid % nig) % gsz); u.pn = (wgid % nig) / gsz; return true;
    }
    __device__ __forceinline__ const char* a_ptr(const Gemm& g, const Unit& u) const { return (const char*)g.A + ((size_t)u.pm * BM * g.lda + (a_div ? (size_t)((u.pn / a_div) * a_add) : (size_t)0)) * 2; }
    __device__ __forceinline__ const char* b_ptr(const Gemm& g, const Unit& u) const { return (const char*)g.Bt + (size_t)u.pn * BM * g.ldb * 2; }
    __device__ __forceinline__ int grow(int, int) const { return 0; }
};

struct MoeOrder {
    int G, vcu, nN, ntiles; const PG8_LAS int* tb; const PG8_LAS int* gtab; size_t wstride;
    bool gather;
    __device__ __forceinline__ bool next(int i, Unit& u) const { const long L = (long)i * G + vcu; if (L >= (long)ntiles * nN) return false; u.pm = (int)(L / nN); u.pn = (int)(L % nN); return true; }
    __device__ __forceinline__ int expert_of(int pm) const { int e = 0;
#pragma unroll
        for (int k = 1; k < 16; ++k) e += (pm >= tb[k]) ? 1 : 0; return e; }
    __device__ __forceinline__ const char* a_ptr(const Gemm& g, const Unit& u) const { return gather ? (const char*)g.A : (const char*)g.A + (size_t)u.pm * BM * g.lda * 2; }
    __device__ __forceinline__ const char* b_ptr(const Gemm& g, const Unit& u) const { return (const char*)g.Bt + ((size_t)expert_of(u.pm) * wstride + (size_t)u.pn * BM * g.ldb) * 2; }
    __device__ __forceinline__ int grow(int ui, int r) const { const int v = gtab[ui * 256 + r]; return v >= 0 ? (v >> 1) : 0; }
};

__device__ __forceinline__ unsigned cvt_pk_bf16(float lo, float hi) { unsigned r; asm volatile("v_cvt_pk_bf16_f32 %0, %1, %2" : "=v"(r) : "v"(lo), "v"(hi)); return r; }
__device__ __forceinline__ float bf_lo(unsigned w) { return __uint_as_float(w << 16); }
__device__ __forceinline__ float bf_hi(unsigned w) { return __uint_as_float(w & 0xffff0000u); }
__device__ __forceinline__ float sigmoidf_fast(float x) { return __builtin_amdgcn_rcpf(1.0f + __builtin_amdgcn_exp2f(-1.4426950408889634f * x)); }

struct EpiBf16 {
    static constexpr bool PERM = true;
    bf16_t* O; int ldc; const float* bias;
    __device__ __forceinline__ void operator()(const f32x4 (&acc)[2][2][4][2], const Unit& u, int ui, int wr, int wc, int fr, int fq) const {
        const int row0 = u.pm * BM + wr * 64 + fr, col0 = u.pn * BM + wc * 32 + 8 * fq;
        f32x4 bv[2][2];
#pragma unroll
        for (int bj = 0; bj < 2; ++bj)
#pragma unroll
            for (int n = 0; n < 2; ++n) bv[bj][n] = bias ? *(const f32x4*)(bias + col0 + bj * HALF + 4 * n) : (f32x4){0.f, 0.f, 0.f, 0.f};
#pragma unroll
        for (int ai = 0; ai < 2; ++ai)
#pragma unroll
            for (int m = 0; m < 4; ++m) { bf16_t* rowp = O + (size_t)(row0 + ai * HALF + m * 16) * ldc + col0;
#pragma unroll
                for (int bj = 0; bj < 2; ++bj) { const f32x4 v0 = acc[ai][bj][m][0] + bv[bj][0], v1 = acc[ai][bj][m][1] + bv[bj][1];
                    u32x4 w; w.x = cvt_pk_bf16(v0[0], v0[1]); w.y = cvt_pk_bf16(v0[2], v0[3]); w.z = cvt_pk_bf16(v1[0], v1[1]); w.w = cvt_pk_bf16(v1[2], v1[3]);
                    *(u32x4*)(rowp + bj * HALF) = w; } }
    }
};
struct EpiGateMix {
    static constexpr bool PERM = false;
    const bf16_t* U; bf16_t* O; const float* bias;
    __device__ __forceinline__ void operator()(const f32x4 (&acc)[2][2][4][2], const Unit& u, int ui, int wr, int wc, int fr, int fq) const {
        const int row0 = u.pm * BM + wr * 64 + fr, d0 = 64 * u.pn + 16 * wc + 4 * fq;
        f32x4 bv[2][2];
#pragma unroll
        for (int bj = 0; bj < 2; ++bj)
#pragma unroll
            for (int n = 0; n < 2; ++n) bv[bj][n] = *(const f32x4*)(bias + u.pn * BM + 128 * bj + 32 * wc + 16 * n + 4 * fq);
#pragma unroll
        for (int ai = 0; ai < 2; ++ai)
#pragma unroll
            for (int m = 0; m < 4; ++m) { const size_t row = (size_t)(row0 + ai * HALF + m * 16); const bf16_t* up = U + row * 4096 + d0;
                f32x4 o = (f32x4){0.f, 0.f, 0.f, 0.f};
#pragma unroll
                for (int bj = 0; bj < 2; ++bj)
#pragma unroll
                    for (int n = 0; n < 2; ++n) { const u32x2 w = *(const u32x2*)(up + (2 * bj + n) * 1024);
                        const f32x4 z = acc[ai][bj][m][n] + bv[bj][n];
                        o[0] += sigmoidf_fast(z[0]) * bf_lo(w.x); o[1] += sigmoidf_fast(z[1]) * bf_hi(w.x); o[2] += sigmoidf_fast(z[2]) * bf_lo(w.y); o[3] += sigmoidf_fast(z[3]) * bf_hi(w.y); }
                u32x2 ow; ow.x = cvt_pk_bf16(o[0], o[1]); ow.y = cvt_pk_bf16(o[2], o[3]);
                *(u32x2*)(O + row * 1024 + d0) = ow; }
    }
};
struct EpiMoe1 {
    static constexpr bool PERM = true;
    bf16_t* act;
    __device__ __forceinline__ void operator()(const f32x4 (&acc)[2][2][4][2], const Unit& u, int ui, int wr, int wc, int fr, int fq) const {
        const int row0 = u.pm * BM + wr * 64 + fr, col0 = 128 * u.pn + 32 * wc + 8 * fq;
#pragma unroll
        for (int ai = 0; ai < 2; ++ai)
#pragma unroll
            for (int m = 0; m < 4; ++m) { const size_t row = (size_t)(row0 + ai * HALF + m * 16);
                float a[8];
#pragma unroll
                for (int n = 0; n < 2; ++n)
#pragma unroll
                    for (int j = 0; j < 4; ++j) { const float g = acc[ai][0][m][n][j], uu = acc[ai][1][m][n][j]; a[4 * n + j] = g * sigmoidf_fast(g) * uu; }
                u32x4 w; w.x = cvt_pk_bf16(a[0], a[1]); w.y = cvt_pk_bf16(a[2], a[3]); w.z = cvt_pk_bf16(a[4], a[5]); w.w = cvt_pk_bf16(a[6], a[7]);
                *(u32x4*)(act + row * 512 + col0) = w; }
    }
};
struct EpiMoe2 {
    static constexpr bool PERM = true;
    bf16_t* Y; const PG8_LAS int* gtab; const PG8_LAS float* wtab;
    __device__ __forceinline__ void operator()(const f32x4 (&acc)[2][2][4][2], const Unit& u, int ui, int wr, int wc, int fr, int fq) const {
        const int col0 = u.pn * BM + wc * 32 + 8 * fq;
#pragma unroll
        for (int ai = 0; ai < 2; ++ai)
#pragma unroll
            for (int m = 0; m < 4; ++m) { const int rl = ai * HALF + wr * 64 + m * 16 + fr; const int slot = gtab[ui * 256 + rl]; const float wgt = wtab[ui * 256 + rl];
                if (slot >= 0) { bf16_t* rowp = Y + (size_t)slot * 1024 + col0;
#pragma unroll
                    for (int bj = 0; bj < 2; ++bj) { const f32x4 v0 = acc[ai][bj][m][0] * wgt, v1 = acc[ai][bj][m][1] * wgt;
                        u32x4 w; w.x = cvt_pk_bf16(v0[0], v0[1]); w.y = cvt_pk_bf16(v0[2], v0[3]); w.z = cvt_pk_bf16(v1[0], v1[1]); w.w = cvt_pk_bf16(v1[2], v1[3]);
                        *(u32x4*)(rowp + bj * HALF) = w; } } }
    }
};

template <class Epi, class Sched, bool ALIGN_EPI, bool GATHER>
__device__ __forceinline__ void gemm_phase(PG8_LAS unsigned char* lds, const Gemm g, const Sched& S, const Epi& E) {
    int tid_ = threadIdx.x; asm volatile("" : "+v"(tid_));
    const int tid = tid_, wid = __builtin_amdgcn_readfirstlane(tid >> 6), lane = tid & 63, wr = wid >> 2, wc = wid & 3, fr = lane & 15, fq = lane >> 4;
    const int K = g.K, nt = K / BK;
    unsigned voffA[2], voffB[2]; int RA[2]; unsigned CA2[2];
#pragma unroll
    for (int i = 0; i < 2; ++i) { int R, C; stage_rc(tid * 16 + i * 8192, R, C); const int Rb = Epi::PERM ? ((R & ~31) + perm32(R & 31)) : R;
        voffA[i] = (unsigned)(R * g.lda + C) * 2u; voffB[i] = (unsigned)(Rb * g.ldb + C) * 2u; RA[i] = R; CA2[i] = (unsigned)C * 2u; }
    const size_t kstep = (size_t)(BK * 2);
    const size_t hstepA = (size_t)HALF * g.lda * 2, hstepB = (size_t)HALF * g.ldb * 2;
    const unsigned ldsw = (unsigned)wid * 1024u;
    const int aoff = lds_byte(wr * 64 + fr, fq * 8), boff = lds_byte(wc * 32 + fr, fq * 8);
    unsigned gvc[2][2], gvn[2][2];
#define PG8_SA(b, h) (((b) * 2 + (h)) * HTB)
#define PG8_SB(b, h) ((4 + (b) * 2 + (h)) * HTB)
#define PG8_STG(bufoff, gbase, voff) do { _Pragma("unroll") for (int _i = 0; _i < 2; ++_i) \
        __builtin_amdgcn_global_load_lds((const unsigned*)((const char*)(gbase) + (voff)[_i]), (PG8_LAS unsigned*)(lds + (bufoff) + ldsw + _i * 8192), 16, 0, 0); } while (0)
#define PG8_STG_B(bufoff, kptr, h) PG8_STG(bufoff, (kptr) + (h) * hstepB, voffB)
#define PG8_STG_A(bufoff, kptr, h, nx) do { if constexpr (GATHER) { unsigned _v[2]; _v[0] = (nx) ? gvn[h][0] : gvc[h][0]; _v[1] = (nx) ? gvn[h][1] : gvc[h][1]; PG8_STG(bufoff, kptr, _v); } \
        else { PG8_STG(bufoff, (kptr) + (h) * hstepA, voffA); } } while (0)
#define PG8_GLOAD(dst, uix) do { _Pragma("unroll") for (int _h = 0; _h < 2; ++_h) _Pragma("unroll") for (int _i = 0; _i < 2; ++_i) \
        dst[_h][_i] = (unsigned)S.grow((uix), _h * HALF + RA[_i]) * (unsigned)(g.lda * 2) + CA2[_i]; } while (0)
#define PG8_LDA(dst, b, h) do { _Pragma("unroll") for (int m = 0; m < 4; ++m) _Pragma("unroll") for (int k = 0; k < 2; ++k) dst[m][k] = *(const PG8_LAS bf16x8*)(lds + PG8_SA(b, h) + aoff + m * 2048 + k * 1024); } while (0)
#define PG8_LDB(dst, b, h) do { _Pragma("unroll") for (int n = 0; n < 2; ++n) _Pragma("unroll") for (int k = 0; k < 2; ++k) dst[n][k] = *(const PG8_LAS bf16x8*)(lds + PG8_SB(b, h) + boff + n * 2048 + k * 1024); } while (0)
#define PG8_MMA(ai, bj, At, Bt) do { __builtin_amdgcn_s_setprio(1); _Pragma("unroll") for (int m = 0; m < 4; ++m) _Pragma("unroll") for (int n = 0; n < 2; ++n) _Pragma("unroll") for (int k = 0; k < 2; ++k) \
        acc[ai][bj][m][n] = __builtin_amdgcn_mfma_f32_16x16x32_bf16(Bt[n][k], At[m][k], acc[ai][bj][m][n], 0, 0, 0); __builtin_amdgcn_s_setprio(0); } while (0)
#define PG8_WAIT_V(n) asm volatile("s_waitcnt vmcnt(" #n ")" ::: "memory")
#define PG8_WAIT_L(n) asm volatile("s_waitcnt lgkmcnt(" #n ")" ::: "memory")
#define PG8_BAR __builtin_amdgcn_s_barrier()
#define PG8_SCHED __builtin_amdgcn_sched_barrier(0)
    Unit cur, nxt; int ui = 0;
    if (!S.next(0, cur)) return;
    f32x4 acc[2][2][4][2];
#pragma unroll
    for (int a = 0; a < 2; ++a)
#pragma unroll
        for (int b = 0; b < 2; ++b)
#pragma unroll
            for (int m = 0; m < 4; ++m)
#pragma unroll
                for (int n = 0; n < 2; ++n) acc[a][b][m][n] = (f32x4){0.f, 0.f, 0.f, 0.f};
    bf16x8 At[4][2], B0[2][2], B1[2][2];
    const char* cA = S.a_ptr(g, cur); const char* cB = S.b_ptr(g, cur);
    if constexpr (GATHER) { PG8_GLOAD(gvc, 0); PG8_GLOAD(gvn, 0); }
    PG8_STG_B(PG8_SB(0, 0), cB, 0); PG8_STG_B(PG8_SB(0, 1), cB, 1); PG8_STG_A(PG8_SA(0, 0), cA, 0, false); PG8_STG_A(PG8_SA(0, 1), cA, 1, false);
    if (wr == 1) PG8_BAR;
    PG8_WAIT_V(2); PG8_BAR;
    PG8_STG_B(PG8_SB(1, 0), cB + kstep, 0); PG8_STG_A(PG8_SA(1, 0), cA + kstep, 0, false); PG8_STG_B(PG8_SB(1, 1), cB + kstep, 1);
    PG8_WAIT_V(6); PG8_BAR;
    for (;;) {
        const bool has_next = S.next(ui + 1, nxt);
        const char* nA = has_next ? S.a_ptr(g, nxt) : cA; const char* nB = has_next ? S.b_ptr(g, nxt) : cB;
        if constexpr (GATHER) { if (has_next) { PG8_GLOAD(gvn, ui + 1); } else {
#pragma unroll
            for (int h = 0; h < 2; ++h) { gvn[h][0] = gvc[h][0]; gvn[h][1] = gvc[h][1]; } } }
        for (int t = 0; t < nt; t += 2) {
            const bool last = (t == nt - 2);
            const char* a1 = cA + (size_t)(t + 1) * kstep;
            const char* a2 = last ? nA : cA + (size_t)(t + 2) * kstep; const char* b2 = last ? nB : cB + (size_t)(t + 2) * kstep;
            const char* a3 = a2 + kstep; const char* b3 = b2 + kstep;
            PG8_LDB(B0, 0, 0); PG8_LDB(B1, 0, 1); PG8_SCHED; PG8_LDA(At, 0, 0); PG8_STG_A(PG8_SA(1, 1), a1, 1, false);
            PG8_WAIT_V(8); PG8_WAIT_L(0); PG8_BAR; PG8_MMA(0, 0, At, B0); PG8_MMA(0, 1, At, B1); PG8_BAR; PG8_SCHED;
            PG8_LDA(At, 0, 1); PG8_STG_B(PG8_SB(0, 0), b2, 0); PG8_STG_B(PG8_SB(0, 1), b2, 1); PG8_STG_A(PG8_SA(0, 0), a2, 0, last);
            PG8_WAIT_V(8); PG8_WAIT_L(0); PG8_BAR; PG8_MMA(1, 0, At, B0); PG8_MMA(1, 1, At, B1); PG8_BAR; PG8_SCHED;
            PG8_LDB(B0, 1, 0); PG8_LDB(B1, 1, 1); PG8_SCHED; PG8_LDA(At, 1, 0); PG8_STG_A(PG8_SA(0, 1), a2, 1, last);
            PG8_WAIT_V(8); PG8_WAIT_L(0); PG8_BAR; PG8_MMA(0, 0, At, B0); PG8_MMA(0, 1, At, B1); PG8_BAR; PG8_SCHED;
            PG8_LDA(At, 1, 1); PG8_STG_B(PG8_SB(1, 0), b3, 0); PG8_STG_B(PG8_SB(1, 1), b3, 1); PG8_STG_A(PG8_SA(1, 0), a3, 0, last);
            PG8_WAIT_V(8); PG8_WAIT_L(0); PG8_BAR; PG8_MMA(1, 0, At, B0); PG8_MMA(1, 1, At, B1); PG8_BAR; PG8_SCHED;
        }
        if constexpr (ALIGN_EPI) { if (wr == 0) PG8_BAR; }
        E(acc, cur, ui, wr, wc, fr, fq);
        if (!has_next) break;
#pragma unroll
        for (int a = 0; a < 2; ++a)
#pragma unroll
            for (int b = 0; b < 2; ++b)
#pragma unroll
                for (int m = 0; m < 4; ++m)
#pragma unroll
                    for (int n = 0; n < 2; ++n) acc[a][b][m][n] = (f32x4){0.f, 0.f, 0.f, 0.f};
        cur = nxt; cA = nA; cB = nB; ++ui;
        if constexpr (GATHER) {
#pragma unroll
            for (int h = 0; h < 2; ++h) { gvc[h][0] = gvn[h][0]; gvc[h][1] = gvn[h][1]; } }
        if constexpr (ALIGN_EPI) { if (wr == 1) PG8_BAR; }
    }
    PG8_WAIT_V(0);
    if constexpr (!ALIGN_EPI) { if (wr == 0) PG8_BAR; }
    PG8_BAR;
#undef PG8_SA
#undef PG8_SB
#undef PG8_STG
#undef PG8_STG_A
#undef PG8_STG_B
#undef PG8_GLOAD
#undef PG8_LDA
#undef PG8_LDB
#undef PG8_MMA
#undef PG8_WAIT_V
#undef PG8_WAIT_L
#undef PG8_BAR
#undef PG8_SCHED
}
}

constexpr int NWAVES = 8;
constexpr int BATCH = 32, SEQ = 2048, DM = 1024, NLAYER = 2, NH = 4, HD = 64, NMEM = 256;
constexpr int T = BATCH * SEQ;
constexpr int MEMROWS = BATCH * NMEM;
constexpr int NIN = 7172, NPROJ = 3072, NGATE = 4096, NE = 16, DE = 512;
constexpr int FOX_F_COL = 768, GATE_COL = 3076;
constexpr float ALPHA = 1.4142135623730951f;
constexpr float LN_EPS = 1e-5f, GN_EPS = 1e-6f;
constexpr int LISTCAP = 65536;
constexpr int MAXU = 10;

constexpr size_t MiB = 1u << 20;
constexpr size_t WS_CTL = 0, CTL_ZERO_BYTES = 1 * MiB;
constexpr size_t WS_LF = 2 * MiB;
constexpr size_t WS_CC = 3 * MiB;
constexpr size_t WS_WT = 4 * MiB;
constexpr size_t WS_ROPE = 5 * MiB;
constexpr size_t WS_BIASP = 6 * MiB;
constexpr size_t WS_BIASG = 6 * MiB + 65536;
constexpr size_t WS_PAR = 7 * MiB;
constexpr int PAR_LNG = 0, PAR_LNB = 4096, PAR_WR = 8192, PAR_BR = 24576, PAR_LB = 24592, PAR_NG = 25104, PAR_WFF = 25232;
constexpr size_t WS_LIST = 8 * MiB;
constexpr size_t WS_W = 16 * MiB;
constexpr size_t W_IN = 0, W_G = 6 * MiB, W_B = 14 * MiB, W_OUT = 16 * MiB, W_E1 = 18 * MiB, W_E2 = 50 * MiB, W_LAYER = 66 * MiB;
constexpr size_t WS_WMEM = WS_W + 2 * W_LAYER;
constexpr size_t WS_MEMB = 152 * MiB;
constexpr size_t WS_MEMKV = 168 * MiB;
constexpr size_t WS_XB = 184 * MiB;
constexpr size_t WS_X1B = 312 * MiB;
constexpr size_t WS_PROJ = 440 * MiB;
constexpr size_t WS_BR = 824 * MiB;
constexpr size_t WS_U = 312 * MiB;
constexpr size_t WS_MIX = 824 * MiB;
constexpr size_t WS_Y = 440 * MiB;
constexpr size_t WS_ACT = 568 * MiB;
constexpr size_t WS_Y2 = 700 * MiB;
constexpr size_t WS_END = 1024 * MiB;
static_assert(WS_WMEM + 2 * MiB <= WS_MEMB && WS_U + (size_t)T * 4096 * 2 <= WS_BR && WS_ACT + (size_t)135168 * 512 * 2 <= WS_Y2 && WS_Y2 + (size_t)T * 2 * 1024 * 2 <= WS_END, "d_ws map");
constexpr int CW_TMO = 0, CW_CODE = 1, CW_BAR = 4096, CW_CNT = 16384;

constexpr int RING_OFF = 0, RING_BYTES = 131072;
constexpr int GT_OFF = 131072, WTB_OFF = GT_OFF + MAXU * 1024, SM_OFF = WTB_OFF + MAXU * 1024;
constexpr int LDSCTL_OFF = SM_OFF + 1024, MISC_OFF = LDSCTL_OFF + 320;
constexpr int LDS_BYTES = 155648;
static_assert(MISC_OFF + 128 <= LDS_BYTES, "LDS map");

#define GAS __attribute__((address_space(1)))
#define LAS __attribute__((address_space(3)))
typedef unsigned short bf16;
typedef unsigned v4u __attribute__((ext_vector_type(4)));
typedef unsigned v2u __attribute__((ext_vector_type(2)));
typedef float f32x4 __attribute__((ext_vector_type(4)));
typedef GAS unsigned gu32;
#define RLX_AGENT __ATOMIC_RELAXED, __HIP_MEMORY_SCOPE_AGENT
#define LDS_WAIT() asm volatile("s_waitcnt lgkmcnt(0)" ::: "memory")
#define VM_WAIT() asm volatile("s_waitcnt vmcnt(0)" ::: "memory")
__device__ __forceinline__ unsigned f2bf(float f) { unsigned u = __builtin_bit_cast(unsigned, f); return (u + 0x7fffu + ((u >> 16) & 1u)) >> 16; }
__device__ __forceinline__ unsigned pk2(float lo, float hi) { return f2bf(lo) | (f2bf(hi) << 16); }
__device__ __forceinline__ float bfl(unsigned w) { return __uint_as_float(w << 16); }
__device__ __forceinline__ float bfh(unsigned w) { return __uint_as_float(w & 0xffff0000u); }
__device__ __forceinline__ float bf1(bf16 h) { return __uint_as_float((unsigned)h << 16); }

#define XB_TMO      128
#define XB_XCNT(j)  (256  + 64 * (j))
#define XB_XSUB(j)  (1280 + 64 * (j))
#define XB_XGEN(j)  (2304 + 64 * (j))
#define XB_TOP      3328
#define XB_TOPGEN   3392
#define XCD_BAR_WORDS 3456
#define XB_SPIN_CAP (1u << 18)
__device__ __forceinline__ unsigned xb_ld(unsigned* p)              { return __hip_atomic_load(p, __ATOMIC_RELAXED, __HIP_MEMORY_SCOPE_AGENT); }
__device__ __forceinline__ unsigned xb_add(unsigned* p, unsigned v) { return __hip_atomic_fetch_add(p, v, __ATOMIC_RELAXED, __HIP_MEMORY_SCOPE_AGENT); }
__device__ __forceinline__ unsigned xb_xcc_id() { return (unsigned)__builtin_amdgcn_s_getreg((3 << 11) | 20) & 0xFu; }
#define XB_SPIN(cond, bar) do { unsigned _sp = 0; while (cond) { __builtin_amdgcn_s_sleep(1); \
    if ((++_sp & 255u) == 0u) { if (xb_ld(&(bar)[XB_TMO])) break; if (_sp > XB_SPIN_CAP) { atomicAdd(&(bar)[XB_TMO], 1u); break; } } } } while (0)
struct XcdBarrier { unsigned* bar; unsigned x; volatile LAS unsigned* st; };
__device__ __forceinline__ XcdBarrier xcd_barrier_post(unsigned* bar, volatile LAS unsigned* st) {
    XcdBarrier b; b.bar = bar; b.x = xb_xcc_id(); b.st = st;
    if (threadIdx.x == 0) (void)xb_add(&bar[XB_XCNT(b.x)], 1u);
    return b;
}
__device__ __forceinline__ void xcd_barrier_complete(unsigned* bar, unsigned x, unsigned& nloc, unsigned& nx) {
    const unsigned G = gridDim.x * gridDim.y * gridDim.z;
    unsigned sum, cnt, mine, sp = 0u;
    for (;;) {
        sum = 0u; cnt = 0u; mine = 0u;
#pragma unroll
        for (unsigned j = 0; j < 16; ++j) { const unsigned c = xb_ld(&bar[XB_XCNT(j)]); sum += c; cnt += (c > 0u) ? 1u : 0u; mine = (j == x) ? c : mine; }
        if (sum == G) break;
        __builtin_amdgcn_s_sleep(1);
        if ((++sp & 255u) == 0u) { if (xb_ld(&bar[XB_TMO])) break; if (sp > XB_SPIN_CAP) { atomicAdd(&bar[XB_TMO], 1u); break; } }
    }
    nloc = mine > 0u ? mine : 1u; nx = cnt > 0u ? cnt : 1u;
}
__device__ __forceinline__ void xcd_barrier(const XcdBarrier& b) {
    asm volatile("s_waitcnt vmcnt(0)" ::: "memory");
    __syncthreads();
    if (threadIdx.x == 0) {
        unsigned* bar = b.bar;
        __builtin_amdgcn_s_waitcnt(0);
        unsigned nloc = b.st[0], nx = b.st[1];
        if (nloc == 0u) { xcd_barrier_complete(bar, b.x, nloc, nx); b.st[0] = nloc; b.st[1] = nx; }
        const unsigned old = xb_add(&bar[XB_XSUB(b.x)], 1u);
        const unsigned gen = old / nloc;
        if (old + 1u == (gen + 1u) * nloc) {
            __builtin_amdgcn_fence(__ATOMIC_RELEASE, "agent");
            asm volatile("s_waitcnt vmcnt(0)" ::: "memory");
            const unsigned og = xb_add(&bar[XB_TOP], 1u);
            const unsigned tg = og / nx;
            if (og + 1u == (tg + 1u) * nx) xb_add(&bar[XB_TOPGEN], 1u);
            else XB_SPIN(xb_ld(&bar[XB_TOPGEN]) == tg, bar);
            __builtin_amdgcn_fence(__ATOMIC_ACQUIRE, "agent");
            xb_add(&bar[XB_XGEN(b.x)], 1u);
            asm volatile("s_waitcnt vmcnt(0)" ::: "memory");
        } else {
            XB_SPIN(xb_ld(&bar[XB_XGEN(b.x)]) == gen, bar);
            __builtin_amdgcn_fence(__ATOMIC_ACQUIRE, "agent");
            asm volatile("s_waitcnt vmcnt(0)" ::: "memory");
        }
    }
    __syncthreads();
}

struct Frame {
    LAS unsigned char* lds;
    volatile LAS unsigned* MISC;
    gu32* ctl;
    int tid, vcu, G, bx;
    float* out; unsigned char* ws;
};
#define OPAQUE_V(x) asm volatile("" : "+v"(x))
enum { I_X = 0, I_MEM, I_WIN, I_BIN, I_WMEMKV, I_LB, I_NORMG, I_WBRANCH, I_WOUT, I_LNG, I_LNB, I_WROUTER, I_BROUTER, I_WEIN, I_WEOUT };

__device__ __forceinline__ float wave_sum(float v) {
#pragma unroll
    for (int o = 1; o < 64; o <<= 1) v += __shfl_xor(v, o);
    return v;
}
__device__ __forceinline__ float wave_max(float v) {
#pragma unroll
    for (int o = 1; o < 64; o <<= 1) v = fmaxf(v, __shfl_xor(v, o));
    return v;
}
__device__ __forceinline__ float log_sigmoid(float z) { return z >= 0.f ? -log1pf(expf(-z)) : z - log1pf(expf(z)); }

__device__ __forceinline__ int src_col(int mode, int r) {
    if (mode == 1) { const int tile = r >> 8; return r + (tile >= 3 ? 4 : 0); }
    if (mode == 2) { const int nb = 2 * ((r >> 7) & 1) + ((r >> 4) & 1), d = 64 * (r >> 8) + 16 * ((r >> 5) & 3) + (r & 15); return GATE_COL + nb * 1024 + d; }
    if (mode == 3) { return ((r >> 7) & 1) * 512 + 128 * (r >> 8) + (r & 127); }
    return r;
}
__device__ __forceinline__ void p0_transpose_item(const float* W, int K, int N, bf16* WT, int mode, LAS float* scr, int item, int ndst32, int lane) {
    const int kb = item / ndst32, nb = item % ndst32, k0 = 64 * kb, n0 = 32 * nb;
    const int sc = src_col(mode, n0 + (lane & 31));
#pragma unroll 8
    for (int i = 0; i < 32; ++i) { const int kk = 2 * i + (lane >> 5); scr[kk * 33 + (lane & 31)] = W[(size_t)(k0 + kk) * N + sc]; }
    LDS_WAIT(); asm volatile("" ::: "memory");
    const int c = lane & 7;
#pragma unroll
    for (int j = 0; j < 4; ++j) { const int n = (lane >> 3) + 8 * j; const LAS float* s = scr + (8 * c) * 33 + n;
        v4u o; o.x = pk2(s[0 * 33], s[1 * 33]); o.y = pk2(s[2 * 33], s[3 * 33]); o.z = pk2(s[4 * 33], s[5 * 33]); o.w = pk2(s[6 * 33], s[7 * 33]);
        *(GAS v4u*)(WT + (size_t)(n0 + n) * K + k0 + 8 * c) = o; }
    LDS_WAIT(); asm volatile("" ::: "memory");
}
__device__ __forceinline__ void store_row_bf16(bf16* orow, int lane, const f32x4 (&v)[4]) {
    GAS unsigned long long* o8 = (GAS unsigned long long*)orow + lane;
#pragma unroll
    for (int j = 0; j < 4; ++j) o8[64 * j] = (unsigned long long)pk2(v[j].x, v[j].y) | ((unsigned long long)pk2(v[j].z, v[j].w) << 32);
}
__device__ __forceinline__ void load_row_bf16(const bf16* irow, int lane, f32x4 (&v)[4]) {
    const GAS v2u* i8 = (const GAS v2u*)irow + lane;
#pragma unroll
    for (int j = 0; j < 4; ++j) { const v2u w = i8[64 * j]; v[j] = (f32x4){bfl(w.x), bfh(w.x), bfl(w.y), bfh(w.y)}; }
}
__device__ __forceinline__ void forget_row(const f32x4 (&v)[4], const LAS float* wff, float* lfrow, int lane) {
    float p[4];
#pragma unroll
    for (int h = 0; h < 4; ++h) { float s = 0.f;
#pragma unroll
        for (int j = 0; j < 4; ++j) { const f32x4 w = *(const LAS f32x4*)(wff + h * 1024 + 256 * j + 4 * lane); s += (v[j].x * w.x + v[j].y * w.y) + (v[j].z * w.z + v[j].w * w.w); }
        p[h] = wave_sum(s) + wff[4096 + h]; }
    if (lane < 4) { const float z = lane == 0 ? p[0] : lane == 1 ? p[1] : lane == 2 ? p[2] : p[3]; lfrow[lane] = log_sigmoid(z); }
}
__device__ __forceinline__ void stage_wff(Frame& F, int l, LAS float* wff) {
    const float* src = (const float*)(F.ws + WS_PAR) + PAR_WFF + l * 4100;
    for (int idx = F.tid; idx < 4100; idx += NWAVES * 64) wff[idx] = src[idx];
}

struct Args { const float* in[15]; float* out; unsigned char* ws; int naive, pad; };
__device__ __forceinline__ void p0_prologue(Frame& F, const Args& A) {
    const int p_lane = F.tid & 63, p_wave = __builtin_amdgcn_readfirstlane(F.tid >> 6);
    LAS float* scr = (LAS float*)(F.lds + RING_OFF + p_wave * 8704);
    LAS float* wff = (LAS float*)(F.lds + RING_OFF + 81920);
    const int gw = F.vcu * NWAVES + p_wave, NGW = F.G * NWAVES;
    { const float* Win0 = A.in[I_WIN]; const float* bin0 = A.in[I_BIN];
      for (int idx = F.tid; idx < 4096; idx += NWAVES * 64) { const int k = idx >> 2, h = idx & 3; wff[h * 1024 + k] = Win0[(size_t)k * NIN + FOX_F_COL + h]; }
      if (F.tid < 4) wff[4096 + F.tid] = bin0[FOX_F_COL + F.tid]; }
    for (int l = 0; l < NLAYER; ++l) {
        unsigned char* wl = F.ws + WS_W + (size_t)l * W_LAYER;
        const float* win = A.in[I_WIN] + (size_t)l * DM * NIN;
        constexpr int I_IN = 16 * 96, I_G = 16 * 128, I_B = 4 * 4 * 32, I_O = 16 * 32, I_E1 = 16 * 16 * 32, I_E2 = 16 * 8 * 32, I_M = 16 * 16;
        constexpr int NITEMS = I_IN + I_G + I_B + I_O + I_E1 + I_E2 + I_M;
        for (int it = gw; it < NITEMS; it += NGW) {
            int r = it;
            if (r < I_IN) { p0_transpose_item(win, DM, NIN, (bf16*)(wl + W_IN), 1, scr, r, 96, p_lane); continue; } r -= I_IN;
            if (r < I_G) { p0_transpose_item(win, DM, NIN, (bf16*)(wl + W_G), 2, scr, r, 128, p_lane); continue; } r -= I_G;
            if (r < I_B) { const int nb = r / 128; p0_transpose_item(A.in[I_WBRANCH] + ((size_t)l * 4 + nb) * 256 * 1024, 256, 1024, (bf16*)(wl + W_B) + (size_t)nb * 1024 * 256, 0, scr, r % 128, 32, p_lane); continue; } r -= I_B;
            if (r < I_O) { p0_transpose_item(A.in[I_WOUT] + (size_t)l * 1024 * 1024, 1024, 1024, (bf16*)(wl + W_OUT), 0, scr, r, 32, p_lane); continue; } r -= I_O;
            if (r < I_E1) { const int e = r / 512; p0_transpose_item(A.in[I_WEIN] + ((size_t)l * 16 + e) * 1024 * 1024, 1024, 1024, (bf16*)(wl + W_E1) + (size_t)e * 1024 * 1024, 3, scr, r % 512, 32, p_lane); continue; } r -= I_E1;
            if (r < I_E2) { const int e = r / 256; p0_transpose_item(A.in[I_WEOUT] + ((size_t)l * 16 + e) * 512 * 1024, 512, 1024, (bf16*)(wl + W_E2) + (size_t)e * 1024 * 512, 0, scr, r % 256, 32, p_lane); continue; } r -= I_E2;
            p0_transpose_item(A.in[I_WMEMKV] + (size_t)l * 1024 * 512, 1024, 512, (bf16*)(F.ws + WS_WMEM) + (size_t)l * 512 * 1024, 0, scr, r, 16, p_lane);
        }
    }
    { const int gt = blockIdx.x * (NWAVES * 64) + F.tid, NGT = F.G * NWAVES * 64;
      float* bp = (float*)(F.ws + WS_BIASP); float* bg = (float*)(F.ws + WS_BIASG);
      for (int i = gt; i < NLAYER * NPROJ; i += NGT) { const int l = i / NPROJ, r = i % NPROJ; bp[i] = A.in[I_BIN][(size_t)l * NIN + src_col(1, r)]; }
      for (int i = gt; i < NLAYER * NGATE; i += NGT) { const int l = i / NGATE, r = i % NGATE; bg[i] = A.in[I_BIN][(size_t)l * NIN + src_col(2, r)]; }
      float* rc = (float*)(F.ws + WS_ROPE); float* rs = rc + SEQ * 32;
      for (int i = gt; i < SEQ * 32; i += NGT) { const int pos = i >> 5, f = i & 31; const float inv = powf(10000.0f, -2.0f * (float)f / 64.0f); const float ang = (float)pos * inv; rc[i] = cosf(ang); rs[i] = sinf(ang); }
      float* par = (float*)(F.ws + WS_PAR);
      for (int i = gt; i < 4096; i += NGT) { par[PAR_LNG + i] = A.in[I_LNG][i]; par[PAR_LNB + i] = A.in[I_LNB][i]; }
      for (int i = gt; i < 16384; i += NGT) par[PAR_WR + i] = A.in[I_WROUTER][i];
      for (int i = gt; i < 16; i += NGT) par[PAR_BR + i] = A.in[I_BROUTER][i];
      for (int i = gt; i < 512; i += NGT) par[PAR_LB + i] = A.in[I_LB][i];
      for (int i = gt; i < 128; i += NGT) par[PAR_NG + i] = A.in[I_NORMG][i];
      for (int i = gt; i < NLAYER * 4096; i += NGT) { const int l = i >> 12, k = (i & 4095) >> 2, h = i & 3; par[PAR_WFF + l * 4100 + h * 1024 + k] = A.in[I_WIN][((size_t)l * DM + k) * NIN + FOX_F_COL + h]; }
      for (int i = gt; i < NLAYER * 4; i += NGT) { const int l = i >> 2, h = i & 3; par[PAR_WFF + l * 4100 + 4096 + h] = A.in[I_BIN][(size_t)l * NIN + FOX_F_COL + h]; } }
    __syncthreads();
    for (int m = gw; m < T; m += NGW) {
        const GAS f32x4* xr = (const GAS f32x4*)(A.in[I_X] + (size_t)m * DM) + p_lane;
        f32x4 v[4];
#pragma unroll
        for (int j = 0; j < 4; ++j) v[j] = xr[64 * j];
        store_row_bf16((bf16*)(F.ws + WS_XB) + (size_t)m * DM, p_lane, v);
        forget_row(v, wff, (float*)(F.ws + WS_LF) + (size_t)m * 4, p_lane);
    }
    for (int m = gw; m < MEMROWS; m += NGW) {
        const GAS f32x4* xr = (const GAS f32x4*)(A.in[I_MEM] + (size_t)m * DM) + p_lane;
        f32x4 v[4];
#pragma unroll
        for (int j = 0; j < 4; ++j) v[j] = xr[64 * j];
        store_row_bf16((bf16*)(F.ws + WS_MEMB) + (size_t)m * DM, p_lane, v);
    }
}

__device__ __forceinline__ void cc_scan(Frame& F) {
    int tid_ = F.tid; OPAQUE_V(tid_); const int c_lane = tid_ & 63, c_wave = __builtin_amdgcn_readfirstlane(tid_ >> 6);
    if (F.bx < BATCH * NH && c_wave == 0) {
        const int bh = F.bx, b = bh >> 2, h = bh & 3, s0 = 32 * c_lane;
        const float* lf = (const float*)(F.ws + WS_LF) + ((size_t)b * SEQ + s0) * 4 + h;
        float loc[32]; float run = 0.f;
#pragma unroll
        for (int i = 0; i < 32; ++i) { run += lf[4 * i]; loc[i] = run; }
        float incl = run;
#pragma unroll
        for (int o = 1; o < 64; o <<= 1) { const float t = __shfl_up(incl, o); if (c_lane >= o) incl += t; }
        const float excl = incl - run;
        float* cc = (float*)(F.ws + WS_CC) + (size_t)bh * SEQ + s0;
#pragma unroll
        for (int i = 0; i < 32; ++i) cc[i] = excl + loc[i];
    }
}

__device__ __forceinline__ void naive_attn(Frame& F, int l) {
    int tid_ = F.tid; OPAQUE_V(tid_); const int lane = tid_ & 63, wave_ = __builtin_amdgcn_readfirstlane(tid_ >> 6);
    const int gw = F.vcu * NWAVES + wave_, NGW = F.G * NWAVES;
    const bf16* proj = (const bf16*)(F.ws + WS_PROJ); const bf16* memkv = (const bf16*)(F.ws + WS_MEMKV);
    const float* cc = (const float*)(F.ws + WS_CC); bf16* br = (bf16*)(F.ws + WS_BR);
    constexpr int BHS = BATCH * NH * SEQ;
    for (int it = gw; it < 2 * BHS; it += NGW) {
        const bool is_mem = it >= BHS; const int r = is_mem ? it - BHS : it; const int bh = r / SEQ, s = r % SEQ, b = bh >> 2, h = bh & 3;
        const size_t tok = (size_t)b * SEQ + s;
        const bf16* qp = proj + tok * NPROJ + (is_mem ? 2816 : 0) + h * 64;
        float q[64];
#pragma unroll
        for (int c = 0; c < 8; ++c) { const v4u w = *(const v4u*)(qp + 8 * c); q[8 * c + 0] = bfl(w.x); q[8 * c + 1] = bfh(w.x); q[8 * c + 2] = bfl(w.y); q[8 * c + 3] = bfh(w.y); q[8 * c + 4] = bfl(w.z); q[8 * c + 5] = bfh(w.z); q[8 * c + 6] = bfl(w.w); q[8 * c + 7] = bfh(w.w); }
        const int nkeys = is_mem ? NMEM : s + 1;
        const bf16* kbase = is_mem ? memkv + (size_t)b * NMEM * 1024 + l * 512 + h * 64 : proj + (size_t)b * SEQ * NPROJ + 256 + h * 64;
        const size_t kpitch = is_mem ? 1024 : NPROJ; const int voff = 256;
        const float cq = is_mem ? 0.f : cc[(size_t)bh * SEQ + s];
        float mrun = -1e30f, lrun = 0.f; float o[64];
#pragma unroll
        for (int d = 0; d < 64; ++d) o[d] = 0.f;
        for (int k0 = 0; k0 < nkeys; k0 += 64) { const int kk = k0 + lane;
            if (kk < nkeys) { const bf16* kp = kbase + (size_t)kk * kpitch; float dot = 0.f;
#pragma unroll
                for (int c = 0; c < 8; ++c) { const v4u w = *(const v4u*)(kp + 8 * c);
                    dot += q[8 * c + 0] * bfl(w.x) + q[8 * c + 1] * bfh(w.x) + q[8 * c + 2] * bfl(w.y) + q[8 * c + 3] * bfh(w.y) + q[8 * c + 4] * bfl(w.z) + q[8 * c + 5] * bfh(w.z) + q[8 * c + 6] * bfl(w.w) + q[8 * c + 7] * bfh(w.w); }
                float sv = dot * 0.125f; if (!is_mem) sv += cq - cc[(size_t)bh * SEQ + kk];
                const float mn = fmaxf(mrun, sv), corr = expf(mrun - mn), p = expf(sv - mn); mrun = mn; lrun = lrun * corr + p;
                const bf16* vp = kp + voff;
#pragma unroll
                for (int c = 0; c < 8; ++c) { const v4u w = *(const v4u*)(vp + 8 * c);
                    o[8 * c + 0] = o[8 * c + 0] * corr + p * bfl(w.x); o[8 * c + 1] = o[8 * c + 1] * corr + p * bfh(w.x); o[8 * c + 2] = o[8 * c + 2] * corr + p * bfl(w.y); o[8 * c + 3] = o[8 * c + 3] * corr + p * bfh(w.y);
                    o[8 * c + 4] = o[8 * c + 4] * corr + p * bfl(w.z); o[8 * c + 5] = o[8 * c + 5] * corr + p * bfh(w.z); o[8 * c + 6] = o[8 * c + 6] * corr + p * bfl(w.w); o[8 * c + 7] = o[8 * c + 7] * corr + p * bfh(w.w); } } }
        const float M = wave_max(mrun), sc = expf(mrun - M), L = wave_sum(lrun * sc);
        float res = 0.f;
#pragma unroll
        for (int d = 0; d < 64; ++d) { const float v = wave_sum(o[d] * sc); if (lane == d) res = v; }
        br[tok * 1024 + (is_mem ? 768 : 0) + h * 64 + lane] = (bf16)f2bf(res / L);
    }
}
__device__ __forceinline__ void naive_recur(Frame& F, int l) {
    int tid = F.tid; OPAQUE_V(tid); const int lane = tid & 63, wave = __builtin_amdgcn_readfirstlane(tid >> 6);
    const bf16* proj = (const bf16*)(F.ws + WS_PROJ); bf16* br = (bf16*)(F.ws + WS_BR);
    LAS float* L0 = (LAS float*)(F.lds + RING_OFF);
    if (F.bx < 128) {
        const int bh = F.bx, b = bh >> 2, h = bh & 3;
        LAS float* qr = L0; LAS float* kr = L0 + 4096; LAS float* vv = L0 + 8192; LAS float* sc = L0 + 12288; LAS float* st = L0 + 16384;
        const float* rc = (const float*)(F.ws + WS_ROPE); const float* rs = rc + SEQ * 32;
        const float lg = log1pf(-exp2f(-5.0f - (float)h));
        for (int i = tid; i < 4096; i += 512) st[i] = 0.f;
        for (int n = 0; n < SEQ / 64; ++n) {
            const size_t row0 = (size_t)b * SEQ + n * 64;
            for (int idx = tid; idx < 2048; idx += 512) { const int t = idx >> 5, c = idx & 31; const bf16* p = proj + (row0 + t) * NPROJ + h * 64;
                const float co = rc[(n * 64 + t) * 32 + c], si = rs[(n * 64 + t) * 32 + c];
                const float q1 = bf1(p[768 + c]), q2 = bf1(p[768 + c + 32]), k1 = bf1(p[1024 + c]), k2 = bf1(p[1024 + c + 32]);
                qr[t * 64 + c] = q1 * co - q2 * si; qr[t * 64 + c + 32] = q1 * si + q2 * co;
                kr[t * 64 + c] = (k1 * co - k2 * si) * 0.125f; kr[t * 64 + c + 32] = (k1 * si + k2 * co) * 0.125f;
                vv[t * 64 + c] = bf1(p[1280 + c]); vv[t * 64 + c + 32] = bf1(p[1280 + c + 32]); }
            __syncthreads();
            for (int j = 0; j < 8; ++j) { const int idx = tid + 512 * j, i = idx >> 6, jj = idx & 63; float s = 0.f;
                for (int d = 0; d < 64; ++d) s += qr[i * 64 + d] * kr[jj * 64 + d];
                sc[idx] = s * expf(lg * fabsf((float)(i - jj))); }
            __syncthreads();
            float oreg[8];
            for (int j = 0; j < 8; ++j) { const int idx = tid + 512 * j, i = idx >> 6, v = idx & 63; float s = 0.f, s2 = 0.f;
                for (int jj = 0; jj < 64; ++jj) s += sc[i * 64 + jj] * vv[jj * 64 + v];
                for (int d = 0; d < 64; ++d) s2 += qr[i * 64 + d] * st[d * 64 + v];
                oreg[j] = s + expf(lg * (float)(i + 1)) * s2; }
            __syncthreads();
            for (int j = 0; j < 8; ++j) { const int idx = tid + 512 * j, d = idx >> 6, v = idx & 63; float s = 0.f;
                for (int jj = 0; jj < 64; ++jj) s += kr[jj * 64 + d] * expf(lg * (float)(63 - jj)) * vv[jj * 64 + v];
                st[idx] = expf(lg * 64.0f) * st[idx] + s; }
            for (int j = 0; j < 8; ++j) { const int i = wave + 8 * j;
                const float mean = wave_sum(oreg[j]) * (1.f / 64.f), dv = oreg[j] - mean, var = wave_sum(dv * dv) * (1.f / 64.f);
                const float g = bf1(proj[(row0 + i) * NPROJ + 1536 + h * 64 + lane]);
                br[(row0 + i) * 1024 + 256 + h * 64 + lane] = (bf16)f2bf(dv * rsqrtf(var + GN_EPS) * g / (1.f + expf(-g))); }
            __syncthreads();
        }
    } else {
        const int bh = F.bx - 128, b = bh >> 2, h = bh & 3;
        if (bh >= 128) return;
        LAS float* qf = L0; LAS float* ff = L0 + 4096; LAS float* kf = L0 + 8192; LAS float* iv = L0 + 12288; LAS float* ob = L0 + 16384;
        const int v = tid >> 3, k8 = tid & 7;
        float Sreg[8];
#pragma unroll
        for (int i = 0; i < 8; ++i) Sreg[i] = 0.f;
        const float* lbp = (const float*)(F.ws + WS_PAR) + PAR_LB;
        for (int n = 0; n < SEQ / 64; ++n) {
            const size_t row0 = (size_t)b * SEQ + n * 64;
            for (int j = 0; j < 8; ++j) { const int idx = tid + 512 * j, t = idx >> 6, c = idx & 63; const bf16* p = proj + (row0 + t) * NPROJ + h * 64 + c;
                float lb = 0.f; if (l == 1) { const float a0 = lbp[h * 64 + c], a1 = lbp[256 + h * 64 + c]; lb = 1.f / (1.f + expf(a0 - a1)); }
                const float zf = bf1(p[1792]); const float kfv = (1.f - lb) / (1.f + expf(zf));
                qf[idx] = bf1(p[2304]); ff[idx] = 1.f - kfv; kf[idx] = kfv; iv[idx] = bf1(p[2048]); }
            __syncthreads();
            for (int t = 0; t < 64; ++t) { const float ivt = iv[t * 64 + v]; float p = 0.f;
#pragma unroll
                for (int i = 0; i < 8; ++i) { const int k = k8 * 8 + i; Sreg[i] = ff[t * 64 + k] * Sreg[i] + kf[t * 64 + k] * ivt; p += Sreg[i] * qf[t * 64 + k]; }
                p += __shfl_xor(p, 1); p += __shfl_xor(p, 2); p += __shfl_xor(p, 4);
                if (k8 == 0) ob[t * 64 + v] = p; }
            __syncthreads();
            { const int t = tid >> 3, seg = tid & 7; float ov[8]; float ss = 0.f;
#pragma unroll
              for (int i = 0; i < 8; ++i) { ov[i] = ob[t * 64 + seg * 8 + i]; ss += ov[i] * ov[i]; }
              ss += __shfl_xor(ss, 1); ss += __shfl_xor(ss, 2); ss += __shfl_xor(ss, 4);
              const float rr = rsqrtf(ss * (1.f / 64.f) + GN_EPS);
              const bf16* gp = proj + (row0 + t) * NPROJ + 2560 + h * 64 + seg * 8; const float* ng = (const float*)(F.ws + WS_PAR) + PAR_NG + l * 64 + seg * 8;
              unsigned w[4];
#pragma unroll
              for (int i = 0; i < 4; ++i) { const float g0 = bf1(gp[2 * i]), g1 = bf1(gp[2 * i + 1]);
                  w[i] = pk2(ov[2 * i] * rr * ng[2 * i] * g0 / (1.f + expf(-g0)), ov[2 * i + 1] * rr * ng[2 * i + 1] * g1 / (1.f + expf(-g1))); }
              *(v4u*)(br + (row0 + t) * 1024 + 512 + h * 64 + seg * 8) = (v4u){w[0], w[1], w[2], w[3]}; }
            __syncthreads();
        }
    }
}

__device__ __forceinline__ void ln1_phase(Frame& F, int l) {
    LAS float* WrT = (LAS float*)(F.lds + RING_OFF);
    LAS int* se1 = (LAS int*)(F.lds + RING_OFF + 65536); LAS int* se2 = se1 + 256; LAS float* sw = (LAS float*)(se2 + 256);
    LAS int* hist = (LAS int*)(F.lds + SM_OFF + 256); LAS int* base = hist + 16;
    int tid = F.tid; OPAQUE_V(tid); const int lane = tid & 63, wave = __builtin_amdgcn_readfirstlane(tid >> 6);
    for (int idx = tid; idx < 16384; idx += 512) { const int d = idx >> 4, e = idx & 15; WrT[e * 1024 + d] = ((const float*)(F.ws + WS_PAR))[PAR_WR + idx]; }
    if (tid < 16) hist[tid] = 0;
    __syncthreads();
    const bf16* xb = (const bf16*)(F.ws + WS_XB); const bf16* yb = (const bf16*)(F.ws + WS_Y); bf16* x1b = (bf16*)(F.ws + WS_X1B);
    const float* lng = (const float*)(F.ws + WS_PAR) + PAR_LNG + (l * 2 + 0) * DM; const float* lnb = (const float*)(F.ws + WS_PAR) + PAR_LNB + (l * 2 + 0) * DM;
    f32x4 gg[4], bb[4];
#pragma unroll
    for (int j = 0; j < 4; ++j) { gg[j] = *(const f32x4*)(lng + 256 * j + 4 * lane); bb[j] = *(const f32x4*)(lnb + 256 * j + 4 * lane); }
    for (int rb = F.bx; rb < T / 256; rb += F.G) {
        for (int i = 0; i < 32; ++i) { const int rl = wave * 32 + i; const size_t row = (size_t)rb * 256 + rl;
            f32x4 xv[4], yv[4]; load_row_bf16(xb + row * DM, lane, xv); load_row_bf16(yb + row * DM, lane, yv);
            float s = 0.f;
#pragma unroll
            for (int j = 0; j < 4; ++j) { xv[j] = xv[j] * ALPHA + yv[j]; s += (xv[j].x + xv[j].y) + (xv[j].z + xv[j].w); }
            const float mean = wave_sum(s) * (1.f / DM); float s2 = 0.f;
#pragma unroll
            for (int j = 0; j < 4; ++j) { xv[j] = xv[j] - mean; s2 += (xv[j].x * xv[j].x + xv[j].y * xv[j].y) + (xv[j].z * xv[j].z + xv[j].w * xv[j].w); }
            const float rstd = 1.f / sqrtf(wave_sum(s2) * (1.f / DM) + LN_EPS);
#pragma unroll
            for (int j = 0; j < 4; ++j) xv[j] = xv[j] * rstd * gg[j] + bb[j];
            store_row_bf16(x1b + row * DM, lane, xv);
            float lg[16];
#pragma unroll
            for (int e = 0; e < 16; ++e) { float p = 0.f;
#pragma unroll
                for (int j = 0; j < 4; ++j) { const f32x4 w = *(const LAS f32x4*)(WrT + e * 1024 + 256 * j + 4 * lane); p += (xv[j].x * w.x + xv[j].y * w.y) + (xv[j].z * w.z + xv[j].w * w.w); }
                lg[e] = wave_sum(p) + ((const float*)(F.ws + WS_PAR))[PAR_BR + e]; }
            float gm[4];
#pragma unroll
            for (int g = 0; g < 4; ++g) gm[g] = fmaxf(fmaxf(lg[4 * g], lg[4 * g + 1]), fmaxf(lg[4 * g + 2], lg[4 * g + 3]));
            int gs = 0; float gb = gm[0];
#pragma unroll
            for (int g = 1; g < 4; ++g) if (gm[g] > gb) { gb = gm[g]; gs = g; }
            float v0 = gs == 0 ? lg[0] : gs == 1 ? lg[4] : gs == 2 ? lg[8] : lg[12], v1 = gs == 0 ? lg[1] : gs == 1 ? lg[5] : gs == 2 ? lg[9] : lg[13];
            float v2 = gs == 0 ? lg[2] : gs == 1 ? lg[6] : gs == 2 ? lg[10] : lg[14], v3 = gs == 0 ? lg[3] : gs == 1 ? lg[7] : gs == 2 ? lg[11] : lg[15];
            int i1 = 0; float m1 = v0; if (v1 > m1) { m1 = v1; i1 = 1; } if (v2 > m1) { m1 = v2; i1 = 2; } if (v3 > m1) { m1 = v3; i1 = 3; }
            int i2 = -1; float m2 = -3.0e38f;
            if (i1 != 0 && v0 > m2) { m2 = v0; i2 = 0; } if (i1 != 1 && v1 > m2) { m2 = v1; i2 = 1; } if (i1 != 2 && v2 > m2) { m2 = v2; i2 = 2; } if (i1 != 3 && v3 > m2) { m2 = v3; i2 = 3; }
            if (lane == 0) { const int e1 = gs * 4 + i1, e2 = gs * 4 + i2;
                const int r1 = __hip_atomic_fetch_add(hist + e1, 1, __ATOMIC_RELAXED, __HIP_MEMORY_SCOPE_WORKGROUP), r2 = __hip_atomic_fetch_add(hist + e2, 1, __ATOMIC_RELAXED, __HIP_MEMORY_SCOPE_WORKGROUP);
                se1[rl] = e1 | (r1 << 8); se2[rl] = e2 | (r2 << 8); sw[rl] = 1.f / (1.f + expf(m2 - m1)); }
        }
        __syncthreads();
        if (tid < 16) { base[tid] = (int)__hip_atomic_fetch_add((unsigned*)(F.ctl + CW_CNT + (l * 16 + tid) * 64), (unsigned)hist[tid], RLX_AGENT); }
        __syncthreads();
        { const int rl = tid >> 1, k = tid & 1; const int v = k ? se2[rl] : se1[rl]; const int e = v & 255, r = v >> 8; const int slot = (rb * 256 + rl) * 2 + k;
          ((int*)(F.ws + WS_LIST))[(size_t)e * LISTCAP + base[e] + r] = slot; ((float*)(F.ws + WS_WT))[slot] = k ? 1.f - sw[rl] : sw[rl]; }
        __syncthreads();
        if (tid < 16) hist[tid] = 0;
        __syncthreads();
    }
}

__device__ __forceinline__ void ln2_phase(Frame& F, int l) {
    LAS float* wff = (LAS float*)(F.lds + RING_OFF + 81920);
    int tid_ = F.tid; OPAQUE_V(tid_); const int lane = tid_ & 63, wave_ = __builtin_amdgcn_readfirstlane(tid_ >> 6); const bool last = (l == NLAYER - 1);
    if (!last) { stage_wff(F, l + 1, wff); }
    __syncthreads();
    const int gw = F.vcu * NWAVES + wave_, NGW = F.G * NWAVES;
    const bf16* x1b = (const bf16*)(F.ws + WS_X1B); const bf16* y2 = (const bf16*)(F.ws + WS_Y2); bf16* xb = (bf16*)(F.ws + WS_XB);
    const float* lng = (const float*)(F.ws + WS_PAR) + PAR_LNG + (l * 2 + 1) * DM; const float* lnb = (const float*)(F.ws + WS_PAR) + PAR_LNB + (l * 2 + 1) * DM;
    f32x4 gg[4], bb[4];
#pragma unroll
    for (int j = 0; j < 4; ++j) { gg[j] = *(const f32x4*)(lng + 256 * j + 4 * lane); bb[j] = *(const f32x4*)(lnb + 256 * j + 4 * lane); }
    for (int m = gw; m < T; m += NGW) {
        f32x4 xv[4], ya[4], yb[4]; load_row_bf16(x1b + (size_t)m * DM, lane, xv); load_row_bf16(y2 + (size_t)(2 * m) * DM, lane, ya); load_row_bf16(y2 + (size_t)(2 * m + 1) * DM, lane, yb);
        float s = 0.f;
#pragma unroll
        for (int j = 0; j < 4; ++j) { xv[j] = xv[j] * ALPHA + (ya[j] + yb[j]); s += (xv[j].x + xv[j].y) + (xv[j].z + xv[j].w); }
        const float mean = wave_sum(s) * (1.f / DM); float s2 = 0.f;
#pragma unroll
        for (int j = 0; j < 4; ++j) { xv[j] = xv[j] - mean; s2 += (xv[j].x * xv[j].x + xv[j].y * xv[j].y) + (xv[j].z * xv[j].z + xv[j].w * xv[j].w); }
        const float rstd = 1.f / sqrtf(wave_sum(s2) * (1.f / DM) + LN_EPS);
#pragma unroll
        for (int j = 0; j < 4; ++j) xv[j] = xv[j] * rstd * gg[j] + bb[j];
        if (last) { GAS f32x4* o = (GAS f32x4*)(F.out + (size_t)m * DM) + lane;
#pragma unroll
            for (int j = 0; j < 4; ++j) o[64 * j] = xv[j]; }
        else { store_row_bf16(xb + (size_t)m * DM, lane, xv); forget_row(xv, wff, (float*)(F.ws + WS_LF) + (size_t)m * 4, lane); }
    }
}

__device__ __forceinline__ int moe_tables(Frame& F, int l) {
    LAS int* tb = (LAS int*)(F.lds + SM_OFF); LAS int* cn = tb + 32;
    LAS int* gtab = (LAS int*)(F.lds + GT_OFF); LAS float* wtab = (LAS float*)(F.lds + WTB_OFF);
    if (F.tid < 16) cn[F.tid] = (int)__hip_atomic_load((unsigned*)(F.ctl + CW_CNT + (l * 16 + F.tid) * 64), RLX_AGENT);
    __syncthreads();
    if (F.tid == 0) { int a = 0; for (int e = 0; e < 16; ++e) { tb[e] = a; a += (cn[e] + 255) >> 8; } tb[16] = a; }
    __syncthreads();
    const int ntiles = tb[16];
    const int* list = (const int*)(F.ws + WS_LIST); const float* wt = (const float*)(F.ws + WS_WT);
    for (int i = 0; i < MAXU; ++i) { const long L = (long)i * F.G + F.vcu; if (L >= (long)ntiles * 4) break; const int pm = (int)(L >> 2);
        if (F.tid < 256) { int e = 0;
#pragma unroll
            for (int k = 1; k < 16; ++k) e += (pm >= tb[k]) ? 1 : 0;
            const int p = (pm - tb[e]) * 256 + F.tid; int v = -1; float w = 0.f;
            if (p < cn[e]) { v = list[(size_t)e * LISTCAP + p]; w = wt[v]; }
            gtab[i * 256 + F.tid] = v; wtab[i * 256 + F.tid] = w; } }
    __syncthreads();
    return ntiles;
}

__global__ void __launch_bounds__(NWAVES * 64, 2) fwd_kernel(Args args) {
    extern __shared__ __attribute__((aligned(16))) unsigned char lds[];
    Frame F0;
    F0.lds = (LAS unsigned char*)lds;
    F0.MISC = (volatile LAS unsigned*)(F0.lds + MISC_OFF);
    F0.tid = threadIdx.x;
    F0.G = gridDim.x; F0.bx = blockIdx.x; { const int bx = blockIdx.x; F0.vcu = (F0.G % 8 == 0) ? (bx % 8) * (F0.G / 8) + bx / 8 : bx; }
    F0.ws = args.ws; F0.out = args.out; F0.ctl = (gu32*)(args.ws + WS_CTL);
    for (int u = F0.tid; u < (LDS_BYTES - LDSCTL_OFF) / 4; u += NWAVES * 64) ((LAS unsigned*)(F0.lds + LDSCTL_OFF))[u] = 0u;
    __syncthreads();
    XcdBarrier bar = xcd_barrier_post((unsigned*)(F0.ctl + CW_BAR), F0.MISC + 8);
#define GRID_BAR() do { XcdBarrier bb_ = bar; asm volatile("" : "+s"(bb_.bar), "+s"(bb_.x)); xcd_barrier(bb_); } while (0)

#ifndef SKIP_P0
    p0_prologue(F0, args);
#endif
    GRID_BAR();

    for (int l = 0; l < NLAYER; ++l) {
        Frame F = F0; asm volatile("" : "+s"(F.ws), "+s"(F.vcu), "+s"(F.bx), "+s"(F.G), "+v"(F.tid));
        unsigned char* ws = F.ws; const pg8::bf16_t* xb = (const pg8::bf16_t*)(ws + WS_XB);
        const unsigned char* wl = ws + WS_W + (size_t)l * W_LAYER;
#ifndef SKIP_CC
        cc_scan(F);
#endif
#ifndef SKIP_GA
        { pg8::Gemm g{xb, (const pg8::bf16_t*)(wl + W_IN), DM, DM, DM}; pg8::StaticOrder S; S.init(T, NPROJ, F.G, F.bx);
          pg8::EpiBf16 E{(pg8::bf16_t*)(ws + WS_PROJ), NPROJ, (const float*)(ws + WS_BIASP) + l * NPROJ};
          pg8::gemm_phase<pg8::EpiBf16, pg8::StaticOrder, true, false>(F.lds + RING_OFF, g, S, E); }
#endif
#ifndef SKIP_GM
        if (l == 0) { pg8::Gemm g{(const pg8::bf16_t*)(ws + WS_MEMB), (const pg8::bf16_t*)(ws + WS_WMEM), DM, DM, DM}; pg8::StaticOrder S; S.init(MEMROWS, 1024, F.G, F.bx);
          pg8::EpiBf16 E{(pg8::bf16_t*)(ws + WS_MEMKV), 1024, nullptr};
          pg8::gemm_phase<pg8::EpiBf16, pg8::StaticOrder, true, false>(F.lds + RING_OFF, g, S, E); }
#endif
        GRID_BAR();
#ifndef SKIP_RECUR
        naive_recur(F, l);
#endif
#ifndef SKIP_ATTN
        naive_attn(F, l);
#endif
        GRID_BAR();
#ifndef SKIP_GC
        { pg8::Gemm g{(const pg8::bf16_t*)(ws + WS_BR), (const pg8::bf16_t*)(wl + W_B), DM, 256, 256}; pg8::StaticOrder S; S.init(T, 4096, F.G, F.bx, 4, 256);
          pg8::EpiBf16 E{(pg8::bf16_t*)(ws + WS_U), 4096, nullptr};
          pg8::gemm_phase<pg8::EpiBf16, pg8::StaticOrder, true, false>(F.lds + RING_OFF, g, S, E); }
#endif
        GRID_BAR();
#ifndef SKIP_GD
        { pg8::Gemm g{xb, (const pg8::bf16_t*)(wl + W_G), DM, DM, DM}; pg8::StaticOrder S; S.init(T, NGATE, F.G, F.bx);
          pg8::EpiGateMix E{(const pg8::bf16_t*)(ws + WS_U), (pg8::bf16_t*)(ws + WS_MIX), (const float*)(ws + WS_BIASG) + l * NGATE};
          pg8::gemm_phase<pg8::EpiGateMix, pg8::StaticOrder, true, false>(F.lds + RING_OFF, g, S, E); }
#endif
        GRID_BAR();
#ifndef SKIP_GE
        { pg8::Gemm g{(const pg8::bf16_t*)(ws + WS_MIX), (const pg8::bf16_t*)(wl + W_OUT), DM, DM, DM}; pg8::StaticOrder S; S.init(T, DM, F.G, F.bx);
          pg8::EpiBf16 E{(pg8::bf16_t*)(ws + WS_Y), DM, nullptr};
          pg8::gemm_phase<pg8::EpiBf16, pg8::StaticOrder, true, false>(F.lds + RING_OFF, g, S, E); }
#endif
        GRID_BAR();
#ifndef SKIP_LN1
        ln1_phase(F, l);
#endif
        GRID_BAR();
        const int ntiles = moe_tables(F, l);
#ifndef SKIP_GG
        { pg8::Gemm g{(const pg8::bf16_t*)(ws + WS_X1B), (const pg8::bf16_t*)(wl + W_E1), DM, DM, DM};
          pg8::MoeOrder S{F.G, F.vcu, 4, ntiles, (const LAS int*)(F.lds + SM_OFF), (const LAS int*)(F.lds + GT_OFF), (size_t)1024 * 1024, true};
          pg8::EpiMoe1 E{(pg8::bf16_t*)(ws + WS_ACT)};
          pg8::gemm_phase<pg8::EpiMoe1, pg8::MoeOrder, true, true>(F.lds + RING_OFF, g, S, E); }
#endif
        GRID_BAR();
#ifndef SKIP_GH
        { pg8::Gemm g{(const pg8::bf16_t*)(ws + WS_ACT), (const pg8::bf16_t*)(wl + W_E2), DE, DE, DE};
          pg8::MoeOrder S{F.G, F.vcu, 4, ntiles, (const LAS int*)(F.lds + SM_OFF), (const LAS int*)(F.lds + GT_OFF), (size_t)1024 * 512, false};
          pg8::EpiMoe2 E{(pg8::bf16_t*)(ws + WS_Y2), (const LAS int*)(F.lds + GT_OFF), (const LAS float*)(F.lds + WTB_OFF)};
          pg8::gemm_phase<pg8::EpiMoe2, pg8::MoeOrder, true, false>(F.lds + RING_OFF, g, S, E); }
#endif
        GRID_BAR();
#ifndef SKIP_LN2
        ln2_phase(F, l);
#endif
        if (l + 1 < NLAYER) GRID_BAR();
    }
}

extern "C" void kernel_launch(void* const* d_in, const int* in_sizes, int n_in, void* d_out, int out_size, void* d_ws, size_t ws_size, hipStream_t stream) {
    static int grid = 0;
    if (grid == 0) {
        if (n_in != 15 || in_sizes[0] != T * DM || out_size != T * DM || ws_size < WS_END) { fprintf(stderr, "kernel_launch: unexpected shapes / workspace (n_in %d, in0 %d, out %d, ws %zu); nothing launched\n", n_in, n_in > 0 ? in_sizes[0] : -1, out_size, ws_size); grid = -1; return; }
        int dev = 0, cus = 0, per_cu = 0;
        if (hipGetDevice(&dev) != hipSuccess || hipDeviceGetAttribute(&cus, hipDeviceAttributeMultiprocessorCount, dev) != hipSuccess) { grid = -1; return; }
        if (hipFuncSetAttribute((const void*)fwd_kernel, hipFuncAttributeMaxDynamicSharedMemorySize, LDS_BYTES) != hipSuccess) { fprintf(stderr, "kernel_launch: hipFuncSetAttribute failed\n"); grid = -1; return; }
        if (hipOccupancyMaxActiveBlocksPerMultiprocessor(&per_cu, (const void*)fwd_kernel, NWAVES * 64, LDS_BYTES) != hipSuccess || per_cu < 1) fprintf(stderr, "kernel_launch: occupancy query reports %d\n", per_cu);
        (void)hipGetLastError();
        grid = cus;
    }
    if (grid < 0) return;
    if (hipMemsetAsync((char*)d_ws + WS_CTL, 0, CTL_ZERO_BYTES, stream) != hipSuccess) return;
    Args a{};
    for (int i = 0; i < 15; ++i) a.in[i] = (const float*)d_in[i];
    a.out = (float*)d_out; a.ws = (unsigned char*)d_ws; a.naive = 0; a.pad = 0;
    hipLaunchKernelGGL(fwd_kernel, dim3(grid), dim3(NWAVES * 64), LDS_BYTES, stream, a);
}
```

```cpp
#include <hip/hip_runtime.h>
#include <cstdio>
#include <cstdint>

namespace pg8 {
#define PG8_LAS __attribute__((address_space(3)))
typedef unsigned short bf16_t;
typedef short bf16x8 __attribute__((ext_vector_type(8)));
typedef float f32x4 __attribute__((ext_vector_type(4)));
typedef float f32x2 __attribute__((ext_vector_type(2)));
typedef unsigned u32x4 __attribute__((ext_vector_type(4)));
typedef unsigned u32x2 __attribute__((ext_vector_type(2)));
constexpr int BM = 256, BK = 64, HALF = 128, HTB = HALF * BK * 2  , STAGE_BYTES = 8 * HTB, NXCD = 8, WGM = 8;

__host__ __device__ __forceinline__ int lds_byte(int r, int c) { const int st = (r >> 4) * 2 + (c >> 5), rr = r & 15, cc = c & 31, ob = rr * 64 + cc * 2; return st * 1024 + (ob ^ (((ob >> 9) & 1) << 5)); }
__host__ __device__ __forceinline__ void stage_rc(int b, int& R, int& C) { const int st = b / 1024, sb = b % 1024, swz = sb ^ (((sb >> 9) & 1) << 5); R = (st >> 1) * 16 + swz / 64; C = (st & 1) * 32 + (swz % 64) / 2; }
__host__ __device__ __forceinline__ int perm32(int rho) { const int n = rho >> 4, i = rho & 15; return 8 * (i >> 2) + 4 * n + (i & 3); }

struct Unit { int pm, pn; };
struct Gemm { const bf16_t* A; const bf16_t* Bt; int lda, ldb, K; };

struct StaticOrder {
    int nM, nN, nwg, G, c, a_div, a_add;
    __device__ void init(int M, int N, int G_, int c_, int a_div_ = 0, int a_add_ = 0) { nM = M / BM; nN = N / BM; nwg = nM * nN; G = G_; c = c_; a_div = a_div_; a_add = a_add_; }
    __device__ bool next(int i, Unit& u) const {
        const long L = (long)i * G + c; if (L >= nwg) return false;
        int wgid = (int)L; { const int q = nwg / NXCD, r = nwg % NXCD, xcd = wgid % NXCD, off = wgid / NXCD; wgid = (xcd < r ? xcd * (q + 1) : r * (q + 1) + (xcd - r) * q) + off; }
        const int nig = WGM * nN, gid = wgid / nig, fm = gid * WGM, gsz = (nM - fm) < WGM ? (nM - fm) : WGM;
        u.pm = fm + ((wgid % nig) % gsz); u.pn = (wgid % nig) / gsz; return true;
    }
    __device__ __forceinline__ const char* a_ptr(const Gemm& g, const Unit& u) const { return (const char*)g.A + ((size_t)u.pm * BM * g.lda + (a_div ? (size_t)((u.pn / a_div) * a_add) : (size_t)0)) * 2; }
    __device__ __forceinline__ const char* b_ptr(const Gemm& g, const Unit& u) const { return (const char*)g.Bt + (size_t)u.pn * BM * g.ldb * 2; }
    __device__ __forceinline__ int grow(int, int) const { return 0; }
};

struct MoeOrder {
    int G, vcu, nN, ntiles; const PG8_LAS int* tb; const PG8_LAS int* gtab; size_t wstride;
    bool gather;
    __device__ __forceinline__ bool next(int i, Unit& u) const { const long L = (long)i * G + vcu; if (L >= (long)ntiles * nN) return false; u.pm = (int)(L / nN); u.pn = (int)(L % nN); return true; }
    __device__ __forceinline__ int expert_of(int pm) const { int e = 0;
#pragma unroll
        for (int k = 1; k < 16; ++k) e += (pm >= tb[k]) ? 1 : 0; return e; }
    __device__ __forceinline__ const char* a_ptr(const Gemm& g, const Unit& u) const { return gather ? (const char*)g.A : (const char*)g.A + (size_t)u.pm * BM * g.lda * 2; }
    __device__ __forceinline__ const char* b_ptr(const Gemm& g, const Unit& u) const { return (const char*)g.Bt + ((size_t)expert_of(u.pm) * wstride + (size_t)u.pn * BM * g.ldb) * 2; }
    __device__ __forceinline__ int grow(int ui, int r) const { const int v = gtab[ui * 256 + r]; return v >= 0 ? (v >> 1) : 0; }
};

__device__ __forceinline__ unsigned cvt_pk_bf16(float lo, float hi) { unsigned r; asm volatile("v_cvt_pk_bf16_f32 %0, %1, %2" : "=v"(r) : "v"(lo), "v"(hi)); return r; }
__device__ __forceinline__ float bf_lo(unsigned w) { return __uint_as_float(w << 16); }
__device__ __forceinline__ float bf_hi(unsigned w) { return __uint_as_float(w & 0xffff0000u); }
__device__ __forceinline__ float sigmoidf_fast(float x) { return __builtin_amdgcn_rcpf(1.0f + __builtin_amdgcn_exp2f(-1.4426950408889634f * x)); }

struct EpiBf16 {
    static constexpr bool PERM = true;
    bf16_t* O; int ldc; const float* bias;
    __device__ __forceinline__ void operator()(const f32x4 (&acc)[2][2][4][2], const Unit& u, int ui, int wr, int wc, int fr, int fq) const {
        const int row0 = u.pm * BM + wr * 64 + fr, col0 = u.pn * BM + wc * 32 + 8 * fq;
        f32x4 bv[2][2];
#pragma unroll
        for (int bj = 0; bj < 2; ++bj)
#pragma unroll
            for (int n = 0; n < 2; ++n) bv[bj][n] = bias ? *(const f32x4*)(bias + col0 + bj * HALF + 4 * n) : (f32x4){0.f, 0.f, 0.f, 0.f};
#pragma unroll
        for (int ai = 0; ai < 2; ++ai)
#pragma unroll
            for (int m = 0; m < 4; ++m) { bf16_t* rowp = O + (size_t)(row0 + ai * HALF + m * 16) * ldc + col0;
#pragma unroll
                for (int bj = 0; bj < 2; ++bj) { const f32x4 v0 = acc[ai][bj][m][0] + bv[bj][0], v1 = acc[ai][bj][m][1] + bv[bj][1];
                    u32x4 w; w.x = cvt_pk_bf16(v0[0], v0[1]); w.y = cvt_pk_bf16(v0[2], v0[3]); w.z = cvt_pk_bf16(v1[0], v1[1]); w.w = cvt_pk_bf16(v1[2], v1[3]);
                    *(u32x4*)(rowp + bj * HALF) = w; } }
    }
};
struct EpiGateMix {
    static constexpr bool PERM = false;
    const bf16_t* U; bf16_t* O; const float* bias;
    __device__ __forceinline__ void operator()(const f32x4 (&acc)[2][2][4][2], const Unit& u, int ui, int wr, int wc, int fr, int fq) const {
        const int row0 = u.pm * BM + wr * 64 + fr, d0 = 64 * u.pn + 16 * wc + 4 * fq;
        f32x4 bv[2][2];
#pragma unroll
        for (int bj = 0; bj < 2; ++bj)
#pragma unroll
            for (int n = 0; n < 2; ++n) bv[bj][n] = *(const f32x4*)(bias + u.pn * BM + 128 * bj + 32 * wc + 16 * n + 4 * fq);
#pragma unroll
        for (int ai = 0; ai < 2; ++ai)
#pragma unroll
            for (int m = 0; m < 4; ++m) { const size_t row = (size_t)(row0 + ai * HALF + m * 16); const bf16_t* up = U + row * 4096 + d0;
                f32x4 o = (f32x4){0.f, 0.f, 0.f, 0.f};
#pragma unroll
                for (int bj = 0; bj < 2; ++bj)
#pragma unroll
                    for (int n = 0; n < 2; ++n) { const u32x2 w = *(const u32x2*)(up + (2 * bj + n) * 1024);
                        const f32x4 z = acc[ai][bj][m][n] + bv[bj][n];
                        o[0] += sigmoidf_fast(z[0]) * bf_lo(w.x); o[1] += sigmoidf_fast(z[1]) * bf_hi(w.x); o[2] += sigmoidf_fast(z[2]) * bf_lo(w.y); o[3] += sigmoidf_fast(z[3]) * bf_hi(w.y); }
                u32x2 ow; ow.x = cvt_pk_bf16(o[0], o[1]); ow.y = cvt_pk_bf16(o[2], o[3]);
                *(u32x2*)(O + row * 1024 + d0) = ow; }
    }
};
struct EpiMoe1 {
    static constexpr bool PERM = true;
    bf16_t* act;
    __device__ __forceinline__ void operator()(const f32x4 (&acc)[2][2][4][2], const Unit& u, int ui, int wr, int wc, int fr, int fq) const {
        const int row0 = u.pm * BM + wr * 64 + fr, col0 = 128 * u.pn + 32 * wc + 8 * fq;
#pragma unroll
        for (int ai = 0; ai < 2; ++ai)
#pragma unroll
            for (int m = 0; m < 4; ++m) { const size_t row = (size_t)(row0 + ai * HALF + m * 16);
                float a[8];
#pragma unroll
                for (int n = 0; n < 2; ++n)
#pragma unroll
                    for (int j = 0; j < 4; ++j) { const float g = acc[ai][0][m][n][j], uu = acc[ai][1][m][n][j]; a[4 * n + j] = g * sigmoidf_fast(g) * uu; }
                u32x4 w; w.x = cvt_pk_bf16(a[0], a[1]); w.y = cvt_pk_bf16(a[2], a[3]); w.z = cvt_pk_bf16(a[4], a[5]); w.w = cvt_pk_bf16(a[6], a[7]);
                *(u32x4*)(act + row * 512 + col0) = w; }
    }
};
struct EpiMoe2 {
    static constexpr bool PERM = true;
    bf16_t* Y; const PG8_LAS int* gtab; const PG8_LAS float* wtab;
    __device__ __forceinline__ void operator()(const f32x4 (&acc)[2][2][4][2], const Unit& u, int ui, int wr, int wc, int fr, int fq) const {
        const int col0 = u.pn * BM + wc * 32 + 8 * fq;
#pragma unroll
        for (int ai = 0; ai < 2; ++ai)
#pragma unroll
            for (int m = 0; m < 4; ++m) { const int rl = ai * HALF + wr * 64 + m * 16 + fr; const int slot = gtab[ui * 256 + rl]; const float wgt = wtab[ui * 256 + rl];
                if (slot >= 0) { bf16_t* rowp = Y + (size_t)slot * 1024 + col0;
#pragma unroll
                    for (int bj = 0; bj < 2; ++bj) { const f32x4 v0 = acc[ai][bj][m][0] * wgt, v1 = acc[ai][bj][m][1] * wgt;
                        u32x4 w; w.x = cvt_pk_bf16(v0[0], v0[1]); w.y = cvt_pk_bf16(v0[2], v0[3]); w.z = cvt_pk_bf16(v1[0], v1[1]); w.w = cvt_pk_bf16(v1[2], v1[3]);
                        *(u32x4*)(rowp + bj * HALF) = w; } } }
    }
};

template <class Epi, class Sched, bool ALIGN_EPI, bool GATHER>
__device__ __forceinline__ void gemm_phase(PG8_LAS unsigned char* lds, const Gemm g, const Sched& S, const Epi& E) {
    int tid_ = threadIdx.x; asm volatile("" : "+v"(tid_));
    const int tid = tid_, wid = __builtin_amdgcn_readfirstlane(tid >> 6), lane = tid & 63, wr = wid >> 2, wc = wid & 3, fr = lane & 15, fq = lane >> 4;
    const int K = g.K, nt = K / BK;
    unsigned voffA[2], voffB[2]; int RA[2]; unsigned CA2[2];
#pragma unroll
    for (int i = 0; i < 2; ++i) { int R, C; stage_rc(tid * 16 + i * 8192, R, C); const int Rb = Epi::PERM ? ((R & ~31) + perm32(R & 31)) : R;
        voffA[i] = (unsigned)(R * g.lda + C) * 2u; voffB[i] = (unsigned)(Rb * g.ldb + C) * 2u; RA[i] = R; CA2[i] = (unsigned)C * 2u; }
    const size_t kstep = (size_t)(BK * 2);
    const size_t hstepA = (size_t)HALF * g.lda * 2, hstepB = (size_t)HALF * g.ldb * 2;
    const unsigned ldsw = (unsigned)wid * 1024u;
    const int aoff = lds_byte(wr * 64 + fr, fq * 8), boff = lds_byte(wc * 32 + fr, fq * 8);
    unsigned gvc[2][2], gvn[2][2];
#define PG8_SA(b, h) (((b) * 2 + (h)) * HTB)
#define PG8_SB(b, h) ((4 + (b) * 2 + (h)) * HTB)
#define PG8_STG(bufoff, gbase, voff) do { _Pragma("unroll") for (int _i = 0; _i < 2; ++_i) \
        __builtin_amdgcn_global_load_lds((const unsigned*)((const char*)(gbase) + (voff)[_i]), (PG8_LAS unsigned*)(lds + (bufoff) + ldsw + _i * 8192), 16, 0, 0); } while (0)
#define PG8_STG_B(bufoff, kptr, h) PG8_STG(bufoff, (kptr) + (h) * hstepB, voffB)
#define PG8_STG_A(bufoff, kptr, h, nx) do { if constexpr (GATHER) { unsigned _v[2]; _v[0] = (nx) ? gvn[h][0] : gvc[h][0]; _v[1] = (nx) ? gvn[h][1] : gvc[h][1]; PG8_STG(bufoff, kptr, _v); } \
        else { PG8_STG(bufoff, (kptr) + (h) * hstepA, voffA); } } while (0)
#define PG8_GLOAD(dst, uix) do { _Pragma("unroll") for (int _h = 0; _h < 2; ++_h) _Pragma("unroll") for (int _i = 0; _i < 2; ++_i) \
        dst[_h][_i] = (unsigned)S.grow((uix), _h * HALF + RA[_i]) * (unsigned)(g.lda * 2) + CA2[_i]; } while (0)
#define PG8_LDA(dst, b, h) do { _Pragma("unroll") for (int m = 0; m < 4; ++m) _Pragma("unroll") for (int k = 0; k < 2; ++k) dst[m][k] = *(const PG8_LAS bf16x8*)(lds + PG8_SA(b, h) + aoff + m * 2048 + k * 1024); } while (0)
#define PG8_LDB(dst, b, h) do { _Pragma("unroll") for (int n = 0; n < 2; ++n) _Pragma("unroll") for (int k = 0; k < 2; ++k) dst[n][k] = *(const PG8_LAS bf16x8*)(lds + PG8_SB(b, h) + boff + n * 2048 + k * 1024); } while (0)
#define PG8_MMA(ai, bj, At, Bt) do { __builtin_amdgcn_s_setprio(1); _Pragma("unroll") for (int m = 0; m < 4; ++m) _Pragma("unroll") for (int n = 0; n < 2; ++n) _Pragma("unroll") for (int k = 0; k < 2; ++k) \
        acc[ai][bj][m][n] = __builtin_amdgcn_mfma_f32_16x16x32_bf16(Bt[n][k], At[m][k], acc[ai][bj][m][n], 0, 0, 0); __builtin_amdgcn_s_setprio(0); } while (0)
#define PG8_WAIT_V(n) asm volatile("s_waitcnt vmcnt(" #n ")" ::: "memory")
#define PG8_WAIT_L(n) asm volatile("s_waitcnt lgkmcnt(" #n ")" ::: "memory")
#define PG8_BAR __builtin_amdgcn_s_barrier()
#define PG8_SCHED __builtin_amdgcn_sched_barrier(0)
    Unit cur, nxt; int ui = 0;
    if (!S.next(0, cur)) return;
    f32x4 acc[2][2][4][2];
#pragma unroll
    for (int a = 0; a < 2; ++a)
#pragma unroll
        for (int b = 0; b < 2; ++b)
#pragma unroll
            for (int m = 0; m < 4; ++m)
#pragma unroll
                for (int n = 0; n < 2; ++n) acc[a][b][m][n] = (f32x4){0.f, 0.f, 0.f, 0.f};
    bf16x8 At[4][2], B0[2][2], B1[2][2];
    const char* cA = S.a_ptr(g, cur); const char* cB = S.b_ptr(g, cur);
    if constexpr (GATHER) { PG8_GLOAD(gvc, 0); PG8_GLOAD(gvn, 0); }
    PG8_STG_B(PG8_SB(0, 0), cB, 0); PG8_STG_B(PG8_SB(0, 1), cB, 1); PG8_STG_A(PG8_SA(0, 0), cA, 0, false); PG8_STG_A(PG8_SA(0, 1), cA, 1, false);
    if (wr == 1) PG8_BAR;
    PG8_WAIT_V(2); PG8_BAR;
    PG8_STG_B(PG8_SB(1, 0), cB + kstep, 0); PG8_STG_A(PG8_SA(1, 0), cA + kstep, 0, false); PG8_STG_B(PG8_SB(1, 1), cB + kstep, 1);
    PG8_WAIT_V(6); PG8_BAR;
    for (;;) {
        const bool has_next = S.next(ui + 1, nxt);
        const char* nA = has_next ? S.a_ptr(g, nxt) : cA; const char* nB = has_next ? S.b_ptr(g, nxt) : cB;
        if constexpr (GATHER) { if (has_next) { PG8_GLOAD(gvn, ui + 1); } else {
#pragma unroll
            for (int h = 0; h < 2; ++h) { gvn[h][0] = gvc[h][0]; gvn[h][1] = gvc[h][1]; } } }
        for (int t = 0; t < nt; t += 2) {
            const bool last = (t == nt - 2);
            const char* a1 = cA + (size_t)(t + 1) * kstep;
            const char* a2 = last ? nA : cA + (size_t)(t + 2) * kstep; const char* b2 = last ? nB : cB + (size_t)(t + 2) * kstep;
            const char* a3 = a2 + kstep; const char* b3 = b2 + kstep;
            PG8_LDB(B0, 0, 0); PG8_LDB(B1, 0, 1); PG8_SCHED; PG8_LDA(At, 0, 0); PG8_STG_A(PG8_SA(1, 1), a1, 1, false);
            PG8_WAIT_V(8); PG8_WAIT_L(0); PG8_BAR; PG8_MMA(0, 0, At, B0); PG8_MMA(0, 1, At, B1); PG8_BAR; PG8_SCHED;
            PG8_LDA(At, 0, 1); PG8_STG_B(PG8_SB(0, 0), b2, 0); PG8_STG_B(PG8_SB(0, 1), b2, 1); PG8_STG_A(PG8_SA(0, 0), a2, 0, last);
            PG8_WAIT_V(8); PG8_WAIT_L(0); PG8_BAR; PG8_MMA(1, 0, At, B0); PG8_MMA(1, 1, At, B1); PG8_BAR; PG8_SCHED;
            PG8_LDB(B0, 1, 0); PG8_LDB(B1, 1, 1); PG8_SCHED; PG8_LDA(At, 1, 0); PG8_STG_A(PG8_SA(0, 1), a2, 1, last);
            PG8_WAIT_V(8); PG8_WAIT_L(0); PG8_BAR; PG8_MMA(0, 0, At, B0); PG8_MMA(0, 1, At, B1); PG8_BAR; PG8_SCHED;
            PG8_LDA(At, 1, 1); PG8_STG_B(PG8_SB(1, 0), b3, 0); PG8_STG_B(PG8_SB(1, 1), b3, 1); PG8_STG_A(PG8_SA(1, 0), a3, 0, last);
            PG8_WAIT_V(8); PG8_WAIT_L(0); PG8_BAR; PG8_MMA(1, 0, At, B0); PG8_MMA(1, 1, At, B1); PG8_BAR; PG8_SCHED;
        }
        if constexpr (ALIGN_EPI) { if (wr == 0) PG8_BAR; }
        E(acc, cur, ui, wr, wc, fr, fq);
        if (!has_next) break;
#pragma unroll
        for (int a = 0; a < 2; ++a)
#pragma unroll
            for (int b = 0; b < 2; ++b)
#pragma unroll
                for (int m = 0; m < 4; ++m)
#pragma unroll
                    for (int n = 0; n < 2; ++n) acc[a][b][m][n] = (f32x4){0.f, 0.f, 0.f, 0.f};
        cur = nxt; cA = nA; cB = nB; ++ui;
        if constexpr (GATHER) {
#pragma unroll
            for (int h = 0; h < 2; ++h) { gvc[h][0] = gvn[h][0]; gvc[h][1] = gvn[h][1]; } }
        if constexpr (ALIGN_EPI) { if (wr == 1) PG8_BAR; }
    }
    PG8_WAIT_V(0);
    if constexpr (!ALIGN_EPI) { if (wr == 0) PG8_BAR; }
    PG8_BAR;
#undef PG8_SA
#undef PG8_SB
#undef PG8_STG
#undef PG8_STG_A
#undef PG8_STG_B
#undef PG8_GLOAD
#undef PG8_LDA
#undef PG8_LDB
#undef PG8_MMA
#undef PG8_WAIT_V
#undef PG8_WAIT_L
#undef PG8_BAR
#undef PG8_SCHED
}
}

constexpr int NWAVES = 8;
constexpr int BATCH = 32, SEQ = 2048, DM = 1024, NLAYER = 2, NH = 4, HD = 64, NMEM = 256;
constexpr int T = BATCH * SEQ;
constexpr int MEMROWS = BATCH * NMEM;
constexpr int NIN = 7172, NPROJ = 3072, NGATE = 4096, NE = 16, DE = 512;
constexpr int FOX_F_COL = 768, GATE_COL = 3076;
constexpr float ALPHA = 1.4142135623730951f;
constexpr float LN_EPS = 1e-5f, GN_EPS = 1e-6f;
constexpr int LISTCAP = 65536;
constexpr int MAXU = 10;

constexpr size_t MiB = 1u << 20;
constexpr size_t WS_CTL = 0, CTL_ZERO_BYTES = 1 * MiB;
constexpr size_t WS_LF = 2 * MiB;
constexpr size_t WS_CC = 3 * MiB;
constexpr size_t WS_WT = 4 * MiB;
constexpr size_t WS_ROPE = 5 * MiB;
constexpr size_t WS_BIASP = 6 * MiB;
constexpr size_t WS_BIASG = 6 * MiB + 65536;
constexpr size_t WS_PAR = 7 * MiB;
constexpr int PAR_LNG = 0, PAR_LNB = 4096, PAR_WR = 8192, PAR_BR = 24576, PAR_LB = 24592, PAR_NG = 25104, PAR_WFF = 25232;
constexpr size_t WS_LIST = 8 * MiB;
constexpr size_t WS_W = 16 * MiB;
constexpr size_t W_IN = 0, W_G = 6 * MiB, W_B = 14 * MiB, W_OUT = 16 * MiB, W_E1 = 18 * MiB, W_E2 = 50 * MiB, W_LAYER = 66 * MiB;
constexpr size_t WS_WMEM = WS_W + 2 * W_LAYER;
constexpr size_t WS_MEMB = 152 * MiB;
constexpr size_t WS_MEMKV = 168 * MiB;
constexpr size_t WS_XB = 184 * MiB;
constexpr size_t WS_X1B = 312 * MiB;
constexpr size_t WS_PROJ = 440 * MiB;
constexpr size_t WS_BR = 824 * MiB;
constexpr size_t WS_U = 312 * MiB;
constexpr size_t WS_MIX = 824 * MiB;
constexpr size_t WS_Y = 440 * MiB;
constexpr size_t WS_ACT = 568 * MiB;
constexpr size_t WS_Y2 = 700 * MiB;
constexpr size_t WS_END = 1024 * MiB;
static_assert(WS_WMEM + 2 * MiB <= WS_MEMB && WS_U + (size_t)T * 4096 * 2 <= WS_BR && WS_ACT + (size_t)135168 * 512 * 2 <= WS_Y2 && WS_Y2 + (size_t)T * 2 * 1024 * 2 <= WS_END, "d_ws map");
constexpr int CW_TMO = 0, CW_CODE = 1, CW_BAR = 4096, CW_CNT = 16384;

constexpr int RING_OFF = 0, RING_BYTES = 131072;
constexpr int GT_OFF = 131072, WTB_OFF = GT_OFF + MAXU * 1024, SM_OFF = WTB_OFF + MAXU * 1024;
constexpr int LDSCTL_OFF = SM_OFF + 1024, MISC_OFF = LDSCTL_OFF + 320;
constexpr int LDS_BYTES = 155648;
static_assert(MISC_OFF + 128 <= LDS_BYTES, "LDS map");

#define GAS __attribute__((address_space(1)))
#define LAS __attribute__((address_space(3)))
typedef unsigned short bf16;
typedef unsigned v4u __attribute__((ext_vector_type(4)));
typedef unsigned v2u __attribute__((ext_vector_type(2)));
typedef float f32x4 __attribute__((ext_vector_type(4)));
typedef GAS unsigned gu32;
#define RLX_AGENT __ATOMIC_RELAXED, __HIP_MEMORY_SCOPE_AGENT
#define LDS_WAIT() asm volatile("s_waitcnt lgkmcnt(0)" ::: "memory")
#define VM_WAIT() asm volatile("s_waitcnt vmcnt(0)" ::: "memory")
__device__ __forceinline__ unsigned f2bf(float f) { unsigned u = __builtin_bit_cast(unsigned, f); return (u + 0x7fffu + ((u >> 16) & 1u)) >> 16; }
__device__ __forceinline__ unsigned pk2(float lo, float hi) { return f2bf(lo) | (f2bf(hi) << 16); }
__device__ __forceinline__ float bfl(unsigned w) { return __uint_as_float(w << 16); }
__device__ __forceinline__ float bfh(unsigned w) { return __uint_as_float(w & 0xffff0000u); }
__device__ __forceinline__ float bf1(bf16 h) { return __uint_as_float((unsigned)h << 16); }

#define XB_TMO      128
#define XB_XCNT(j)  (256  + 64 * (j))
#define XB_XSUB(j)  (1280 + 64 * (j))
#define XB_XGEN(j)  (2304 + 64 * (j))
#define XB_TOP      3328
#define XB_TOPGEN   3392
#define XCD_BAR_WORDS 3456
#define XB_SPIN_CAP (1u << 18)
__device__ __forceinline__ unsigned xb_ld(unsigned* p)              { return __hip_atomic_load(p, __ATOMIC_RELAXED, __HIP_MEMORY_SCOPE_AGENT); }
__device__ __forceinline__ unsigned xb_add(unsigned* p, unsigned v) { return __hip_atomic_fetch_add(p, v, __ATOMIC_RELAXED, __HIP_MEMORY_SCOPE_AGENT); }
__device__ __forceinline__ unsigned xb_xcc_id() { return (unsigned)__builtin_amdgcn_s_getreg((3 << 11) | 20) & 0xFu; }
#define XB_SPIN(cond, bar) do { unsigned _sp = 0; while (cond) { __builtin_amdgcn_s_sleep(1); \
    if ((++_sp & 255u) == 0u) { if (xb_ld(&(bar)[XB_TMO])) break; if (_sp > XB_SPIN_CAP) { atomicAdd(&(bar)[XB_TMO], 1u); break; } } } } while (0)
struct XcdBarrier { unsigned* bar; unsigned x; volatile LAS unsigned* st; };
__device__ __forceinline__ XcdBarrier xcd_barrier_post(unsigned* bar, volatile LAS unsigned* st) {
    XcdBarrier b; b.bar = bar; b.x = xb_xcc_id(); b.st = st;
    if (threadIdx.x == 0) (void)xb_add(&bar[XB_XCNT(b.x)], 1u);
    return b;
}
__device__ __forceinline__ void xcd_barrier_complete(unsigned* bar, unsigned x, unsigned& nloc, unsigned& nx) {
    const unsigned G = gridDim.x * gridDim.y * gridDim.z;
    unsigned sum, cnt, mine, sp = 0u;
    for (;;) {
        sum = 0u; cnt = 0u; mine = 0u;
#pragma unroll
        for (unsigned j = 0; j < 16; ++j) { const unsigned c = xb_ld(&bar[XB_XCNT(j)]); sum += c; cnt += (c > 0u) ? 1u : 0u; mine = (j == x) ? c : mine; }
        if (sum == G) break;
        __builtin_amdgcn_s_sleep(1);
        if ((++sp & 255u) == 0u) { if (xb_ld(&bar[XB_TMO])) break; if (sp > XB_SPIN_CAP) { atomicAdd(&bar[XB_TMO], 1u); break; } }
    }
    nloc = mine > 0u ? mine : 1u; nx = cnt > 0u ? cnt : 1u;
}
__device__ __forceinline__ void xcd_barrier(const XcdBarrier& b) {
    asm volatile("s_waitcnt vmcnt(0)" ::: "memory");
    __syncthreads();
    if (threadIdx.x == 0) {
        unsigned* bar = b.bar;
        __builtin_amdgcn_s_waitcnt(0);
        unsigned nloc = b.st[0], nx = b.st[1];
        if (nloc == 0u) { xcd_barrier_complete(bar, b.x, nloc, nx); b.st[0] = nloc; b.st[1] = nx; }
        const unsigned old = xb_add(&bar[XB_XSUB(b.x)], 1u);
        const unsigned gen = old / nloc;
        if (old + 1u == (gen + 1u) * nloc) {
            __builtin_amdgcn_fence(__ATOMIC_RELEASE, "agent");
            asm volatile("s_waitcnt vmcnt(0)" ::: "memory");
            const unsigned og = xb_add(&bar[XB_TOP], 1u);
            const unsigned tg = og / nx;
            if (og + 1u == (tg + 1u) * nx) xb_add(&bar[XB_TOPGEN], 1u);
            else XB_SPIN(xb_ld(&bar[XB_TOPGEN]) == tg, bar);
            __builtin_amdgcn_fence(__ATOMIC_ACQUIRE, "agent");
            xb_add(&bar[XB_XGEN(b.x)], 1u);
            asm volatile("s_waitcnt vmcnt(0)" ::: "memory");
        } else {
            XB_SPIN(xb_ld(&bar[XB_XGEN(b.x)]) == gen, bar);
            __builtin_amdgcn_fence(__ATOMIC_ACQUIRE, "agent");
            asm volatile("s_waitcnt vmcnt(0)" ::: "memory");
        }
    }
    __syncthreads();
}

struct Frame {
    LAS unsigned char* lds;
    volatile LAS unsigned* MISC;
    gu32* ctl;
    int tid, vcu, G, bx;
    float* out; unsigned char* ws;
};
#define OPAQUE_V(x) asm volatile("" : "+v"(x))
enum { I_X = 0, I_MEM, I_WIN, I_BIN, I_WMEMKV, I_LB, I_NORMG, I_WBRANCH, I_WOUT, I_LNG, I_LNB, I_WROUTER, I_BROUTER, I_WEIN, I_WEOUT };

__device__ __forceinline__ float wave_sum(float v) {
#pragma unroll
    for (int o = 1; o < 64; o <<= 1) v += __shfl_xor(v, o);
    return v;
}
__device__ __forceinline__ float wave_max(float v) {
#pragma unroll
    for (int o = 1; o < 64; o <<= 1) v = fmaxf(v, __shfl_xor(v, o));
    return v;
}
__device__ __forceinline__ float log_sigmoid(float z) { return z >= 0.f ? -log1pf(expf(-z)) : z - log1pf(expf(z)); }

__device__ __forceinline__ int src_col(int mode, int r) {
    if (mode == 1) { const int tile = r >> 8; return r + (tile >= 3 ? 4 : 0); }
    if (mode == 2) { const int nb = 2 * ((r >> 7) & 1) + ((r >> 4) & 1), d = 64 * (r >> 8) + 16 * ((r >> 5) & 3) + (r & 15); return GATE_COL + nb * 1024 + d; }
    if (mode == 3) { return ((r >> 7) & 1) * 512 + 128 * (r >> 8) + (r & 127); }
    return r;
}
__device__ __forceinline__ void p0_transpose_item(const float* W, int K, int N, bf16* WT, int mode, LAS float* scr, int item, int ndst32, int lane) {
    const int kb = item / ndst32, nb = item % ndst32, k0 = 64 * kb, n0 = 32 * nb;
    const int sc = src_col(mode, n0 + (lane & 31));
#pragma unroll 8
    for (int i = 0; i < 32; ++i) { const int kk = 2 * i + (lane >> 5); scr[kk * 33 + (lane & 31)] = W[(size_t)(k0 + kk) * N + sc]; }
    LDS_WAIT(); asm volatile("" ::: "memory");
    const int c = lane & 7;
#pragma unroll
    for (int j = 0; j < 4; ++j) { const int n = (lane >> 3) + 8 * j; const LAS float* s = scr + (8 * c) * 33 + n;
        v4u o; o.x = pk2(s[0 * 33], s[1 * 33]); o.y = pk2(s[2 * 33], s[3 * 33]); o.z = pk2(s[4 * 33], s[5 * 33]); o.w = pk2(s[6 * 33], s[7 * 33]);
        *(GAS v4u*)(WT + (size_t)(n0 + n) * K + k0 + 8 * c) = o; }
    LDS_WAIT(); asm volatile("" ::: "memory");
}
__device__ __forceinline__ void store_row_bf16(bf16* orow, int lane, const f32x4 (&v)[4]) {
    GAS unsigned long long* o8 = (GAS unsigned long long*)orow + lane;
#pragma unroll
    for (int j = 0; j < 4; ++j) o8[64 * j] = (unsigned long long)pk2(v[j].x, v[j].y) | ((unsigned long long)pk2(v[j].z, v[j].w) << 32);
}
__device__ __forceinline__ void load_row_bf16(const bf16* irow, int lane, f32x4 (&v)[4]) {
    const GAS v2u* i8 = (const GAS v2u*)irow + lane;
#pragma unroll
    for (int j = 0; j < 4; ++j) { const v2u w = i8[64 * j]; v[j] = (f32x4){bfl(w.x), bfh(w.x), bfl(w.y), bfh(w.y)}; }
}
__device__ __forceinline__ void forget_row(const f32x4 (&v)[4], const LAS float* wff, float* lfrow, int lane) {
    float p[4];
#pragma unroll
    for (int h = 0; h < 4; ++h) { float s = 0.f;
#pragma unroll
        for (int j = 0; j < 4; ++j) { const f32x4 w = *(const LAS f32x4*)(wff + h * 1024 + 256 * j + 4 * lane); s += (v[j].x * w.x + v[j].y * w.y) + (v[j].z * w.z + v[j].w * w.w); }
        p[h] = wave_sum(s) + wff[4096 + h]; }
    if (lane < 4) { const float z = lane == 0 ? p[0] : lane == 1 ? p[1] : lane == 2 ? p[2] : p[3]; lfrow[lane] = log_sigmoid(z); }
}
__device__ __forceinline__ void stage_wff(Frame& F, int l, LAS float* wff) {
    const float* src = (const float*)(F.ws + WS_PAR) + PAR_WFF + l * 4100;
    for (int idx = F.tid; idx < 4100; idx += NWAVES * 64) wff[idx] = src[idx];
}

struct Args { const float* in[15]; float* out; unsigned char* ws; int naive, pad; };
__device__ __forceinline__ void p0_prologue(Frame& F, const Args& A) {
    const int p_lane = F.tid & 63, p_wave = __builtin_amdgcn_readfirstlane(F.tid >> 6);
    LAS float* scr = (LAS float*)(F.lds + RING_OFF + p_wave * 8704);
    LAS float* wff = (LAS float*)(F.lds + RING_OFF + 81920);
    const int gw = F.vcu * NWAVES + p_wave, NGW = F.G * NWAVES;
    { const float* Win0 = A.in[I_WIN]; const float* bin0 = A.in[I_BIN];
      for (int idx = F.tid; idx < 4096; idx += NWAVES * 64) { const int k = idx >> 2, h = idx & 3; wff[h * 1024 + k] = Win0[(size_t)k * NIN + FOX_F_COL + h]; }
      if (F.tid < 4) wff[4096 + F.tid] = bin0[FOX_F_COL + F.tid]; }
    for (int l = 0; l < NLAYER; ++l) {
        unsigned char* wl = F.ws + WS_W + (size_t)l * W_LAYER;
        const float* win = A.in[I_WIN] + (size_t)l * DM * NIN;
        constexpr int I_IN = 16 * 96, I_G = 16 * 128, I_B = 4 * 4 * 32, I_O = 16 * 32, I_E1 = 16 * 16 * 32, I_E2 = 16 * 8 * 32, I_M = 16 * 16;
        constexpr int NITEMS = I_IN + I_G + I_B + I_O + I_E1 + I_E2 + I_M;
        for (int it = gw; it < NITEMS; it += NGW) {
            int r = it;
            if (r < I_IN) { p0_transpose_item(win, DM, NIN, (bf16*)(wl + W_IN), 1, scr, r, 96, p_lane); continue; } r -= I_IN;
            if (r < I_G) { p0_transpose_item(win, DM, NIN, (bf16*)(wl + W_G), 2, scr, r, 128, p_lane); continue; } r -= I_G;
            if (r < I_B) { const int nb = r / 128; p0_transpose_item(A.in[I_WBRANCH] + ((size_t)l * 4 + nb) * 256 * 1024, 256, 1024, (bf16*)(wl + W_B) + (size_t)nb * 1024 * 256, 0, scr, r % 128, 32, p_lane); continue; } r -= I_B;
            if (r < I_O) { p0_transpose_item(A.in[I_WOUT] + (size_t)l * 1024 * 1024, 1024, 1024, (bf16*)(wl + W_OUT), 0, scr, r, 32, p_lane); continue; } r -= I_O;
            if (r < I_E1) { const int e = r / 512; p0_transpose_item(A.in[I_WEIN] + ((size_t)l * 16 + e) * 1024 * 1024, 1024, 1024, (bf16*)(wl + W_E1) + (size_t)e * 1024 * 1024, 3, scr, r % 512, 32, p_lane); continue; } r -= I_E1;
            if (r < I_E2) { const int e = r / 256; p0_transpose_item(A.in[I_WEOUT] + ((size_t)l * 16 + e) * 512 * 1024, 512, 1024, (bf16*)(wl + W_E2) + (size_t)e * 1024 * 512, 0, scr, r % 256, 32, p_lane); continue; } r -= I_E2;
            p0_transpose_item(A.in[I_WMEMKV] + (size_t)l * 1024 * 512, 1024, 512, (bf16*)(F.ws + WS_WMEM) + (size_t)l * 512 * 1024, 0, scr, r, 16, p_lane);
        }
    }
    { const int gt = blockIdx.x * (NWAVES * 64) + F.tid, NGT = F.G * NWAVES * 64;
      float* bp = (float*)(F.ws + WS_BIASP); float* bg = (float*)(F.ws + WS_BIASG);
      for (int i = gt; i < NLAYER * NPROJ; i += NGT) { const int l = i / NPROJ, r = i % NPROJ; bp[i] = A.in[I_BIN][(size_t)l * NIN + src_col(1, r)]; }
      for (int i = gt; i < NLAYER * NGATE; i += NGT) { const int l = i / NGATE, r = i % NGATE; bg[i] = A.in[I_BIN][(size_t)l * NIN + src_col(2, r)]; }
      float* rc = (float*)(F.ws + WS_ROPE); float* rs = rc + SEQ * 32;
      for (int i = gt; i < SEQ * 32; i += NGT) { const int pos = i >> 5, f = i & 31; const float inv = powf(10000.0f, -2.0f * (float)f / 64.0f); const float ang = (float)pos * inv; rc[i] = cosf(ang); rs[i] = sinf(ang); }
      float* par = (float*)(F.ws + WS_PAR);
      for (int i = gt; i < 4096; i += NGT) { par[PAR_LNG + i] = A.in[I_LNG][i]; par[PAR_LNB + i] = A.in[I_LNB][i]; }
      for (int i = gt; i < 16384; i += NGT) par[PAR_WR + i] = A.in[I_WROUTER][i];
      for (int i = gt; i < 16; i += NGT) par[PAR_BR + i] = A.in[I_BROUTER][i];
      for (int i = gt; i < 512; i += NGT) par[PAR_LB + i] = A.in[I_LB][i];
      for (int i = gt; i < 128; i += NGT) par[PAR_NG + i] = A.in[I_NORMG][i];
      for (int i = gt; i < NLAYER * 4096; i += NGT) { const int l = i >> 12, k = (i & 4095) >> 2, h = i & 3; par[PAR_WFF + l * 4100 + h * 1024 + k] = A.in[I_WIN][((size_t)l * DM + k) * NIN + FOX_F_COL + h]; }
      for (int i = gt; i < NLAYER * 4; i += NGT) { const int l = i >> 2, h = i & 3; par[PAR_WFF + l * 4100 + 4096 + h] = A.in[I_BIN][(size_t)l * NIN + FOX_F_COL + h]; } }
    __syncthreads();
    for (int m = gw; m < T; m += NGW) {
        const GAS f32x4* xr = (const GAS f32x4*)(A.in[I_X] + (size_t)m * DM) + p_lane;
        f32x4 v[4];
#pragma unroll
        for (int j = 0; j < 4; ++j) v[j] = xr[64 * j];
        store_row_bf16((bf16*)(F.ws + WS_XB) + (size_t)m * DM, p_lane, v);
        forget_row(v, wff, (float*)(F.ws + WS_LF) + (size_t)m * 4, p_lane);
    }
    for (int m = gw; m < MEMROWS; m += NGW) {
        const GAS f32x4* xr = (const GAS f32x4*)(A.in[I_MEM] + (size_t)m * DM) + p_lane;
        f32x4 v[4];
#pragma unroll
        for (int j = 0; j < 4; ++j) v[j] = xr[64 * j];
        store_row_bf16((bf16*)(F.ws + WS_MEMB) + (size_t)m * DM, p_lane, v);
    }
}

__device__ __forceinline__ void cc_scan(Frame& F) {
    int tid_ = F.tid; OPAQUE_V(tid_); const int c_lane = tid_ & 63, c_wave = __builtin_amdgcn_readfirstlane(tid_ >> 6);
    if (F.bx < BATCH * NH && c_wave == 0) {
        const int bh = F.bx, b = bh >> 2, h = bh & 3, s0 = 32 * c_lane;
        const float* lf = (const float*)(F.ws + WS_LF) + ((size_t)b * SEQ + s0) * 4 + h;
        float loc[32]; float run = 0.f;
#pragma unroll
        for (int i = 0; i < 32; ++i) { run += lf[4 * i]; loc[i] = run; }
        float incl = run;
#pragma unroll
        for (int o = 1; o < 64; o <<= 1) { const float t = __shfl_up(incl, o); if (c_lane >= o) incl += t; }
        const float excl = incl - run;
        float* cc = (float*)(F.ws + WS_CC) + (size_t)bh * SEQ + s0;
#pragma unroll
        for (int i = 0; i < 32; ++i) cc[i] = excl + loc[i];
    }
}

namespace att {
typedef float f32x16 __attribute__((ext_vector_type(16)));
typedef short bf16x8 __attribute__((ext_vector_type(8)));
typedef short s16x4 __attribute__((ext_vector_type(4)));
typedef short v4i16_t __attribute__((ext_vector_type(4)));
constexpr int KBUF = 0, VBUF = 16384, KB_OFF = 32768, ATT_LDS = 32768 + 8192;
constexpr float C2 = 0.125f * 1.4426950408889634f;
__device__ __forceinline__ int crow(int r, int hi) { return (r & 3) + 8 * (r >> 2) + 4 * hi; }
__device__ __forceinline__ s16x4 vtr(const LAS char* p) { return __builtin_bit_cast(s16x4, __builtin_amdgcn_ds_read_tr16_b64_v4i16((LAS v4i16_t*)p)); }
template <bool CAUSAL>
__device__ __forceinline__ void attn_unit(LAS char* lds, const bf16* Qp, int qpitch, const bf16* Kp, const bf16* Vp, int kvpitch, int ntiles, int q0, const float* ccp, bf16* Op, int opitch, int tid) {
    const int lane = tid & 63, wid = __builtin_amdgcn_readfirstlane(tid >> 6), r32 = lane & 31, hi = lane >> 5;
    LAS float* kb = (LAS float*)(lds + KB_OFF);
    if (CAUSAL) { for (int k = tid; k < ntiles * 64; k += 512) kb[k] = -1.4426950408889634f * ccp[k]; }
    bf16x8 qr[4];
#pragma unroll
    for (int d0 = 0; d0 < 4; ++d0) qr[d0] = *(const bf16x8*)(Qp + (size_t)(32 * wid + r32) * qpitch + 16 * d0 + 8 * hi);
    const int kvr = tid >> 3, ch = tid & 7;
    const bf16* kg = Kp + (size_t)kvr * kvpitch + ch * 8; const bf16* vg = Vp + (size_t)kvr * kvpitch + ch * 8;
    const int kl = ch * 1024 + kvr * 16, vl = (ch >> 2) * 4096 + kvr * 64 + (ch & 3) * 16;
    v4u kreg = *(const v4u*)kg, vreg = *(const v4u*)vg;
    *(LAS v4u*)(lds + KBUF + kl) = kreg; *(LAS v4u*)(lds + VBUF + vl) = vreg;
    __syncthreads();
    float mrun = -1e30f, lrun = 0.f; f32x16 o0 = {}, o1 = {};
    const int qabs = q0 + 32 * wid + r32, qwmax = q0 + 32 * wid + 31;
    const int vrd = (4 * hi + ((lane & 15) >> 2)) * 64 + ((lane >> 4) & 1) * 32 + (lane & 3) * 8;
    for (int t = 0; t < ntiles; ++t) {
        const int buf = (t & 1) * 8192;
        if (t + 1 < ntiles) { kreg = *(const v4u*)(kg + (size_t)(t + 1) * 64 * kvpitch); vreg = *(const v4u*)(vg + (size_t)(t + 1) * 64 * kvpitch); }
        const int kv0 = 64 * t;
        if (!CAUSAL || kv0 <= qwmax) {
            const LAS char* Kb = lds + KBUF + buf; const LAS char* Vb = lds + VBUF + buf;
            f32x16 p0 = {}, p1 = {};
#pragma unroll
            for (int d0 = 0; d0 < 4; ++d0) { const bf16x8 a0 = *(const LAS bf16x8*)(Kb + (2 * d0 + hi) * 1024 + r32 * 16), a1 = *(const LAS bf16x8*)(Kb + (2 * d0 + hi) * 1024 + (32 + r32) * 16);
                p0 = __builtin_amdgcn_mfma_f32_32x32x16_bf16(a0, qr[d0], p0, 0, 0, 0); p1 = __builtin_amdgcn_mfma_f32_32x32x16_bf16(a1, qr[d0], p1, 0, 0, 0); }
            float mx = -1e30f;
#pragma unroll
            for (int g = 0; g < 4; ++g) { f32x4 b0 = {0.f, 0.f, 0.f, 0.f}, b1 = {0.f, 0.f, 0.f, 0.f};
                if (CAUSAL) { b0 = *(const LAS f32x4*)(kb + kv0 + 8 * g + 4 * hi); b1 = *(const LAS f32x4*)(kb + kv0 + 32 + 8 * g + 4 * hi); }
#pragma unroll
                for (int j = 0; j < 4; ++j) { const int r = 4 * g + j; float s0 = p0[r] * C2 + b0[j], s1 = p1[r] * C2 + b1[j];
                    if (CAUSAL) { const int kv = kv0 + 8 * g + 4 * hi + j; if (kv > qabs) s0 = -INFINITY; if (kv + 32 > qabs) s1 = -INFINITY; }
                    p0[r] = s0; p1[r] = s1; mx = fmaxf(mx, fmaxf(s0, s1)); } }
            mx = fmaxf(mx, __shfl_xor(mx, 32));
            const float mnew = fmaxf(mrun, mx), alpha = __builtin_amdgcn_exp2f(mrun - mnew); mrun = mnew;
            float rs = 0.f;
#pragma unroll
            for (int r = 0; r < 16; ++r) { p0[r] = __builtin_amdgcn_exp2f(p0[r] - mnew); p1[r] = __builtin_amdgcn_exp2f(p1[r] - mnew); rs += p0[r] + p1[r]; }
            lrun = lrun * alpha + rs;
#pragma unroll
            for (int r = 0; r < 16; ++r) { o0[r] *= alpha; o1[r] *= alpha; }
            bf16x8 pf[4];
#pragma unroll
            for (int s = 0; s < 2; ++s) { pg8::u32x4 w0, w1;
                w0.x = pg8::cvt_pk_bf16(p0[8 * s + 0], p0[8 * s + 1]); w0.y = pg8::cvt_pk_bf16(p0[8 * s + 2], p0[8 * s + 3]); w0.z = pg8::cvt_pk_bf16(p0[8 * s + 4], p0[8 * s + 5]); w0.w = pg8::cvt_pk_bf16(p0[8 * s + 6], p0[8 * s + 7]);
                w1.x = pg8::cvt_pk_bf16(p1[8 * s + 0], p1[8 * s + 1]); w1.y = pg8::cvt_pk_bf16(p1[8 * s + 2], p1[8 * s + 3]); w1.z = pg8::cvt_pk_bf16(p1[8 * s + 4], p1[8 * s + 5]); w1.w = pg8::cvt_pk_bf16(p1[8 * s + 6], p1[8 * s + 7]);
                pf[s] = __builtin_bit_cast(bf16x8, w0); pf[2 + s] = __builtin_bit_cast(bf16x8, w1); }
#pragma unroll
            for (int s = 0; s < 4; ++s) {
                const s16x4 l0 = vtr(Vb + vrd + s * 1024), h0 = vtr(Vb + vrd + s * 1024 + 512), l1 = vtr(Vb + 4096 + vrd + s * 1024), h1 = vtr(Vb + 4096 + vrd + s * 1024 + 512);
                const bf16x8 va = (bf16x8){l0[0], l0[1], l0[2], l0[3], h0[0], h0[1], h0[2], h0[3]}, vb = (bf16x8){l1[0], l1[1], l1[2], l1[3], h1[0], h1[1], h1[2], h1[3]};
                o0 = __builtin_amdgcn_mfma_f32_32x32x16_bf16(va, pf[s], o0, 0, 0, 0); o1 = __builtin_amdgcn_mfma_f32_32x32x16_bf16(vb, pf[s], o1, 0, 0, 0); }
        }
        if (t + 1 < ntiles) { *(LAS v4u*)(lds + KBUF + (buf ^ 8192) + kl) = kreg; *(LAS v4u*)(lds + VBUF + (buf ^ 8192) + vl) = vreg; }
        __syncthreads();
    }
    const float inv = 1.0f / (lrun + __shfl_xor(lrun, 32));
    bf16* orow = Op + (size_t)(32 * wid + r32) * opitch + 4 * hi;
#pragma unroll
    for (int g = 0; g < 4; ++g) { v2u w0, w1;
        w0.x = pg8::cvt_pk_bf16(o0[4 * g] * inv, o0[4 * g + 1] * inv); w0.y = pg8::cvt_pk_bf16(o0[4 * g + 2] * inv, o0[4 * g + 3] * inv);
        w1.x = pg8::cvt_pk_bf16(o1[4 * g] * inv, o1[4 * g + 1] * inv); w1.y = pg8::cvt_pk_bf16(o1[4 * g + 2] * inv, o1[4 * g + 3] * inv);
        *(v2u*)(orow + 8 * g) = w0; *(v2u*)(orow + 32 + 8 * g) = w1; }
}
}
__device__ __forceinline__ void attn_phase(Frame& F, int l) {
    int tid = F.tid; OPAQUE_V(tid);
    LAS char* lds = (LAS char*)(F.lds + RING_OFF);
    const bf16* proj = (const bf16*)(F.ws + WS_PROJ); const bf16* memkv = (const bf16*)(F.ws + WS_MEMKV); const float* cc = (const float*)(F.ws + WS_CC); bf16* br = (bf16*)(F.ws + WS_BR);
    for (int p = F.vcu; p < BATCH * NH * 4; p += F.G) { const int bh = p >> 2, pi = p & 3, b = bh >> 2, h = bh & 3;
        for (int k = 0; k < 2; ++k) { const int qb = k ? 7 - pi : pi, q0 = qb * 256; const size_t row0 = (size_t)b * SEQ;
            att::attn_unit<true>(lds, proj + (row0 + q0) * NPROJ + h * 64, NPROJ, proj + row0 * NPROJ + 256 + h * 64, proj + row0 * NPROJ + 512 + h * 64, NPROJ, q0 / 64 + 4, q0, cc + (size_t)bh * SEQ,
                                 br + (row0 + q0) * 1024 + h * 64, 1024, tid); } }
    for (int u = F.vcu; u < BATCH * NH * 8; u += F.G) { const int bh = u >> 3, qb = u & 7, b = bh >> 2, h = bh & 3, q0 = qb * 256; const size_t row0 = (size_t)b * SEQ;
        const bf16* kp = memkv + (size_t)b * NMEM * 1024 + l * 512 + h * 64;
        att::attn_unit<false>(lds, proj + (row0 + q0) * NPROJ + 2816 + h * 64, NPROJ, kp, kp + 256, 1024, NMEM / 64, q0, nullptr, br + (row0 + q0) * 1024 + 768 + h * 64, 1024, tid); }
}

namespace rec {
using att::f32x16; using att::bf16x8; using att::s16x4; using att::vtr;
constexpr int Q1C = 0, Q2C = 8192, K1C = 16384, K2V = 24576, VV = 32768, ST0 = 40960, ST1 = 49152, OFO = 57344, LFO = 74752, TOTO = 91136, BMO = 93184, BLO = 93440, DECO = 93696;
constexpr int OFP = 68;
__device__ __forceinline__ v2u pk4(float a, float b, float c, float d) { v2u w; w.x = pg8::cvt_pk_bf16(a, b); w.y = pg8::cvt_pk_bf16(c, d); return w; }
template <bool HG>
__device__ __forceinline__ void recur_unit(LAS char* lds, const bf16* pj, bf16* ob, int h, int l, const float* par, const float* rope, int tid) {
    const int lane = tid & 63, wid = __builtin_amdgcn_readfirstlane(tid >> 6), r32 = lane & 31, hi = lane >> 5;
    const int t = tid >> 3, c8 = tid & 7;
    constexpr int CQ = HG ? 2304 : 768, CK = HG ? 1792 : 1024, CV = HG ? 2048 : 1280, CG = HG ? 2560 : 1536;
    const float lg2 = HG ? 0.f : log2f(1.0f - exp2f(-5.0f - (float)h));
    float lbv[8];
#pragma unroll
    for (int e = 0; e < 8; ++e) { lbv[e] = 0.f; if (HG && l == 1) { const float a0 = par[PAR_LB + h * 64 + 8 * c8 + e], a1 = par[PAR_LB + 256 + h * 64 + 8 * c8 + e]; lbv[e] = 1.f / (1.f + expf(a0 - a1)); } }
    float ngv[8];
#pragma unroll
    for (int e = 0; e < 8; ++e) ngv[e] = HG ? par[PAR_NG + l * 64 + 8 * c8 + e] : 1.f;
    for (int i = tid; i < 4096; i += 512) ((LAS unsigned*)(lds + ST0))[i] = 0u;
    if (!HG && tid < 64) ((LAS float*)(lds + DECO))[tid] = exp2f(lg2 * 64.f);
    f32x16 st = {};
    v4u rq, rk, rv, rg; f32x4 rco = {0.f, 0.f, 0.f, 0.f}, rsi = {0.f, 0.f, 0.f, 0.f};
#define REC_LOAD(n) do { const bf16* rp_ = pj + (size_t)((n) * 64 + t) * NPROJ; \
        if (HG) { rq = *(const v4u*)(rp_ + CQ + 8 * c8); rk = *(const v4u*)(rp_ + CK + 8 * c8); } \
        else { const v2u a_ = *(const v2u*)(rp_ + CQ + 4 * c8), b_ = *(const v2u*)(rp_ + CQ + 32 + 4 * c8), c_ = *(const v2u*)(rp_ + CK + 4 * c8), d_ = *(const v2u*)(rp_ + CK + 32 + 4 * c8); \
               rq = (v4u){a_.x, a_.y, b_.x, b_.y}; rk = (v4u){c_.x, c_.y, d_.x, d_.y}; \
               rco = *(const f32x4*)(rope + ((n) * 64 + t) * 32 + 4 * c8); rsi = *(const f32x4*)(rope + SEQ * 32 + ((n) * 64 + t) * 32 + 4 * c8); } \
        rv = *(const v4u*)(rp_ + CV + 8 * c8); rg = *(const v4u*)(rp_ + CG + 8 * c8); } while (0)
    REC_LOAD(0);
    __syncthreads();
#pragma unroll 1
    for (int n = 0; n < SEQ / 64; ++n) {
        const v4u gcur = rg;
        if (!HG) {
            const float q1[4] = {bfl(rq.x), bfh(rq.x), bfl(rq.y), bfh(rq.y)}, q2[4] = {bfl(rq.z), bfh(rq.z), bfl(rq.w), bfh(rq.w)};
            const float k1[4] = {bfl(rk.x), bfh(rk.x), bfl(rk.y), bfh(rk.y)}, k2[4] = {bfl(rk.z), bfh(rk.z), bfl(rk.w), bfh(rk.w)};
            float qa[4], qb[4], ka[4], kb[4];
#pragma unroll
            for (int e = 0; e < 4; ++e) { qa[e] = q1[e] * rco[e] - q2[e] * rsi[e]; qb[e] = q1[e] * rsi[e] + q2[e] * rco[e]; ka[e] = (k1[e] * rco[e] - k2[e] * rsi[e]) * 0.125f; kb[e] = (k1[e] * rsi[e] + k2[e] * rco[e]) * 0.125f; }
            const float gq = exp2f(lg2 * (float)(t + 1)), gk = exp2f(lg2 * (float)(63 - t));
            const int ca = (c8 >> 1) * 1024 + t * 16 + 8 * (c8 & 1), cb = ca + 4096;
            *(LAS v2u*)(lds + Q1C + ca) = pk4(qa[0], qa[1], qa[2], qa[3]); *(LAS v2u*)(lds + Q1C + cb) = pk4(qb[0], qb[1], qb[2], qb[3]);
            *(LAS v2u*)(lds + Q2C + ca) = pk4(qa[0] * gq, qa[1] * gq, qa[2] * gq, qa[3] * gq); *(LAS v2u*)(lds + Q2C + cb) = pk4(qb[0] * gq, qb[1] * gq, qb[2] * gq, qb[3] * gq);
            *(LAS v2u*)(lds + K1C + ca) = pk4(ka[0], ka[1], ka[2], ka[3]); *(LAS v2u*)(lds + K1C + cb) = pk4(kb[0], kb[1], kb[2], kb[3]);
            const int va = t * 64 + 8 * c8;
            *(LAS v2u*)(lds + K2V + va) = pk4(ka[0] * gk, ka[1] * gk, ka[2] * gk, ka[3] * gk); *(LAS v2u*)(lds + K2V + 4096 + va) = pk4(kb[0] * gk, kb[1] * gk, kb[2] * gk, kb[3] * gk);
            *(LAS v4u*)(lds + VV + (c8 >> 2) * 4096 + t * 64 + (c8 & 3) * 16) = rv;
        } else {
            const float zf[8] = {bfl(rk.x), bfh(rk.x), bfl(rk.y), bfh(rk.y), bfl(rk.z), bfh(rk.z), bfl(rk.w), bfh(rk.w)};
            float kf[8], lf[8];
#pragma unroll
            for (int e = 0; e < 8; ++e) { const float ez = expf(-zf[e]); const float sg = 1.f / (1.f + ez); const float f = lbv[e] + (1.f - lbv[e]) * sg; lf[e] = logf(f); kf[e] = (1.f - lbv[e]) * (ez / (1.f + ez)); }
            LAS float* LF = (LAS float*)(lds + LFO);
            *(LAS f32x4*)(LF + t * 64 + 8 * c8) = (f32x4){lf[0], lf[1], lf[2], lf[3]}; *(LAS f32x4*)(LF + t * 64 + 8 * c8 + 4) = (f32x4){lf[4], lf[5], lf[6], lf[7]};
            __syncthreads();
            float loc[8]; { float run = 0.f;
#pragma unroll
                for (int tt = 0; tt < 8; ++tt) { run += LF[(8 * wid + tt) * 64 + lane]; loc[tt] = run; } }
            LAS float* TOT = (LAS float*)(lds + TOTO); TOT[wid * 64 + lane] = loc[7];
            __syncthreads();
            { float pre = 0.f;
#pragma unroll
              for (int w2 = 0; w2 < 7; ++w2) pre += (w2 < wid) ? TOT[w2 * 64 + lane] : 0.f;
#pragma unroll
              for (int tt = 0; tt < 8; ++tt) LF[(8 * wid + tt) * 64 + lane] = pre + loc[tt];
              if (wid == 3) ((LAS float*)(lds + BMO))[lane] = pre + loc[7];
              if (wid == 7) ((LAS float*)(lds + BLO))[lane] = pre + loc[7]; }
            __syncthreads();
            const f32x4 b0 = *(const LAS f32x4*)(LF + t * 64 + 8 * c8), b1 = *(const LAS f32x4*)(LF + t * 64 + 8 * c8 + 4);
            const f32x4 m0 = *(const LAS f32x4*)((LAS float*)(lds + BMO) + 8 * c8), m1 = *(const LAS f32x4*)((LAS float*)(lds + BMO) + 8 * c8 + 4);
            const f32x4 l0 = *(const LAS f32x4*)((LAS float*)(lds + BLO) + 8 * c8), l1 = *(const LAS f32x4*)((LAS float*)(lds + BLO) + 8 * c8 + 4);
            const float bb[8] = {b0[0], b0[1], b0[2], b0[3], b1[0], b1[1], b1[2], b1[3]}, bm[8] = {m0[0], m0[1], m0[2], m0[3], m1[0], m1[1], m1[2], m1[3]}, bl[8] = {l0[0], l0[1], l0[2], l0[3], l1[0], l1[1], l1[2], l1[3]};
            const float qv[8] = {bfl(rq.x), bfh(rq.x), bfl(rq.y), bfh(rq.y), bfl(rq.z), bfh(rq.z), bfl(rq.w), bfh(rq.w)};
            float A1[8], A2[8], B1[8], B2[8];
#pragma unroll
            for (int e = 0; e < 8; ++e) { A1[e] = qv[e] * expf(fminf(bb[e] - bm[e], 80.f)); A2[e] = qv[e] * expf(bb[e]); B1[e] = kf[e] * expf(fminf(bm[e] - bb[e], 80.f)); B2[e] = kf[e] * expf(bl[e] - bb[e]); }
            const int ca = c8 * 1024 + t * 16, va = (c8 >> 2) * 4096 + t * 64 + (c8 & 3) * 16;
#define PK8(x) (v4u){pg8::cvt_pk_bf16(x[0], x[1]), pg8::cvt_pk_bf16(x[2], x[3]), pg8::cvt_pk_bf16(x[4], x[5]), pg8::cvt_pk_bf16(x[6], x[7])}
            *(LAS v4u*)(lds + Q1C + ca) = PK8(A1); *(LAS v4u*)(lds + Q2C + ca) = PK8(A2); *(LAS v4u*)(lds + K1C + ca) = PK8(B1); *(LAS v4u*)(lds + K2V + va) = PK8(B2);
#undef PK8
            *(LAS v4u*)(lds + VV + va) = rv;
            if (t == 0) {
#pragma unroll
                for (int e = 0; e < 8; ++e) ((LAS float*)(lds + DECO))[8 * c8 + e] = expf(bl[e]); }
        }
        if (n + 1 < SEQ / 64) REC_LOAD(n + 1);
        __syncthreads();
        const int stc = (n & 1) ? ST1 : ST0, stn = (n & 1) ? ST0 : ST1;
        const int vrd = (4 * hi + ((lane & 15) >> 2)) * 64 + ((lane >> 4) & 1) * 32 + (lane & 3) * 8;
        if (wid < 4) {
            const int tv = wid >> 1, ti = wid & 1;
            bf16x8 pf[4];
#pragma unroll
            for (int tj = 0; tj < 2; ++tj) {
                f32x16 p = {};
                if (!HG || tj <= ti) {
#pragma unroll
                    for (int ks = 0; ks < 4; ++ks) { const bf16x8 a = *(const LAS bf16x8*)(lds + K1C + (2 * ks + hi) * 1024 + (32 * tj + r32) * 16), b = *(const LAS bf16x8*)(lds + Q1C + (2 * ks + hi) * 1024 + (32 * ti + r32) * 16);
                        p = __builtin_amdgcn_mfma_f32_32x32x16_bf16(a, b, p, 0, 0, 0); }
                    const int iabs = 32 * ti + r32;
#pragma unroll
                    for (int r = 0; r < 16; ++r) { const int jabs = 32 * tj + (r & 3) + 8 * (r >> 2) + 4 * hi;
                        if (HG) p[r] = (jabs <= iabs) ? p[r] : 0.f; else p[r] *= exp2f(lg2 * fabsf((float)(iabs - jabs))); }
                }
                pg8::u32x4 w0, w1;
                w0.x = pg8::cvt_pk_bf16(p[0], p[1]); w0.y = pg8::cvt_pk_bf16(p[2], p[3]); w0.z = pg8::cvt_pk_bf16(p[4], p[5]); w0.w = pg8::cvt_pk_bf16(p[6], p[7]);
                w1.x = pg8::cvt_pk_bf16(p[8], p[9]); w1.y = pg8::cvt_pk_bf16(p[10], p[11]); w1.z = pg8::cvt_pk_bf16(p[12], p[13]); w1.w = pg8::cvt_pk_bf16(p[14], p[15]);
                pf[2 * tj] = __builtin_bit_cast(bf16x8, w0); pf[2 * tj + 1] = __builtin_bit_cast(bf16x8, w1);
            }
            f32x16 o = {};
#pragma unroll
            for (int ks = 0; ks < 4; ++ks) { const bf16x8 a = *(const LAS bf16x8*)(lds + stc + (2 * ks + hi) * 1024 + (32 * tv + r32) * 16), b = *(const LAS bf16x8*)(lds + Q2C + (2 * ks + hi) * 1024 + (32 * ti + r32) * 16);
                o = __builtin_amdgcn_mfma_f32_32x32x16_bf16(a, b, o, 0, 0, 0); }
#pragma unroll
            for (int s2 = 0; s2 < 4; ++s2) { const s16x4 lo = vtr(lds + VV + tv * 4096 + vrd + s2 * 1024), hh = vtr(lds + VV + tv * 4096 + vrd + s2 * 1024 + 512);
                const bf16x8 va = (bf16x8){lo[0], lo[1], lo[2], lo[3], hh[0], hh[1], hh[2], hh[3]};
                o = __builtin_amdgcn_mfma_f32_32x32x16_bf16(va, pf[s2], o, 0, 0, 0); }
            LAS float* OFp = (LAS float*)(lds + OFO) + (32 * ti + r32) * OFP + 32 * tv + 4 * hi;
#pragma unroll
            for (int g = 0; g < 4; ++g) *(LAS f32x4*)(OFp + 8 * g) = (f32x4){o[4 * g], o[4 * g + 1], o[4 * g + 2], o[4 * g + 3]};
        } else {
            const int td = (wid - 4) & 1, tv = (wid - 4) >> 1;
            f32x16 pr = {};
#pragma unroll
            for (int s2 = 0; s2 < 4; ++s2) { const s16x4 lo = vtr(lds + VV + tv * 4096 + vrd + s2 * 1024), hh = vtr(lds + VV + tv * 4096 + vrd + s2 * 1024 + 512);
                const s16x4 ko = vtr(lds + K2V + td * 4096 + vrd + s2 * 1024), kh = vtr(lds + K2V + td * 4096 + vrd + s2 * 1024 + 512);
                const bf16x8 va = (bf16x8){lo[0], lo[1], lo[2], lo[3], hh[0], hh[1], hh[2], hh[3]}, kb2 = (bf16x8){ko[0], ko[1], ko[2], ko[3], kh[0], kh[1], kh[2], kh[3]};
                pr = __builtin_amdgcn_mfma_f32_32x32x16_bf16(va, kb2, pr, 0, 0, 0); }
            const float dec = ((LAS float*)(lds + DECO))[32 * td + r32];
            const int d = 32 * td + r32;
            LAS bf16* stw = (LAS bf16*)(lds + stn + (d >> 3) * 1024 + (d & 7) * 2);
#pragma unroll
            for (int r = 0; r < 16; ++r) { st[r] = st[r] * dec + pr[r]; const int v = 32 * tv + (r & 3) + 8 * (r >> 2) + 4 * hi; stw[v * 8] = (bf16)f2bf(st[r]); }
        }
        __syncthreads();
        { const LAS float* OFr = (const LAS float*)(lds + OFO) + t * OFP + 8 * c8;
          const f32x4 x0 = *(const LAS f32x4*)OFr, x1 = *(const LAS f32x4*)(OFr + 4);
          float ov[8] = {x0[0], x0[1], x0[2], x0[3], x1[0], x1[1], x1[2], x1[3]};
          float s1 = 0.f;
          if (!HG) {
#pragma unroll
              for (int e = 0; e < 8; ++e) s1 += ov[e];
              s1 += __shfl_xor(s1, 1); s1 += __shfl_xor(s1, 2); s1 += __shfl_xor(s1, 4);
              const float mean = s1 * (1.f / 64.f);
#pragma unroll
              for (int e = 0; e < 8; ++e) ov[e] -= mean; }
          float ss = 0.f;
#pragma unroll
          for (int e = 0; e < 8; ++e) ss += ov[e] * ov[e];
          ss += __shfl_xor(ss, 1); ss += __shfl_xor(ss, 2); ss += __shfl_xor(ss, 4);
          const float rr = rsqrtf(ss * (1.f / 64.f) + GN_EPS);
          const float gv[8] = {bfl(gcur.x), bfh(gcur.x), bfl(gcur.y), bfh(gcur.y), bfl(gcur.z), bfh(gcur.z), bfl(gcur.w), bfh(gcur.w)};
          float y[8];
#pragma unroll
          for (int e = 0; e < 8; ++e) y[e] = ov[e] * rr * ngv[e] * gv[e] / (1.f + expf(-gv[e]));
          *(v4u*)(ob + (size_t)(n * 64 + t) * 1024 + 8 * c8) = (v4u){pg8::cvt_pk_bf16(y[0], y[1]), pg8::cvt_pk_bf16(y[2], y[3]), pg8::cvt_pk_bf16(y[4], y[5]), pg8::cvt_pk_bf16(y[6], y[7])}; }
    }
    __syncthreads();
#undef REC_LOAD
}
}
__device__ __forceinline__ void recur_phase(Frame& F, int l) {
    int tid = F.tid; OPAQUE_V(tid);
    LAS char* lds = (LAS char*)(F.lds + RING_OFF);
    const bf16* proj = (const bf16*)(F.ws + WS_PROJ); bf16* br = (bf16*)(F.ws + WS_BR); const float* par = (const float*)(F.ws + WS_PAR); const float* rope = (const float*)(F.ws + WS_ROPE);
    for (int u = F.vcu; u < 2 * BATCH * NH; u += F.G) { const int bh = u & 127, b = bh >> 2, h = bh & 3; const size_t row0 = (size_t)b * SEQ;
        if (u < 128) rec::recur_unit<false>(lds, proj + row0 * NPROJ + h * 64, br + row0 * 1024 + 256 + h * 64, h, l, par, rope, tid);
        else rec::recur_unit<true>(lds, proj + row0 * NPROJ + h * 64, br + row0 * 1024 + 512 + h * 64, h, l, par, rope, tid); }
}

__device__ __forceinline__ void naive_attn(Frame& F, int l) {
    int tid_ = F.tid; OPAQUE_V(tid_); const int lane = tid_ & 63, wave_ = __builtin_amdgcn_readfirstlane(tid_ >> 6);
    const int gw = F.vcu * NWAVES + wave_, NGW = F.G * NWAVES;
    const bf16* proj = (const bf16*)(F.ws + WS_PROJ); const bf16* memkv = (const bf16*)(F.ws + WS_MEMKV);
    const float* cc = (const float*)(F.ws + WS_CC); bf16* br = (bf16*)(F.ws + WS_BR);
    constexpr int BHS = BATCH * NH * SEQ;
    for (int it = gw; it < 2 * BHS; it += NGW) {
        const bool is_mem = it >= BHS; const int r = is_mem ? it - BHS : it; const int bh = r / SEQ, s = r % SEQ, b = bh >> 2, h = bh & 3;
        const size_t tok = (size_t)b * SEQ + s;
        const bf16* qp = proj + tok * NPROJ + (is_mem ? 2816 : 0) + h * 64;
        float q[64];
#pragma unroll
        for (int c = 0; c < 8; ++c) { const v4u w = *(const v4u*)(qp + 8 * c); q[8 * c + 0] = bfl(w.x); q[8 * c + 1] = bfh(w.x); q[8 * c + 2] = bfl(w.y); q[8 * c + 3] = bfh(w.y); q[8 * c + 4] = bfl(w.z); q[8 * c + 5] = bfh(w.z); q[8 * c + 6] = bfl(w.w); q[8 * c + 7] = bfh(w.w); }
        const int nkeys = is_mem ? NMEM : s + 1;
        const bf16* kbase = is_mem ? memkv + (size_t)b * NMEM * 1024 + l * 512 + h * 64 : proj + (size_t)b * SEQ * NPROJ + 256 + h * 64;
        const size_t kpitch = is_mem ? 1024 : NPROJ; const int voff = 256;
        const float cq = is_mem ? 0.f : cc[(size_t)bh * SEQ + s];
        float mrun = -1e30f, lrun = 0.f; float o[64];
#pragma unroll
        for (int d = 0; d < 64; ++d) o[d] = 0.f;
        for (int k0 = 0; k0 < nkeys; k0 += 64) { const int kk = k0 + lane;
            if (kk < nkeys) { const bf16* kp = kbase + (size_t)kk * kpitch; float dot = 0.f;
#pragma unroll
                for (int c = 0; c < 8; ++c) { const v4u w = *(const v4u*)(kp + 8 * c);
                    dot += q[8 * c + 0] * bfl(w.x) + q[8 * c + 1] * bfh(w.x) + q[8 * c + 2] * bfl(w.y) + q[8 * c + 3] * bfh(w.y) + q[8 * c + 4] * bfl(w.z) + q[8 * c + 5] * bfh(w.z) + q[8 * c + 6] * bfl(w.w) + q[8 * c + 7] * bfh(w.w); }
                float sv = dot * 0.125f; if (!is_mem) sv += cq - cc[(size_t)bh * SEQ + kk];
                const float mn = fmaxf(mrun, sv), corr = expf(mrun - mn), p = expf(sv - mn); mrun = mn; lrun = lrun * corr + p;
                const bf16* vp = kp + voff;
#pragma unroll
                for (int c = 0; c < 8; ++c) { const v4u w = *(const v4u*)(vp + 8 * c);
                    o[8 * c + 0] = o[8 * c + 0] * corr + p * bfl(w.x); o[8 * c + 1] = o[8 * c + 1] * corr + p * bfh(w.x); o[8 * c + 2] = o[8 * c + 2] * corr + p * bfl(w.y); o[8 * c + 3] = o[8 * c + 3] * corr + p * bfh(w.y);
                    o[8 * c + 4] = o[8 * c + 4] * corr + p * bfl(w.z); o[8 * c + 5] = o[8 * c + 5] * corr + p * bfh(w.z); o[8 * c + 6] = o[8 * c + 6] * corr + p * bfl(w.w); o[8 * c + 7] = o[8 * c + 7] * corr + p * bfh(w.w); } } }
        const float M = wave_max(mrun), sc = expf(mrun - M), L = wave_sum(lrun * sc);
        float res = 0.f;
#pragma unroll
        for (int d = 0; d < 64; ++d) { const float v = wave_sum(o[d] * sc); if (lane == d) res = v; }
        br[tok * 1024 + (is_mem ? 768 : 0) + h * 64 + lane] = (bf16)f2bf(res / L);
    }
}
__device__ __forceinline__ void naive_recur(Frame& F, int l) {
    int tid = F.tid; OPAQUE_V(tid); const int lane = tid & 63, wave = __builtin_amdgcn_readfirstlane(tid >> 6);
    const bf16* proj = (const bf16*)(F.ws + WS_PROJ); bf16* br = (bf16*)(F.ws + WS_BR);
    LAS float* L0 = (LAS float*)(F.lds + RING_OFF);
    if (F.bx < 128) {
        const int bh = F.bx, b = bh >> 2, h = bh & 3;
        LAS float* qr = L0; LAS float* kr = L0 + 4096; LAS float* vv = L0 + 8192; LAS float* sc = L0 + 12288; LAS float* st = L0 + 16384;
        const float* rc = (const float*)(F.ws + WS_ROPE); const float* rs = rc + SEQ * 32;
        const float lg = log1pf(-exp2f(-5.0f - (float)h));
        for (int i = tid; i < 4096; i += 512) st[i] = 0.f;
#pragma unroll 1
        for (int n = 0; n < SEQ / 64; ++n) {
            const size_t row0 = (size_t)b * SEQ + n * 64;
            for (int idx = tid; idx < 2048; idx += 512) { const int t = idx >> 5, c = idx & 31; const bf16* p = proj + (row0 + t) * NPROJ + h * 64;
                const float co = rc[(n * 64 + t) * 32 + c], si = rs[(n * 64 + t) * 32 + c];
                const float q1 = bf1(p[768 + c]), q2 = bf1(p[768 + c + 32]), k1 = bf1(p[1024 + c]), k2 = bf1(p[1024 + c + 32]);
                qr[t * 64 + c] = q1 * co - q2 * si; qr[t * 64 + c + 32] = q1 * si + q2 * co;
                kr[t * 64 + c] = (k1 * co - k2 * si) * 0.125f; kr[t * 64 + c + 32] = (k1 * si + k2 * co) * 0.125f;
                vv[t * 64 + c] = bf1(p[1280 + c]); vv[t * 64 + c + 32] = bf1(p[1280 + c + 32]); }
            __syncthreads();
#pragma unroll 1
            for (int j = 0; j < 8; ++j) { const int idx = tid + 512 * j, i = idx >> 6, jj = idx & 63; float s = 0.f;
#pragma unroll 4
                for (int d = 0; d < 64; ++d) s += qr[i * 64 + d] * kr[jj * 64 + d];
                sc[idx] = s * expf(lg * fabsf((float)(i - jj))); }
            __syncthreads();
            float oreg[8];
#pragma unroll
            for (int j = 0; j < 8; ++j) { const int idx = tid + 512 * j, i = idx >> 6, v = idx & 63; float s = 0.f, s2 = 0.f;
#pragma unroll 4
                for (int jj = 0; jj < 64; ++jj) s += sc[i * 64 + jj] * vv[jj * 64 + v];
#pragma unroll 4
                for (int d = 0; d < 64; ++d) s2 += qr[i * 64 + d] * st[d * 64 + v];
                oreg[j] = s + expf(lg * (float)(i + 1)) * s2; }
            __syncthreads();
#pragma unroll 1
            for (int j = 0; j < 8; ++j) { const int idx = tid + 512 * j, d = idx >> 6, v = idx & 63; float s = 0.f;
#pragma unroll 2
                for (int jj = 0; jj < 64; ++jj) s += kr[jj * 64 + d] * expf(lg * (float)(63 - jj)) * vv[jj * 64 + v];
                st[idx] = expf(lg * 64.0f) * st[idx] + s; }
            for (int j = 0; j < 8; ++j) { const int i = wave + 8 * j;
                const float mean = wave_sum(oreg[j]) * (1.f / 64.f), dv = oreg[j] - mean, var = wave_sum(dv * dv) * (1.f / 64.f);
                const float g = bf1(proj[(row0 + i) * NPROJ + 1536 + h * 64 + lane]);
                br[(row0 + i) * 1024 + 256 + h * 64 + lane] = (bf16)f2bf(dv * rsqrtf(var + GN_EPS) * g / (1.f + expf(-g))); }
            __syncthreads();
        }
    } else {
        const int bh = F.bx - 128, b = bh >> 2, h = bh & 3;
        if (bh >= 128) return;
        LAS float* qf = L0; LAS float* ff = L0 + 4096; LAS float* kf = L0 + 8192; LAS float* iv = L0 + 12288; LAS float* ob = L0 + 16384;
        const int v = tid >> 3, k8 = tid & 7;
        float Sreg[8];
#pragma unroll
        for (int i = 0; i < 8; ++i) Sreg[i] = 0.f;
        const float* lbp = (const float*)(F.ws + WS_PAR) + PAR_LB;
#pragma unroll 1
        for (int n = 0; n < SEQ / 64; ++n) {
            const size_t row0 = (size_t)b * SEQ + n * 64;
            for (int j = 0; j < 8; ++j) { const int idx = tid + 512 * j, t = idx >> 6, c = idx & 63; const bf16* p = proj + (row0 + t) * NPROJ + h * 64 + c;
                float lb = 0.f; if (l == 1) { const float a0 = lbp[h * 64 + c], a1 = lbp[256 + h * 64 + c]; lb = 1.f / (1.f + expf(a0 - a1)); }
                const float zf = bf1(p[1792]); const float kfv = (1.f - lb) / (1.f + expf(zf));
                qf[idx] = bf1(p[2304]); ff[idx] = 1.f - kfv; kf[idx] = kfv; iv[idx] = bf1(p[2048]); }
            __syncthreads();
#pragma unroll 1
            for (int t = 0; t < 64; ++t) { const float ivt = iv[t * 64 + v]; float p = 0.f;
#pragma unroll
                for (int i = 0; i < 8; ++i) { const int k = k8 * 8 + i; Sreg[i] = ff[t * 64 + k] * Sreg[i] + kf[t * 64 + k] * ivt; p += Sreg[i] * qf[t * 64 + k]; }
                p += __shfl_xor(p, 1); p += __shfl_xor(p, 2); p += __shfl_xor(p, 4);
                if (k8 == 0) ob[t * 64 + v] = p; }
            __syncthreads();
            { const int t = tid >> 3, seg = tid & 7; float ov[8]; float ss = 0.f;
#pragma unroll
              for (int i = 0; i < 8; ++i) { ov[i] = ob[t * 64 + seg * 8 + i]; ss += ov[i] * ov[i]; }
              ss += __shfl_xor(ss, 1); ss += __shfl_xor(ss, 2); ss += __shfl_xor(ss, 4);
              const float rr = rsqrtf(ss * (1.f / 64.f) + GN_EPS);
              const bf16* gp = proj + (row0 + t) * NPROJ + 2560 + h * 64 + seg * 8; const float* ng = (const float*)(F.ws + WS_PAR) + PAR_NG + l * 64 + seg * 8;
              unsigned w[4];
#pragma unroll
              for (int i = 0; i < 4; ++i) { const float g0 = bf1(gp[2 * i]), g1 = bf1(gp[2 * i + 1]);
                  w[i] = pk2(ov[2 * i] * rr * ng[2 * i] * g0 / (1.f + expf(-g0)), ov[2 * i + 1] * rr * ng[2 * i + 1] * g1 / (1.f + expf(-g1))); }
              *(v4u*)(br + (row0 + t) * 1024 + 512 + h * 64 + seg * 8) = (v4u){w[0], w[1], w[2], w[3]}; }
            __syncthreads();
        }
    }
}

__device__ __forceinline__ void ln1_phase(Frame& F, int l, bool commit = true) {
    LAS float* WrT = (LAS float*)(F.lds + RING_OFF);
    LAS int* se1 = (LAS int*)(F.lds + RING_OFF + 65536); LAS int* se2 = se1 + 256; LAS float* sw = (LAS float*)(se2 + 256);
    LAS int* hist = (LAS int*)(F.lds + SM_OFF + 256); LAS int* base = hist + 16;
    int tid = F.tid; OPAQUE_V(tid); const int lane = tid & 63, wave = __builtin_amdgcn_readfirstlane(tid >> 6);
    for (int idx = tid; idx < 16384; idx += 512) { const int d = idx >> 4, e = idx & 15; WrT[e * 1024 + d] = ((const float*)(F.ws + WS_PAR))[PAR_WR + idx]; }
    if (tid < 16) hist[tid] = 0;
    __syncthreads();
    const bf16* xb = (const bf16*)(F.ws + WS_XB); const bf16* yb = (const bf16*)(F.ws + WS_Y); bf16* x1b = (bf16*)(F.ws + WS_X1B);
    const float* lng = (const float*)(F.ws + WS_PAR) + PAR_LNG + (l * 2 + 0) * DM; const float* lnb = (const float*)(F.ws + WS_PAR) + PAR_LNB + (l * 2 + 0) * DM;
    f32x4 gg[4], bb[4];
#pragma unroll
    for (int j = 0; j < 4; ++j) { gg[j] = *(const f32x4*)(lng + 256 * j + 4 * lane); bb[j] = *(const f32x4*)(lnb + 256 * j + 4 * lane); }
    for (int rb = F.bx; rb < T / 256; rb += F.G) {
        for (int i = 0; i < 32; ++i) { const int rl = wave * 32 + i; const size_t row = (size_t)rb * 256 + rl;
            f32x4 xv[4], yv[4]; load_row_bf16(xb + row * DM, lane, xv); load_row_bf16(yb + row * DM, lane, yv);
            float s = 0.f;
#pragma unroll
            for (int j = 0; j < 4; ++j) { xv[j] = xv[j] * ALPHA + yv[j]; s += (xv[j].x + xv[j].y) + (xv[j].z + xv[j].w); }
            const float mean = wave_sum(s) * (1.f / DM); float s2 = 0.f;
#pragma unroll
            for (int j = 0; j < 4; ++j) { xv[j] = xv[j] - mean; s2 += (xv[j].x * xv[j].x + xv[j].y * xv[j].y) + (xv[j].z * xv[j].z + xv[j].w * xv[j].w); }
            const float rstd = 1.f / sqrtf(wave_sum(s2) * (1.f / DM) + LN_EPS);
#pragma unroll
            for (int j = 0; j < 4; ++j) xv[j] = xv[j] * rstd * gg[j] + bb[j];
            store_row_bf16(x1b + row * DM, lane, xv);
            float lg[16];
#pragma unroll
            for (int e = 0; e < 16; ++e) { float p = 0.f;
#pragma unroll
                for (int j = 0; j < 4; ++j) { const f32x4 w = *(const LAS f32x4*)(WrT + e * 1024 + 256 * j + 4 * lane); p += (xv[j].x * w.x + xv[j].y * w.y) + (xv[j].z * w.z + xv[j].w * w.w); }
                lg[e] = wave_sum(p) + ((const float*)(F.ws + WS_PAR))[PAR_BR + e]; }
            float gm[4];
#pragma unroll
            for (int g = 0; g < 4; ++g) gm[g] = fmaxf(fmaxf(lg[4 * g], lg[4 * g + 1]), fmaxf(lg[4 * g + 2], lg[4 * g + 3]));
            int gs = 0; float gb = gm[0];
#pragma unroll
            for (int g = 1; g < 4; ++g) if (gm[g] > gb) { gb = gm[g]; gs = g; }
            float v0 = gs == 0 ? lg[0] : gs == 1 ? lg[4] : gs == 2 ? lg[8] : lg[12], v1 = gs == 0 ? lg[1] : gs == 1 ? lg[5] : gs == 2 ? lg[9] : lg[13];
            float v2 = gs == 0 ? lg[2] : gs == 1 ? lg[6] : gs == 2 ? lg[10] : lg[14], v3 = gs == 0 ? lg[3] : gs == 1 ? lg[7] : gs == 2 ? lg[11] : lg[15];
            int i1 = 0; float m1 = v0; if (v1 > m1) { m1 = v1; i1 = 1; } if (v2 > m1) { m1 = v2; i1 = 2; } if (v3 > m1) { m1 = v3; i1 = 3; }
            int i2 = -1; float m2 = -3.0e38f;
            if (i1 != 0 && v0 > m2) { m2 = v0; i2 = 0; } if (i1 != 1 && v1 > m2) { m2 = v1; i2 = 1; } if (i1 != 2 && v2 > m2) { m2 = v2; i2 = 2; } if (i1 != 3 && v3 > m2) { m2 = v3; i2 = 3; }
            if (lane == 0) { const int e1 = gs * 4 + i1, e2 = gs * 4 + i2;
                const int r1 = __hip_atomic_fetch_add(hist + e1, 1, __ATOMIC_RELAXED, __HIP_MEMORY_SCOPE_WORKGROUP), r2 = __hip_atomic_fetch_add(hist + e2, 1, __ATOMIC_RELAXED, __HIP_MEMORY_SCOPE_WORKGROUP);
                se1[rl] = e1 | (r1 << 8); se2[rl] = e2 | (r2 << 8); sw[rl] = 1.f / (1.f + expf(m2 - m1)); }
        }
        __syncthreads();
        if (tid < 16 && commit) { base[tid] = (int)__hip_atomic_fetch_add((unsigned*)(F.ctl + CW_CNT + (l * 16 + tid) * 64), (unsigned)hist[tid], RLX_AGENT); }
        __syncthreads();
        if (commit) { const int rl = tid >> 1, k = tid & 1; const int v = k ? se2[rl] : se1[rl]; const int e = v & 255, r = v >> 8; const int slot = (rb * 256 + rl) * 2 + k;
          ((int*)(F.ws + WS_LIST))[(size_t)e * LISTCAP + base[e] + r] = slot; ((float*)(F.ws + WS_WT))[slot] = k ? 1.f - sw[rl] : sw[rl]; }
        __syncthreads();
        if (tid < 16) hist[tid] = 0;
        __syncthreads();
    }
}

__device__ __forceinline__ void ln2_phase(Frame& F, int l) {
    LAS float* wff = (LAS float*)(F.lds + RING_OFF + 81920);
    int tid_ = F.tid; OPAQUE_V(tid_); const int lane = tid_ & 63, wave_ = __builtin_amdgcn_readfirstlane(tid_ >> 6); const bool last = (l == NLAYER - 1);
    if (!last) { stage_wff(F, l + 1, wff); }
    __syncthreads();
    const int gw = F.vcu * NWAVES + wave_, NGW = F.G * NWAVES;
    const bf16* x1b = (const bf16*)(F.ws + WS_X1B); const bf16* y2 = (const bf16*)(F.ws + WS_Y2); bf16* xb = (bf16*)(F.ws + WS_XB);
    const float* lng = (const float*)(F.ws + WS_PAR) + PAR_LNG + (l * 2 + 1) * DM; const float* lnb = (const float*)(F.ws + WS_PAR) + PAR_LNB + (l * 2 + 1) * DM;
    f32x4 gg[4], bb[4];
#pragma unroll
    for (int j = 0; j < 4; ++j) { gg[j] = *(const f32x4*)(lng + 256 * j + 4 * lane); bb[j] = *(const f32x4*)(lnb + 256 * j + 4 * lane); }
    for (int m = gw; m < T; m += NGW) {
        f32x4 xv[4], ya[4], yb[4]; load_row_bf16(x1b + (size_t)m * DM, lane, xv); load_row_bf16(y2 + (size_t)(2 * m) * DM, lane, ya); load_row_bf16(y2 + (size_t)(2 * m + 1) * DM, lane, yb);
        float s = 0.f;
#pragma unroll
        for (int j = 0; j < 4; ++j) { xv[j] = xv[j] * ALPHA + (ya[j] + yb[j]); s += (xv[j].x + xv[j].y) + (xv[j].z + xv[j].w); }
        const float mean = wave_sum(s) * (1.f / DM); float s2 = 0.f;
#pragma unroll
        for (int j = 0; j < 4; ++j) { xv[j] = xv[j] - mean; s2 += (xv[j].x * xv[j].x + xv[j].y * xv[j].y) + (xv[j].z * xv[j].z + xv[j].w * xv[j].w); }
        const float rstd = 1.f / sqrtf(wave_sum(s2) * (1.f / DM) + LN_EPS);
#pragma unroll
        for (int j = 0; j < 4; ++j) xv[j] = xv[j] * rstd * gg[j] + bb[j];
        if (last) { GAS f32x4* o = (GAS f32x4*)(F.out + (size_t)m * DM) + lane;
#pragma unroll
            for (int j = 0; j < 4; ++j) o[64 * j] = xv[j]; }
        else { store_row_bf16(xb + (size_t)m * DM, lane, xv); forget_row(xv, wff, (float*)(F.ws + WS_LF) + (size_t)m * 4, lane); }
    }
}

__device__ __forceinline__ int moe_tables(Frame& F, int l) {
    LAS int* tb = (LAS int*)(F.lds + SM_OFF); LAS int* cn = tb + 32;
    LAS int* gtab = (LAS int*)(F.lds + GT_OFF); LAS float* wtab = (LAS float*)(F.lds + WTB_OFF);
    if (F.tid < 16) cn[F.tid] = (int)__hip_atomic_load((unsigned*)(F.ctl + CW_CNT + (l * 16 + F.tid) * 64), RLX_AGENT);
    __syncthreads();
    if (F.tid == 0) { int a = 0; for (int e = 0; e < 16; ++e) { tb[e] = a; a += (cn[e] + 255) >> 8; } tb[16] = a; }
    __syncthreads();
    const int ntiles = tb[16];
    const int* list = (const int*)(F.ws + WS_LIST); const float* wt = (const float*)(F.ws + WS_WT);
    for (int i = 0; i < MAXU; ++i) { const long L = (long)i * F.G + F.vcu; if (L >= (long)ntiles * 4) break; const int pm = (int)(L >> 2);
        if (F.tid < 256) { int e = 0;
#pragma unroll
            for (int k = 1; k < 16; ++k) e += (pm >= tb[k]) ? 1 : 0;
            const int p = (pm - tb[e]) * 256 + F.tid; int v = -1; float w = 0.f;
            if (p < cn[e]) { v = list[(size_t)e * LISTCAP + p]; w = wt[v]; }
            gtab[i * 256 + F.tid] = v; wtab[i * 256 + F.tid] = w; } }
    __syncthreads();
    return ntiles;
}

#define GRID_BAR() do { XcdBarrier bb_ = bar; asm volatile("" : "+s"(bb_.bar), "+s"(bb_.x)); xcd_barrier(bb_); } while (0)
template <int l> __device__ __forceinline__ void layer_body(const Frame& F0, const XcdBarrier& bar) {
        Frame F = F0; asm volatile("" : "+s"(F.ws), "+s"(F.vcu), "+s"(F.bx), "+s"(F.G), "+v"(F.tid));
        unsigned char* ws = F.ws; const pg8::bf16_t* xb = (const pg8::bf16_t*)(ws + WS_XB);
        const unsigned char* wl = ws + WS_W + (size_t)l * W_LAYER;
#ifndef SKIP_CC
        cc_scan(F);
#endif
#ifdef DUP_GA
        { pg8::Gemm g{xb, (const pg8::bf16_t*)(wl + W_IN), DM, DM, DM}; pg8::StaticOrder S; S.init(T, NPROJ, F.G, F.bx);
          pg8::EpiBf16 E{(pg8::bf16_t*)(ws + WS_PROJ), NPROJ, (const float*)(ws + WS_BIASP) + l * NPROJ};
          pg8::gemm_phase<pg8::EpiBf16, pg8::StaticOrder, true, false>(F.lds + RING_OFF, g, S, E); }
#endif
#ifndef SKIP_GA
        { pg8::Gemm g{xb, (const pg8::bf16_t*)(wl + W_IN), DM, DM, DM}; pg8::StaticOrder S; S.init(T, NPROJ, F.G, F.bx);
          pg8::EpiBf16 E{(pg8::bf16_t*)(ws + WS_PROJ), NPROJ, (const float*)(ws + WS_BIASP) + l * NPROJ};
          pg8::gemm_phase<pg8::EpiBf16, pg8::StaticOrder, true, false>(F.lds + RING_OFF, g, S, E); }
#endif
#ifndef SKIP_GM
        if (l == 0) { pg8::Gemm g{(const pg8::bf16_t*)(ws + WS_MEMB), (const pg8::bf16_t*)(ws + WS_WMEM), DM, DM, DM}; pg8::StaticOrder S; S.init(MEMROWS, 1024, F.G, F.bx);
          pg8::EpiBf16 E{(pg8::bf16_t*)(ws + WS_MEMKV), 1024, nullptr};
          pg8::gemm_phase<pg8::EpiBf16, pg8::StaticOrder, true, false>(F.lds + RING_OFF, g, S, E); }
#endif
        GRID_BAR();
#ifdef NAIVE_RECUR
        naive_recur(F, l);
#else
        recur_phase(F, l);
#ifdef DUP_RECUR
        recur_phase(F, l);
#endif
#endif
#ifdef NAIVE_ATTN
        naive_attn(F, l);
#else
        attn_phase(F, l);
#ifdef DUP_ATTN
        attn_phase(F, l);
#endif
#endif
        GRID_BAR();
#ifdef DUP_GC
        { pg8::Gemm g{(const pg8::bf16_t*)(ws + WS_BR), (const pg8::bf16_t*)(wl + W_B), DM, 256, 256}; pg8::StaticOrder S; S.init(T, 4096, F.G, F.bx, 4, 256);
          pg8::EpiBf16 E{(pg8::bf16_t*)(ws + WS_U), 4096, nullptr};
          pg8::gemm_phase<pg8::EpiBf16, pg8::StaticOrder, true, false>(F.lds + RING_OFF, g, S, E); }
#endif
#ifndef SKIP_GC
        { pg8::Gemm g{(const pg8::bf16_t*)(ws + WS_BR), (const pg8::bf16_t*)(wl + W_B), DM, 256, 256}; pg8::StaticOrder S; S.init(T, 4096, F.G, F.bx, 4, 256);
          pg8::EpiBf16 E{(pg8::bf16_t*)(ws + WS_U), 4096, nullptr};
          pg8::gemm_phase<pg8::EpiBf16, pg8::StaticOrder, true, false>(F.lds + RING_OFF, g, S, E); }
#endif
        GRID_BAR();
#ifdef DUP_GD
        { pg8::Gemm g{xb, (const pg8::bf16_t*)(wl + W_G), DM, DM, DM}; pg8::StaticOrder S; S.init(T, NGATE, F.G, F.bx);
          pg8::EpiGateMix E{(const pg8::bf16_t*)(ws + WS_U), (pg8::bf16_t*)(ws + WS_MIX), (const float*)(ws + WS_BIASG) + l * NGATE};
          pg8::gemm_phase<pg8::EpiGateMix, pg8::StaticOrder, true, false>(F.lds + RING_OFF, g, S, E); }
#endif
#ifndef SKIP_GD
        { pg8::Gemm g{xb, (const pg8::bf16_t*)(wl + W_G), DM, DM, DM}; pg8::StaticOrder S; S.init(T, NGATE, F.G, F.bx);
          pg8::EpiGateMix E{(const pg8::bf16_t*)(ws + WS_U), (pg8::bf16_t*)(ws + WS_MIX), (const float*)(ws + WS_BIASG) + l * NGATE};
          pg8::gemm_phase<pg8::EpiGateMix, pg8::StaticOrder, true, false>(F.lds + RING_OFF, g, S, E); }
#endif
        GRID_BAR();
#ifdef DUP_GE
        { pg8::Gemm g{(const pg8::bf16_t*)(ws + WS_MIX), (const pg8::bf16_t*)(wl + W_OUT), DM, DM, DM}; pg8::StaticOrder S; S.init(T, DM, F.G, F.bx);
          pg8::EpiBf16 E{(pg8::bf16_t*)(ws + WS_Y), DM, nullptr};
          pg8::gemm_phase<pg8::EpiBf16, pg8::StaticOrder, true, false>(F.lds + RING_OFF, g, S, E); }
#endif
#ifndef SKIP_GE
        { pg8::Gemm g{(const pg8::bf16_t*)(ws + WS_MIX), (const pg8::bf16_t*)(wl + W_OUT), DM, DM, DM}; pg8::StaticOrder S; S.init(T, DM, F.G, F.bx);
          pg8::EpiBf16 E{(pg8::bf16_t*)(ws + WS_Y), DM, nullptr};
          pg8::gemm_phase<pg8::EpiBf16, pg8::StaticOrder, true, false>(F.lds + RING_OFF, g, S, E); }
#endif
        GRID_BAR();
#ifdef DUP_LN1
        ln1_phase(F, l, false); __syncthreads();
#endif
#ifndef SKIP_LN1
        ln1_phase(F, l);
#endif
        GRID_BAR();
        const int ntiles = moe_tables(F, l);
#ifdef DUP_GG
        { pg8::Gemm g{(const pg8::bf16_t*)(ws + WS_X1B), (const pg8::bf16_t*)(wl + W_E1), DM, DM, DM};
          pg8::MoeOrder S{F.G, F.vcu, 4, ntiles, (const LAS int*)(F.lds + SM_OFF), (const LAS int*)(F.lds + GT_OFF), (size_t)1024 * 1024, true};
          pg8::EpiMoe1 E{(pg8::bf16_t*)(ws + WS_ACT)};
          pg8::gemm_phase<pg8::EpiMoe1, pg8::MoeOrder, true, true>(F.lds + RING_OFF, g, S, E); }
#endif
#ifndef SKIP_GG
        { pg8::Gemm g{(const pg8::bf16_t*)(ws + WS_X1B), (const pg8::bf16_t*)(wl + W_E1), DM, DM, DM};
          pg8::MoeOrder S{F.G, F.vcu, 4, ntiles, (const LAS int*)(F.lds + SM_OFF), (const LAS int*)(F.lds + GT_OFF), (size_t)1024 * 1024, true};
          pg8::EpiMoe1 E{(pg8::bf16_t*)(ws + WS_ACT)};
          pg8::gemm_phase<pg8::EpiMoe1, pg8::MoeOrder, true, true>(F.lds + RING_OFF, g, S, E); }
#endif
        GRID_BAR();
#ifdef DUP_GH
        { pg8::Gemm g{(const pg8::bf16_t*)(ws + WS_ACT), (const pg8::bf16_t*)(wl + W_E2), DE, DE, DE};
          pg8::MoeOrder S{F.G, F.vcu, 4, ntiles, (const LAS int*)(F.lds + SM_OFF), (const LAS int*)(F.lds + GT_OFF), (size_t)1024 * 512, false};
          pg8::EpiMoe2 E{(pg8::bf16_t*)(ws + WS_Y2), (const LAS int*)(F.lds + GT_OFF), (const LAS float*)(F.lds + WTB_OFF)};
          pg8::gemm_phase<pg8::EpiMoe2, pg8::MoeOrder, true, false>(F.lds + RING_OFF, g, S, E); }
#endif
#ifndef SKIP_GH
        { pg8::Gemm g{(const pg8::bf16_t*)(ws + WS_ACT), (const pg8::bf16_t*)(wl + W_E2), DE, DE, DE};
          pg8::MoeOrder S{F.G, F.vcu, 4, ntiles, (const LAS int*)(F.lds + SM_OFF), (const LAS int*)(F.lds + GT_OFF), (size_t)1024 * 512, false};
          pg8::EpiMoe2 E{(pg8::bf16_t*)(ws + WS_Y2), (const LAS int*)(F.lds + GT_OFF), (const LAS float*)(F.lds + WTB_OFF)};
          pg8::gemm_phase<pg8::EpiMoe2, pg8::MoeOrder, true, false>(F.lds + RING_OFF, g, S, E); }
#endif
        GRID_BAR();
#ifdef DUP_LN2
        ln2_phase(F, l); __syncthreads();
#endif
#ifndef SKIP_LN2
        ln2_phase(F, l);
#endif
        if (l + 1 < NLAYER) GRID_BAR();
}

__global__ void __launch_bounds__(NWAVES * 64, 2) fwd_kernel(Args args) {
    extern __shared__ __attribute__((aligned(16))) unsigned char lds[];
    Frame F0;
    F0.lds = (LAS unsigned char*)lds;
    F0.MISC = (volatile LAS unsigned*)(F0.lds + MISC_OFF);
    F0.tid = threadIdx.x;
    F0.G = gridDim.x; F0.bx = blockIdx.x; { const int bx = blockIdx.x; F0.vcu = (F0.G % 8 == 0) ? (bx % 8) * (F0.G / 8) + bx / 8 : bx; }
    F0.ws = args.ws; F0.out = args.out; F0.ctl = (gu32*)(args.ws + WS_CTL);
    for (int u = F0.tid; u < (LDS_BYTES - LDSCTL_OFF) / 4; u += NWAVES * 64) ((LAS unsigned*)(F0.lds + LDSCTL_OFF))[u] = 0u;
    __syncthreads();
    XcdBarrier bar = xcd_barrier_post((unsigned*)(F0.ctl + CW_BAR), F0.MISC + 8);

#ifdef DUP_P0
    p0_prologue(F0, args); __syncthreads();
#endif
#ifndef SKIP_P0
    p0_prologue(F0, args);
#endif
    GRID_BAR();

    layer_body<0>(F0, bar);
    layer_body<1>(F0, bar);
}

extern "C" void kernel_launch(void* const* d_in, const int* in_sizes, int n_in, void* d_out, int out_size, void* d_ws, size_t ws_size, hipStream_t stream) {
    static int grid = 0;
    if (grid == 0) {
        if (n_in != 15 || in_sizes[0] != T * DM || out_size != T * DM || ws_size < WS_END) { fprintf(stderr, "kernel_launch: unexpected shapes / workspace (n_in %d, in0 %d, out %d, ws %zu); nothing launched\n", n_in, n_in > 0 ? in_sizes[0] : -1, out_size, ws_size); grid = -1; return; }
        int dev = 0, cus = 0, per_cu = 0;
        if (hipGetDevice(&dev) != hipSuccess || hipDeviceGetAttribute(&cus, hipDeviceAttributeMultiprocessorCount, dev) != hipSuccess) { grid = -1; return; }
        if (hipFuncSetAttribute((const void*)fwd_kernel, hipFuncAttributeMaxDynamicSharedMemorySize, LDS_BYTES) != hipSuccess) { fprintf(stderr, "kernel_launch: hipFuncSetAttribute failed\n"); grid = -1; return; }
        if (hipOccupancyMaxActiveBlocksPerMultiprocessor(&per_cu, (const void*)fwd_kernel, NWAVES * 64, LDS_BYTES) != hipSuccess || per_cu < 1) fprintf(stderr, "kernel_launch: occupancy query reports %d\n", per_cu);
        (void)hipGetLastError();
        grid = cus;
    }
    if (grid < 0) return;
    if (hipMemsetAsync((char*)d_ws + WS_CTL, 0, CTL_ZERO_BYTES, stream) != hipSuccess) return;
    Args a{};
    for (int i = 0; i < 15; ++i) a.in[i] = (const float*)d_in[i];
    a.out = (float*)d_out; a.ws = (unsigned char*)d_ws; a.naive = 0; a.pad = 0;
    hipLaunchKernelGGL(fwd_kernel, dim3(grid), dim3(NWAVES * 64), LDS_BYTES, stream, a);
}
```

```cpp
#include <hip/hip_runtime.h>
#include <cstdio>
#include <cstdint>
#include <type_traits>

namespace pg8 {
#define PG8_LAS __attribute__((address_space(3)))
typedef unsigned short bf16_t;
typedef short bf16x8 __attribute__((ext_vector_type(8)));
typedef float f32x4 __attribute__((ext_vector_type(4)));
typedef float f32x2 __attribute__((ext_vector_type(2)));
typedef unsigned u32x4 __attribute__((ext_vector_type(4)));
typedef unsigned u32x2 __attribute__((ext_vector_type(2)));
typedef int i32x4 __attribute__((ext_vector_type(4)));
__device__ __forceinline__ f32x4 tof(const f32x4& v) { return v; }
__device__ __forceinline__ f32x4 tof(const i32x4& v) { return (f32x4){(float)v[0], (float)v[1], (float)v[2], (float)v[3]}; }
constexpr int BM = 256, BK = 64, HALF = 128, HTB = HALF * BK * 2  , STAGE_BYTES = 8 * HTB, NXCD = 8, WGM = 8;

__host__ __device__ __forceinline__ int lds_byte(int r, int c) { const int st = (r >> 4) * 2 + (c >> 5), rr = r & 15, cc = c & 31, ob = rr * 64 + cc * 2; return st * 1024 + (ob ^ (((ob >> 9) & 1) << 5)); }
__host__ __device__ __forceinline__ void stage_rc(int b, int& R, int& C) { const int st = b / 1024, sb = b % 1024, swz = sb ^ (((sb >> 9) & 1) << 5); R = (st >> 1) * 16 + swz / 64; C = (st & 1) * 32 + (swz % 64) / 2; }
__host__ __device__ __forceinline__ int perm32(int rho) { const int n = rho >> 4, i = rho & 15; return 8 * (i >> 2) + 4 * n + (i & 3); }

struct Unit { int pm, pn; };
struct Gemm { const bf16_t* A; const bf16_t* Bt; int lda, ldb, K; };

struct StaticOrder {
    int nM, nN, nwg, G, c, a_div, a_add;
    __device__ void init(int M, int N, int G_, int c_, int a_div_ = 0, int a_add_ = 0) { nM = M / BM; nN = N / BM; nwg = nM * nN; G = G_; c = c_; a_div = a_div_; a_add = a_add_; }
    __device__ bool next(int i, Unit& u) const {
        const long L = (long)i * G + c; if (L >= nwg) return false;
        int wgid = (int)L; { const int q = nwg / NXCD, r = nwg % NXCD, xcd = wgid % NXCD, off = wgid / NXCD; wgid = (xcd < r ? xcd * (q + 1) : r * (q + 1) + (xcd - r) * q) + off; }
        const int nig = WGM * nN, gid = wgid / nig, fm = gid * WGM, gsz = (nM - fm) < WGM ? (nM - fm) : WGM;
        u.pm = fm + ((wgid % nig) % gsz); u.pn = (wgid % nig) / gsz; return true;
    }
    __device__ __forceinline__ const char* a_ptr(const Gemm& g, const Unit& u) const { return (const char*)g.A + ((size_t)u.pm * BM * g.lda + (a_div ? (size_t)((u.pn / a_div) * a_add) : (size_t)0)) * 2; }
    __device__ __forceinline__ const char* b_ptr(const Gemm& g, const Unit& u) const { return (const char*)g.Bt + (size_t)u.pn * BM * g.ldb * 2; }
    __device__ __forceinline__ int grow(int, int) const { return 0; }
};

struct MoeOrder {
    int G, vcu, nN, ntiles; const PG8_LAS int* tb; const PG8_LAS int* gtab; size_t wstride;
    bool gather;
    __device__ __forceinline__ bool next(int i, Unit& u) const { const long L = (long)i * G + vcu; if (L >= (long)ntiles * nN) return false; u.pm = (int)(L / nN); u.pn = (int)(L % nN); return true; }
    __device__ __forceinline__ int expert_of(int pm) const { int e = 0;
#pragma unroll
        for (int k = 1; k < 16; ++k) e += (pm >= tb[k]) ? 1 : 0; return e; }
    __device__ __forceinline__ const char* a_ptr(const Gemm& g, const Unit& u) const { return gather ? (const char*)g.A : (const char*)g.A + (size_t)u.pm * BM * g.lda * 2; }
    __device__ __forceinline__ const char* b_ptr(const Gemm& g, const Unit& u) const { return (const char*)g.Bt + ((size_t)expert_of(u.pm) * wstride + (size_t)u.pn * BM * g.ldb) * 2; }
    __device__ __forceinline__ int grow(int ui, int r) const { const int v = gtab[ui * 256 + r]; return v >= 0 ? (v >> 1) : 0; }
};

__device__ __forceinline__ unsigned cvt_pk_bf16(float lo, float hi) { unsigned r; asm volatile("v_cvt_pk_bf16_f32 %0, %1, %2" : "=v"(r) : "v"(lo), "v"(hi)); return r; }
__device__ __forceinline__ float bf_lo(unsigned w) { return __uint_as_float(w << 16); }
__device__ __forceinline__ float bf_hi(unsigned w) { return __uint_as_float(w & 0xffff0000u); }
__device__ __forceinline__ float sigmoidf_fast(float x) { return __builtin_amdgcn_rcpf(1.0f + __builtin_amdgcn_exp2f(-1.4426950408889634f * x)); }

struct EpiBf16 {
    static constexpr bool PERM = true;
    bf16_t* O; int ldc; const float* bias; const float* rs; const float* cs;
    template <class AccT>
    __device__ __forceinline__ void operator()(const AccT (&acc)[2][2][4][2], const Unit& u, int ui, int wr, int wc, int fr, int fq) const {
        const int row0 = u.pm * BM + wr * 64 + fr, col0 = u.pn * BM + wc * 32 + 8 * fq;
        f32x4 bv[2][2], cv[2][2];
#pragma unroll
        for (int bj = 0; bj < 2; ++bj)
#pragma unroll
            for (int n = 0; n < 2; ++n) { bv[bj][n] = bias ? *(const f32x4*)(bias + col0 + bj * HALF + 4 * n) : (f32x4){0.f, 0.f, 0.f, 0.f}; cv[bj][n] = cs ? *(const f32x4*)(cs + col0 + bj * HALF + 4 * n) : (f32x4){1.f, 1.f, 1.f, 1.f}; }
#pragma unroll
        for (int ai = 0; ai < 2; ++ai)
#pragma unroll
            for (int m = 0; m < 4; ++m) { const int row = row0 + ai * HALF + m * 16; bf16_t* rowp = O + (size_t)row * ldc + col0; const float rsc = rs ? rs[row] : 1.f;
#pragma unroll
                for (int bj = 0; bj < 2; ++bj) { const f32x4 v0 = tof(acc[ai][bj][m][0]) * rsc * cv[bj][0] + bv[bj][0], v1 = tof(acc[ai][bj][m][1]) * rsc * cv[bj][1] + bv[bj][1];
                    u32x4 w; w.x = cvt_pk_bf16(v0[0], v0[1]); w.y = cvt_pk_bf16(v0[2], v0[3]); w.z = cvt_pk_bf16(v1[0], v1[1]); w.w = cvt_pk_bf16(v1[2], v1[3]);
                    *(u32x4*)(rowp + bj * HALF) = w; } }
    }
};
struct EpiGateMix {
    static constexpr bool PERM = false;
    const bf16_t* U; bf16_t* O; const float* bias; const float* rs; const float* cs;
    template <class AccT>
    __device__ __forceinline__ void operator()(const AccT (&acc)[2][2][4][2], const Unit& u, int ui, int wr, int wc, int fr, int fq) const {
        const int row0 = u.pm * BM + wr * 64 + fr, d0 = 64 * u.pn + 16 * wc + 4 * fq;
        f32x4 bv[2][2], cv[2][2];
#pragma unroll
        for (int bj = 0; bj < 2; ++bj)
#pragma unroll
            for (int n = 0; n < 2; ++n) { const int vc = u.pn * BM + 128 * bj + 32 * wc + 16 * n + 4 * fq; bv[bj][n] = *(const f32x4*)(bias + vc); cv[bj][n] = *(const f32x4*)(cs + vc); }
#pragma unroll
        for (int ai = 0; ai < 2; ++ai)
#pragma unroll
            for (int m = 0; m < 4; ++m) { const size_t row = (size_t)(row0 + ai * HALF + m * 16); const bf16_t* up = U + row * 4096 + d0; const float rsc = rs[row];
                f32x4 o = (f32x4){0.f, 0.f, 0.f, 0.f};
#pragma unroll
                for (int bj = 0; bj < 2; ++bj)
#pragma unroll
                    for (int n = 0; n < 2; ++n) { const u32x2 w = *(const u32x2*)(up + (2 * bj + n) * 1024);
                        const f32x4 z = tof(acc[ai][bj][m][n]) * rsc * cv[bj][n] + bv[bj][n];
                        o[0] += sigmoidf_fast(z[0]) * bf_lo(w.x); o[1] += sigmoidf_fast(z[1]) * bf_hi(w.x); o[2] += sigmoidf_fast(z[2]) * bf_lo(w.y); o[3] += sigmoidf_fast(z[3]) * bf_hi(w.y); }
                u32x2 ow; ow.x = cvt_pk_bf16(o[0], o[1]); ow.y = cvt_pk_bf16(o[2], o[3]);
                *(u32x2*)(O + row * 1024 + d0) = ow; }
    }
};
struct EpiMoe1 {
    static constexpr bool PERM = true;
    bf16_t* act; const PG8_LAS float* stab; const PG8_LAS int* tb; const float* cs;
    template <class AccT>
    __device__ __forceinline__ void operator()(const AccT (&acc)[2][2][4][2], const Unit& u, int ui, int wr, int wc, int fr, int fq) const {
        const int row0 = u.pm * BM + wr * 64 + fr, col0 = 128 * u.pn + 32 * wc + 8 * fq;
        int e = 0;
#pragma unroll
        for (int k = 1; k < 16; ++k) e += (u.pm >= tb[k]) ? 1 : 0;
        const float* csp = cs + e * 1024 + u.pn * BM + 32 * wc + 8 * fq;
        f32x4 cg[2], cu[2];
#pragma unroll
        for (int n = 0; n < 2; ++n) { cg[n] = *(const f32x4*)(csp + 4 * n); cu[n] = *(const f32x4*)(csp + HALF + 4 * n); }
#pragma unroll
        for (int ai = 0; ai < 2; ++ai)
#pragma unroll
            for (int m = 0; m < 4; ++m) { const int rl = ai * HALF + wr * 64 + m * 16 + fr; const size_t row = (size_t)(u.pm * BM + rl); const float rsc = stab[ui * 256 + rl];
                float a[8];
#pragma unroll
                for (int n = 0; n < 2; ++n) { const f32x4 g4 = tof(acc[ai][0][m][n]) * rsc * cg[n], u4 = tof(acc[ai][1][m][n]) * rsc * cu[n];
#pragma unroll
                    for (int j = 0; j < 4; ++j) a[4 * n + j] = g4[j] * sigmoidf_fast(g4[j]) * u4[j]; }
                u32x4 w; w.x = cvt_pk_bf16(a[0], a[1]); w.y = cvt_pk_bf16(a[2], a[3]); w.z = cvt_pk_bf16(a[4], a[5]); w.w = cvt_pk_bf16(a[6], a[7]);
                *(u32x4*)(act + row * 512 + col0) = w; }
    }
};
struct EpiMoe2 {
    static constexpr bool PERM = true;
    bf16_t* Y; const PG8_LAS int* gtab; const PG8_LAS float* wtab;
    template <class AccT>
    __device__ __forceinline__ void operator()(const AccT (&acc)[2][2][4][2], const Unit& u, int ui, int wr, int wc, int fr, int fq) const {
        const int col0 = u.pn * BM + wc * 32 + 8 * fq;
#pragma unroll
        for (int ai = 0; ai < 2; ++ai)
#pragma unroll
            for (int m = 0; m < 4; ++m) { const int rl = ai * HALF + wr * 64 + m * 16 + fr; const int slot = gtab[ui * 256 + rl]; const float wgt = wtab[ui * 256 + rl];
                if (slot >= 0) { bf16_t* rowp = Y + (size_t)slot * 1024 + col0;
#pragma unroll
                    for (int bj = 0; bj < 2; ++bj) { const f32x4 v0 = tof(acc[ai][bj][m][0]) * wgt, v1 = tof(acc[ai][bj][m][1]) * wgt;
                        u32x4 w; w.x = cvt_pk_bf16(v0[0], v0[1]); w.y = cvt_pk_bf16(v0[2], v0[3]); w.z = cvt_pk_bf16(v1[0], v1[1]); w.w = cvt_pk_bf16(v1[2], v1[3]);
                        *(u32x4*)(rowp + bj * HALF) = w; } } }
    }
};

template <class Epi, class Sched, bool ALIGN_EPI, bool GATHER, bool I8 = false>
__device__ __forceinline__ void gemm_phase(PG8_LAS unsigned char* lds, const Gemm g, const Sched& S, const Epi& E) {
    int tid_ = threadIdx.x; asm volatile("" : "+v"(tid_));
    const int tid = tid_, wid = __builtin_amdgcn_readfirstlane(tid >> 6), lane = tid & 63, wr = wid >> 2, wc = wid & 3, fr = lane & 15, fq = lane >> 4;
    const int K = g.K, nt = K / BK;
    unsigned voffA[2], voffB[2]; int RA[2]; unsigned CA2[2];
#pragma unroll
    for (int i = 0; i < 2; ++i) { int R, C; stage_rc(tid * 16 + i * 8192, R, C); const int Rb = Epi::PERM ? ((R & ~31) + perm32(R & 31)) : R;
        voffA[i] = (unsigned)(R * g.lda + C) * 2u; voffB[i] = (unsigned)(Rb * g.ldb + C) * 2u; RA[i] = R; CA2[i] = (unsigned)C * 2u; }
    const size_t kstep = (size_t)(BK * 2);
    const size_t hstepA = (size_t)HALF * g.lda * 2, hstepB = (size_t)HALF * g.ldb * 2;
    const unsigned ldsw = (unsigned)wid * 1024u;
    const int aoff = lds_byte(wr * 64 + fr, fq * 8), boff = lds_byte(wc * 32 + fr, fq * 8);
    unsigned gvc[2][2], gvn[2][2];
#define PG8_SA(b, h) (((b) * 2 + (h)) * HTB)
#define PG8_SB(b, h) ((4 + (b) * 2 + (h)) * HTB)
#define PG8_STG(bufoff, gbase, voff) do { _Pragma("unroll") for (int _i = 0; _i < 2; ++_i) \
        __builtin_amdgcn_global_load_lds((const unsigned*)((const char*)(gbase) + (voff)[_i]), (PG8_LAS unsigned*)(lds + (bufoff) + ldsw + _i * 8192), 16, 0, 0); } while (0)
#define PG8_STG_B(bufoff, kptr, h) PG8_STG(bufoff, (kptr) + (h) * hstepB, voffB)
#define PG8_STG_A(bufoff, kptr, h, nx) do { if constexpr (GATHER) { unsigned _v[2]; _v[0] = (nx) ? gvn[h][0] : gvc[h][0]; _v[1] = (nx) ? gvn[h][1] : gvc[h][1]; PG8_STG(bufoff, kptr, _v); } \
        else { PG8_STG(bufoff, (kptr) + (h) * hstepA, voffA); } } while (0)
#define PG8_GLOAD(dst, uix) do { _Pragma("unroll") for (int _h = 0; _h < 2; ++_h) _Pragma("unroll") for (int _i = 0; _i < 2; ++_i) \
        dst[_h][_i] = (unsigned)S.grow((uix), _h * HALF + RA[_i]) * (unsigned)(g.lda * 2) + CA2[_i]; } while (0)
#define PG8_LDA(dst, b, h) do { _Pragma("unroll") for (int m = 0; m < 4; ++m) _Pragma("unroll") for (int k = 0; k < 2; ++k) dst[m][k] = *(const PG8_LAS bf16x8*)(lds + PG8_SA(b, h) + aoff + m * 2048 + k * 1024); } while (0)
#define PG8_LDB(dst, b, h) do { _Pragma("unroll") for (int n = 0; n < 2; ++n) _Pragma("unroll") for (int k = 0; k < 2; ++k) dst[n][k] = *(const PG8_LAS bf16x8*)(lds + PG8_SB(b, h) + boff + n * 2048 + k * 1024); } while (0)
#define PG8_MMA(ai, bj, At, Bt) do { __builtin_amdgcn_s_setprio(1); _Pragma("unroll") for (int m = 0; m < 4; ++m) _Pragma("unroll") for (int n = 0; n < 2; ++n) _Pragma("unroll") for (int k = 0; k < 2; ++k) \
        { if constexpr (I8) acc[ai][bj][m][n] = __builtin_amdgcn_mfma_i32_16x16x64_i8(__builtin_bit_cast(i32x4, Bt[n][k]), __builtin_bit_cast(i32x4, At[m][k]), acc[ai][bj][m][n], 0, 0, 0); \
          else acc[ai][bj][m][n] = __builtin_amdgcn_mfma_f32_16x16x32_bf16(Bt[n][k], At[m][k], acc[ai][bj][m][n], 0, 0, 0); } __builtin_amdgcn_s_setprio(0); } while (0)
#define PG8_WAIT_V(n) asm volatile("s_waitcnt vmcnt(" #n ")" ::: "memory")
#define PG8_WAIT_L(n) asm volatile("s_waitcnt lgkmcnt(" #n ")" ::: "memory")
#define PG8_BAR __builtin_amdgcn_s_barrier()
#define PG8_SCHED __builtin_amdgcn_sched_barrier(0)
    Unit cur, nxt; int ui = 0;
    if (!S.next(0, cur)) return;
    typedef typename std::conditional<I8, i32x4, f32x4>::type AccT;
    AccT acc[2][2][4][2];
#pragma unroll
    for (int a = 0; a < 2; ++a)
#pragma unroll
        for (int b = 0; b < 2; ++b)
#pragma unroll
            for (int m = 0; m < 4; ++m)
#pragma unroll
                for (int n = 0; n < 2; ++n) acc[a][b][m][n] = AccT{};
    bf16x8 At[4][2], B0[2][2], B1[2][2];
    const char* cA = S.a_ptr(g, cur); const char* cB = S.b_ptr(g, cur);
    if constexpr (GATHER) { PG8_GLOAD(gvc, 0); PG8_GLOAD(gvn, 0); }
    PG8_STG_B(PG8_SB(0, 0), cB, 0); PG8_STG_B(PG8_SB(0, 1), cB, 1); PG8_STG_A(PG8_SA(0, 0), cA, 0, false); PG8_STG_A(PG8_SA(0, 1), cA, 1, false);
    if (wr == 1) PG8_BAR;
    PG8_WAIT_V(2); PG8_BAR;
    PG8_STG_B(PG8_SB(1, 0), cB + kstep, 0); PG8_STG_A(PG8_SA(1, 0), cA + kstep, 0, false); PG8_STG_B(PG8_SB(1, 1), cB + kstep, 1);
    PG8_WAIT_V(6); PG8_BAR;
    for (;;) {
        const bool has_next = S.next(ui + 1, nxt);
        const char* nA = has_next ? S.a_ptr(g, nxt) : cA; const char* nB = has_next ? S.b_ptr(g, nxt) : cB;
        if constexpr (GATHER) { if (has_next) { PG8_GLOAD(gvn, ui + 1); } else {
#pragma unroll
            for (int h = 0; h < 2; ++h) { gvn[h][0] = gvc[h][0]; gvn[h][1] = gvc[h][1]; } } }
        for (int t = 0; t < nt; t += 2) {
            const bool last = (t == nt - 2);
            const char* a1 = cA + (size_t)(t + 1) * kstep;
            const char* a2 = last ? nA : cA + (size_t)(t + 2) * kstep; const char* b2 = last ? nB : cB + (size_t)(t + 2) * kstep;
            const char* a3 = a2 + kstep; const char* b3 = b2 + kstep;
            PG8_LDB(B0, 0, 0); PG8_LDB(B1, 0, 1); PG8_SCHED; PG8_LDA(At, 0, 0); PG8_STG_A(PG8_SA(1, 1), a1, 1, false);
            PG8_WAIT_V(8); PG8_WAIT_L(0); PG8_BAR; PG8_MMA(0, 0, At, B0); PG8_MMA(0, 1, At, B1); PG8_BAR; PG8_SCHED;
            PG8_LDA(At, 0, 1); PG8_STG_B(PG8_SB(0, 0), b2, 0); PG8_STG_B(PG8_SB(0, 1), b2, 1); PG8_STG_A(PG8_SA(0, 0), a2, 0, last);
            PG8_WAIT_V(8); PG8_WAIT_L(0); PG8_BAR; PG8_MMA(1, 0, At, B0); PG8_MMA(1, 1, At, B1); PG8_BAR; PG8_SCHED;
            PG8_LDB(B0, 1, 0); PG8_LDB(B1, 1, 1); PG8_SCHED; PG8_LDA(At, 1, 0); PG8_STG_A(PG8_SA(0, 1), a2, 1, last);
            PG8_WAIT_V(8); PG8_WAIT_L(0); PG8_BAR; PG8_MMA(0, 0, At, B0); PG8_MMA(0, 1, At, B1); PG8_BAR; PG8_SCHED;
            PG8_LDA(At, 1, 1); PG8_STG_B(PG8_SB(1, 0), b3, 0); PG8_STG_B(PG8_SB(1, 1), b3, 1); PG8_STG_A(PG8_SA(1, 0), a3, 0, last);
            PG8_WAIT_V(8); PG8_WAIT_L(0); PG8_BAR; PG8_MMA(1, 0, At, B0); PG8_MMA(1, 1, At, B1); PG8_BAR; PG8_SCHED;
        }
        if constexpr (ALIGN_EPI) { if (wr == 0) PG8_BAR; }
        E(acc, cur, ui, wr, wc, fr, fq);
        if (!has_next) break;
#pragma unroll
        for (int a = 0; a < 2; ++a)
#pragma unroll
            for (int b = 0; b < 2; ++b)
#pragma unroll
                for (int m = 0; m < 4; ++m)
#pragma unroll
                    for (int n = 0; n < 2; ++n) acc[a][b][m][n] = AccT{};
        cur = nxt; cA = nA; cB = nB; ++ui;
        if constexpr (GATHER) {
#pragma unroll
            for (int h = 0; h < 2; ++h) { gvc[h][0] = gvn[h][0]; gvc[h][1] = gvn[h][1]; } }
        if constexpr (ALIGN_EPI) { if (wr == 1) PG8_BAR; }
    }
    PG8_WAIT_V(0);
    if constexpr (!ALIGN_EPI) { if (wr == 0) PG8_BAR; }
    PG8_BAR;
#undef PG8_SA
#undef PG8_SB
#undef PG8_STG
#undef PG8_STG_A
#undef PG8_STG_B
#undef PG8_GLOAD
#undef PG8_LDA
#undef PG8_LDB
#undef PG8_MMA
#undef PG8_WAIT_V
#undef PG8_WAIT_L
#undef PG8_BAR
#undef PG8_SCHED
}
}

constexpr int NWAVES = 8;
constexpr int BATCH = 32, SEQ = 2048, DM = 1024, NLAYER = 2, NH = 4, HD = 64, NMEM = 256;
constexpr int T = BATCH * SEQ;
constexpr int MEMROWS = BATCH * NMEM;
constexpr int NIN = 7172, NPROJ = 3072, NGATE = 4096, NE = 16, DE = 512;
constexpr int FOX_F_COL = 768, GATE_COL = 3076;
constexpr float ALPHA = 1.4142135623730951f;
constexpr float LN_EPS = 1e-5f, GN_EPS = 1e-6f;
constexpr int LISTCAP = 65536;
constexpr int MAXU = 10;

constexpr size_t MiB = 1u << 20;
constexpr size_t WS_CTL = 0, CTL_ZERO_BYTES = 1 * MiB;
constexpr size_t WS_LF = 2 * MiB;
constexpr size_t WS_CC = 3 * MiB;
constexpr size_t WS_WT = 4 * MiB;
constexpr size_t WS_ROPE = 5 * MiB;
constexpr size_t WS_BIASP = 6 * MiB;
constexpr size_t WS_BIASG = 6 * MiB + 65536;
constexpr size_t WS_PAR = 7 * MiB;
constexpr int PAR_LNG = 0, PAR_LNB = 4096, PAR_WR = 8192, PAR_BR = 24576, PAR_LB = 24592, PAR_NG = 25104, PAR_WFF = 25232;
constexpr size_t WS_LIST = 8 * MiB;
constexpr size_t WS_W = 16 * MiB;
constexpr size_t W_IN = 0, W_G = 3 * MiB, W_B = 7 * MiB, W_OUT = 9 * MiB, W_E1 = 11 * MiB, W_E2 = 27 * MiB, W_LAYER = 43 * MiB;
constexpr size_t WS_WMEM = WS_W + 2 * W_LAYER;
constexpr size_t WS_MEMB = 104 * MiB;
constexpr size_t WS_MEMKV = 120 * MiB;
constexpr size_t WS_XB = 136 * MiB;
constexpr size_t WS_X8 = 264 * MiB;
constexpr size_t WS_X1B = 328 * MiB;
constexpr size_t WS_X18 = 456 * MiB;
constexpr size_t WS_PROJ = 520 * MiB;
constexpr size_t WS_U = 328 * MiB;
constexpr size_t WS_Y = 520 * MiB;
constexpr size_t WS_ACT = 648 * MiB;
constexpr size_t WS_END = 904 * MiB;
static_assert(WS_WMEM + 2 * MiB <= WS_MEMB && WS_U + (size_t)T * 4096 * 2 <= WS_PROJ + (size_t)T * 3072 * 2 && WS_ACT + (size_t)135168 * 512 * 2 <= WS_END && WS_PROJ + (size_t)T * 3072 * 2 <= WS_END, "d_ws map");
constexpr size_t CM_IN = 256 * 1024, CM_E = 320 * 1024;
constexpr size_t WS_SX = 12 * MiB, WS_S1 = 12 * MiB + 512 * 1024;
constexpr size_t WS_SWP = 13 * MiB, WS_SWG = 13 * MiB + 65536, WS_SWE = 13 * MiB + 131072;
constexpr int CW_TMO = 0, CW_CODE = 1, CW_BAR = 4096, CW_CNT = 16384;

constexpr int RING_OFF = 0, RING_BYTES = 131072;
constexpr int GT_OFF = 131072, WTB_OFF = GT_OFF + MAXU * 1024, STB_OFF = WTB_OFF + MAXU * 1024, SM_OFF = STB_OFF + MAXU * 1024;
constexpr int LDSCTL_OFF = SM_OFF + 1024, MISC_OFF = LDSCTL_OFF + 320;
constexpr int LDS_BYTES = 163840;
static_assert(MISC_OFF + 128 <= LDS_BYTES, "LDS map");

#define GAS __attribute__((address_space(1)))
#define LAS __attribute__((address_space(3)))
typedef unsigned short bf16;
typedef unsigned v4u __attribute__((ext_vector_type(4)));
typedef unsigned v2u __attribute__((ext_vector_type(2)));
typedef float f32x4 __attribute__((ext_vector_type(4)));
typedef GAS unsigned gu32;
#define RLX_AGENT __ATOMIC_RELAXED, __HIP_MEMORY_SCOPE_AGENT
#define LDS_WAIT() asm volatile("s_waitcnt lgkmcnt(0)" ::: "memory")
#define VM_WAIT() asm volatile("s_waitcnt vmcnt(0)" ::: "memory")
__device__ __forceinline__ unsigned f2bf(float f) { unsigned u = __builtin_bit_cast(unsigned, f); return (u + 0x7fffu + ((u >> 16) & 1u)) >> 16; }
__device__ __forceinline__ unsigned pk2(float lo, float hi) { return f2bf(lo) | (f2bf(hi) << 16); }
__device__ __forceinline__ float bfl(unsigned w) { return __uint_as_float(w << 16); }
__device__ __forceinline__ float bfh(unsigned w) { return __uint_as_float(w & 0xffff0000u); }
__device__ __forceinline__ float bf1(bf16 h) { return __uint_as_float((unsigned)h << 16); }

#define XB_TMO      128
#define XB_XCNT(j)  (256  + 64 * (j))
#define XB_XSUB(j)  (1280 + 64 * (j))
#define XB_XGEN(j)  (2304 + 64 * (j))
#define XB_TOP      3328
#define XB_TOPGEN   3392
#define XCD_BAR_WORDS 3456
#define XB_SPIN_CAP (1u << 18)
__device__ __forceinline__ unsigned xb_ld(unsigned* p)              { return __hip_atomic_load(p, __ATOMIC_RELAXED, __HIP_MEMORY_SCOPE_AGENT); }
__device__ __forceinline__ unsigned xb_add(unsigned* p, unsigned v) { return __hip_atomic_fetch_add(p, v, __ATOMIC_RELAXED, __HIP_MEMORY_SCOPE_AGENT); }
__device__ __forceinline__ unsigned xb_xcc_id() { return (unsigned)__builtin_amdgcn_s_getreg((3 << 11) | 20) & 0xFu; }
#define XB_SPIN(cond, bar) do { unsigned _sp = 0; while (cond) { __builtin_amdgcn_s_sleep(1); \
    if ((++_sp & 255u) == 0u) { if (xb_ld(&(bar)[XB_TMO])) break; if (_sp > XB_SPIN_CAP) { atomicAdd(&(bar)[XB_TMO], 1u); break; } } } } while (0)
struct XcdBarrier { unsigned* bar; unsigned x; volatile LAS unsigned* st; };
__device__ __forceinline__ XcdBarrier xcd_barrier_post(unsigned* bar, volatile LAS unsigned* st) {
    XcdBarrier b; b.bar = bar; b.x = xb_xcc_id(); b.st = st;
    if (threadIdx.x == 0) (void)xb_add(&bar[XB_XCNT(b.x)], 1u);
    return b;
}
__device__ __forceinline__ void xcd_barrier_complete(unsigned* bar, unsigned x, unsigned& nloc, unsigned& nx) {
    const unsigned G = gridDim.x * gridDim.y * gridDim.z;
    unsigned sum, cnt, mine, sp = 0u;
    for (;;) {
        sum = 0u; cnt = 0u; mine = 0u;
#pragma unroll
        for (unsigned j = 0; j < 16; ++j) { const unsigned c = xb_ld(&bar[XB_XCNT(j)]); sum += c; cnt += (c > 0u) ? 1u : 0u; mine = (j == x) ? c : mine; }
        if (sum == G) break;
        __builtin_amdgcn_s_sleep(1);
        if ((++sp & 255u) == 0u) { if (xb_ld(&bar[XB_TMO])) break; if (sp > XB_SPIN_CAP) { atomicAdd(&bar[XB_TMO], 1u); break; } }
    }
    nloc = mine > 0u ? mine : 1u; nx = cnt > 0u ? cnt : 1u;
}
__device__ __forceinline__ void xcd_barrier(const XcdBarrier& b) {
    asm volatile("s_waitcnt vmcnt(0)" ::: "memory");
    __syncthreads();
    if (threadIdx.x == 0) {
        unsigned* bar = b.bar;
        __builtin_amdgcn_s_waitcnt(0);
        unsigned nloc = b.st[0], nx = b.st[1];
        if (nloc == 0u) { xcd_barrier_complete(bar, b.x, nloc, nx); b.st[0] = nloc; b.st[1] = nx; }
        const unsigned old = xb_add(&bar[XB_XSUB(b.x)], 1u);
        const unsigned gen = old / nloc;
        if (old + 1u == (gen + 1u) * nloc) {
            __builtin_amdgcn_fence(__ATOMIC_RELEASE, "agent");
            asm volatile("s_waitcnt vmcnt(0)" ::: "memory");
            const unsigned og = xb_add(&bar[XB_TOP], 1u);
            const unsigned tg = og / nx;
            if (og + 1u == (tg + 1u) * nx) xb_add(&bar[XB_TOPGEN], 1u);
            else XB_SPIN(xb_ld(&bar[XB_TOPGEN]) == tg, bar);
            __builtin_amdgcn_fence(__ATOMIC_ACQUIRE, "agent");
            xb_add(&bar[XB_XGEN(b.x)], 1u);
            asm volatile("s_waitcnt vmcnt(0)" ::: "memory");
        } else {
            XB_SPIN(xb_ld(&bar[XB_XGEN(b.x)]) == gen, bar);
            __builtin_amdgcn_fence(__ATOMIC_ACQUIRE, "agent");
            asm volatile("s_waitcnt vmcnt(0)" ::: "memory");
        }
    }
    __syncthreads();
}

struct Frame {
    LAS unsigned char* lds;
    volatile LAS unsigned* MISC;
    gu32* ctl;
    int tid, vcu, G, bx;
    float* out; unsigned char* ws;
};
#define OPAQUE_V(x) asm volatile("" : "+v"(x))
enum { I_X = 0, I_MEM, I_WIN, I_BIN, I_WMEMKV, I_LB, I_NORMG, I_WBRANCH, I_WOUT, I_LNG, I_LNB, I_WROUTER, I_BROUTER, I_WEIN, I_WEOUT };

__device__ __forceinline__ float wave_sum(float v) {
#pragma unroll
    for (int o = 1; o < 64; o <<= 1) v += __shfl_xor(v, o);
    return v;
}
__device__ __forceinline__ float wave_max(float v) {
#pragma unroll
    for (int o = 1; o < 64; o <<= 1) v = fmaxf(v, __shfl_xor(v, o));
    return v;
}
__device__ __forceinline__ float log_sigmoid(float z) { return z >= 0.f ? -log1pf(expf(-z)) : z - log1pf(expf(z)); }

__device__ __forceinline__ int src_col(int mode, int r) {
    if (mode == 1) { const int tile = r >> 8; return r + (tile >= 3 ? 4 : 0); }
    if (mode == 2) { const int nb = 2 * ((r >> 7) & 1) + ((r >> 4) & 1), d = 64 * (r >> 8) + 16 * ((r >> 5) & 3) + (r & 15); return GATE_COL + nb * 1024 + d; }
    if (mode == 3) { return ((r >> 7) & 1) * 512 + 128 * (r >> 8) + (r & 127); }
    return r;
}
__device__ __forceinline__ unsigned q8(float v, float inv) { int q = (int)rintf(v * inv); q = q > 127 ? 127 : (q < -127 ? -127 : q); return (unsigned)q & 255u; }
__device__ __forceinline__ unsigned q8x4(float a, float b, float c, float d, float inv) { return q8(a, inv) | (q8(b, inv) << 8) | (q8(c, inv) << 16) | (q8(d, inv) << 24); }
__device__ __forceinline__ void store_row_i8(signed char* orow, float* srow, int lane, const f32x4 (&v)[4]) {
    float am = 0.f;
#pragma unroll
    for (int j = 0; j < 4; ++j) am = fmaxf(am, fmaxf(fmaxf(fabsf(v[j].x), fabsf(v[j].y)), fmaxf(fabsf(v[j].z), fabsf(v[j].w))));
    am = fmaxf(wave_max(am), 1e-30f);
    const float inv = 127.0f / am;
    GAS unsigned* o4 = (GAS unsigned*)orow + lane;
#pragma unroll
    for (int j = 0; j < 4; ++j) o4[64 * j] = q8x4(v[j].x, v[j].y, v[j].z, v[j].w, inv);
    if (lane == 0) *srow = am * (1.0f / 127.0f);
}
__device__ __forceinline__ void p0_transpose_item_q(const float* W, int K, int N, signed char* WT, int mode, const unsigned* cm, LAS float* scr, int item, int ndst32, int lane) {
    const int kb = item / ndst32, nb = item % ndst32, k0 = 64 * kb, n0 = 32 * nb;
    const int sc = src_col(mode, n0 + (lane & 31));
#pragma unroll 8
    for (int i = 0; i < 32; ++i) { const int kk = 2 * i + (lane >> 5); scr[kk * 33 + (lane & 31)] = W[(size_t)(k0 + kk) * N + sc]; }
    LDS_WAIT(); asm volatile("" ::: "memory");
    const int c = lane & 7;
#pragma unroll
    for (int j = 0; j < 4; ++j) { const int n = (lane >> 3) + 8 * j; const LAS float* sp = scr + (8 * c) * 33 + n;
        const float inv = 127.0f / fmaxf(__uint_as_float(cm[src_col(mode, n0 + n)]), 1e-30f);
        v2u o; o.x = q8x4(sp[0 * 33], sp[1 * 33], sp[2 * 33], sp[3 * 33], inv); o.y = q8x4(sp[4 * 33], sp[5 * 33], sp[6 * 33], sp[7 * 33], inv);
        *(GAS v2u*)(WT + (size_t)(n0 + n) * K + k0 + 8 * c) = o; }
    LDS_WAIT(); asm volatile("" ::: "memory");
}
__device__ __forceinline__ void p0_transpose_item(const float* W, int K, int N, bf16* WT, int mode, LAS float* scr, int item, int ndst32, int lane) {
    const int kb = item / ndst32, nb = item % ndst32, k0 = 64 * kb, n0 = 32 * nb;
    const int sc = src_col(mode, n0 + (lane & 31));
#pragma unroll 8
    for (int i = 0; i < 32; ++i) { const int kk = 2 * i + (lane >> 5); scr[kk * 33 + (lane & 31)] = W[(size_t)(k0 + kk) * N + sc]; }
    LDS_WAIT(); asm volatile("" ::: "memory");
    const int c = lane & 7;
#pragma unroll
    for (int j = 0; j < 4; ++j) { const int n = (lane >> 3) + 8 * j; const LAS float* s = scr + (8 * c) * 33 + n;
        v4u o; o.x = pk2(s[0 * 33], s[1 * 33]); o.y = pk2(s[2 * 33], s[3 * 33]); o.z = pk2(s[4 * 33], s[5 * 33]); o.w = pk2(s[6 * 33], s[7 * 33]);
        *(GAS v4u*)(WT + (size_t)(n0 + n) * K + k0 + 8 * c) = o; }
    LDS_WAIT(); asm volatile("" ::: "memory");
}
__device__ __forceinline__ void store_row_bf16(bf16* orow, int lane, const f32x4 (&v)[4]) {
    GAS unsigned long long* o8 = (GAS unsigned long long*)orow + lane;
#pragma unroll
    for (int j = 0; j < 4; ++j) o8[64 * j] = (unsigned long long)pk2(v[j].x, v[j].y) | ((unsigned long long)pk2(v[j].z, v[j].w) << 32);
}
__device__ __forceinline__ void load_row_bf16(const bf16* irow, int lane, f32x4 (&v)[4]) {
    const GAS v2u* i8 = (const GAS v2u*)irow + lane;
#pragma unroll
    for (int j = 0; j < 4; ++j) { const v2u w = i8[64 * j]; v[j] = (f32x4){bfl(w.x), bfh(w.x), bfl(w.y), bfh(w.y)}; }
}
__device__ __forceinline__ void forget_row(const f32x4 (&v)[4], const LAS float* wff, float* lfrow, int lane) {
    float p[4];
#pragma unroll
    for (int h = 0; h < 4; ++h) { float s = 0.f;
#pragma unroll
        for (int j = 0; j < 4; ++j) { const f32x4 w = *(const LAS f32x4*)(wff + h * 1024 + 256 * j + 4 * lane); s += (v[j].x * w.x + v[j].y * w.y) + (v[j].z * w.z + v[j].w * w.w); }
        p[h] = wave_sum(s) + wff[4096 + h]; }
    if (lane < 4) { const float z = lane == 0 ? p[0] : lane == 1 ? p[1] : lane == 2 ? p[2] : p[3]; lfrow[lane] = log_sigmoid(z); }
}
__device__ __forceinline__ void stage_wff(Frame& F, int l, LAS float* wff) {
    const float* src = (const float*)(F.ws + WS_PAR) + PAR_WFF + l * 4100;
    for (int idx = F.tid; idx < 4100; idx += NWAVES * 64) wff[idx] = src[idx];
}

struct Args { const float* in[15]; float* out; unsigned char* ws; int naive, pad; };
__device__ __forceinline__ void p0_colmax(Frame& F, const Args& A) {
    const int p_lane = F.tid & 63, p_wave = __builtin_amdgcn_readfirstlane(F.tid >> 6);
    const int gw = F.vcu * NWAVES + p_wave, NGW = F.G * NWAVES;
    constexpr int CB_IN = (NIN + 63) / 64, PER_L = (CB_IN + 256) * 8;
    for (int it = gw; it < NLAYER * PER_L; it += NGW) { const int l = it / PER_L, r = it % PER_L, seg = r & 7, cbk = r >> 3;
        const float* W; int N, col; unsigned* cm;
        if (cbk < CB_IN) { W = A.in[I_WIN] + (size_t)l * DM * NIN; N = NIN; col = cbk * 64 + p_lane; cm = (unsigned*)(F.ws + CM_IN) + l * NIN; }
        else { const int e = (cbk - CB_IN) >> 4, cb = (cbk - CB_IN) & 15; W = A.in[I_WEIN] + ((size_t)l * 16 + e) * 1024 * 1024; N = 1024; col = cb * 64 + p_lane; cm = (unsigned*)(F.ws + CM_E) + (l * 16 + e) * 1024; }
        if (col < N) { float m = 0.f; const float* p = W + (size_t)(seg * 128) * N + col;
#pragma unroll 16
            for (int rr = 0; rr < 128; ++rr) m = fmaxf(m, fabsf(p[(size_t)rr * N]));
            __hip_atomic_fetch_max(cm + col, __float_as_uint(m), RLX_AGENT); } }
}
__device__ __forceinline__ void p0_prologue(Frame& F, const Args& A) {
    const int p_lane = F.tid & 63, p_wave = __builtin_amdgcn_readfirstlane(F.tid >> 6);
    LAS float* scr = (LAS float*)(F.lds + RING_OFF + p_wave * 8704);
    LAS float* wff = (LAS float*)(F.lds + RING_OFF + 81920);
    const int gw = F.vcu * NWAVES + p_wave, NGW = F.G * NWAVES;
    { const float* Win0 = A.in[I_WIN]; const float* bin0 = A.in[I_BIN];
      for (int idx = F.tid; idx < 4096; idx += NWAVES * 64) { const int k = idx >> 2, h = idx & 3; wff[h * 1024 + k] = Win0[(size_t)k * NIN + FOX_F_COL + h]; }
      if (F.tid < 4) wff[4096 + F.tid] = bin0[FOX_F_COL + F.tid]; }
    for (int l = 0; l < NLAYER; ++l) {
        unsigned char* wl = F.ws + WS_W + (size_t)l * W_LAYER;
        const float* win = A.in[I_WIN] + (size_t)l * DM * NIN;
        const unsigned* cmin = (const unsigned*)(F.ws + CM_IN) + l * NIN;
        constexpr int I_IN = 16 * 96, I_G = 16 * 128, I_B = 4 * 4 * 32, I_O = 16 * 32, I_E1 = 16 * 16 * 32, I_E2 = 16 * 8 * 32, I_M = 16 * 16;
        constexpr int NITEMS = I_IN + I_G + I_B + I_O + I_E1 + I_E2 + I_M;
        for (int it = gw; it < NITEMS; it += NGW) {
            int r = it;
            if (r < I_IN) { p0_transpose_item_q(win, DM, NIN, (signed char*)(wl + W_IN), 1, cmin, scr, r, 96, p_lane); continue; } r -= I_IN;
            if (r < I_G) { p0_transpose_item_q(win, DM, NIN, (signed char*)(wl + W_G), 2, cmin, scr, r, 128, p_lane); continue; } r -= I_G;
            if (r < I_B) { const int nb = r / 128; p0_transpose_item(A.in[I_WBRANCH] + ((size_t)l * 4 + nb) * 256 * 1024, 256, 1024, (bf16*)(wl + W_B) + (size_t)nb * 1024 * 256, 0, scr, r % 128, 32, p_lane); continue; } r -= I_B;
            if (r < I_O) { p0_transpose_item(A.in[I_WOUT] + (size_t)l * 1024 * 1024, 1024, 1024, (bf16*)(wl + W_OUT), 0, scr, r, 32, p_lane); continue; } r -= I_O;
            if (r < I_E1) { const int e = r / 512; p0_transpose_item_q(A.in[I_WEIN] + ((size_t)l * 16 + e) * 1024 * 1024, 1024, 1024, (signed char*)(wl + W_E1) + (size_t)e * 1024 * 1024, 3, (const unsigned*)(F.ws + CM_E) + (l * 16 + e) * 1024, scr, r % 512, 32, p_lane); continue; } r -= I_E1;
            if (r < I_E2) { const int e = r / 256; p0_transpose_item(A.in[I_WEOUT] + ((size_t)l * 16 + e) * 512 * 1024, 512, 1024, (bf16*)(wl + W_E2) + (size_t)e * 1024 * 512, 0, scr, r % 256, 32, p_lane); continue; } r -= I_E2;
            p0_transpose_item(A.in[I_WMEMKV] + (size_t)l * 1024 * 512, 1024, 512, (bf16*)(F.ws + WS_WMEM) + (size_t)l * 512 * 1024, 0, scr, r, 16, p_lane);
        }
    }
    { const int gt = blockIdx.x * (NWAVES * 64) + F.tid, NGT = F.G * NWAVES * 64;
      float* bp = (float*)(F.ws + WS_BIASP); float* bg = (float*)(F.ws + WS_BIASG);
      float* swp = (float*)(F.ws + WS_SWP); float* swg = (float*)(F.ws + WS_SWG); float* swe = (float*)(F.ws + WS_SWE);
      const unsigned* cmi = (const unsigned*)(F.ws + CM_IN); const unsigned* cme = (const unsigned*)(F.ws + CM_E);
      for (int i = gt; i < NLAYER * NPROJ; i += NGT) { const int l = i / NPROJ, r = i % NPROJ; bp[i] = A.in[I_BIN][(size_t)l * NIN + src_col(1, r)]; swp[i] = fmaxf(__uint_as_float(cmi[l * NIN + src_col(1, r)]), 1e-30f) * (1.0f / 127.0f); }
      for (int i = gt; i < NLAYER * NGATE; i += NGT) { const int l = i / NGATE, r = i % NGATE; bg[i] = A.in[I_BIN][(size_t)l * NIN + src_col(2, r)]; swg[i] = fmaxf(__uint_as_float(cmi[l * NIN + src_col(2, r)]), 1e-30f) * (1.0f / 127.0f); }
      for (int i = gt; i < NLAYER * 16 * 1024; i += NGT) { const int le = i >> 10, r = i & 1023; swe[i] = fmaxf(__uint_as_float(cme[le * 1024 + src_col(3, r)]), 1e-30f) * (1.0f / 127.0f); }
      float* rc = (float*)(F.ws + WS_ROPE); float* rs = rc + SEQ * 32;
      for (int i = gt; i < SEQ * 32; i += NGT) { const int pos = i >> 5, f = i & 31; const float inv = powf(10000.0f, -2.0f * (float)f / 64.0f); const float ang = (float)pos * inv; rc[i] = cosf(ang); rs[i] = sinf(ang); }
      float* par = (float*)(F.ws + WS_PAR);
      for (int i = gt; i < 4096; i += NGT) { par[PAR_LNG + i] = A.in[I_LNG][i]; par[PAR_LNB + i] = A.in[I_LNB][i]; }
      for (int i = gt; i < 16384; i += NGT) par[PAR_WR + i] = A.in[I_WROUTER][i];
      for (int i = gt; i < 16; i += NGT) par[PAR_BR + i] = A.in[I_BROUTER][i];
      for (int i = gt; i < 512; i += NGT) par[PAR_LB + i] = A.in[I_LB][i];
      for (int i = gt; i < 128; i += NGT) par[PAR_NG + i] = A.in[I_NORMG][i];
      for (int i = gt; i < NLAYER * 4096; i += NGT) { const int l = i >> 12, k = (i & 4095) >> 2, h = i & 3; par[PAR_WFF + l * 4100 + h * 1024 + k] = A.in[I_WIN][((size_t)l * DM + k) * NIN + FOX_F_COL + h]; }
      for (int i = gt; i < NLAYER * 4; i += NGT) { const int l = i >> 2, h = i & 3; par[PAR_WFF + l * 4100 + 4096 + h] = A.in[I_BIN][(size_t)l * NIN + FOX_F_COL + h]; } }
    __syncthreads();
    for (int m = gw; m < T; m += NGW) {
        const GAS f32x4* xr = (const GAS f32x4*)(A.in[I_X] + (size_t)m * DM) + p_lane;
        f32x4 v[4];
#pragma unroll
        for (int j = 0; j < 4; ++j) v[j] = xr[64 * j];
        store_row_bf16((bf16*)(F.ws + WS_XB) + (size_t)m * DM, p_lane, v);
        store_row_i8((signed char*)(F.ws + WS_X8) + (size_t)m * DM, (float*)(F.ws + WS_SX) + m, p_lane, v);
        forget_row(v, wff, (float*)(F.ws + WS_LF) + (size_t)m * 4, p_lane);
    }
    for (int m = gw; m < MEMROWS; m += NGW) {
        const GAS f32x4* xr = (const GAS f32x4*)(A.in[I_MEM] + (size_t)m * DM) + p_lane;
        f32x4 v[4];
#pragma unroll
        for (int j = 0; j < 4; ++j) v[j] = xr[64 * j];
        store_row_bf16((bf16*)(F.ws + WS_MEMB) + (size_t)m * DM, p_lane, v);
    }
}

__device__ __forceinline__ void cc_scan(Frame& F) {
    int tid_ = F.tid; OPAQUE_V(tid_); const int c_lane = tid_ & 63, c_wave = __builtin_amdgcn_readfirstlane(tid_ >> 6);
    if (F.bx < BATCH * NH && c_wave == 0) {
        const int bh = F.bx, b = bh >> 2, h = bh & 3, s0 = 32 * c_lane;
        const float* lf = (const float*)(F.ws + WS_LF) + ((size_t)b * SEQ + s0) * 4 + h;
        float loc[32]; float run = 0.f;
#pragma unroll
        for (int i = 0; i < 32; ++i) { run += lf[4 * i]; loc[i] = run; }
        float incl = run;
#pragma unroll
        for (int o = 1; o < 64; o <<= 1) { const float t = __shfl_up(incl, o); if (c_lane >= o) incl += t; }
        const float excl = incl - run;
        float* cc = (float*)(F.ws + WS_CC) + (size_t)bh * SEQ + s0;
#pragma unroll
        for (int i = 0; i < 32; ++i) cc[i] = excl + loc[i];
    }
}

namespace att {
typedef float f32x16 __attribute__((ext_vector_type(16)));
typedef short bf16x8 __attribute__((ext_vector_type(8)));
typedef short s16x4 __attribute__((ext_vector_type(4)));
typedef short v4i16_t __attribute__((ext_vector_type(4)));
constexpr int KBUF = 0, VBUF = 16384, KB_OFF = 32768, ATT_LDS = 32768 + 8192;
constexpr float C2 = 0.125f * 1.4426950408889634f;
__device__ __forceinline__ int crow(int r, int hi) { return (r & 3) + 8 * (r >> 2) + 4 * hi; }
__device__ __forceinline__ s16x4 vtr(const LAS char* p) { return __builtin_bit_cast(s16x4, __builtin_amdgcn_ds_read_tr16_b64_v4i16((LAS v4i16_t*)p)); }
template <bool CAUSAL>
__device__ __forceinline__ void attn_unit(LAS char* lds, const bf16* Qp, int qpitch, const bf16* Kp, const bf16* Vp, int kvpitch, int ntiles, int q0, const float* ccp, bf16* Op, int opitch, int tid) {
    const int lane = tid & 63, wid = __builtin_amdgcn_readfirstlane(tid >> 6), r32 = lane & 31, hi = lane >> 5;
    LAS float* kb = (LAS float*)(lds + KB_OFF);
    if (CAUSAL) { for (int k = tid; k < ntiles * 64; k += 512) kb[k] = -1.4426950408889634f * ccp[k]; }
    bf16x8 qr[4];
#pragma unroll
    for (int d0 = 0; d0 < 4; ++d0) qr[d0] = *(const bf16x8*)(Qp + (size_t)(32 * wid + r32) * qpitch + 16 * d0 + 8 * hi);
    const int kvr = tid >> 3, ch = tid & 7;
    const bf16* kg = Kp + (size_t)kvr * kvpitch + ch * 8; const bf16* vg = Vp + (size_t)kvr * kvpitch + ch * 8;
    const int kl = ch * 1024 + kvr * 16, vl = (ch >> 2) * 4096 + kvr * 64 + (ch & 3) * 16;
    v4u kreg = *(const v4u*)kg, vreg = *(const v4u*)vg;
    *(LAS v4u*)(lds + KBUF + kl) = kreg; *(LAS v4u*)(lds + VBUF + vl) = vreg;
    __syncthreads();
    float mrun = -1e30f, lrun = 0.f; f32x16 o0 = {}, o1 = {};
    const int qabs = q0 + 32 * wid + r32, qwmax = q0 + 32 * wid + 31;
    const int vrd = (4 * hi + ((lane & 15) >> 2)) * 64 + ((lane >> 4) & 1) * 32 + (lane & 3) * 8;
    for (int t = 0; t < ntiles; ++t) {
        const int buf = (t & 1) * 8192;
        if (t + 1 < ntiles) { kreg = *(const v4u*)(kg + (size_t)(t + 1) * 64 * kvpitch); vreg = *(const v4u*)(vg + (size_t)(t + 1) * 64 * kvpitch); }
        const int kv0 = 64 * t;
        if (!CAUSAL || kv0 <= qwmax) {
            const LAS char* Kb = lds + KBUF + buf; const LAS char* Vb = lds + VBUF + buf;
            f32x16 p0 = {}, p1 = {};
#pragma unroll
            for (int d0 = 0; d0 < 4; ++d0) { const bf16x8 a0 = *(const LAS bf16x8*)(Kb + (2 * d0 + hi) * 1024 + r32 * 16), a1 = *(const LAS bf16x8*)(Kb + (2 * d0 + hi) * 1024 + (32 + r32) * 16);
                p0 = __builtin_amdgcn_mfma_f32_32x32x16_bf16(a0, qr[d0], p0, 0, 0, 0); p1 = __builtin_amdgcn_mfma_f32_32x32x16_bf16(a1, qr[d0], p1, 0, 0, 0); }
            float mx = -1e30f;
#pragma unroll
            for (int g = 0; g < 4; ++g) { f32x4 b0 = {0.f, 0.f, 0.f, 0.f}, b1 = {0.f, 0.f, 0.f, 0.f};
                if (CAUSAL) { b0 = *(const LAS f32x4*)(kb + kv0 + 8 * g + 4 * hi); b1 = *(const LAS f32x4*)(kb + kv0 + 32 + 8 * g + 4 * hi); }
#pragma unroll
                for (int j = 0; j < 4; ++j) { const int r = 4 * g + j; float s0 = p0[r] * C2 + b0[j], s1 = p1[r] * C2 + b1[j];
                    if (CAUSAL) { const int kv = kv0 + 8 * g + 4 * hi + j; if (kv > qabs) s0 = -INFINITY; if (kv + 32 > qabs) s1 = -INFINITY; }
                    p0[r] = s0; p1[r] = s1; mx = fmaxf(mx, fmaxf(s0, s1)); } }
            mx = fmaxf(mx, __shfl_xor(mx, 32));
            const float mnew = fmaxf(mrun, mx), alpha = __builtin_amdgcn_exp2f(mrun - mnew); mrun = mnew;
            float rs = 0.f;
#pragma unroll
            for (int r = 0; r < 16; ++r) { p0[r] = __builtin_amdgcn_exp2f(p0[r] - mnew); p1[r] = __builtin_amdgcn_exp2f(p1[r] - mnew); rs += p0[r] + p1[r]; }
            lrun = lrun * alpha + rs;
#pragma unroll
            for (int r = 0; r < 16; ++r) { o0[r] *= alpha; o1[r] *= alpha; }
            bf16x8 pf[4];
#pragma unroll
            for (int s = 0; s < 2; ++s) { pg8::u32x4 w0, w1;
                w0.x = pg8::cvt_pk_bf16(p0[8 * s + 0], p0[8 * s + 1]); w0.y = pg8::cvt_pk_bf16(p0[8 * s + 2], p0[8 * s + 3]); w0.z = pg8::cvt_pk_bf16(p0[8 * s + 4], p0[8 * s + 5]); w0.w = pg8::cvt_pk_bf16(p0[8 * s + 6], p0[8 * s + 7]);
                w1.x = pg8::cvt_pk_bf16(p1[8 * s + 0], p1[8 * s + 1]); w1.y = pg8::cvt_pk_bf16(p1[8 * s + 2], p1[8 * s + 3]); w1.z = pg8::cvt_pk_bf16(p1[8 * s + 4], p1[8 * s + 5]); w1.w = pg8::cvt_pk_bf16(p1[8 * s + 6], p1[8 * s + 7]);
                pf[s] = __builtin_bit_cast(bf16x8, w0); pf[2 + s] = __builtin_bit_cast(bf16x8, w1); }
#pragma unroll
            for (int s = 0; s < 4; ++s) {
                const s16x4 l0 = vtr(Vb + vrd + s * 1024), h0 = vtr(Vb + vrd + s * 1024 + 512), l1 = vtr(Vb + 4096 + vrd + s * 1024), h1 = vtr(Vb + 4096 + vrd + s * 1024 + 512);
                const bf16x8 va = (bf16x8){l0[0], l0[1], l0[2], l0[3], h0[0], h0[1], h0[2], h0[3]}, vb = (bf16x8){l1[0], l1[1], l1[2], l1[3], h1[0], h1[1], h1[2], h1[3]};
                o0 = __builtin_amdgcn_mfma_f32_32x32x16_bf16(va, pf[s], o0, 0, 0, 0); o1 = __builtin_amdgcn_mfma_f32_32x32x16_bf16(vb, pf[s], o1, 0, 0, 0); }
        }
        if (t + 1 < ntiles) { *(LAS v4u*)(lds + KBUF + (buf ^ 8192) + kl) = kreg; *(LAS v4u*)(lds + VBUF + (buf ^ 8192) + vl) = vreg; }
        __syncthreads();
    }
    const float inv = 1.0f / (lrun + __shfl_xor(lrun, 32));
    bf16* orow = Op + (size_t)(32 * wid + r32) * opitch + 4 * hi;
#pragma unroll
    for (int g = 0; g < 4; ++g) { v2u w0, w1;
        w0.x = pg8::cvt_pk_bf16(o0[4 * g] * inv, o0[4 * g + 1] * inv); w0.y = pg8::cvt_pk_bf16(o0[4 * g + 2] * inv, o0[4 * g + 3] * inv);
        w1.x = pg8::cvt_pk_bf16(o1[4 * g] * inv, o1[4 * g + 1] * inv); w1.y = pg8::cvt_pk_bf16(o1[4 * g + 2] * inv, o1[4 * g + 3] * inv);
        *(v2u*)(orow + 8 * g) = w0; *(v2u*)(orow + 32 + 8 * g) = w1; }
}
}
__device__ __forceinline__ void attn_phase(Frame& F, int l) {
    int tid = F.tid; OPAQUE_V(tid);
    LAS char* lds = (LAS char*)(F.lds + RING_OFF);
    const bf16* proj = (const bf16*)(F.ws + WS_PROJ); const bf16* memkv = (const bf16*)(F.ws + WS_MEMKV); const float* cc = (const float*)(F.ws + WS_CC); bf16* br = (bf16*)((unsigned char*)F.out);
    for (int p = F.vcu; p < BATCH * NH * 4; p += F.G) { const int bh = p >> 2, pi = p & 3, b = bh >> 2, h = bh & 3;
        for (int k = 0; k < 2; ++k) { const int qb = k ? 7 - pi : pi, q0 = qb * 256; const size_t row0 = (size_t)b * SEQ;
            att::attn_unit<true>(lds, proj + (row0 + q0) * NPROJ + h * 64, NPROJ, proj + row0 * NPROJ + 256 + h * 64, proj + row0 * NPROJ + 512 + h * 64, NPROJ, q0 / 64 + 4, q0, cc + (size_t)bh * SEQ,
                                 br + (row0 + q0) * 1024 + h * 64, 1024, tid); } }
    for (int u = F.vcu; u < BATCH * NH * 8; u += F.G) { const int bh = u >> 3, qb = u & 7, b = bh >> 2, h = bh & 3, q0 = qb * 256; const size_t row0 = (size_t)b * SEQ;
        const bf16* kp = memkv + (size_t)b * NMEM * 1024 + l * 512 + h * 64;
        att::attn_unit<false>(lds, proj + (row0 + q0) * NPROJ + 2816 + h * 64, NPROJ, kp, kp + 256, 1024, NMEM / 64, q0, nullptr, br + (row0 + q0) * 1024 + 768 + h * 64, 1024, tid); }
}

namespace rec {
using att::f32x16; using att::bf16x8; using att::s16x4; using att::vtr;
constexpr int Q1C = 0, Q2C = 8192, K1C = 16384, K2V = 24576, VV = 32768, ST0 = 40960, ST1 = 49152, OFO = 57344, LFO = 74752, TOTO = 91136, BMO = 93184, BLO = 93440, DECO = 93696;
constexpr int OFP = 68;
__device__ __forceinline__ v2u pk4(float a, float b, float c, float d) { v2u w; w.x = pg8::cvt_pk_bf16(a, b); w.y = pg8::cvt_pk_bf16(c, d); return w; }
template <bool HG>
__device__ __forceinline__ void recur_unit(LAS char* lds, const bf16* pj, bf16* ob, int h, int l, const float* par, const float* rope, int tid) {
    const int lane = tid & 63, wid = __builtin_amdgcn_readfirstlane(tid >> 6), r32 = lane & 31, hi = lane >> 5;
    const int t = tid >> 3, c8 = tid & 7;
    constexpr int CQ = HG ? 2304 : 768, CK = HG ? 1792 : 1024, CV = HG ? 2048 : 1280, CG = HG ? 2560 : 1536;
    const float lg2 = HG ? 0.f : log2f(1.0f - exp2f(-5.0f - (float)h));
    float lbv[8];
#pragma unroll
    for (int e = 0; e < 8; ++e) { lbv[e] = 0.f; if (HG && l == 1) { const float a0 = par[PAR_LB + h * 64 + 8 * c8 + e], a1 = par[PAR_LB + 256 + h * 64 + 8 * c8 + e]; lbv[e] = 1.f / (1.f + expf(a0 - a1)); } }
    float ngv[8];
#pragma unroll
    for (int e = 0; e < 8; ++e) ngv[e] = HG ? par[PAR_NG + l * 64 + 8 * c8 + e] : 1.f;
    for (int i = tid; i < 4096; i += 512) ((LAS unsigned*)(lds + ST0))[i] = 0u;
    if (!HG && tid < 64) ((LAS float*)(lds + DECO))[tid] = exp2f(lg2 * 64.f);
    f32x16 st = {};
    v4u rq, rk, rv, rg; f32x4 rco = {0.f, 0.f, 0.f, 0.f}, rsi = {0.f, 0.f, 0.f, 0.f};
#define REC_LOAD(n) do { const bf16* rp_ = pj + (size_t)((n) * 64 + t) * NPROJ; \
        if (HG) { rq = *(const v4u*)(rp_ + CQ + 8 * c8); rk = *(const v4u*)(rp_ + CK + 8 * c8); } \
        else { const v2u a_ = *(const v2u*)(rp_ + CQ + 4 * c8), b_ = *(const v2u*)(rp_ + CQ + 32 + 4 * c8), c_ = *(const v2u*)(rp_ + CK + 4 * c8), d_ = *(const v2u*)(rp_ + CK + 32 + 4 * c8); \
               rq = (v4u){a_.x, a_.y, b_.x, b_.y}; rk = (v4u){c_.x, c_.y, d_.x, d_.y}; \
               rco = *(const f32x4*)(rope + ((n) * 64 + t) * 32 + 4 * c8); rsi = *(const f32x4*)(rope + SEQ * 32 + ((n) * 64 + t) * 32 + 4 * c8); } \
        rv = *(const v4u*)(rp_ + CV + 8 * c8); rg = *(const v4u*)(rp_ + CG + 8 * c8); } while (0)
    REC_LOAD(0);
    __syncthreads();
#pragma unroll 1
    for (int n = 0; n < SEQ / 64; ++n) {
        const v4u gcur = rg;
        if (!HG) {
            const float q1[4] = {bfl(rq.x), bfh(rq.x), bfl(rq.y), bfh(rq.y)}, q2[4] = {bfl(rq.z), bfh(rq.z), bfl(rq.w), bfh(rq.w)};
            const float k1[4] = {bfl(rk.x), bfh(rk.x), bfl(rk.y), bfh(rk.y)}, k2[4] = {bfl(rk.z), bfh(rk.z), bfl(rk.w), bfh(rk.w)};
            float qa[4], qb[4], ka[4], kb[4];
#pragma unroll
            for (int e = 0; e < 4; ++e) { qa[e] = q1[e] * rco[e] - q2[e] * rsi[e]; qb[e] = q1[e] * rsi[e] + q2[e] * rco[e]; ka[e] = (k1[e] * rco[e] - k2[e] * rsi[e]) * 0.125f; kb[e] = (k1[e] * rsi[e] + k2[e] * rco[e]) * 0.125f; }
            const float gq = exp2f(lg2 * (float)(t + 1)), gk = exp2f(lg2 * (float)(63 - t));
            const int ca = (c8 >> 1) * 1024 + t * 16 + 8 * (c8 & 1), cb = ca + 4096;
            *(LAS v2u*)(lds + Q1C + ca) = pk4(qa[0], qa[1], qa[2], qa[3]); *(LAS v2u*)(lds + Q1C + cb) = pk4(qb[0], qb[1], qb[2], qb[3]);
            *(LAS v2u*)(lds + Q2C + ca) = pk4(qa[0] * gq, qa[1] * gq, qa[2] * gq, qa[3] * gq); *(LAS v2u*)(lds + Q2C + cb) = pk4(qb[0] * gq, qb[1] * gq, qb[2] * gq, qb[3] * gq);
            *(LAS v2u*)(lds + K1C + ca) = pk4(ka[0], ka[1], ka[2], ka[3]); *(LAS v2u*)(lds + K1C + cb) = pk4(kb[0], kb[1], kb[2], kb[3]);
            const int va = t * 64 + 8 * c8;
            *(LAS v2u*)(lds + K2V + va) = pk4(ka[0] * gk, ka[1] * gk, ka[2] * gk, ka[3] * gk); *(LAS v2u*)(lds + K2V + 4096 + va) = pk4(kb[0] * gk, kb[1] * gk, kb[2] * gk, kb[3] * gk);
            *(LAS v4u*)(lds + VV + (c8 >> 2) * 4096 + t * 64 + (c8 & 3) * 16) = rv;
        } else {
            const float zf[8] = {bfl(rk.x), bfh(rk.x), bfl(rk.y), bfh(rk.y), bfl(rk.z), bfh(rk.z), bfl(rk.w), bfh(rk.w)};
            float kf[8], lf[8];
#pragma unroll
            for (int e = 0; e < 8; ++e) { const float ez = expf(-zf[e]); const float sg = 1.f / (1.f + ez); const float f = lbv[e] + (1.f - lbv[e]) * sg; lf[e] = logf(f); kf[e] = (1.f - lbv[e]) * (ez / (1.f + ez)); }
            LAS float* LF = (LAS float*)(lds + LFO);
            *(LAS f32x4*)(LF + t * 64 + 8 * c8) = (f32x4){lf[0], lf[1], lf[2], lf[3]}; *(LAS f32x4*)(LF + t * 64 + 8 * c8 + 4) = (f32x4){lf[4], lf[5], lf[6], lf[7]};
            __syncthreads();
            float loc[8]; { float run = 0.f;
#pragma unroll
                for (int tt = 0; tt < 8; ++tt) { run += LF[(8 * wid + tt) * 64 + lane]; loc[tt] = run; } }
            LAS float* TOT = (LAS float*)(lds + TOTO); TOT[wid * 64 + lane] = loc[7];
            __syncthreads();
            { float pre = 0.f;
#pragma unroll
              for (int w2 = 0; w2 < 7; ++w2) pre += (w2 < wid) ? TOT[w2 * 64 + lane] : 0.f;
#pragma unroll
              for (int tt = 0; tt < 8; ++tt) LF[(8 * wid + tt) * 64 + lane] = pre + loc[tt];
              if (wid == 3) ((LAS float*)(lds + BMO))[lane] = pre + loc[7];
              if (wid == 7) ((LAS float*)(lds + BLO))[lane] = pre + loc[7]; }
            __syncthreads();
            const f32x4 b0 = *(const LAS f32x4*)(LF + t * 64 + 8 * c8), b1 = *(const LAS f32x4*)(LF + t * 64 + 8 * c8 + 4);
            const f32x4 m0 = *(const LAS f32x4*)((LAS float*)(lds + BMO) + 8 * c8), m1 = *(const LAS f32x4*)((LAS float*)(lds + BMO) + 8 * c8 + 4);
            const f32x4 l0 = *(const LAS f32x4*)((LAS float*)(lds + BLO) + 8 * c8), l1 = *(const LAS f32x4*)((LAS float*)(lds + BLO) + 8 * c8 + 4);
            const float bb[8] = {b0[0], b0[1], b0[2], b0[3], b1[0], b1[1], b1[2], b1[3]}, bm[8] = {m0[0], m0[1], m0[2], m0[3], m1[0], m1[1], m1[2], m1[3]}, bl[8] = {l0[0], l0[1], l0[2], l0[3], l1[0], l1[1], l1[2], l1[3]};
            const float qv[8] = {bfl(rq.x), bfh(rq.x), bfl(rq.y), bfh(rq.y), bfl(rq.z), bfh(rq.z), bfl(rq.w), bfh(rq.w)};
            float A1[8], A2[8], B1[8], B2[8];
#pragma unroll
            for (int e = 0; e < 8; ++e) { A1[e] = qv[e] * expf(fminf(bb[e] - bm[e], 80.f)); A2[e] = qv[e] * expf(bb[e]); B1[e] = kf[e] * expf(fminf(bm[e] - bb[e], 80.f)); B2[e] = kf[e] * expf(bl[e] - bb[e]); }
            const int ca = c8 * 1024 + t * 16, va = (c8 >> 2) * 4096 + t * 64 + (c8 & 3) * 16;
#define PK8(x) (v4u){pg8::cvt_pk_bf16(x[0], x[1]), pg8::cvt_pk_bf16(x[2], x[3]), pg8::cvt_pk_bf16(x[4], x[5]), pg8::cvt_pk_bf16(x[6], x[7])}
            *(LAS v4u*)(lds + Q1C + ca) = PK8(A1); *(LAS v4u*)(lds + Q2C + ca) = PK8(A2); *(LAS v4u*)(lds + K1C + ca) = PK8(B1); *(LAS v4u*)(lds + K2V + va) = PK8(B2);
#undef PK8
            *(LAS v4u*)(lds + VV + va) = rv;
            if (t == 0) {
#pragma unroll
                for (int e = 0; e < 8; ++e) ((LAS float*)(lds + DECO))[8 * c8 + e] = expf(bl[e]); }
        }
        if (n + 1 < SEQ / 64) REC_LOAD(n + 1);
        __syncthreads();
        const int stc = (n & 1) ? ST1 : ST0, stn = (n & 1) ? ST0 : ST1;
        const int vrd = (4 * hi + ((lane & 15) >> 2)) * 64 + ((lane >> 4) & 1) * 32 + (lane & 3) * 8;
        if (wid < 4) {
            const int tv = wid >> 1, ti = wid & 1;
            bf16x8 pf[4];
#pragma unroll
            for (int tj = 0; tj < 2; ++tj) {
                f32x16 p = {};
                if (!HG || tj <= ti) {
#pragma unroll
                    for (int ks = 0; ks < 4; ++ks) { const bf16x8 a = *(const LAS bf16x8*)(lds + K1C + (2 * ks + hi) * 1024 + (32 * tj + r32) * 16), b = *(const LAS bf16x8*)(lds + Q1C + (2 * ks + hi) * 1024 + (32 * ti + r32) * 16);
                        p = __builtin_amdgcn_mfma_f32_32x32x16_bf16(a, b, p, 0, 0, 0); }
                    const int iabs = 32 * ti + r32;
#pragma unroll
                    for (int r = 0; r < 16; ++r) { const int jabs = 32 * tj + (r & 3) + 8 * (r >> 2) + 4 * hi;
                        if (HG) p[r] = (jabs <= iabs) ? p[r] : 0.f; else p[r] *= exp2f(lg2 * fabsf((float)(iabs - jabs))); }
                }
                pg8::u32x4 w0, w1;
                w0.x = pg8::cvt_pk_bf16(p[0], p[1]); w0.y = pg8::cvt_pk_bf16(p[2], p[3]); w0.z = pg8::cvt_pk_bf16(p[4], p[5]); w0.w = pg8::cvt_pk_bf16(p[6], p[7]);
                w1.x = pg8::cvt_pk_bf16(p[8], p[9]); w1.y = pg8::cvt_pk_bf16(p[10], p[11]); w1.z = pg8::cvt_pk_bf16(p[12], p[13]); w1.w = pg8::cvt_pk_bf16(p[14], p[15]);
                pf[2 * tj] = __builtin_bit_cast(bf16x8, w0); pf[2 * tj + 1] = __builtin_bit_cast(bf16x8, w1);
            }
            f32x16 o = {};
#pragma unroll
            for (int ks = 0; ks < 4; ++ks) { const bf16x8 a = *(const LAS bf16x8*)(lds + stc + (2 * ks + hi) * 1024 + (32 * tv + r32) * 16), b = *(const LAS bf16x8*)(lds + Q2C + (2 * ks + hi) * 1024 + (32 * ti + r32) * 16);
                o = __builtin_amdgcn_mfma_f32_32x32x16_bf16(a, b, o, 0, 0, 0); }
#pragma unroll
            for (int s2 = 0; s2 < 4; ++s2) { const s16x4 lo = vtr(lds + VV + tv * 4096 + vrd + s2 * 1024), hh = vtr(lds + VV + tv * 4096 + vrd + s2 * 1024 + 512);
                const bf16x8 va = (bf16x8){lo[0], lo[1], lo[2], lo[3], hh[0], hh[1], hh[2], hh[3]};
                o = __builtin_amdgcn_mfma_f32_32x32x16_bf16(va, pf[s2], o, 0, 0, 0); }
            LAS float* OFp = (LAS float*)(lds + OFO) + (32 * ti + r32) * OFP + 32 * tv + 4 * hi;
#pragma unroll
            for (int g = 0; g < 4; ++g) *(LAS f32x4*)(OFp + 8 * g) = (f32x4){o[4 * g], o[4 * g + 1], o[4 * g + 2], o[4 * g + 3]};
        } else {
            const int td = (wid - 4) & 1, tv = (wid - 4) >> 1;
            f32x16 pr = {};
#pragma unroll
            for (int s2 = 0; s2 < 4; ++s2) { const s16x4 lo = vtr(lds + VV + tv * 4096 + vrd + s2 * 1024), hh = vtr(lds + VV + tv * 4096 + vrd + s2 * 1024 + 512);
                const s16x4 ko = vtr(lds + K2V + td * 4096 + vrd + s2 * 1024), kh = vtr(lds + K2V + td * 4096 + vrd + s2 * 1024 + 512);
                const bf16x8 va = (bf16x8){lo[0], lo[1], lo[2], lo[3], hh[0], hh[1], hh[2], hh[3]}, kb2 = (bf16x8){ko[0], ko[1], ko[2], ko[3], kh[0], kh[1], kh[2], kh[3]};
                pr = __builtin_amdgcn_mfma_f32_32x32x16_bf16(va, kb2, pr, 0, 0, 0); }
            const float dec = ((LAS float*)(lds + DECO))[32 * td + r32];
            const int d = 32 * td + r32;
            LAS bf16* stw = (LAS bf16*)(lds + stn + (d >> 3) * 1024 + (d & 7) * 2);
#pragma unroll
            for (int r = 0; r < 16; ++r) { st[r] = st[r] * dec + pr[r]; const int v = 32 * tv + (r & 3) + 8 * (r >> 2) + 4 * hi; stw[v * 8] = (bf16)f2bf(st[r]); }
        }
        __syncthreads();
        { const LAS float* OFr = (const LAS float*)(lds + OFO) + t * OFP + 8 * c8;
          const f32x4 x0 = *(const LAS f32x4*)OFr, x1 = *(const LAS f32x4*)(OFr + 4);
          float ov[8] = {x0[0], x0[1], x0[2], x0[3], x1[0], x1[1], x1[2], x1[3]};
          float s1 = 0.f;
          if (!HG) {
#pragma unroll
              for (int e = 0; e < 8; ++e) s1 += ov[e];
              s1 += __shfl_xor(s1, 1); s1 += __shfl_xor(s1, 2); s1 += __shfl_xor(s1, 4);
              const float mean = s1 * (1.f / 64.f);
#pragma unroll
              for (int e = 0; e < 8; ++e) ov[e] -= mean; }
          float ss = 0.f;
#pragma unroll
          for (int e = 0; e < 8; ++e) ss += ov[e] * ov[e];
          ss += __shfl_xor(ss, 1); ss += __shfl_xor(ss, 2); ss += __shfl_xor(ss, 4);
          const float rr = rsqrtf(ss * (1.f / 64.f) + GN_EPS);
          const float gv[8] = {bfl(gcur.x), bfh(gcur.x), bfl(gcur.y), bfh(gcur.y), bfl(gcur.z), bfh(gcur.z), bfl(gcur.w), bfh(gcur.w)};
          float y[8];
#pragma unroll
          for (int e = 0; e < 8; ++e) y[e] = ov[e] * rr * ngv[e] * gv[e] / (1.f + expf(-gv[e]));
          *(v4u*)(ob + (size_t)(n * 64 + t) * 1024 + 8 * c8) = (v4u){pg8::cvt_pk_bf16(y[0], y[1]), pg8::cvt_pk_bf16(y[2], y[3]), pg8::cvt_pk_bf16(y[4], y[5]), pg8::cvt_pk_bf16(y[6], y[7])}; }
    }
    __syncthreads();
#undef REC_LOAD
}
}
__device__ __forceinline__ void recur_phase(Frame& F, int l) {
    int tid = F.tid; OPAQUE_V(tid);
    LAS char* lds = (LAS char*)(F.lds + RING_OFF);
    const bf16* proj = (const bf16*)(F.ws + WS_PROJ); bf16* br = (bf16*)((unsigned char*)F.out); const float* par = (const float*)(F.ws + WS_PAR); const float* rope = (const float*)(F.ws + WS_ROPE);
    for (int u = F.vcu; u < 2 * BATCH * NH; u += F.G) { const int bh = u & 127, b = bh >> 2, h = bh & 3; const size_t row0 = (size_t)b * SEQ;
        if (u < 128) rec::recur_unit<false>(lds, proj + row0 * NPROJ + h * 64, br + row0 * 1024 + 256 + h * 64, h, l, par, rope, tid);
        else rec::recur_unit<true>(lds, proj + row0 * NPROJ + h * 64, br + row0 * 1024 + 512 + h * 64, h, l, par, rope, tid); }
}

__device__ __forceinline__ void naive_attn(Frame& F, int l) {
    int tid_ = F.tid; OPAQUE_V(tid_); const int lane = tid_ & 63, wave_ = __builtin_amdgcn_readfirstlane(tid_ >> 6);
    const int gw = F.vcu * NWAVES + wave_, NGW = F.G * NWAVES;
    const bf16* proj = (const bf16*)(F.ws + WS_PROJ); const bf16* memkv = (const bf16*)(F.ws + WS_MEMKV);
    const float* cc = (const float*)(F.ws + WS_CC); bf16* br = (bf16*)((unsigned char*)F.out);
    constexpr int BHS = BATCH * NH * SEQ;
    for (int it = gw; it < 2 * BHS; it += NGW) {
        const bool is_mem = it >= BHS; const int r = is_mem ? it - BHS : it; const int bh = r / SEQ, s = r % SEQ, b = bh >> 2, h = bh & 3;
        const size_t tok = (size_t)b * SEQ + s;
        const bf16* qp = proj + tok * NPROJ + (is_mem ? 2816 : 0) + h * 64;
        float q[64];
#pragma unroll
        for (int c = 0; c < 8; ++c) { const v4u w = *(const v4u*)(qp + 8 * c); q[8 * c + 0] = bfl(w.x); q[8 * c + 1] = bfh(w.x); q[8 * c + 2] = bfl(w.y); q[8 * c + 3] = bfh(w.y); q[8 * c + 4] = bfl(w.z); q[8 * c + 5] = bfh(w.z); q[8 * c + 6] = bfl(w.w); q[8 * c + 7] = bfh(w.w); }
        const int nkeys = is_mem ? NMEM : s + 1;
        const bf16* kbase = is_mem ? memkv + (size_t)b * NMEM * 1024 + l * 512 + h * 64 : proj + (size_t)b * SEQ * NPROJ + 256 + h * 64;
        const size_t kpitch = is_mem ? 1024 : NPROJ; const int voff = 256;
        const float cq = is_mem ? 0.f : cc[(size_t)bh * SEQ + s];
        float mrun = -1e30f, lrun = 0.f; float o[64];
#pragma unroll
        for (int d = 0; d < 64; ++d) o[d] = 0.f;
        for (int k0 = 0; k0 < nkeys; k0 += 64) { const int kk = k0 + lane;
            if (kk < nkeys) { const bf16* kp = kbase + (size_t)kk * kpitch; float dot = 0.f;
#pragma unroll
                for (int c = 0; c < 8; ++c) { const v4u w = *(const v4u*)(kp + 8 * c);
                    dot += q[8 * c + 0] * bfl(w.x) + q[8 * c + 1] * bfh(w.x) + q[8 * c + 2] * bfl(w.y) + q[8 * c + 3] * bfh(w.y) + q[8 * c + 4] * bfl(w.z) + q[8 * c + 5] * bfh(w.z) + q[8 * c + 6] * bfl(w.w) + q[8 * c + 7] * bfh(w.w); }
                float sv = dot * 0.125f; if (!is_mem) sv += cq - cc[(size_t)bh * SEQ + kk];
                const float mn = fmaxf(mrun, sv), corr = expf(mrun - mn), p = expf(sv - mn); mrun = mn; lrun = lrun * corr + p;
                const bf16* vp = kp + voff;
#pragma unroll
                for (int c = 0; c < 8; ++c) { const v4u w = *(const v4u*)(vp + 8 * c);
                    o[8 * c + 0] = o[8 * c + 0] * corr + p * bfl(w.x); o[8 * c + 1] = o[8 * c + 1] * corr + p * bfh(w.x); o[8 * c + 2] = o[8 * c + 2] * corr + p * bfl(w.y); o[8 * c + 3] = o[8 * c + 3] * corr + p * bfh(w.y);
                    o[8 * c + 4] = o[8 * c + 4] * corr + p * bfl(w.z); o[8 * c + 5] = o[8 * c + 5] * corr + p * bfh(w.z); o[8 * c + 6] = o[8 * c + 6] * corr + p * bfl(w.w); o[8 * c + 7] = o[8 * c + 7] * corr + p * bfh(w.w); } } }
        const float M = wave_max(mrun), sc = expf(mrun - M), L = wave_sum(lrun * sc);
        float res = 0.f;
#pragma unroll
        for (int d = 0; d < 64; ++d) { const float v = wave_sum(o[d] * sc); if (lane == d) res = v; }
        br[tok * 1024 + (is_mem ? 768 : 0) + h * 64 + lane] = (bf16)f2bf(res / L);
    }
}
__device__ __forceinline__ void naive_recur(Frame& F, int l) {
    int tid = F.tid; OPAQUE_V(tid); const int lane = tid & 63, wave = __builtin_amdgcn_readfirstlane(tid >> 6);
    const bf16* proj = (const bf16*)(F.ws + WS_PROJ); bf16* br = (bf16*)((unsigned char*)F.out);
    LAS float* L0 = (LAS float*)(F.lds + RING_OFF);
    if (F.bx < 128) {
        const int bh = F.bx, b = bh >> 2, h = bh & 3;
        LAS float* qr = L0; LAS float* kr = L0 + 4096; LAS float* vv = L0 + 8192; LAS float* sc = L0 + 12288; LAS float* st = L0 + 16384;
        const float* rc = (const float*)(F.ws + WS_ROPE); const float* rs = rc + SEQ * 32;
        const float lg = log1pf(-exp2f(-5.0f - (float)h));
        for (int i = tid; i < 4096; i += 512) st[i] = 0.f;
#pragma unroll 1
        for (int n = 0; n < SEQ / 64; ++n) {
            const size_t row0 = (size_t)b * SEQ + n * 64;
            for (int idx = tid; idx < 2048; idx += 512) { const int t = idx >> 5, c = idx & 31; const bf16* p = proj + (row0 + t) * NPROJ + h * 64;
                const float co = rc[(n * 64 + t) * 32 + c], si = rs[(n * 64 + t) * 32 + c];
                const float q1 = bf1(p[768 + c]), q2 = bf1(p[768 + c + 32]), k1 = bf1(p[1024 + c]), k2 = bf1(p[1024 + c + 32]);
                qr[t * 64 + c] = q1 * co - q2 * si; qr[t * 64 + c + 32] = q1 * si + q2 * co;
                kr[t * 64 + c] = (k1 * co - k2 * si) * 0.125f; kr[t * 64 + c + 32] = (k1 * si + k2 * co) * 0.125f;
                vv[t * 64 + c] = bf1(p[1280 + c]); vv[t * 64 + c + 32] = bf1(p[1280 + c + 32]); }
            __syncthreads();
#pragma unroll 1
            for (int j = 0; j < 8; ++j) { const int idx = tid + 512 * j, i = idx >> 6, jj = idx & 63; float s = 0.f;
#pragma unroll 4
                for (int d = 0; d < 64; ++d) s += qr[i * 64 + d] * kr[jj * 64 + d];
                sc[idx] = s * expf(lg * fabsf((float)(i - jj))); }
            __syncthreads();
            float oreg[8];
#pragma unroll
            for (int j = 0; j < 8; ++j) { const int idx = tid + 512 * j, i = idx >> 6, v = idx & 63; float s = 0.f, s2 = 0.f;
#pragma unroll 4
                for (int jj = 0; jj < 64; ++jj) s += sc[i * 64 + jj] * vv[jj * 64 + v];
#pragma unroll 4
                for (int d = 0; d < 64; ++d) s2 += qr[i * 64 + d] * st[d * 64 + v];
                oreg[j] = s + expf(lg * (float)(i + 1)) * s2; }
            __syncthreads();
#pragma unroll 1
            for (int j = 0; j < 8; ++j) { const int idx = tid + 512 * j, d = idx >> 6, v = idx & 63; float s = 0.f;
#pragma unroll 2
                for (int jj = 0; jj < 64; ++jj) s += kr[jj * 64 + d] * expf(lg * (float)(63 - jj)) * vv[jj * 64 + v];
                st[idx] = expf(lg * 64.0f) * st[idx] + s; }
            for (int j = 0; j < 8; ++j) { const int i = wave + 8 * j;
                const float mean = wave_sum(oreg[j]) * (1.f / 64.f), dv = oreg[j] - mean, var = wave_sum(dv * dv) * (1.f / 64.f);
                const float g = bf1(proj[(row0 + i) * NPROJ + 1536 + h * 64 + lane]);
                br[(row0 + i) * 1024 + 256 + h * 64 + lane] = (bf16)f2bf(dv * rsqrtf(var + GN_EPS) * g / (1.f + expf(-g))); }
            __syncthreads();
        }
    } else {
        const int bh = F.bx - 128, b = bh >> 2, h = bh & 3;
        if (bh >= 128) return;
        LAS float* qf = L0; LAS float* ff = L0 + 4096; LAS float* kf = L0 + 8192; LAS float* iv = L0 + 12288; LAS float* ob = L0 + 16384;
        const int v = tid >> 3, k8 = tid & 7;
        float Sreg[8];
#pragma unroll
        for (int i = 0; i < 8; ++i) Sreg[i] = 0.f;
        const float* lbp = (const float*)(F.ws + WS_PAR) + PAR_LB;
#pragma unroll 1
        for (int n = 0; n < SEQ / 64; ++n) {
            const size_t row0 = (size_t)b * SEQ + n * 64;
            for (int j = 0; j < 8; ++j) { const int idx = tid + 512 * j, t = idx >> 6, c = idx & 63; const bf16* p = proj + (row0 + t) * NPROJ + h * 64 + c;
                float lb = 0.f; if (l == 1) { const float a0 = lbp[h * 64 + c], a1 = lbp[256 + h * 64 + c]; lb = 1.f / (1.f + expf(a0 - a1)); }
                const float zf = bf1(p[1792]); const float kfv = (1.f - lb) / (1.f + expf(zf));
                qf[idx] = bf1(p[2304]); ff[idx] = 1.f - kfv; kf[idx] = kfv; iv[idx] = bf1(p[2048]); }
            __syncthreads();
#pragma unroll 1
            for (int t = 0; t < 64; ++t) { const float ivt = iv[t * 64 + v]; float p = 0.f;
#pragma unroll
                for (int i = 0; i < 8; ++i) { const int k = k8 * 8 + i; Sreg[i] = ff[t * 64 + k] * Sreg[i] + kf[t * 64 + k] * ivt; p += Sreg[i] * qf[t * 64 + k]; }
                p += __shfl_xor(p, 1); p += __shfl_xor(p, 2); p += __shfl_xor(p, 4);
                if (k8 == 0) ob[t * 64 + v] = p; }
            __syncthreads();
            { const int t = tid >> 3, seg = tid & 7; float ov[8]; float ss = 0.f;
#pragma unroll
              for (int i = 0; i < 8; ++i) { ov[i] = ob[t * 64 + seg * 8 + i]; ss += ov[i] * ov[i]; }
              ss += __shfl_xor(ss, 1); ss += __shfl_xor(ss, 2); ss += __shfl_xor(ss, 4);
              const float rr = rsqrtf(ss * (1.f / 64.f) + GN_EPS);
              const bf16* gp = proj + (row0 + t) * NPROJ + 2560 + h * 64 + seg * 8; const float* ng = (const float*)(F.ws + WS_PAR) + PAR_NG + l * 64 + seg * 8;
              unsigned w[4];
#pragma unroll
              for (int i = 0; i < 4; ++i) { const float g0 = bf1(gp[2 * i]), g1 = bf1(gp[2 * i + 1]);
                  w[i] = pk2(ov[2 * i] * rr * ng[2 * i] * g0 / (1.f + expf(-g0)), ov[2 * i + 1] * rr * ng[2 * i + 1] * g1 / (1.f + expf(-g1))); }
              *(v4u*)(br + (row0 + t) * 1024 + 512 + h * 64 + seg * 8) = (v4u){w[0], w[1], w[2], w[3]}; }
            __syncthreads();
        }
    }
}

__device__ __forceinline__ void ln1_phase(Frame& F, int l, bool commit = true) {
    LAS float* WrT = (LAS float*)(F.lds + RING_OFF);
    LAS int* se1 = (LAS int*)(F.lds + RING_OFF + 65536); LAS int* se2 = se1 + 256; LAS float* sw = (LAS float*)(se2 + 256);
    LAS int* hist = (LAS int*)(F.lds + SM_OFF + 256); LAS int* base = hist + 16;
    int tid = F.tid; OPAQUE_V(tid); const int lane = tid & 63, wave = __builtin_amdgcn_readfirstlane(tid >> 6);
    for (int idx = tid; idx < 16384; idx += 512) { const int d = idx >> 4, e = idx & 15; WrT[e * 1024 + d] = ((const float*)(F.ws + WS_PAR))[PAR_WR + idx]; }
    if (tid < 16) hist[tid] = 0;
    __syncthreads();
    const bf16* xb = (const bf16*)(F.ws + WS_XB); const bf16* yb = (const bf16*)(F.ws + WS_Y); bf16* x1b = (bf16*)(F.ws + WS_X1B);
    const float* lng = (const float*)(F.ws + WS_PAR) + PAR_LNG + (l * 2 + 0) * DM; const float* lnb = (const float*)(F.ws + WS_PAR) + PAR_LNB + (l * 2 + 0) * DM;
    f32x4 gg[4], bb[4];
#pragma unroll
    for (int j = 0; j < 4; ++j) { gg[j] = *(const f32x4*)(lng + 256 * j + 4 * lane); bb[j] = *(const f32x4*)(lnb + 256 * j + 4 * lane); }
    for (int rb = F.bx; rb < T / 256; rb += F.G) {
        for (int i = 0; i < 32; ++i) { const int rl = wave * 32 + i; const size_t row = (size_t)rb * 256 + rl;
            f32x4 xv[4], yv[4]; load_row_bf16(xb + row * DM, lane, xv); load_row_bf16(yb + row * DM, lane, yv);
            float s = 0.f;
#pragma unroll
            for (int j = 0; j < 4; ++j) { xv[j] = xv[j] * ALPHA + yv[j]; s += (xv[j].x + xv[j].y) + (xv[j].z + xv[j].w); }
            const float mean = wave_sum(s) * (1.f / DM); float s2 = 0.f;
#pragma unroll
            for (int j = 0; j < 4; ++j) { xv[j] = xv[j] - mean; s2 += (xv[j].x * xv[j].x + xv[j].y * xv[j].y) + (xv[j].z * xv[j].z + xv[j].w * xv[j].w); }
            const float rstd = 1.f / sqrtf(wave_sum(s2) * (1.f / DM) + LN_EPS);
#pragma unroll
            for (int j = 0; j < 4; ++j) xv[j] = xv[j] * rstd * gg[j] + bb[j];
            store_row_bf16(x1b + row * DM, lane, xv);
            store_row_i8((signed char*)(F.ws + WS_X18) + row * DM, (float*)(F.ws + WS_S1) + row, lane, xv);
            float lg[16];
#pragma unroll
            for (int e = 0; e < 16; ++e) { float p = 0.f;
#pragma unroll
                for (int j = 0; j < 4; ++j) { const f32x4 w = *(const LAS f32x4*)(WrT + e * 1024 + 256 * j + 4 * lane); p += (xv[j].x * w.x + xv[j].y * w.y) + (xv[j].z * w.z + xv[j].w * w.w); }
                lg[e] = wave_sum(p) + ((const float*)(F.ws + WS_PAR))[PAR_BR + e]; }
            float gm[4];
#pragma unroll
            for (int g = 0; g < 4; ++g) gm[g] = fmaxf(fmaxf(lg[4 * g], lg[4 * g + 1]), fmaxf(lg[4 * g + 2], lg[4 * g + 3]));
            int gs = 0; float gb = gm[0];
#pragma unroll
            for (int g = 1; g < 4; ++g) if (gm[g] > gb) { gb = gm[g]; gs = g; }
            float v0 = gs == 0 ? lg[0] : gs == 1 ? lg[4] : gs == 2 ? lg[8] : lg[12], v1 = gs == 0 ? lg[1] : gs == 1 ? lg[5] : gs == 2 ? lg[9] : lg[13];
            float v2 = gs == 0 ? lg[2] : gs == 1 ? lg[6] : gs == 2 ? lg[10] : lg[14], v3 = gs == 0 ? lg[3] : gs == 1 ? lg[7] : gs == 2 ? lg[11] : lg[15];
            int i1 = 0; float m1 = v0; if (v1 > m1) { m1 = v1; i1 = 1; } if (v2 > m1) { m1 = v2; i1 = 2; } if (v3 > m1) { m1 = v3; i1 = 3; }
            int i2 = -1; float m2 = -3.0e38f;
            if (i1 != 0 && v0 > m2) { m2 = v0; i2 = 0; } if (i1 != 1 && v1 > m2) { m2 = v1; i2 = 1; } if (i1 != 2 && v2 > m2) { m2 = v2; i2 = 2; } if (i1 != 3 && v3 > m2) { m2 = v3; i2 = 3; }
            if (lane == 0) { const int e1 = gs * 4 + i1, e2 = gs * 4 + i2;
                const int r1 = __hip_atomic_fetch_add(hist + e1, 1, __ATOMIC_RELAXED, __HIP_MEMORY_SCOPE_WORKGROUP), r2 = __hip_atomic_fetch_add(hist + e2, 1, __ATOMIC_RELAXED, __HIP_MEMORY_SCOPE_WORKGROUP);
                se1[rl] = e1 | (r1 << 8); se2[rl] = e2 | (r2 << 8); sw[rl] = 1.f / (1.f + expf(m2 - m1)); }
        }
        __syncthreads();
        if (tid < 16 && commit) { base[tid] = (int)__hip_atomic_fetch_add((unsigned*)(F.ctl + CW_CNT + (l * 16 + tid) * 64), (unsigned)hist[tid], RLX_AGENT); }
        __syncthreads();
        if (commit) { const int rl = tid >> 1, k = tid & 1; const int v = k ? se2[rl] : se1[rl]; const int e = v & 255, r = v >> 8; const int slot = (rb * 256 + rl) * 2 + k;
          ((int*)(F.ws + WS_LIST))[(size_t)e * LISTCAP + base[e] + r] = slot; ((float*)(F.ws + WS_WT))[slot] = k ? 1.f - sw[rl] : sw[rl]; }
        __syncthreads();
        if (tid < 16) hist[tid] = 0;
        __syncthreads();
    }
}

__device__ __forceinline__ void ln2_phase(Frame& F, int l) {
    LAS float* wff = (LAS float*)(F.lds + RING_OFF + 81920);
    int tid_ = F.tid; OPAQUE_V(tid_); const int lane = tid_ & 63, wave_ = __builtin_amdgcn_readfirstlane(tid_ >> 6); const bool last = (l == NLAYER - 1);
    if (!last) { stage_wff(F, l + 1, wff); }
    __syncthreads();
    const int gw = F.vcu * NWAVES + wave_, NGW = F.G * NWAVES;
    const bf16* x1b = (const bf16*)(F.ws + WS_X1B); const bf16* y2 = (const bf16*)((unsigned char*)F.out); bf16* xb = (bf16*)(F.ws + WS_XB);
    const float* lng = (const float*)(F.ws + WS_PAR) + PAR_LNG + (l * 2 + 1) * DM; const float* lnb = (const float*)(F.ws + WS_PAR) + PAR_LNB + (l * 2 + 1) * DM;
    f32x4 gg[4], bb[4];
#pragma unroll
    for (int j = 0; j < 4; ++j) { gg[j] = *(const f32x4*)(lng + 256 * j + 4 * lane); bb[j] = *(const f32x4*)(lnb + 256 * j + 4 * lane); }
    for (int m = gw; m < T; m += NGW) {
        f32x4 xv[4], ya[4], yb[4]; load_row_bf16(x1b + (size_t)m * DM, lane, xv); load_row_bf16(y2 + (size_t)(2 * m) * DM, lane, ya); load_row_bf16(y2 + (size_t)(2 * m + 1) * DM, lane, yb);
        float s = 0.f;
#pragma unroll
        for (int j = 0; j < 4; ++j) { xv[j] = xv[j] * ALPHA + (ya[j] + yb[j]); s += (xv[j].x + xv[j].y) + (xv[j].z + xv[j].w); }
        const float mean = wave_sum(s) * (1.f / DM); float s2 = 0.f;
#pragma unroll
        for (int j = 0; j < 4; ++j) { xv[j] = xv[j] - mean; s2 += (xv[j].x * xv[j].x + xv[j].y * xv[j].y) + (xv[j].z * xv[j].z + xv[j].w * xv[j].w); }
        const float rstd = 1.f / sqrtf(wave_sum(s2) * (1.f / DM) + LN_EPS);
#pragma unroll
        for (int j = 0; j < 4; ++j) xv[j] = xv[j] * rstd * gg[j] + bb[j];
        if (last) { GAS f32x4* o = (GAS f32x4*)(F.out + (size_t)m * DM) + lane;
#pragma unroll
            for (int j = 0; j < 4; ++j) o[64 * j] = xv[j]; }
        else { store_row_bf16(xb + (size_t)m * DM, lane, xv); store_row_i8((signed char*)(F.ws + WS_X8) + (size_t)m * DM, (float*)(F.ws + WS_SX) + m, lane, xv); forget_row(xv, wff, (float*)(F.ws + WS_LF) + (size_t)m * 4, lane); }
    }
}

__device__ __forceinline__ int moe_tables(Frame& F, int l) {
    LAS int* tb = (LAS int*)(F.lds + SM_OFF); LAS int* cn = tb + 32;
    LAS int* gtab = (LAS int*)(F.lds + GT_OFF); LAS float* wtab = (LAS float*)(F.lds + WTB_OFF); LAS float* stab = (LAS float*)(F.lds + STB_OFF);
    if (F.tid < 16) cn[F.tid] = (int)__hip_atomic_load((unsigned*)(F.ctl + CW_CNT + (l * 16 + F.tid) * 64), RLX_AGENT);
    __syncthreads();
    if (F.tid == 0) { int a = 0; for (int e = 0; e < 16; ++e) { tb[e] = a; a += (cn[e] + 255) >> 8; } tb[16] = a; }
    __syncthreads();
    const int ntiles = tb[16];
    const int* list = (const int*)(F.ws + WS_LIST); const float* wt = (const float*)(F.ws + WS_WT);
    for (int i = 0; i < MAXU; ++i) { const long L = (long)i * F.G + F.vcu; if (L >= (long)ntiles * 4) break; const int pm = (int)(L >> 2);
        if (F.tid < 256) { int e = 0;
#pragma unroll
            for (int k = 1; k < 16; ++k) e += (pm >= tb[k]) ? 1 : 0;
            const int p = (pm - tb[e]) * 256 + F.tid; int v = -1; float w = 0.f, sc1 = 0.f;
            if (p < cn[e]) { v = list[(size_t)e * LISTCAP + p]; w = wt[v]; sc1 = ((const float*)(F.ws + WS_S1))[v >> 1]; }
            gtab[i * 256 + F.tid] = v; wtab[i * 256 + F.tid] = w; stab[i * 256 + F.tid] = sc1; } }
    __syncthreads();
    return ntiles;
}

#define GRID_BAR() do { XcdBarrier bb_ = bar; asm volatile("" : "+s"(bb_.bar), "+s"(bb_.x)); xcd_barrier(bb_); } while (0)
template <int l> __device__ __forceinline__ void layer_body(const Frame& F0, const XcdBarrier& bar) {
        Frame F = F0; asm volatile("" : "+s"(F.ws), "+s"(F.out), "+s"(F.vcu), "+s"(F.bx), "+s"(F.G), "+v"(F.tid));
        unsigned char* ws = F.ws; const pg8::bf16_t* x8 = (const pg8::bf16_t*)(ws + WS_X8);
        const unsigned char* wl = ws + WS_W + (size_t)l * W_LAYER;
#ifndef SKIP_CC
        cc_scan(F);
#endif
#ifdef DUP_GA
        { pg8::Gemm g{x8, (const pg8::bf16_t*)(wl + W_IN), DM / 2, DM / 2, DM / 2}; pg8::StaticOrder S; S.init(T, NPROJ, F.G, F.bx);
          pg8::EpiBf16 E{(pg8::bf16_t*)(ws + WS_PROJ), NPROJ, (const float*)(ws + WS_BIASP) + l * NPROJ, (const float*)(ws + WS_SX), (const float*)(ws + WS_SWP) + l * NPROJ};
          pg8::gemm_phase<pg8::EpiBf16, pg8::StaticOrder, true, false, true>(F.lds + RING_OFF, g, S, E); }
#endif
#ifndef SKIP_GA
        { pg8::Gemm g{x8, (const pg8::bf16_t*)(wl + W_IN), DM / 2, DM / 2, DM / 2}; pg8::StaticOrder S; S.init(T, NPROJ, F.G, F.bx);
          pg8::EpiBf16 E{(pg8::bf16_t*)(ws + WS_PROJ), NPROJ, (const float*)(ws + WS_BIASP) + l * NPROJ, (const float*)(ws + WS_SX), (const float*)(ws + WS_SWP) + l * NPROJ};
          pg8::gemm_phase<pg8::EpiBf16, pg8::StaticOrder, true, false, true>(F.lds + RING_OFF, g, S, E); }
#endif
#ifndef SKIP_GM
        if (l == 0) { pg8::Gemm g{(const pg8::bf16_t*)(ws + WS_MEMB), (const pg8::bf16_t*)(ws + WS_WMEM), DM, DM, DM}; pg8::StaticOrder S; S.init(MEMROWS, 1024, F.G, F.bx);
          pg8::EpiBf16 E{(pg8::bf16_t*)(ws + WS_MEMKV), 1024, nullptr, nullptr, nullptr};
          pg8::gemm_phase<pg8::EpiBf16, pg8::StaticOrder, true, false>(F.lds + RING_OFF, g, S, E); }
#endif
        GRID_BAR();
#ifdef NAIVE_RECUR
        naive_recur(F, l);
#else
        recur_phase(F, l);
#ifdef DUP_RECUR
        recur_phase(F, l);
#endif
#endif
#ifdef NAIVE_ATTN
        naive_attn(F, l);
#else
        attn_phase(F, l);
#ifdef DUP_ATTN
        attn_phase(F, l);
#endif
#endif
        GRID_BAR();
#ifdef DUP_GC
        { pg8::Gemm g{(const pg8::bf16_t*)((unsigned char*)F.out), (const pg8::bf16_t*)(wl + W_B), DM, 256, 256}; pg8::StaticOrder S; S.init(T, 4096, F.G, F.bx, 4, 256);
          pg8::EpiBf16 E{(pg8::bf16_t*)(ws + WS_U), 4096, nullptr, nullptr, nullptr};
          pg8::gemm_phase<pg8::EpiBf16, pg8::StaticOrder, true, false>(F.lds + RING_OFF, g, S, E); }
#endif
#ifndef SKIP_GC
        { pg8::Gemm g{(const pg8::bf16_t*)((unsigned char*)F.out), (const pg8::bf16_t*)(wl + W_B), DM, 256, 256}; pg8::StaticOrder S; S.init(T, 4096, F.G, F.bx, 4, 256);
          pg8::EpiBf16 E{(pg8::bf16_t*)(ws + WS_U), 4096, nullptr, nullptr, nullptr};
          pg8::gemm_phase<pg8::EpiBf16, pg8::StaticOrder, true, false>(F.lds + RING_OFF, g, S, E); }
#endif
        GRID_BAR();
#ifdef DUP_GD
        { pg8::Gemm g{x8, (const pg8::bf16_t*)(wl + W_G), DM / 2, DM / 2, DM / 2}; pg8::StaticOrder S; S.init(T, NGATE, F.G, F.bx);
          pg8::EpiGateMix E{(const pg8::bf16_t*)(ws + WS_U), (pg8::bf16_t*)((unsigned char*)F.out), (const float*)(ws + WS_BIASG) + l * NGATE, (const float*)(ws + WS_SX), (const float*)(ws + WS_SWG) + l * NGATE};
          pg8::gemm_phase<pg8::EpiGateMix, pg8::StaticOrder, true, false, true>(F.lds + RING_OFF, g, S, E); }
#endif
#ifndef SKIP_GD
        { pg8::Gemm g{x8, (const pg8::bf16_t*)(wl + W_G), DM / 2, DM / 2, DM / 2}; pg8::StaticOrder S; S.init(T, NGATE, F.G, F.bx);
          pg8::EpiGateMix E{(const pg8::bf16_t*)(ws + WS_U), (pg8::bf16_t*)((unsigned char*)F.out), (const float*)(ws + WS_BIASG) + l * NGATE, (const float*)(ws + WS_SX), (const float*)(ws + WS_SWG) + l * NGATE};
          pg8::gemm_phase<pg8::EpiGateMix, pg8::StaticOrder, true, false, true>(F.lds + RING_OFF, g, S, E); }
#endif
        GRID_BAR();
#ifdef DUP_GE
        { pg8::Gemm g{(const pg8::bf16_t*)((unsigned char*)F.out), (const pg8::bf16_t*)(wl + W_OUT), DM, DM, DM}; pg8::StaticOrder S; S.init(T, DM, F.G, F.bx);
          pg8::EpiBf16 E{(pg8::bf16_t*)(ws + WS_Y), DM, nullptr, nullptr, nullptr};
          pg8::gemm_phase<pg8::EpiBf16, pg8::StaticOrder, true, false>(F.lds + RING_OFF, g, S, E); }
#endif
#ifndef SKIP_GE
        { pg8::Gemm g{(const pg8::bf16_t*)((unsigned char*)F.out), (const pg8::bf16_t*)(wl + W_OUT), DM, DM, DM}; pg8::StaticOrder S; S.init(T, DM, F.G, F.bx);
          pg8::EpiBf16 E{(pg8::bf16_t*)(ws + WS_Y), DM, nullptr, nullptr, nullptr};
          pg8::gemm_phase<pg8::EpiBf16, pg8::StaticOrder, true, false>(F.lds + RING_OFF, g, S, E); }
#endif
        GRID_BAR();
#ifdef DUP_LN1
        ln1_phase(F, l, false); __syncthreads();
#endif
#ifndef SKIP_LN1
        ln1_phase(F, l);
#endif
        GRID_BAR();
        const int ntiles = moe_tables(F, l);
#ifdef DUP_GG
        { pg8::Gemm g{(const pg8::bf16_t*)(ws + WS_X18), (const pg8::bf16_t*)(wl + W_E1), DM / 2, DM / 2, DM / 2};
          pg8::MoeOrder S{F.G, F.vcu, 4, ntiles, (const LAS int*)(F.lds + SM_OFF), (const LAS int*)(F.lds + GT_OFF), (size_t)1024 * 512, true};
          pg8::EpiMoe1 E{(pg8::bf16_t*)(ws + WS_ACT), (const LAS float*)(F.lds + STB_OFF), (const LAS int*)(F.lds + SM_OFF), (const float*)(ws + WS_SWE) + l * 16 * 1024};
          pg8::gemm_phase<pg8::EpiMoe1, pg8::MoeOrder, true, true, true>(F.lds + RING_OFF, g, S, E); }
#endif
#ifndef SKIP_GG
        { pg8::Gemm g{(const pg8::bf16_t*)(ws + WS_X18), (const pg8::bf16_t*)(wl + W_E1), DM / 2, DM / 2, DM / 2};
          pg8::MoeOrder S{F.G, F.vcu, 4, ntiles, (const LAS int*)(F.lds + SM_OFF), (const LAS int*)(F.lds + GT_OFF), (size_t)1024 * 512, true};
          pg8::EpiMoe1 E{(pg8::bf16_t*)(ws + WS_ACT), (const LAS float*)(F.lds + STB_OFF), (const LAS int*)(F.lds + SM_OFF), (const float*)(ws + WS_SWE) + l * 16 * 1024};
          pg8::gemm_phase<pg8::EpiMoe1, pg8::MoeOrder, true, true, true>(F.lds + RING_OFF, g, S, E); }
#endif
        GRID_BAR();
#ifdef DUP_GH
        { pg8::Gemm g{(const pg8::bf16_t*)(ws + WS_ACT), (const pg8::bf16_t*)(wl + W_E2), DE, DE, DE};
          pg8::MoeOrder S{F.G, F.vcu, 4, ntiles, (const LAS int*)(F.lds + SM_OFF), (const LAS int*)(F.lds + GT_OFF), (size_t)1024 * 512, false};
          pg8::EpiMoe2 E{(pg8::bf16_t*)((unsigned char*)F.out), (const LAS int*)(F.lds + GT_OFF), (const LAS float*)(F.lds + WTB_OFF)};
          pg8::gemm_phase<pg8::EpiMoe2, pg8::MoeOrder, true, false>(F.lds + RING_OFF, g, S, E); }
#endif
#ifndef SKIP_GH
        { pg8::Gemm g{(const pg8::bf16_t*)(ws + WS_ACT), (const pg8::bf16_t*)(wl + W_E2), DE, DE, DE};
          pg8::MoeOrder S{F.G, F.vcu, 4, ntiles, (const LAS int*)(F.lds + SM_OFF), (const LAS int*)(F.lds + GT_OFF), (size_t)1024 * 512, false};
          pg8::EpiMoe2 E{(pg8::bf16_t*)((unsigned char*)F.out), (const LAS int*)(F.lds + GT_OFF), (const LAS float*)(F.lds + WTB_OFF)};
          pg8::gemm_phase<pg8::EpiMoe2, pg8::MoeOrder, true, false>(F.lds + RING_OFF, g, S, E); }
#endif
        GRID_BAR();
#ifdef DUP_LN2
        ln2_phase(F, l); __syncthreads();
#endif
#ifndef SKIP_LN2
        ln2_phase(F, l);
#endif
        if (l + 1 < NLAYER) GRID_BAR();
}

__global__ void __launch_bounds__(NWAVES * 64, 2) fwd_kernel(Args args) {
    extern __shared__ __attribute__((aligned(16))) unsigned char lds[];
    Frame F0;
    F0.lds = (LAS unsigned char*)lds;
    F0.MISC = (volatile LAS unsigned*)(F0.lds + MISC_OFF);
    F0.tid = threadIdx.x;
    F0.G = gridDim.x; F0.bx = blockIdx.x; { const int bx = blockIdx.x; F0.vcu = (F0.G % 8 == 0) ? (bx % 8) * (F0.G / 8) + bx / 8 : bx; }
    F0.ws = args.ws; F0.out = args.out; F0.ctl = (gu32*)(args.ws + WS_CTL);
    for (int u = F0.tid; u < (LDS_BYTES - LDSCTL_OFF) / 4; u += NWAVES * 64) ((LAS unsigned*)(F0.lds + LDSCTL_OFF))[u] = 0u;
    __syncthreads();
    XcdBarrier bar = xcd_barrier_post((unsigned*)(F0.ctl + CW_BAR), F0.MISC + 8);

    p0_colmax(F0, args);
    GRID_BAR();
#ifdef DUP_P0
    p0_prologue(F0, args); __syncthreads();
#endif
#ifndef SKIP_P0
    p0_prologue(F0, args);
#endif
    GRID_BAR();

    layer_body<0>(F0, bar);
    layer_body<1>(F0, bar);
}

extern "C" void kernel_launch(void* const* d_in, const int* in_sizes, int n_in, void* d_out, int out_size, void* d_ws, size_t ws_size, hipStream_t stream) {
    static int grid = 0;
    if (grid == 0) {
        if (n_in != 15 || in_sizes[0] != T * DM || out_size != T * DM || ws_size < WS_END) { fprintf(stderr, "kernel_launch: unexpected shapes / workspace (n_in %d, in0 %d, out %d, ws %zu); nothing launched\n", n_in, n_in > 0 ? in_sizes[0] : -1, out_size, ws_size); grid = -1; return; }
        int dev = 0, cus = 0, per_cu = 0;
        if (hipGetDevice(&dev) != hipSuccess || hipDeviceGetAttribute(&cus, hipDeviceAttributeMultiprocessorCount, dev) != hipSuccess) { grid = -1; return; }
        if (hipFuncSetAttribute((const void*)fwd_kernel, hipFuncAttributeMaxDynamicSharedMemorySize, LDS_BYTES) != hipSuccess) { fprintf(stderr, "kernel_launch: hipFuncSetAttribute failed\n"); grid = -1; return; }
        if (hipOccupancyMaxActiveBlocksPerMultiprocessor(&per_cu, (const void*)fwd_kernel, NWAVES * 64, LDS_BYTES) != hipSuccess || per_cu < 1) fprintf(stderr, "kernel_launch: occupancy query reports %d\n", per_cu);
        (void)hipGetLastError();
        grid = cus;
    }
    if (grid < 0) return;
    if (hipMemsetAsync((char*)d_ws + WS_CTL, 0, CTL_ZERO_BYTES, stream) != hipSuccess) return;
    Args a{};
    for (int i = 0; i < 15; ++i) a.in[i] = (const float*)d_in[i];
    a.out = (float*)d_out; a.ws = (unsigned char*)d_ws; a.naive = 0; a.pad = 0;
    hipLaunchKernelGGL(fwd_kernel, dim3(grid), dim3(NWAVES * 64), LDS_BYTES, stream, a);
}
```

```cpp
#include <hip/hip_runtime.h>
#include <cstdio>
#include <cstdint>
#include <type_traits>

namespace pg8 {
#define PG8_LAS __attribute__((address_space(3)))
typedef unsigned short bf16_t;
typedef short bf16x8 __attribute__((ext_vector_type(8)));
typedef float f32x4 __attribute__((ext_vector_type(4)));
typedef float f32x2 __attribute__((ext_vector_type(2)));
typedef unsigned u32x4 __attribute__((ext_vector_type(4)));
typedef unsigned u32x2 __attribute__((ext_vector_type(2)));
typedef int i32x4 __attribute__((ext_vector_type(4)));
__device__ __forceinline__ f32x4 tof(const f32x4& v) { return v; }
__device__ __forceinline__ f32x4 tof(const i32x4& v) { return (f32x4){(float)v[0], (float)v[1], (float)v[2], (float)v[3]}; }
constexpr int BM = 256, BK = 64, HALF = 128, HTB = HALF * BK * 2  , STAGE_BYTES = 8 * HTB, NXCD = 8, WGM = 8;

__host__ __device__ __forceinline__ int lds_byte(int r, int c) { const int st = (r >> 4) * 2 + (c >> 5), rr = r & 15, cc = c & 31, ob = rr * 64 + cc * 2; return st * 1024 + (ob ^ (((ob >> 9) & 1) << 5)); }
__host__ __device__ __forceinline__ void stage_rc(int b, int& R, int& C) { const int st = b / 1024, sb = b % 1024, swz = sb ^ (((sb >> 9) & 1) << 5); R = (st >> 1) * 16 + swz / 64; C = (st & 1) * 32 + (swz % 64) / 2; }
__host__ __device__ __forceinline__ int perm32(int rho) { const int n = rho >> 4, i = rho & 15; return 8 * (i >> 2) + 4 * n + (i & 3); }

#ifdef PG8_NT_STORE
#define PG8_ST16(p, v) __builtin_nontemporal_store((v), (u32x4*)(p))
#else
#define PG8_ST16(p, v) (*(u32x4*)(p) = (v))
#endif
__host__ __device__ __forceinline__ int perm32s(int rho) { const int n = rho >> 4, i = rho & 15, q = i >> 2, sg = ((q & 1) << 1) | (q >> 1); return 8 * sg + 4 * n + (i & 3); }
struct Unit { int pm, pn; };
struct Gemm { const bf16_t* A; const bf16_t* Bt; int lda, ldb, K; };

struct StaticOrder {
    int nM, nN, nwg, G, c, a_div, a_add;
    __device__ void init(int M, int N, int G_, int c_, int a_div_ = 0, int a_add_ = 0) { nM = M / BM; nN = N / BM; nwg = nM * nN; G = G_; c = c_; a_div = a_div_; a_add = a_add_; }
    __device__ bool next(int i, Unit& u) const {
        const long L = (long)i * G + c; if (L >= nwg) return false;
        int wgid = (int)L; { const int q = nwg / NXCD, r = nwg % NXCD, xcd = wgid % NXCD, off = wgid / NXCD; wgid = (xcd < r ? xcd * (q + 1) : r * (q + 1) + (xcd - r) * q) + off; }
        const int nig = WGM * nN, gid = wgid / nig, fm = gid * WGM, gsz = (nM - fm) < WGM ? (nM - fm) : WGM;
        u.pm = fm + ((wgid % nig) % gsz); u.pn = (wgid % nig) / gsz; return true;
    }
    __device__ __forceinline__ const char* a_ptr(const Gemm& g, const Unit& u) const { return (const char*)g.A + ((size_t)u.pm * BM * g.lda + (a_div ? (size_t)((u.pn / a_div) * a_add) : (size_t)0)) * 2; }
    __device__ __forceinline__ const char* b_ptr(const Gemm& g, const Unit& u) const { return (const char*)g.Bt + (size_t)u.pn * BM * g.ldb * 2; }
    __device__ __forceinline__ int grow(int, int) const { return 0; }
};

struct MoeOrder {
    int G, vcu, nN, ntiles; const PG8_LAS int* tb; const PG8_LAS int* gtab; size_t wstride;
    bool gather;
    __device__ __forceinline__ bool next(int i, Unit& u) const { const long L = (long)i * G + vcu; if (L >= (long)ntiles * nN) return false; u.pm = (int)(L / nN); u.pn = (int)(L % nN); return true; }
    __device__ __forceinline__ int expert_of(int pm) const { int e = 0;
#pragma unroll
        for (int k = 1; k < 16; ++k) e += (pm >= tb[k]) ? 1 : 0; return e; }
    __device__ __forceinline__ const char* a_ptr(const Gemm& g, const Unit& u) const { return gather ? (const char*)g.A : (const char*)g.A + (size_t)u.pm * BM * g.lda * 2; }
    __device__ __forceinline__ const char* b_ptr(const Gemm& g, const Unit& u) const { return (const char*)g.Bt + ((size_t)expert_of(u.pm) * wstride + (size_t)u.pn * BM * g.ldb) * 2; }
    __device__ __forceinline__ int grow(int ui, int r) const { const int v = gtab[ui * 256 + r]; return v >= 0 ? (v >> 1) : 0; }
};

__device__ __forceinline__ unsigned cvt_pk_bf16(float lo, float hi) { unsigned r; asm volatile("v_cvt_pk_bf16_f32 %0, %1, %2" : "=v"(r) : "v"(lo), "v"(hi)); return r; }
__device__ __forceinline__ float bf_lo(unsigned w) { return __uint_as_float(w << 16); }
__device__ __forceinline__ float bf_hi(unsigned w) { return __uint_as_float(w & 0xffff0000u); }
__device__ __forceinline__ float sig2(float z) { return __builtin_amdgcn_rcpf(1.0f + __builtin_amdgcn_exp2f(z)); }
__device__ __forceinline__ float sigmoidf_fast(float x) { return __builtin_amdgcn_rcpf(1.0f + __builtin_amdgcn_exp2f(-1.4426950408889634f * x)); }

template <bool SC> struct EpiBf16 { static constexpr bool PSIG = false;
    static constexpr bool PERM = true; static constexpr int NTAB = SC ? 12 : 0, NST = 16;
    bf16_t* O; int ldc; const float* bias; const float* rs; const float* cs;
    __device__ __forceinline__ const float* tab_src(const Unit& u, int ch) const { return ch < 4 ? rs + u.pm * BM + 64 * ch : (ch < 8 ? bias + u.pn * BM + 64 * (ch - 4) : cs + u.pn * BM + 64 * (ch - 8)); }
    template <class AccT>
    __device__ __forceinline__ void operator()(const AccT (&acc)[2][2][4][2], const Unit& u, int ui, int wr, int wc, int fr, int fq, const PG8_LAS float* tab) const {
        const int row0 = u.pm * BM + wr * 64 + fr, col0 = u.pn * BM + wc * 32 + 8 * fq;
        f32x4 bv[2][2], cv[2][2];
#pragma unroll
        for (int bj = 0; bj < 2; ++bj)
#pragma unroll
            for (int n = 0; n < 2; ++n) { bv[bj][n] = SC ? *(const PG8_LAS f32x4*)(tab + 256 + wc * 32 + 8 * fq + bj * HALF + 4 * n) : (f32x4){0.f, 0.f, 0.f, 0.f}; cv[bj][n] = SC ? *(const PG8_LAS f32x4*)(tab + 512 + wc * 32 + 8 * fq + bj * HALF + 4 * n) : (f32x4){1.f, 1.f, 1.f, 1.f}; }
#pragma unroll
        for (int ai = 0; ai < 2; ++ai)
#pragma unroll
            for (int m = 0; m < 4; ++m) { const int rl = wr * 64 + fr + ai * HALF + m * 16; bf16_t* rowp = O + (size_t)(u.pm * BM + rl) * ldc + col0; const float rsc = SC ? tab[rl] : 1.f;
#pragma unroll
                for (int bj = 0; bj < 2; ++bj) { f32x4 v0 = tof(acc[ai][bj][m][0]), v1 = tof(acc[ai][bj][m][1]);
                    if (SC) { v0 = v0 * rsc * cv[bj][0] + bv[bj][0]; v1 = v1 * rsc * cv[bj][1] + bv[bj][1]; }
                    u32x4 w; w.x = cvt_pk_bf16(v0[0], v0[1]); w.y = cvt_pk_bf16(v0[2], v0[3]); w.z = cvt_pk_bf16(v1[0], v1[1]); w.w = cvt_pk_bf16(v1[2], v1[3]);
                    PG8_ST16(rowp + bj * HALF, w); } }
    }
};
__device__ __forceinline__ unsigned pk_fp8x4(float a, float b, float c, float d) { unsigned w; asm volatile("v_cvt_pk_fp8_f32 %0, %1, %2" : "=v"(w) : "v"(a), "v"(b)); asm volatile("v_cvt_pk_fp8_f32 %0, %1, %2 op_sel:[0,0,1]" : "+v"(w) : "v"(c), "v"(d)); return w; }
struct EpiU8 {
    static constexpr bool PERM = true, PSIG = true; static constexpr int NTAB = 0, NST = 8;
    unsigned char* O; int ld;
    __device__ __forceinline__ const float* tab_src(const Unit&, int) const { return nullptr; }
    template <class AccT>
    __device__ __forceinline__ void operator()(const AccT (&acc)[2][2][4][2], const Unit& u, int ui, int wr, int wc, int fr, int fq, const PG8_LAS float* tab) const {
        const int row0 = u.pm * BM + wr * 64 + fr, col0 = u.pn * BM + 128 * (fq >> 1) + wc * 32 + 16 * (fq & 1);
#pragma unroll
        for (int ai = 0; ai < 2; ++ai)
#pragma unroll
            for (int m = 0; m < 4; ++m) { unsigned char* rowp = O + (size_t)(row0 + ai * HALF + m * 16) * ld + col0;
                u32x2 w[2];
#pragma unroll
                for (int bj = 0; bj < 2; ++bj) { const f32x4 v0 = tof(acc[ai][bj][m][0]), v1 = tof(acc[ai][bj][m][1]);
                    w[bj].x = pk_fp8x4(v0[0], v0[1], v0[2], v0[3]); w[bj].y = pk_fp8x4(v1[0], v1[1], v1[2], v1[3]); }
                const auto r0 = __builtin_amdgcn_permlane32_swap(w[0].x, w[1].x, false, false), r1 = __builtin_amdgcn_permlane32_swap(w[0].y, w[1].y, false, false);
                u32x4 o; o.x = r0[0]; o.y = r1[0]; o.z = r0[1]; o.w = r1[1];
                *(u32x4*)rowp = o; }
    }
};
struct EpiGateMix { static constexpr bool PSIG = false;
    static constexpr bool PERM = false; static constexpr int NTAB = 12, NST = 8;
    const unsigned char* U; bf16_t* O; const float* bias; const float* rs; const float* cs;
    __device__ __forceinline__ const float* tab_src(const Unit& u, int ch) const { return ch < 4 ? rs + u.pm * BM + 64 * ch : (ch < 8 ? bias + u.pn * BM + 64 * (ch - 4) : cs + u.pn * BM + 64 * (ch - 8)); }
    template <class AccT>
    __device__ __forceinline__ void operator()(const AccT (&acc)[2][2][4][2], const Unit& u, int ui, int wr, int wc, int fr, int fq, const PG8_LAS float* tab) const {
        const int row0 = u.pm * BM + wr * 64 + fr, d0 = 64 * u.pn + 16 * wc + 4 * fq;
        f32x4 bv[2][2], cv[2][2];
#pragma unroll
        for (int bj = 0; bj < 2; ++bj)
#pragma unroll
            for (int n = 0; n < 2; ++n) { const int vc = 128 * bj + 32 * wc + 16 * n + 4 * fq; bv[bj][n] = *(const PG8_LAS f32x4*)(tab + 256 + vc); cv[bj][n] = *(const PG8_LAS f32x4*)(tab + 512 + vc); }
#pragma unroll
        for (int ai = 0; ai < 2; ++ai)
#pragma unroll
            for (int m = 0; m < 4; ++m) { const int rl = wr * 64 + fr + ai * HALF + m * 16; const size_t row = (size_t)(u.pm * BM + rl); const unsigned char* up = U + row * 4096 + d0; const float rsc = tab[rl];
                f32x4 o = (f32x4){0.f, 0.f, 0.f, 0.f};
#pragma unroll
                for (int bj = 0; bj < 2; ++bj)
#pragma unroll
                    for (int n = 0; n < 2; ++n) { const int w = *(const int*)(up + (2 * bj + n) * 1024);
                        const f32x2 ul = __builtin_amdgcn_cvt_pk_f32_fp8(w, false), uh = __builtin_amdgcn_cvt_pk_f32_fp8(w, true);
                        const f32x4 z = tof(acc[ai][bj][m][n]) * rsc * cv[bj][n] + bv[bj][n];
                        o[0] += sig2(z[0]) * ul.x; o[1] += sig2(z[1]) * ul.y; o[2] += sig2(z[2]) * uh.x; o[3] += sig2(z[3]) * uh.y; }
                u32x2 ow; ow.x = cvt_pk_bf16(o[0] * 0.03125f, o[1] * 0.03125f); ow.y = cvt_pk_bf16(o[2] * 0.03125f, o[3] * 0.03125f);
                *(u32x2*)(O + row * 1024 + d0) = ow; }
    }
};
struct EpiMoe1 { static constexpr bool PSIG = false;
    static constexpr bool PERM = true; static constexpr int NTAB = 4, NST = 8;
    bf16_t* act; const PG8_LAS float* stab; const PG8_LAS int* tb; const float* cs;
    __device__ __forceinline__ const float* tab_src(const Unit& u, int ch) const { int e = 0;
#pragma unroll
        for (int k = 1; k < 16; ++k) e += (u.pm >= tb[k]) ? 1 : 0;
        return cs + e * 1024 + u.pn * BM + 64 * ch; }
    template <class AccT>
    __device__ __forceinline__ void operator()(const AccT (&acc)[2][2][4][2], const Unit& u, int ui, int wr, int wc, int fr, int fq, const PG8_LAS float* tab) const {
        const int row0 = u.pm * BM + wr * 64 + fr, col0 = 128 * u.pn + 32 * wc + 8 * fq;
        f32x4 cg[2], cu[2];
#pragma unroll
        for (int n = 0; n < 2; ++n) { cg[n] = *(const PG8_LAS f32x4*)(tab + 32 * wc + 8 * fq + 4 * n); cu[n] = *(const PG8_LAS f32x4*)(tab + HALF + 32 * wc + 8 * fq + 4 * n); }
#pragma unroll
        for (int ai = 0; ai < 2; ++ai)
#pragma unroll
            for (int m = 0; m < 4; ++m) { const int rl = ai * HALF + wr * 64 + m * 16 + fr; const size_t row = (size_t)(u.pm * BM + rl); const float rsc = stab[ui * 256 + rl];
                float a[8];
#pragma unroll
                for (int n = 0; n < 2; ++n) { const f32x4 g4 = tof(acc[ai][0][m][n]) * rsc * cg[n], u4 = tof(acc[ai][1][m][n]) * rsc * cu[n];
#pragma unroll
                    for (int j = 0; j < 4; ++j) a[4 * n + j] = g4[j] * sigmoidf_fast(g4[j]) * u4[j]; }
                u32x4 w; w.x = cvt_pk_bf16(a[0], a[1]); w.y = cvt_pk_bf16(a[2], a[3]); w.z = cvt_pk_bf16(a[4], a[5]); w.w = cvt_pk_bf16(a[6], a[7]);
                *(u32x4*)(act + row * 512 + col0) = w; }
    }
};
struct EpiMoe2 { static constexpr bool PSIG = false;
    static constexpr bool PERM = true; static constexpr int NTAB = 0, NST = 0;
    __device__ __forceinline__ const float* tab_src(const Unit&, int) const { return nullptr; }
    unsigned char* Y; const PG8_LAS int* gtab; const PG8_LAS float* wtab;
    template <class AccT>
    __device__ __forceinline__ void operator()(const AccT (&acc)[2][2][4][2], const Unit& u, int ui, int wr, int wc, int fr, int fq, const PG8_LAS float* tab) const {
        const int col0 = u.pn * BM + wc * 32 + 8 * fq;
#pragma unroll
        for (int ai = 0; ai < 2; ++ai)
#pragma unroll
            for (int m = 0; m < 4; ++m) { const int rl = ai * HALF + wr * 64 + m * 16 + fr; const int slot = gtab[ui * 256 + rl]; const float wgt = wtab[ui * 256 + rl];
                if (slot >= 0) { unsigned char* rowp = Y + (size_t)slot * 1024 + col0;
#pragma unroll
                    for (int bj = 0; bj < 2; ++bj) { const f32x4 v0 = tof(acc[ai][bj][m][0]) * wgt, v1 = tof(acc[ai][bj][m][1]) * wgt;
                        u32x2 w; w.x = pk_fp8x4(v0[0], v0[1], v0[2], v0[3]); w.y = pk_fp8x4(v1[0], v1[1], v1[2], v1[3]);
                        *(u32x2*)(rowp + bj * HALF) = w; } } }
    }
};

template <class Epi, class Sched, bool ALIGN_EPI, bool GATHER, bool I8 = false>
__device__ __forceinline__ void gemm_phase(PG8_LAS unsigned char* lds, PG8_LAS unsigned char* lds_tab, const Gemm g, const Sched& S, const Epi& E, int stag_ticks = 0) {
    int tid_ = threadIdx.x; asm volatile("" : "+v"(tid_));
    const int tid = tid_, wid = __builtin_amdgcn_readfirstlane(tid >> 6), lane = tid & 63, wr = wid >> 2, wc = wid & 3, fr = lane & 15, fq = lane >> 4;
    const int K = g.K, nt = K / BK;
    unsigned voffA[2], voffB[2]; int RA[2]; unsigned CA2[2];
#pragma unroll
    for (int i = 0; i < 2; ++i) { int R, C; stage_rc(tid * 16 + i * 8192, R, C); const int Rb = Epi::PERM ? ((R & ~31) + (Epi::PSIG ? perm32s(R & 31) : perm32(R & 31))) : R;
        voffA[i] = (unsigned)(R * g.lda + C) * 2u; voffB[i] = (unsigned)(Rb * g.ldb + C) * 2u; RA[i] = R; CA2[i] = (unsigned)C * 2u; }
    const size_t kstep = (size_t)(BK * 2);
    const size_t hstepA = (size_t)HALF * g.lda * 2, hstepB = (size_t)HALF * g.ldb * 2;
    const unsigned ldsw = (unsigned)wid * 1024u;
    const int aoff = lds_byte(wr * 64 + fr, fq * 8), boff = lds_byte(wc * 32 + fr, fq * 8);
    unsigned gvc[2][2], gvn[2][2];
#define PG8_SA(b, h) (((b) * 2 + (h)) * HTB)
#define PG8_SB(b, h) ((4 + (b) * 2 + (h)) * HTB)
#define PG8_STG(bufoff, gbase, voff) do { _Pragma("unroll") for (int _i = 0; _i < 2; ++_i) \
        __builtin_amdgcn_global_load_lds((const unsigned*)((const char*)(gbase) + (voff)[_i]), (PG8_LAS unsigned*)(lds + (bufoff) + ldsw + _i * 8192), 16, 0, 0); } while (0)
#define PG8_STG_B(bufoff, kptr, h) PG8_STG(bufoff, (kptr) + (h) * hstepB, voffB)
#define PG8_STG_A(bufoff, kptr, h, nx) do { if constexpr (GATHER) { unsigned _v[2]; _v[0] = (nx) ? gvn[h][0] : gvc[h][0]; _v[1] = (nx) ? gvn[h][1] : gvc[h][1]; PG8_STG(bufoff, kptr, _v); } \
        else { PG8_STG(bufoff, (kptr) + (h) * hstepA, voffA); } } while (0)
#define PG8_GLOAD(dst, uix) do { _Pragma("unroll") for (int _h = 0; _h < 2; ++_h) _Pragma("unroll") for (int _i = 0; _i < 2; ++_i) \
        dst[_h][_i] = (unsigned)S.grow((uix), _h * HALF + RA[_i]) * (unsigned)(g.lda * 2) + CA2[_i]; } while (0)
#define PG8_LDA(dst, b, h) do { _Pragma("unroll") for (int m = 0; m < 4; ++m) _Pragma("unroll") for (int k = 0; k < 2; ++k) dst[m][k] = *(const PG8_LAS bf16x8*)(lds + PG8_SA(b, h) + aoff + m * 2048 + k * 1024); } while (0)
#define PG8_LDB(dst, b, h) do { _Pragma("unroll") for (int n = 0; n < 2; ++n) _Pragma("unroll") for (int k = 0; k < 2; ++k) dst[n][k] = *(const PG8_LAS bf16x8*)(lds + PG8_SB(b, h) + boff + n * 2048 + k * 1024); } while (0)
#define PG8_MMA(ai, bj, At, Bt) do { __builtin_amdgcn_s_setprio(1); _Pragma("unroll") for (int m = 0; m < 4; ++m) _Pragma("unroll") for (int n = 0; n < 2; ++n) _Pragma("unroll") for (int k = 0; k < 2; ++k) \
        { if constexpr (I8) acc[ai][bj][m][n] = __builtin_amdgcn_mfma_i32_16x16x64_i8(__builtin_bit_cast(i32x4, Bt[n][k]), __builtin_bit_cast(i32x4, At[m][k]), acc[ai][bj][m][n], 0, 0, 0); \
          else acc[ai][bj][m][n] = __builtin_amdgcn_mfma_f32_16x16x32_bf16(Bt[n][k], At[m][k], acc[ai][bj][m][n], 0, 0, 0); } __builtin_amdgcn_s_setprio(0); } while (0)
#define PG8_WAIT_V(n) asm volatile("s_waitcnt vmcnt(" #n ")" ::: "memory")
    constexpr int ND = (Epi::NTAB + 7) / 8, RELAX = 8 + Epi::NST + ND;
#define PG8_TABS(uix, U) do { if constexpr (Epi::NTAB > 0) { _Pragma("unroll") for (int c_ = 0; c_ < ND; ++c_) { const int ch_ = (wid + 8 * c_) % Epi::NTAB; \
        __builtin_amdgcn_global_load_lds((const unsigned*)(E.tab_src(U, ch_) + lane), (PG8_LAS unsigned*)((PG8_LAS float*)lds_tab + ((uix) & 1) * Epi::NTAB * 64 + 64 * ch_), 4, 0, 0); } } } while (0)
#ifdef PG8_RELAX
#define PG8_WAIT_V8R(rx) do { if (rx) asm volatile("s_waitcnt vmcnt(%0)" :: "n"(RELAX) : "memory"); else asm volatile("s_waitcnt vmcnt(8)" ::: "memory"); } while (0)
#else
#define PG8_WAIT_V8R(rx) asm volatile("s_waitcnt vmcnt(8)" ::: "memory")
#endif
#define PG8_WAIT_L(n) asm volatile("s_waitcnt lgkmcnt(" #n ")" ::: "memory")
#define PG8_BAR __builtin_amdgcn_s_barrier()
#define PG8_SCHED __builtin_amdgcn_sched_barrier(0)
    Unit cur, nxt; int ui = 0;
    if (!S.next(0, cur)) return;
    if (stag_ticks > 0) { const unsigned long long t0_ = __builtin_amdgcn_s_memrealtime(); const unsigned long long w_ = (unsigned long long)stag_ticks; while (__builtin_amdgcn_s_memrealtime() - t0_ < w_) __builtin_amdgcn_s_sleep(8); }
    typedef typename std::conditional<I8, i32x4, f32x4>::type AccT;
    AccT acc[2][2][4][2];
#pragma unroll
    for (int a = 0; a < 2; ++a)
#pragma unroll
        for (int b = 0; b < 2; ++b)
#pragma unroll
            for (int m = 0; m < 4; ++m)
#pragma unroll
                for (int n = 0; n < 2; ++n) acc[a][b][m][n] = AccT{};
    bf16x8 At[4][2], B0[2][2], B1[2][2];
    const char* cA = S.a_ptr(g, cur); const char* cB = S.b_ptr(g, cur);
    if constexpr (GATHER) { PG8_GLOAD(gvc, 0); PG8_GLOAD(gvn, 0); }
    PG8_TABS(0, cur);
    PG8_STG_B(PG8_SB(0, 0), cB, 0); PG8_STG_B(PG8_SB(0, 1), cB, 1); PG8_STG_A(PG8_SA(0, 0), cA, 0, false); PG8_STG_A(PG8_SA(0, 1), cA, 1, false);
    if (wr == 1) PG8_BAR;
    PG8_WAIT_V(2); PG8_BAR;
    PG8_STG_B(PG8_SB(1, 0), cB + kstep, 0); PG8_STG_A(PG8_SA(1, 0), cA + kstep, 0, false); PG8_STG_B(PG8_SB(1, 1), cB + kstep, 1);
    PG8_WAIT_V(6); PG8_BAR;
    for (;;) {
        const bool has_next = S.next(ui + 1, nxt);
        const char* nA = has_next ? S.a_ptr(g, nxt) : cA; const char* nB = has_next ? S.b_ptr(g, nxt) : cB;
        if constexpr (GATHER) { if (has_next) { PG8_GLOAD(gvn, ui + 1); } else {
#pragma unroll
            for (int h = 0; h < 2; ++h) { gvn[h][0] = gvc[h][0]; gvn[h][1] = gvc[h][1]; } } }
#pragma nounroll
        for (int t = 0; t < nt; t += 2) {
            const bool last = (t == nt - 2); const bool rx = (t == 0) && (ui > 0) && (RELAX > 8);
            const char* a1 = cA + (size_t)(t + 1) * kstep;
            const char* a2 = last ? nA : cA + (size_t)(t + 2) * kstep; const char* b2 = last ? nB : cB + (size_t)(t + 2) * kstep;
            const char* a3 = a2 + kstep; const char* b3 = b2 + kstep;
            PG8_LDB(B0, 0, 0); PG8_LDB(B1, 0, 1); PG8_SCHED; PG8_LDA(At, 0, 0); PG8_STG_A(PG8_SA(1, 1), a1, 1, false);
            PG8_WAIT_V8R(rx); PG8_WAIT_L(0); PG8_BAR; PG8_MMA(0, 0, At, B0); PG8_MMA(0, 1, At, B1); PG8_BAR; PG8_SCHED;
            PG8_LDA(At, 0, 1); PG8_STG_B(PG8_SB(0, 0), b2, 0); PG8_STG_B(PG8_SB(0, 1), b2, 1); PG8_STG_A(PG8_SA(0, 0), a2, 0, last);
            PG8_WAIT_V8R(rx); PG8_WAIT_L(0); PG8_BAR; PG8_MMA(1, 0, At, B0); PG8_MMA(1, 1, At, B1); PG8_BAR; PG8_SCHED;
            PG8_LDB(B0, 1, 0); PG8_LDB(B1, 1, 1); PG8_SCHED; PG8_LDA(At, 1, 0); PG8_STG_A(PG8_SA(0, 1), a2, 1, last);
            PG8_WAIT_V(8); PG8_WAIT_L(0); PG8_BAR; PG8_MMA(0, 0, At, B0); PG8_MMA(0, 1, At, B1); PG8_BAR; PG8_SCHED;
            PG8_LDA(At, 1, 1); PG8_STG_B(PG8_SB(1, 0), b3, 0); PG8_STG_B(PG8_SB(1, 1), b3, 1); PG8_STG_A(PG8_SA(1, 0), a3, 0, last);
            PG8_WAIT_V(8); PG8_WAIT_L(0); PG8_BAR; PG8_MMA(1, 0, At, B0); PG8_MMA(1, 1, At, B1); PG8_BAR; PG8_SCHED;
        }
        if constexpr (ALIGN_EPI) { if (wr == 0) PG8_BAR; }
        E(acc, cur, ui, wr, wc, fr, fq, (const PG8_LAS float*)lds_tab + (ui & 1) * Epi::NTAB * 64);
        if (!has_next) break;
#pragma unroll
        for (int a = 0; a < 2; ++a)
#pragma unroll
            for (int b = 0; b < 2; ++b)
#pragma unroll
                for (int m = 0; m < 4; ++m)
#pragma unroll
                    for (int n = 0; n < 2; ++n) acc[a][b][m][n] = AccT{};
        cur = nxt; cA = nA; cB = nB; ++ui;
        PG8_TABS(ui, cur);
        if constexpr (GATHER) {
#pragma unroll
            for (int h = 0; h < 2; ++h) { gvc[h][0] = gvn[h][0]; gvc[h][1] = gvn[h][1]; } }
        if constexpr (ALIGN_EPI) { if (wr == 1) PG8_BAR; }
    }
    PG8_WAIT_V(0);
    if constexpr (!ALIGN_EPI) { if (wr == 0) PG8_BAR; }
    PG8_BAR;
#undef PG8_SA
#undef PG8_SB
#undef PG8_STG
#undef PG8_STG_A
#undef PG8_STG_B
#undef PG8_GLOAD
#undef PG8_LDA
#undef PG8_LDB
#undef PG8_MMA
#undef PG8_WAIT_V
#undef PG8_TABS
#undef PG8_WAIT_V8R
#undef PG8_WAIT_L
#undef PG8_BAR
#undef PG8_SCHED
}
}

#ifndef PG8_ALIGN
#define PG8_ALIGN true
#endif
constexpr int NWAVES = 8;
constexpr int BATCH = 32, SEQ = 2048, DM = 1024, NLAYER = 2, NH = 4, HD = 64, NMEM = 256;
constexpr int T = BATCH * SEQ;
constexpr int MEMROWS = BATCH * NMEM;
constexpr int NIN = 7172, NPROJ = 3072, NGATE = 4096, NE = 16, DE = 512;
constexpr int FOX_F_COL = 768, GATE_COL = 3076;
constexpr float ALPHA = 1.4142135623730951f;
constexpr float LN_EPS = 1e-5f, GN_EPS = 1e-6f;
constexpr int LISTCAP = 65536;
constexpr int MAXU = 9;

constexpr size_t MiB = 1u << 20;
constexpr size_t WS_CTL = 0, CTL_ZERO_BYTES = 1 * MiB;
constexpr size_t WS_LF = 2 * MiB;
constexpr size_t WS_CC = 3 * MiB;
constexpr size_t WS_WT = 4 * MiB;
constexpr size_t WS_ROPE = 5 * MiB;
constexpr size_t WS_BIASP = 6 * MiB;
constexpr size_t WS_BIASG = 6 * MiB + 65536;
constexpr size_t WS_PAR = 7 * MiB;
constexpr int PAR_LNG = 0, PAR_LNB = 4096, PAR_WR = 8192, PAR_BR = 24576, PAR_LB = 24592, PAR_NG = 25104, PAR_WFF = 25232;
constexpr size_t WS_LIST = 8 * MiB;
constexpr size_t WS_W = 16 * MiB;
constexpr size_t W_IN = 0, W_G = 3 * MiB, W_B = 7 * MiB, W_OUT = 9 * MiB, W_E1 = 11 * MiB, W_E2 = 27 * MiB, W_LAYER = 43 * MiB;
constexpr size_t WS_WMEM = WS_W + 2 * W_LAYER;
constexpr size_t WS_MEMB = 104 * MiB;
constexpr size_t WS_MEMKV = 120 * MiB;
constexpr size_t WS_XB = 136 * MiB;
constexpr size_t WS_X8 = 264 * MiB;
constexpr size_t WS_X1B = 328 * MiB;
constexpr size_t WS_X18 = 456 * MiB;
constexpr size_t WS_PROJ = 520 * MiB;
constexpr size_t WS_U = 328 * MiB;
constexpr size_t WS_Y = 520 * MiB;
constexpr size_t WS_Y2 = 520 * MiB;
constexpr size_t WS_ACT = 648 * MiB;
constexpr size_t WS_END = 904 * MiB;
static_assert(WS_WMEM + 2 * MiB <= WS_MEMB && WS_U + (size_t)T * 4096 * 2 <= WS_PROJ + (size_t)T * 3072 * 2 && WS_ACT + (size_t)135168 * 512 * 2 <= WS_END && WS_PROJ + (size_t)T * 3072 * 2 <= WS_END, "d_ws map");
constexpr size_t CM_IN = 256 * 1024, CM_E = 320 * 1024;
constexpr size_t WS_SX = 12 * MiB, WS_S1 = 12 * MiB + 512 * 1024;
constexpr size_t WS_SWP = 13 * MiB, WS_SWG = 13 * MiB + 65536, WS_SWE = 13 * MiB + 131072;
constexpr int CW_TMO = 0, CW_CODE = 1, CW_BAR = 4096, CW_CNT = 16384, CW_Q = 20480;

constexpr int RING_OFF = 0, RING_BYTES = 131072;
constexpr int GT_OFF = 131072, WTB_OFF = GT_OFF + MAXU * 1024, STB_OFF = WTB_OFF + MAXU * 1024, SM_OFF = STB_OFF + MAXU * 1024;
constexpr int EV_OFF = SM_OFF + 1024;
constexpr int LDSCTL_OFF = EV_OFF + 2048, MISC_OFF = LDSCTL_OFF + 320;
constexpr int LDS_BYTES = 163840;
static_assert(MISC_OFF + 128 <= LDS_BYTES, "LDS map");

#define GAS __attribute__((address_space(1)))
#define LAS __attribute__((address_space(3)))
typedef unsigned short bf16;
typedef unsigned v4u __attribute__((ext_vector_type(4)));
typedef unsigned v2u __attribute__((ext_vector_type(2)));
typedef float f32x4 __attribute__((ext_vector_type(4)));
typedef GAS unsigned gu32;
#define RLX_AGENT __ATOMIC_RELAXED, __HIP_MEMORY_SCOPE_AGENT
#define LDS_WAIT() asm volatile("s_waitcnt lgkmcnt(0)" ::: "memory")
#define VM_WAIT() asm volatile("s_waitcnt vmcnt(0)" ::: "memory")
__device__ __forceinline__ unsigned f2bf(float f) { unsigned u = __builtin_bit_cast(unsigned, f); return (u + 0x7fffu + ((u >> 16) & 1u)) >> 16; }
__device__ __forceinline__ unsigned pk2(float lo, float hi) { return pg8::cvt_pk_bf16(lo, hi); }
__device__ __forceinline__ float bfl(unsigned w) { return __uint_as_float(w << 16); }
__device__ __forceinline__ float bfh(unsigned w) { return __uint_as_float(w & 0xffff0000u); }
__device__ __forceinline__ float bf1(bf16 h) { return __uint_as_float((unsigned)h << 16); }

#define XB_TMO      128
#define XB_XCNT(j)  (256  + 64 * (j))
#define XB_XSUB(j)  (1280 + 64 * (j))
#define XB_XGEN(j)  (2304 + 64 * (j))
#define XB_TOP      3328
#define XB_TOPGEN   3392
#define XCD_BAR_WORDS 3456
#define XB_SPIN_CAP (1u << 18)
__device__ __forceinline__ unsigned xb_ld(unsigned* p)              { return __hip_atomic_load(p, __ATOMIC_RELAXED, __HIP_MEMORY_SCOPE_AGENT); }
__device__ __forceinline__ unsigned xb_add(unsigned* p, unsigned v) { return __hip_atomic_fetch_add(p, v, __ATOMIC_RELAXED, __HIP_MEMORY_SCOPE_AGENT); }
__device__ __forceinline__ unsigned xb_xcc_id() { return (unsigned)__builtin_amdgcn_s_getreg((3 << 11) | 20) & 0xFu; }
#define XB_SPIN(cond, bar) do { unsigned _sp = 0; while (cond) { __builtin_amdgcn_s_sleep(1); \
    if ((++_sp & 255u) == 0u) { if (xb_ld(&(bar)[XB_TMO])) break; if (_sp > XB_SPIN_CAP) { atomicAdd(&(bar)[XB_TMO], 1u); break; } } } } while (0)
struct XcdBarrier { unsigned* bar; unsigned x; volatile LAS unsigned* st; };
__device__ __forceinline__ XcdBarrier xcd_barrier_post(unsigned* bar, volatile LAS unsigned* st) {
    XcdBarrier b; b.bar = bar; b.x = xb_xcc_id(); b.st = st;
    if (threadIdx.x == 0) (void)xb_add(&bar[XB_XCNT(b.x)], 1u);
    return b;
}
__device__ __forceinline__ void xcd_barrier_complete(unsigned* bar, unsigned x, unsigned& nloc, unsigned& nx) {
    const unsigned G = gridDim.x * gridDim.y * gridDim.z;
    unsigned sum, cnt, mine, sp = 0u;
    for (;;) {
        sum = 0u; cnt = 0u; mine = 0u;
#pragma unroll
        for (unsigned j = 0; j < 16; ++j) { const unsigned c = xb_ld(&bar[XB_XCNT(j)]); sum += c; cnt += (c > 0u) ? 1u : 0u; mine = (j == x) ? c : mine; }
        if (sum == G) break;
        __builtin_amdgcn_s_sleep(1);
        if ((++sp & 255u) == 0u) { if (xb_ld(&bar[XB_TMO])) break; if (sp > XB_SPIN_CAP) { atomicAdd(&bar[XB_TMO], 1u); break; } }
    }
    nloc = mine > 0u ? mine : 1u; nx = cnt > 0u ? cnt : 1u;
}
__device__ __forceinline__ void xcd_barrier(const XcdBarrier& b) {
    asm volatile("s_waitcnt vmcnt(0)" ::: "memory");
    __syncthreads();
    if (threadIdx.x == 0) {
        unsigned* bar = b.bar;
        __builtin_amdgcn_s_waitcnt(0);
        unsigned nloc = b.st[0], nx = b.st[1];
        if (nloc == 0u) { xcd_barrier_complete(bar, b.x, nloc, nx); b.st[0] = nloc; b.st[1] = nx; }
        const unsigned old = xb_add(&bar[XB_XSUB(b.x)], 1u);
        const unsigned gen = old / nloc;
        if (old + 1u == (gen + 1u) * nloc) {
            __builtin_amdgcn_fence(__ATOMIC_RELEASE, "agent");
            asm volatile("s_waitcnt vmcnt(0)" ::: "memory");
            const unsigned og = xb_add(&bar[XB_TOP], 1u);
            const unsigned tg = og / nx;
            if (og + 1u == (tg + 1u) * nx) xb_add(&bar[XB_TOPGEN], 1u);
            else XB_SPIN(xb_ld(&bar[XB_TOPGEN]) == tg, bar);
            __builtin_amdgcn_fence(__ATOMIC_ACQUIRE, "agent");
            xb_add(&bar[XB_XGEN(b.x)], 1u);
            asm volatile("s_waitcnt vmcnt(0)" ::: "memory");
        } else {
            XB_SPIN(xb_ld(&bar[XB_XGEN(b.x)]) == gen, bar);
            __builtin_amdgcn_fence(__ATOMIC_ACQUIRE, "agent");
            asm volatile("s_waitcnt vmcnt(0)" ::: "memory");
        }
    }
    __syncthreads();
}

struct Frame {
    LAS unsigned char* lds;
    volatile LAS unsigned* MISC;
    gu32* ctl;
    int tid, vcu, G, bx;
    float* out; unsigned char* ws;
};
#define OPAQUE_V(x) asm volatile("" : "+v"(x))
enum { I_X = 0, I_MEM, I_WIN, I_BIN, I_WMEMKV, I_LB, I_NORMG, I_WBRANCH, I_WOUT, I_LNG, I_LNB, I_WROUTER, I_BROUTER, I_WEIN, I_WEOUT };

template <int CTRL> __device__ __forceinline__ float dpp_f(float v) { return __builtin_bit_cast(float, __builtin_amdgcn_update_dpp(0, __builtin_bit_cast(int, v), CTRL, 0xF, 0xF, true)); }
constexpr int DPP_X1 = 0xB1, DPP_X2 = 0x4E, DPP_HMIR = 0x141, DPP_MIR = 0x140;
__device__ __forceinline__ float rl_f(float v, int l) { return __builtin_bit_cast(float, __builtin_amdgcn_readlane(__builtin_bit_cast(int, v), l)); }
__device__ __forceinline__ float wave_sum(float v) {
    v += dpp_f<DPP_X1>(v); v += dpp_f<DPP_X2>(v); v += dpp_f<DPP_HMIR>(v); v += dpp_f<DPP_MIR>(v);
    return (rl_f(v, 15) + rl_f(v, 31)) + (rl_f(v, 47) + rl_f(v, 63));
}
__device__ __forceinline__ float wave_max(float v) {
    v = fmaxf(v, dpp_f<DPP_X1>(v)); v = fmaxf(v, dpp_f<DPP_X2>(v)); v = fmaxf(v, dpp_f<DPP_HMIR>(v)); v = fmaxf(v, dpp_f<DPP_MIR>(v));
    return fmaxf(fmaxf(rl_f(v, 15), rl_f(v, 31)), fmaxf(rl_f(v, 47), rl_f(v, 63)));
}
__device__ __forceinline__ float sum8(float v) { v += dpp_f<DPP_X1>(v); v += dpp_f<DPP_X2>(v); v += dpp_f<DPP_HMIR>(v); return v; }
__device__ __forceinline__ float log_sigmoid(float z) { return z >= 0.f ? -log1pf(expf(-z)) : z - log1pf(expf(z)); }

__device__ __forceinline__ int src_col(int mode, int r) {
    if (mode == 1) { const int tile = r >> 8; return r + (tile >= 3 ? 4 : 0); }
    if (mode == 2) { const int nb = 2 * ((r >> 7) & 1) + ((r >> 4) & 1), d = 64 * (r >> 8) + 16 * ((r >> 5) & 3) + (r & 15); return GATE_COL + nb * 1024 + d; }
    if (mode == 3) { return ((r >> 7) & 1) * 512 + 128 * (r >> 8) + (r & 127); }
    return r;
}
__device__ __forceinline__ unsigned q8(float v, float inv) { int q = (int)rintf(v * inv); q = q > 127 ? 127 : (q < -127 ? -127 : q); return (unsigned)q & 255u; }
__device__ __forceinline__ unsigned q8x4(float a, float b, float c, float d, float inv) {
    const int ia = (int)rintf(a * inv), ib = (int)rintf(b * inv), ic = (int)rintf(c * inv), id = (int)rintf(d * inv);
    const unsigned lo = __builtin_bit_cast(unsigned, __builtin_amdgcn_cvt_pk_i16(ia, ib)), hi = __builtin_bit_cast(unsigned, __builtin_amdgcn_cvt_pk_i16(ic, id));
    return __builtin_amdgcn_perm(hi, lo, 0x06040200u);
}
__device__ __forceinline__ void store_row_i8(signed char* orow, float* srow, int lane, const f32x4 (&v)[4]) {
    float am = 0.f;
#pragma unroll
    for (int j = 0; j < 4; ++j) am = fmaxf(am, fmaxf(fmaxf(fabsf(v[j].x), fabsf(v[j].y)), fmaxf(fabsf(v[j].z), fabsf(v[j].w))));
    am = fmaxf(wave_max(am), 1e-30f);
    const float inv = 127.0f / am;
    GAS unsigned* o4 = (GAS unsigned*)orow + lane;
#pragma unroll
    for (int j = 0; j < 4; ++j) o4[64 * j] = q8x4(v[j].x, v[j].y, v[j].z, v[j].w, inv);
    if (lane == 0) *srow = am * (1.0f / 127.0f);
}
__device__ __forceinline__ void p0_transpose_item_q(const float* W, int K, int N, signed char* WT, int mode, const unsigned* cm, LAS float* scr, int item, int ndst32, int lane) {
    const int kb = item / ndst32, nb = item % ndst32, k0 = 64 * kb, n0 = 32 * nb;
    const int sc = src_col(mode, n0 + (lane & 31));
#pragma unroll 8
    for (int i = 0; i < 32; ++i) { const int kk = 2 * i + (lane >> 5); scr[kk * 33 + (lane & 31)] = W[(size_t)(k0 + kk) * N + sc]; }
    LDS_WAIT(); asm volatile("" ::: "memory");
    const int c = lane & 7;
#pragma unroll
    for (int j = 0; j < 4; ++j) { const int n = (lane >> 3) + 8 * j; const LAS float* sp = scr + (8 * c) * 33 + n;
        const float inv = 127.0f / fmaxf(__uint_as_float(cm[src_col(mode, n0 + n)]), 1e-30f);
        v2u o; o.x = q8x4(sp[0 * 33], sp[1 * 33], sp[2 * 33], sp[3 * 33], inv); o.y = q8x4(sp[4 * 33], sp[5 * 33], sp[6 * 33], sp[7 * 33], inv);
        *(GAS v2u*)(WT + (size_t)(n0 + n) * K + k0 + 8 * c) = o; }
    LDS_WAIT(); asm volatile("" ::: "memory");
}
__device__ __forceinline__ void p0_transpose_item(const float* W, int K, int N, bf16* WT, int mode, LAS float* scr, int item, int ndst32, int lane, float mul = 1.0f) {
    const int kb = item / ndst32, nb = item % ndst32, k0 = 64 * kb, n0 = 32 * nb;
    const int sc = src_col(mode, n0 + (lane & 31));
#pragma unroll 8
    for (int i = 0; i < 32; ++i) { const int kk = 2 * i + (lane >> 5); scr[kk * 33 + (lane & 31)] = W[(size_t)(k0 + kk) * N + sc]; }
    LDS_WAIT(); asm volatile("" ::: "memory");
    const int c = lane & 7;
#pragma unroll
    for (int j = 0; j < 4; ++j) { const int n = (lane >> 3) + 8 * j; const LAS float* s = scr + (8 * c) * 33 + n;
        v4u o; o.x = pk2(s[0 * 33] * mul, s[1 * 33] * mul); o.y = pk2(s[2 * 33] * mul, s[3 * 33] * mul); o.z = pk2(s[4 * 33] * mul, s[5 * 33] * mul); o.w = pk2(s[6 * 33] * mul, s[7 * 33] * mul);
        *(GAS v4u*)(WT + (size_t)(n0 + n) * K + k0 + 8 * c) = o; }
    LDS_WAIT(); asm volatile("" ::: "memory");
}
__device__ __forceinline__ void store_row_bf16(bf16* orow, int lane, const f32x4 (&v)[4]) {
    GAS unsigned long long* o8 = (GAS unsigned long long*)orow + lane;
#pragma unroll
    for (int j = 0; j < 4; ++j) o8[64 * j] = (unsigned long long)pk2(v[j].x, v[j].y) | ((unsigned long long)pk2(v[j].z, v[j].w) << 32);
}
__device__ __forceinline__ void load_row_fp8(const unsigned char* irow, int lane, f32x4 (&v)[4]) {
    const GAS int* i4 = (const GAS int*)irow + lane;
#pragma unroll
    for (int j = 0; j < 4; ++j) { const int w = i4[64 * j]; const pg8::f32x2 a = __builtin_amdgcn_cvt_pk_f32_fp8(w, false), b = __builtin_amdgcn_cvt_pk_f32_fp8(w, true); v[j] = (f32x4){a.x, a.y, b.x, b.y} * 0.03125f; }
}
__device__ __forceinline__ void load_row_bf16(const bf16* irow, int lane, f32x4 (&v)[4]) {
    const GAS v2u* i8 = (const GAS v2u*)irow + lane;
#pragma unroll
    for (int j = 0; j < 4; ++j) { const v2u w = i8[64 * j]; v[j] = (f32x4){bfl(w.x), bfh(w.x), bfl(w.y), bfh(w.y)}; }
}
__device__ __forceinline__ void forget_row(const f32x4 (&v)[4], const LAS float* wff, float* lfrow, int lane) {
    float p[4];
#pragma unroll
    for (int h = 0; h < 4; ++h) { pg8::f32x2 s2 = {0.f, 0.f};
#pragma unroll
        for (int j = 0; j < 4; ++j) { const f32x4 w = *(const LAS f32x4*)(wff + h * 1024 + 256 * j + 4 * lane); s2 = (pg8::f32x2){v[j].x, v[j].y} * (pg8::f32x2){w.x, w.y} + s2; s2 = (pg8::f32x2){v[j].z, v[j].w} * (pg8::f32x2){w.z, w.w} + s2; }
        p[h] = wave_sum(s2.x + s2.y) + wff[4096 + h]; }
    if (lane < 4) { const float z = lane == 0 ? p[0] : lane == 1 ? p[1] : lane == 2 ? p[2] : p[3]; lfrow[lane] = log_sigmoid(z); }
}
__device__ __forceinline__ void stage_wff(Frame& F, int l, LAS float* wff) {
    const float* src = (const float*)(F.ws + WS_PAR) + PAR_WFF + l * 4100;
    for (int idx = F.tid; idx < 4100; idx += NWAVES * 64) wff[idx] = src[idx];
}

struct Args { const float* in[15]; float* out; unsigned char* ws; int naive, pad; };
__device__ __forceinline__ void p0_colmax(Frame& F, const Args& A) {
    const int p_lane = F.tid & 63, p_wave = __builtin_amdgcn_readfirstlane(F.tid >> 6);
    const int gw = F.vcu * NWAVES + p_wave, NGW = F.G * NWAVES;
    constexpr int CB_IN = (NIN + 63) / 64, PER_L = (CB_IN + 256) * 8;
    for (int it = gw; it < NLAYER * PER_L; it += NGW) { const int l = it / PER_L, r = it % PER_L, seg = r & 7, cbk = r >> 3;
        const float* W; int N, col; unsigned* cm;
        if (cbk < CB_IN) { W = A.in[I_WIN] + (size_t)l * DM * NIN; N = NIN; col = cbk * 64 + p_lane; cm = (unsigned*)(F.ws + CM_IN) + l * NIN; }
        else { const int e = (cbk - CB_IN) >> 4, cb = (cbk - CB_IN) & 15; W = A.in[I_WEIN] + ((size_t)l * 16 + e) * 1024 * 1024; N = 1024; col = cb * 64 + p_lane; cm = (unsigned*)(F.ws + CM_E) + (l * 16 + e) * 1024; }
        if (col < N) { float m = 0.f; const float* p = W + (size_t)(seg * 128) * N + col;
#pragma unroll 16
            for (int rr = 0; rr < 128; ++rr) m = fmaxf(m, fabsf(p[(size_t)rr * N]));
            __hip_atomic_fetch_max(cm + col, __float_as_uint(m), RLX_AGENT); } }
}
__device__ __forceinline__ void p0_strips(Frame& F, const Args& A) {
    const int tid = F.tid, lane = tid & 63, wave = __builtin_amdgcn_readfirstlane(tid >> 6);
    LAS float* sb = (LAS float*)(F.lds + RING_OFF);
    LAS float* pm = (LAS float*)(F.lds + GT_OFF);
    constexpr int SPL = 96 + 128 + 512, NSTRIP = NLAYER * SPL;
    struct SD { const float* W; int N, mode, r0; signed char* WT; float* sc; float mul; };
    auto desc = [&](int s_) -> SD { SD d; const int l = s_ / SPL, r = s_ % SPL; unsigned char* wl = F.ws + WS_W + (size_t)l * W_LAYER;
        if (r < 96) { d.W = A.in[I_WIN] + (size_t)l * DM * NIN; d.N = NIN; d.mode = 1; d.r0 = 32 * r; d.WT = (signed char*)(wl + W_IN); d.sc = (float*)(F.ws + WS_SWP) + l * NPROJ; d.mul = 1.0f / 127.0f; }
        else if (r < 224) { d.W = A.in[I_WIN] + (size_t)l * DM * NIN; d.N = NIN; d.mode = 2; d.r0 = 32 * (r - 96); d.WT = (signed char*)(wl + W_G); d.sc = (float*)(F.ws + WS_SWG) + l * NGATE; d.mul = -1.4426950408889634f / 127.0f; }
        else { const int rr = r - 224, e = rr >> 5; d.W = A.in[I_WEIN] + ((size_t)l * 16 + e) * 1024 * 1024; d.N = 1024; d.mode = 3; d.r0 = 32 * (rr & 31); d.WT = (signed char*)(wl + W_E1) + (size_t)e * 1024 * 1024; d.sc = (float*)(F.ws + WS_SWE) + (l * 16 + e) * 1024; d.mul = 1.0f / 127.0f; }
        return d; };
    f32x4 raw[16];
    auto issue = [&](const SD& d) {
#pragma unroll
        for (int j = 0; j < 16; ++j) { const int idx = tid + 512 * j, k = idx >> 3, q = idx & 7; raw[j] = *(const GAS f32x4*)(d.W + (size_t)k * d.N + src_col(d.mode, d.r0 + 4 * q)); } };
    int s_ = F.vcu;
    SD cur = desc(s_ < NSTRIP ? s_ : 0); issue(cur);
    for (; s_ < NSTRIP; s_ += F.G) {
#pragma unroll
        for (int j = 0; j < 16; ++j) { const int idx = tid + 512 * j; *(LAS f32x4*)(sb + (idx >> 3) * 32 + 4 * (idx & 7)) = raw[j]; }
        const SD nxt = desc(s_ + F.G < NSTRIP ? s_ + F.G : s_); issue(nxt);
        __syncthreads();
        const int n = lane & 31, kg = wave * 2 + (lane >> 5);
        float v[64]; float m = 0.f;
#pragma unroll
        for (int i = 0; i < 64; ++i) { v[i] = sb[(64 * kg + i) * 32 + n]; m = fmaxf(m, fabsf(v[i])); }
        pm[n * 16 + kg] = m;
        __syncthreads();
        float cm = 0.f;
#pragma unroll
        for (int g = 0; g < 4; ++g) { const f32x4 t4 = *(const LAS f32x4*)(pm + n * 16 + 4 * g); cm = fmaxf(cm, fmaxf(fmaxf(t4.x, t4.y), fmaxf(t4.z, t4.w))); }
        cm = fmaxf(cm, 1e-30f);
        const float inv = 127.0f / cm;
        signed char* orow = cur.WT + (size_t)(cur.r0 + n) * 1024 + 64 * kg;
#pragma unroll
        for (int g = 0; g < 4; ++g) { v4u o; o.x = q8x4(v[16 * g + 0], v[16 * g + 1], v[16 * g + 2], v[16 * g + 3], inv); o.y = q8x4(v[16 * g + 4], v[16 * g + 5], v[16 * g + 6], v[16 * g + 7], inv);
            o.z = q8x4(v[16 * g + 8], v[16 * g + 9], v[16 * g + 10], v[16 * g + 11], inv); o.w = q8x4(v[16 * g + 12], v[16 * g + 13], v[16 * g + 14], v[16 * g + 15], inv); *(GAS v4u*)(orow + 16 * g) = o; }
        if (kg == 0) cur.sc[cur.r0 + n] = cm * cur.mul;
        cur = nxt;
    }
    __syncthreads();
}
template <int K, class Desc>
__device__ __forceinline__ void p0_strips_bf16(Frame& F, int nstrip, const Desc& desc) {
    const int tid = F.tid, lane = tid & 63, wave = __builtin_amdgcn_readfirstlane(tid >> 6);
    LAS float* sb = (LAS float*)(F.lds + RING_OFF);
    constexpr int NL = K / 64, KPT = K / 16;
    struct BD { const float* W; int N, r0; bf16* WT; float mul; };
    f32x4 raw[NL];
    auto issue = [&](const BD& d) {
#pragma unroll
        for (int j = 0; j < NL; ++j) { const int idx = tid + 512 * j, k = idx >> 3, q = idx & 7; raw[j] = *(const GAS f32x4*)(d.W + (size_t)k * d.N + d.r0 + 4 * q); } };
    int s_ = F.vcu;
    BD cur; { const int c_ = s_ < nstrip ? s_ : 0; desc(c_, cur.W, cur.N, cur.r0, cur.WT, cur.mul); } issue(cur);
    for (; s_ < nstrip; s_ += F.G) {
#pragma unroll
        for (int j = 0; j < NL; ++j) { const int idx = tid + 512 * j; *(LAS f32x4*)(sb + (idx >> 3) * 32 + 4 * (idx & 7)) = raw[j]; }
        BD nxt; { const int c_ = s_ + F.G < nstrip ? s_ + F.G : s_; desc(c_, nxt.W, nxt.N, nxt.r0, nxt.WT, nxt.mul); } issue(nxt);
        __syncthreads();
        const int n = lane & 31, kg = wave * 2 + (lane >> 5);
        bf16* orow = cur.WT + (size_t)(cur.r0 + n) * K + KPT * kg;
#pragma unroll
        for (int g = 0; g < KPT / 8; ++g) { float v[8];
#pragma unroll
            for (int i = 0; i < 8; ++i) v[i] = sb[(KPT * kg + 8 * g + i) * 32 + n] * cur.mul;
            v4u o; o.x = pk2(v[0], v[1]); o.y = pk2(v[2], v[3]); o.z = pk2(v[4], v[5]); o.w = pk2(v[6], v[7]); *(GAS v4u*)(orow + 8 * g) = o; }
        __syncthreads();
        cur = nxt;
    }
}
__device__ __forceinline__ void p0_prologue(Frame& F, const Args& A) {
    const int p_lane = F.tid & 63, p_wave = __builtin_amdgcn_readfirstlane(F.tid >> 6);
    LAS float* scr = (LAS float*)(F.lds + RING_OFF + p_wave * 8704);
    LAS float* wff = (LAS float*)(F.lds + RING_OFF + 81920);
    const int gw = F.vcu * NWAVES + p_wave, NGW = F.G * NWAVES;
    p0_strips(F, A);
    p0_strips_bf16<256>(F, NLAYER * 4 * 32, [&](int c, const float*& W, int& N, int& r0, bf16*& WT, float& mul) { const int l = c >> 7, nb = (c >> 5) & 3; W = A.in[I_WBRANCH] + ((size_t)l * 4 + nb) * 256 * 1024; N = 1024; r0 = 32 * (c & 31);
        WT = (bf16*)(F.ws + WS_W + (size_t)l * W_LAYER + W_B) + (size_t)nb * 1024 * 256; mul = 32.0f; });
    p0_strips_bf16<1024>(F, NLAYER * 32 + NLAYER * 16, [&](int c, const float*& W, int& N, int& r0, bf16*& WT, float& mul) {
        if (c < NLAYER * 32) { const int l = c >> 5; W = A.in[I_WOUT] + (size_t)l * 1024 * 1024; N = 1024; r0 = 32 * (c & 31); WT = (bf16*)(F.ws + WS_W + (size_t)l * W_LAYER + W_OUT); mul = 32.0f; }
        else { const int c2 = c - NLAYER * 32, l = c2 >> 4; W = A.in[I_WMEMKV] + (size_t)l * 1024 * 512; N = 512; r0 = 32 * (c2 & 15); WT = (bf16*)(F.ws + WS_WMEM) + (size_t)l * 512 * 1024; mul = 1.0f; } });
    p0_strips_bf16<512>(F, NLAYER * 16 * 32, [&](int c, const float*& W, int& N, int& r0, bf16*& WT, float& mul) { const int l = c >> 9, e = (c >> 5) & 15; W = A.in[I_WEOUT] + ((size_t)l * 16 + e) * 512 * 1024; N = 1024; r0 = 32 * (c & 31);
        WT = (bf16*)(F.ws + WS_W + (size_t)l * W_LAYER + W_E2) + (size_t)e * 1024 * 512; mul = 1.0f; });
    { const float* Win0 = A.in[I_WIN]; const float* bin0 = A.in[I_BIN];
      for (int idx = F.tid; idx < 4096; idx += NWAVES * 64) { const int k = idx >> 2, h = idx & 3; wff[h * 1024 + k] = Win0[(size_t)k * NIN + FOX_F_COL + h]; }
      if (F.tid < 4) wff[4096 + F.tid] = bin0[FOX_F_COL + F.tid]; }
    { const int gt = blockIdx.x * (NWAVES * 64) + F.tid, NGT = F.G * NWAVES * 64;
      float* bp = (float*)(F.ws + WS_BIASP); float* bg = (float*)(F.ws + WS_BIASG);
      for (int i = gt; i < NLAYER * NPROJ; i += NGT) { const int l = i / NPROJ, r = i % NPROJ; bp[i] = A.in[I_BIN][(size_t)l * NIN + src_col(1, r)]; }
      for (int i = gt; i < NLAYER * NGATE; i += NGT) { const int l = i / NGATE, r = i % NGATE; bg[i] = -1.4426950408889634f * A.in[I_BIN][(size_t)l * NIN + src_col(2, r)]; }
      float* rc = (float*)(F.ws + WS_ROPE); float* rs = rc + SEQ * 32;
      for (int i = gt; i < SEQ * 32; i += NGT) { const int pos = i >> 5, f = i & 31; const float inv = powf(10000.0f, -2.0f * (float)f / 64.0f); const float ang = (float)pos * inv; rc[i] = cosf(ang); rs[i] = sinf(ang); }
      float* par = (float*)(F.ws + WS_PAR);
      for (int i = gt; i < 4096; i += NGT) { par[PAR_LNG + i] = A.in[I_LNG][i]; par[PAR_LNB + i] = A.in[I_LNB][i]; }
      for (int i = gt; i < 16384; i += NGT) par[PAR_WR + i] = A.in[I_WROUTER][i];
      for (int i = gt; i < 16; i += NGT) par[PAR_BR + i] = A.in[I_BROUTER][i];
      for (int i = gt; i < 512; i += NGT) par[PAR_LB + i] = A.in[I_LB][i];
      for (int i = gt; i < 128; i += NGT) par[PAR_NG + i] = A.in[I_NORMG][i];
      for (int i = gt; i < NLAYER * 4096; i += NGT) { const int l = i >> 12, k = (i & 4095) >> 2, h = i & 3; par[PAR_WFF + l * 4100 + h * 1024 + k] = A.in[I_WIN][((size_t)l * DM + k) * NIN + FOX_F_COL + h]; }
      for (int i = gt; i < NLAYER * 4; i += NGT) { const int l = i >> 2, h = i & 3; par[PAR_WFF + l * 4100 + 4096 + h] = A.in[I_BIN][(size_t)l * NIN + FOX_F_COL + h]; } }
    __syncthreads();
    for (int m = gw; m < T; m += NGW) {
        const GAS f32x4* xr = (const GAS f32x4*)(A.in[I_X] + (size_t)m * DM) + p_lane;
        f32x4 v[4];
#pragma unroll
        for (int j = 0; j < 4; ++j) v[j] = xr[64 * j];
        store_row_i8((signed char*)(F.ws + WS_X8) + (size_t)m * DM, (float*)(F.ws + WS_SX) + m, p_lane, v);
        forget_row(v, wff, (float*)(F.ws + WS_LF) + (size_t)m * 4, p_lane);
    }
    for (int m = gw; m < MEMROWS; m += NGW) {
        const GAS f32x4* xr = (const GAS f32x4*)(A.in[I_MEM] + (size_t)m * DM) + p_lane;
        f32x4 v[4];
#pragma unroll
        for (int j = 0; j < 4; ++j) v[j] = xr[64 * j];
        store_row_bf16((bf16*)(F.ws + WS_MEMB) + (size_t)m * DM, p_lane, v);
    }
}

__device__ __forceinline__ void cc_scan(Frame& F) {
    int tid_ = F.tid; OPAQUE_V(tid_); const int c_lane = tid_ & 63, c_wave = __builtin_amdgcn_readfirstlane(tid_ >> 6);
    if (F.bx < BATCH * NH && c_wave == 0) {
        const int bh = F.bx, b = bh >> 2, h = bh & 3, s0 = 32 * c_lane;
        const float* lf = (const float*)(F.ws + WS_LF) + ((size_t)b * SEQ + s0) * 4 + h;
        float loc[32]; float run = 0.f;
#pragma unroll
        for (int i = 0; i < 32; ++i) { run += lf[4 * i]; loc[i] = run; }
        float incl = run;
#pragma unroll
        for (int o = 1; o < 64; o <<= 1) { const float t = __shfl_up(incl, o); if (c_lane >= o) incl += t; }
        const float excl = incl - run;
        float* cc = (float*)(F.ws + WS_CC) + (size_t)bh * SEQ + s0;
#pragma unroll
        for (int i = 0; i < 32; ++i) cc[i] = excl + loc[i];
    }
}

namespace att {
typedef float f32x16 __attribute__((ext_vector_type(16)));
typedef short bf16x8 __attribute__((ext_vector_type(8)));
typedef short s16x4 __attribute__((ext_vector_type(4)));
typedef short v4i16_t __attribute__((ext_vector_type(4)));
constexpr int KBUF = 0, VBUF = 16384, KB_OFF = 32768, ATT_LDS = 32768 + 8192;
constexpr float C2 = 0.125f * 1.4426950408889634f;
__device__ __forceinline__ int crow(int r, int hi) { return (r & 3) + 8 * (r >> 2) + 4 * hi; }
__device__ __forceinline__ s16x4 vtr(const LAS char* p) { return __builtin_bit_cast(s16x4, __builtin_amdgcn_ds_read_tr16_b64_v4i16((LAS v4i16_t*)p)); }
template <bool CAUSAL>
__device__ __forceinline__ void attn_unit(LAS char* lds, const bf16* Qp, int qpitch, const bf16* Kp, const bf16* Vp, int kvpitch, int ntiles, int q0, const float* ccp, bf16* Op, int opitch, int tid) {
    const int lane = tid & 63, wid = __builtin_amdgcn_readfirstlane(tid >> 6), r32 = lane & 31, hi = lane >> 5;
    LAS float* kb = (LAS float*)(lds + KB_OFF);
    if (CAUSAL) { for (int k = tid; k < ntiles * 64; k += 512) kb[k] = -1.4426950408889634f * ccp[k]; }
    bf16x8 qr[4];
#pragma unroll
    for (int d0 = 0; d0 < 4; ++d0) qr[d0] = *(const bf16x8*)(Qp + (size_t)(32 * wid + r32) * qpitch + 16 * d0 + 8 * hi);
    const int kvr = tid >> 3, ch = tid & 7;
    const bf16* kg = Kp + (size_t)kvr * kvpitch + ch * 8; const bf16* vg = Vp + (size_t)kvr * kvpitch + ch * 8;
    const int kl = ch * 1024 + kvr * 16, vl = (ch >> 2) * 4096 + kvr * 64 + (ch & 3) * 16;
    v4u kreg = *(const v4u*)kg, vreg = *(const v4u*)vg;
    *(LAS v4u*)(lds + KBUF + kl) = kreg; *(LAS v4u*)(lds + VBUF + vl) = vreg;
    __syncthreads();
    const int qabs = q0 + 32 * wid + r32, qwmax = q0 + 32 * wid + 31;
    float mrun = CAUSAL ? kb[qabs] : 0.f, lrun = 0.f; f32x16 o0 = {}, o1 = {};
    f32x16 cinit;
#pragma unroll
    for (int r = 0; r < 16; ++r) cinit[r] = -mrun * (1.0f / C2);
    const int vrd = (4 * hi + ((lane & 15) >> 2)) * 64 + ((lane >> 4) & 1) * 32 + (lane & 3) * 8;
    for (int t = 0; t < ntiles; ++t) {
        const int buf = (t & 1) * 8192;
        if (t + 1 < ntiles) { kreg = *(const v4u*)(kg + (size_t)(t + 1) * 64 * kvpitch); vreg = *(const v4u*)(vg + (size_t)(t + 1) * 64 * kvpitch); }
        const int kv0 = 64 * t;
        if (!CAUSAL || kv0 <= qwmax) {
            const LAS char* Kb = lds + KBUF + buf; const LAS char* Vb = lds + VBUF + buf;
            const bool band = t >= ntiles - 4;
            f32x16 p0, p1;
            auto scores = [&]() {
                p0 = cinit; p1 = cinit;
#pragma unroll
                for (int d0 = 0; d0 < 4; ++d0) { const bf16x8 a0 = *(const LAS bf16x8*)(Kb + (2 * d0 + hi) * 1024 + r32 * 16), a1 = *(const LAS bf16x8*)(Kb + (2 * d0 + hi) * 1024 + (32 + r32) * 16);
                    p0 = __builtin_amdgcn_mfma_f32_32x32x16_bf16(a0, qr[d0], p0, 0, 0, 0); p1 = __builtin_amdgcn_mfma_f32_32x32x16_bf16(a1, qr[d0], p1, 0, 0, 0); }
#pragma unroll
                for (int g = 0; g < 4; ++g) { f32x4 b0 = {0.f, 0.f, 0.f, 0.f}, b1 = {0.f, 0.f, 0.f, 0.f};
                    if (CAUSAL) { b0 = *(const LAS f32x4*)(kb + kv0 + 8 * g + 4 * hi); b1 = *(const LAS f32x4*)(kb + kv0 + 32 + 8 * g + 4 * hi); }
#pragma unroll
                    for (int j = 0; j < 4; ++j) { const int r = 4 * g + j; float s0 = p0[r] * C2 + b0[j], s1 = p1[r] * C2 + b1[j];
                        if (CAUSAL && band) { const int kv = kv0 + 8 * g + 4 * hi + j; if (kv > qabs) s0 = -INFINITY; if (kv + 32 > qabs) s1 = -INFINITY; }
                        p0[r] = s0; p1[r] = s1; } } };
            scores();
            float rs = 0.f;
#pragma unroll
            for (int r = 0; r < 16; ++r) { p0[r] = __builtin_amdgcn_exp2f(p0[r]); p1[r] = __builtin_amdgcn_exp2f(p1[r]); rs += p0[r] + p1[r]; }
            if (__any(!(rs < 1.0995116e12f))) {
                scores();
                float mx = -1e30f;
#pragma unroll
                for (int r = 0; r < 16; ++r) mx = fmaxf(mx, fmaxf(p0[r], p1[r]));
                mx = fmaxf(mx, __shfl_xor(mx, 32));
                const float dl = mx > 0.f ? mx : 0.f, alpha = __builtin_amdgcn_exp2f(-dl); mrun += dl; lrun *= alpha;
                rs = 0.f;
#pragma unroll
                for (int r = 0; r < 16; ++r) { o0[r] *= alpha; o1[r] *= alpha; cinit[r] = -mrun * (1.0f / C2); p0[r] = __builtin_amdgcn_exp2f(p0[r] - dl); p1[r] = __builtin_amdgcn_exp2f(p1[r] - dl); rs += p0[r] + p1[r]; } }
            lrun += rs;
            bf16x8 pf[4];
#pragma unroll
            for (int s = 0; s < 2; ++s) { pg8::u32x4 w0, w1;
                w0.x = pg8::cvt_pk_bf16(p0[8 * s + 0], p0[8 * s + 1]); w0.y = pg8::cvt_pk_bf16(p0[8 * s + 2], p0[8 * s + 3]); w0.z = pg8::cvt_pk_bf16(p0[8 * s + 4], p0[8 * s + 5]); w0.w = pg8::cvt_pk_bf16(p0[8 * s + 6], p0[8 * s + 7]);
                w1.x = pg8::cvt_pk_bf16(p1[8 * s + 0], p1[8 * s + 1]); w1.y = pg8::cvt_pk_bf16(p1[8 * s + 2], p1[8 * s + 3]); w1.z = pg8::cvt_pk_bf16(p1[8 * s + 4], p1[8 * s + 5]); w1.w = pg8::cvt_pk_bf16(p1[8 * s + 6], p1[8 * s + 7]);
                pf[s] = __builtin_bit_cast(bf16x8, w0); pf[2 + s] = __builtin_bit_cast(bf16x8, w1); }
#pragma unroll
            for (int s = 0; s < 4; ++s) {
                const s16x4 l0 = vtr(Vb + vrd + s * 1024), h0 = vtr(Vb + vrd + s * 1024 + 512), l1 = vtr(Vb + 4096 + vrd + s * 1024), h1 = vtr(Vb + 4096 + vrd + s * 1024 + 512);
                const bf16x8 va = (bf16x8){l0[0], l0[1], l0[2], l0[3], h0[0], h0[1], h0[2], h0[3]}, vb = (bf16x8){l1[0], l1[1], l1[2], l1[3], h1[0], h1[1], h1[2], h1[3]};
                o0 = __builtin_amdgcn_mfma_f32_32x32x16_bf16(va, pf[s], o0, 0, 0, 0); o1 = __builtin_amdgcn_mfma_f32_32x32x16_bf16(vb, pf[s], o1, 0, 0, 0); }
        }
        if (t + 1 < ntiles) { *(LAS v4u*)(lds + KBUF + (buf ^ 8192) + kl) = kreg; *(LAS v4u*)(lds + VBUF + (buf ^ 8192) + vl) = vreg; }
        __syncthreads();
    }
    const float inv = 1.0f / (lrun + __shfl_xor(lrun, 32));
    bf16* orow = Op + (size_t)(32 * wid + r32) * opitch + 4 * hi;
#pragma unroll
    for (int g = 0; g < 4; ++g) { v2u w0, w1;
        w0.x = pg8::cvt_pk_bf16(o0[4 * g] * inv, o0[4 * g + 1] * inv); w0.y = pg8::cvt_pk_bf16(o0[4 * g + 2] * inv, o0[4 * g + 3] * inv);
        w1.x = pg8::cvt_pk_bf16(o1[4 * g] * inv, o1[4 * g + 1] * inv); w1.y = pg8::cvt_pk_bf16(o1[4 * g + 2] * inv, o1[4 * g + 3] * inv);
        *(v2u*)(orow + 8 * g) = w0; *(v2u*)(orow + 32 + 8 * g) = w1; }
}
}
__device__ __forceinline__ void attn_phase(Frame& F, int l) {
    int tid = F.tid; OPAQUE_V(tid);
    LAS char* lds = (LAS char*)(F.lds + RING_OFF);
    const bf16* proj = (const bf16*)(F.ws + WS_PROJ); const bf16* memkv = (const bf16*)(F.ws + WS_MEMKV); const float* cc = (const float*)(F.ws + WS_CC); bf16* br = (bf16*)((unsigned char*)F.out);
    LAS int* qslot = (LAS int*)(F.lds + SM_OFF + 512);
    for (;;) {
        __syncthreads();
        if (tid == 0) *qslot = (int)__hip_atomic_fetch_add((unsigned*)(F.ctl + CW_Q + l * 64), 1u, RLX_AGENT);
        __syncthreads();
        const int it = *qslot;
        if (it >= 768) break;
        if (it < 512) { const int bh = it >> 2, pi = it & 3, b = bh >> 2, h = bh & 3; const size_t row0 = (size_t)b * SEQ;
            for (int k = 0; k < 2; ++k) { const int qb = k ? 7 - pi : pi, q0 = qb * 256;
                att::attn_unit<true>(lds, proj + (row0 + q0) * NPROJ + h * 64, NPROJ, proj + row0 * NPROJ + 256 + h * 64, proj + row0 * NPROJ + 512 + h * 64, NPROJ, q0 / 64 + 4, q0, cc + (size_t)bh * SEQ,
                                     br + (row0 + q0) * 1024 + h * 64, 1024, tid); } }
        else { for (int k = 0; k < 4; ++k) { const int u = (it - 512) * 4 + k; const int bh = u >> 3, qb = u & 7, b = bh >> 2, h = bh & 3, q0 = qb * 256; const size_t row0 = (size_t)b * SEQ;
                const bf16* kp = memkv + (size_t)b * NMEM * 1024 + l * 512 + h * 64;
                att::attn_unit<false>(lds, proj + (row0 + q0) * NPROJ + 2816 + h * 64, NPROJ, kp, kp + 256, 1024, NMEM / 64, q0, nullptr, br + (row0 + q0) * 1024 + 768 + h * 64, 1024, tid); } }
    }
}

namespace rec {
using att::f32x16; using att::bf16x8; using att::s16x4; using att::vtr;
constexpr int OPB = 40960;
constexpr int Q1C = 0, Q2C = 8192, K1C = 16384, K2V = 24576, VV = 32768, ST0 = 81920, OFO = 98304, OFB = 17408, TOTO = 133120, DECO = 137216;
constexpr int OFP = 68;
__device__ __forceinline__ v2u pk4(float a, float b, float c, float d) { v2u w; w.x = pg8::cvt_pk_bf16(a, b); w.y = pg8::cvt_pk_bf16(c, d); return w; }
template <bool HG>
__device__ __forceinline__ void recur_unit(LAS char* lds, const bf16* pj, bf16* ob, int h, int l, const float* par, const float* rope, int tid) {
    const int lane = tid & 63, wid = __builtin_amdgcn_readfirstlane(tid >> 6), r32 = lane & 31, hi = lane >> 5;
    const int t = tid >> 3, c8 = tid & 7;
    constexpr int NCH = SEQ / 64;
    constexpr int CQ = HG ? 2304 : 768, CK = HG ? 1792 : 1024, CV = HG ? 2048 : 1280, CG = HG ? 2560 : 1536;
    const float lg2 = HG ? 0.f : log2f(1.0f - exp2f(-5.0f - (float)h));
    float lbv[8];
#pragma unroll
    for (int e = 0; e < 8; ++e) { lbv[e] = 0.f; if (HG && l == 1) { const float a0 = par[PAR_LB + h * 64 + 8 * c8 + e], a1 = par[PAR_LB + 256 + h * 64 + 8 * c8 + e]; lbv[e] = 1.f / (1.f + expf(a0 - a1)); } }
    float ngv[8];
#pragma unroll
    for (int e = 0; e < 8; ++e) ngv[e] = HG ? par[PAR_NG + l * 64 + 8 * c8 + e] : 1.f;
    for (int i = tid; i < 4096; i += 512) ((LAS unsigned*)(lds + ST0))[i] = 0u;
    if (!HG && tid < 128) ((LAS float*)(lds + DECO))[tid] = exp2f(lg2 * 64.f);
    f32x16 st = {};
    const int tiO = wid & 1, tvO = (wid >> 1) & 1;
    f32x16 dm0 = {}, dm1 = {};
    if (!HG) {
#pragma unroll
        for (int r = 0; r < 16; ++r) { const int dj = 32 * tiO + r32 - ((r & 3) + 8 * (r >> 2) + 4 * hi); dm0[r] = __builtin_amdgcn_exp2f(lg2 * fabsf((float)dj)); dm1[r] = __builtin_amdgcn_exp2f(lg2 * fabsf((float)(dj - 32))); } }
    const float gq = __builtin_amdgcn_exp2f(lg2 * (float)(t + 1)), gk = __builtin_amdgcn_exp2f(lg2 * (float)(63 - t));
    v4u rq, rk, rv; f32x4 rco = {0.f, 0.f, 0.f, 0.f}, rsi = {0.f, 0.f, 0.f, 0.f};
    float runc[8], kfc[8]; v4u qc = {0u, 0u, 0u, 0u}, vc = {0u, 0u, 0u, 0u};
#pragma unroll
    for (int e = 0; e < 8; ++e) { runc[e] = 0.f; kfc[e] = 0.f; }
#define REC_LOAD(n) do { const bf16* rp_ = pj + (size_t)((n) * 64 + t) * NPROJ; \
        if (HG) { rq = *(const v4u*)(rp_ + CQ + 8 * c8); rk = *(const v4u*)(rp_ + CK + 8 * c8); } \
        else { const v2u a_ = *(const v2u*)(rp_ + CQ + 4 * c8), b_ = *(const v2u*)(rp_ + CQ + 32 + 4 * c8), c_ = *(const v2u*)(rp_ + CK + 4 * c8), d_ = *(const v2u*)(rp_ + CK + 32 + 4 * c8); \
               rq = (v4u){a_.x, a_.y, b_.x, b_.y}; rk = (v4u){c_.x, c_.y, d_.x, d_.y}; \
               rco = *(const f32x4*)(rope + ((n) * 64 + t) * 32 + 4 * c8); rsi = *(const f32x4*)(rope + SEQ * 32 + ((n) * 64 + t) * 32 + 4 * c8); } \
        rv = *(const v4u*)(rp_ + CV + 8 * c8); } while (0)
    REC_LOAD(0);
    __syncthreads();
    v4u gC = {0u, 0u, 0u, 0u};
    const int vrd = (4 * hi + ((lane & 15) >> 2)) * 64 + ((lane >> 4) & 1) * 32 + (lane & 3) * 8;
#pragma unroll 1
    for (int i = HG ? -2 : -1; i <= NCH; ++i) {
        if (!HG) {
            if (i + 1 < NCH) { const int ob_ = ((i + 1) & 1) * OPB;
                const float q1[4] = {bfl(rq.x), bfh(rq.x), bfl(rq.y), bfh(rq.y)}, q2[4] = {bfl(rq.z), bfh(rq.z), bfl(rq.w), bfh(rq.w)};
                const float k1[4] = {bfl(rk.x), bfh(rk.x), bfl(rk.y), bfh(rk.y)}, k2[4] = {bfl(rk.z), bfh(rk.z), bfl(rk.w), bfh(rk.w)};
                float qa[4], qb[4], ka[4], kb[4];
#pragma unroll
                for (int e = 0; e < 4; ++e) { qa[e] = q1[e] * rco[e] - q2[e] * rsi[e]; qb[e] = q1[e] * rsi[e] + q2[e] * rco[e]; ka[e] = (k1[e] * rco[e] - k2[e] * rsi[e]) * 0.125f; kb[e] = (k1[e] * rsi[e] + k2[e] * rco[e]) * 0.125f; }
                const int ca = ob_ + (c8 >> 1) * 1024 + t * 16 + 8 * (c8 & 1), cb = ca + 4096;
                *(LAS v2u*)(lds + Q1C + ca) = pk4(qa[0], qa[1], qa[2], qa[3]); *(LAS v2u*)(lds + Q1C + cb) = pk4(qb[0], qb[1], qb[2], qb[3]);
                *(LAS v2u*)(lds + Q2C + ca) = pk4(qa[0] * gq, qa[1] * gq, qa[2] * gq, qa[3] * gq); *(LAS v2u*)(lds + Q2C + cb) = pk4(qb[0] * gq, qb[1] * gq, qb[2] * gq, qb[3] * gq);
                *(LAS v2u*)(lds + K1C + ca) = pk4(ka[0], ka[1], ka[2], ka[3]); *(LAS v2u*)(lds + K1C + cb) = pk4(kb[0], kb[1], kb[2], kb[3]);
                const int va = ob_ + t * 64 + 8 * c8;
                *(LAS v2u*)(lds + K2V + va) = pk4(ka[0] * gk, ka[1] * gk, ka[2] * gk, ka[3] * gk); *(LAS v2u*)(lds + K2V + 4096 + va) = pk4(kb[0] * gk, kb[1] * gk, kb[2] * gk, kb[3] * gk);
                *(LAS v4u*)(lds + VV + ob_ + (c8 >> 2) * 4096 + t * 64 + (c8 & 3) * 16) = rv; }
        } else {
            if (i + 1 >= 0 && i + 1 < NCH) { const int ob_ = ((i + 1) & 1) * OPB;
                const LAS float* TOT = (const LAS float*)(lds + TOTO + ((i + 1) & 1) * 2048);
                float bb[8], bm[8], bl[8];
#pragma unroll
                for (int e = 0; e < 8; ++e) { bb[e] = runc[e]; bm[e] = 0.f; bl[e] = 0.f; }
#pragma unroll
                for (int w2 = 0; w2 < 8; ++w2) { const f32x4 t0 = *(const LAS f32x4*)(TOT + w2 * 64 + 8 * c8), t1 = *(const LAS f32x4*)(TOT + w2 * 64 + 8 * c8 + 4);
                    const float tt[8] = {t0[0], t0[1], t0[2], t0[3], t1[0], t1[1], t1[2], t1[3]};
#pragma unroll
                    for (int e = 0; e < 8; ++e) { if (w2 < wid) bb[e] += tt[e]; if (w2 < 4) bm[e] += tt[e]; bl[e] += tt[e]; } }
                const float qv[8] = {bfl(qc.x), bfh(qc.x), bfl(qc.y), bfh(qc.y), bfl(qc.z), bfh(qc.z), bfl(qc.w), bfh(qc.w)};
                float A1[8], A2[8], B1[8], B2[8];
#pragma unroll
                for (int e = 0; e < 8; ++e) { A1[e] = qv[e] * __builtin_amdgcn_exp2f(fminf(bb[e] - bm[e], 115.f)); A2[e] = qv[e] * __builtin_amdgcn_exp2f(bb[e]); B1[e] = kfc[e] * __builtin_amdgcn_exp2f(fminf(bm[e] - bb[e], 115.f)); B2[e] = kfc[e] * __builtin_amdgcn_exp2f(bl[e] - bb[e]); }
                const int ca = ob_ + c8 * 1024 + t * 16, va = ob_ + (c8 >> 2) * 4096 + t * 64 + (c8 & 3) * 16;
#define PK8(x) (v4u){pg8::cvt_pk_bf16(x[0], x[1]), pg8::cvt_pk_bf16(x[2], x[3]), pg8::cvt_pk_bf16(x[4], x[5]), pg8::cvt_pk_bf16(x[6], x[7])}
                *(LAS v4u*)(lds + Q1C + ca) = PK8(A1); *(LAS v4u*)(lds + Q2C + ca) = PK8(A2); *(LAS v4u*)(lds + K1C + ca) = PK8(B1); *(LAS v4u*)(lds + K2V + va) = PK8(B2);
#undef PK8
                *(LAS v4u*)(lds + VV + va) = vc;
                if (t == 0) {
#pragma unroll
                    for (int e = 0; e < 8; ++e) ((LAS float*)(lds + DECO + ((i + 1) & 1) * 256))[8 * c8 + e] = __builtin_amdgcn_exp2f(bl[e]); }
            }
            if (i + 2 < NCH) {
                const float zf[8] = {bfl(rk.x), bfh(rk.x), bfl(rk.y), bfh(rk.y), bfl(rk.z), bfh(rk.z), bfl(rk.w), bfh(rk.w)};
#pragma unroll
                for (int e = 0; e < 8; ++e) { const float ez = __builtin_amdgcn_exp2f(-1.4426950408889634f * zf[e]); const float r1 = __builtin_amdgcn_rcpf(1.f + ez); const float f = lbv[e] + (1.f - lbv[e]) * r1; runc[e] = __builtin_amdgcn_logf(f); kfc[e] = (1.f - lbv[e]) * (ez * r1); }
#pragma unroll
                for (int st_ = 8; st_ < 64; st_ <<= 1) {
#pragma unroll
                    for (int e = 0; e < 8; ++e) { const float v_ = __shfl_up(runc[e], st_); if (lane >= st_) runc[e] += v_; } }
                LAS float* TOTw = (LAS float*)(lds + TOTO + ((i + 2) & 1) * 2048);
                if ((lane >> 3) == 7) { *(LAS f32x4*)(TOTw + wid * 64 + 8 * c8) = (f32x4){runc[0], runc[1], runc[2], runc[3]}; *(LAS f32x4*)(TOTw + wid * 64 + 8 * c8 + 4) = (f32x4){runc[4], runc[5], runc[6], runc[7]}; }
                qc = rq; vc = rv; }
        }
        if (i >= 1) { const LAS float* OFr = (const LAS float*)(lds + OFO + ((i - 1) & 1) * OFB) + t * OFP + 8 * c8;
          const f32x4 x0 = *(const LAS f32x4*)OFr, x1 = *(const LAS f32x4*)(OFr + 4);
          float ov[8] = {x0[0], x0[1], x0[2], x0[3], x1[0], x1[1], x1[2], x1[3]};
          float s1 = 0.f;
          if (!HG) {
#pragma unroll
              for (int e = 0; e < 8; ++e) s1 += ov[e];
              s1 = sum8(s1);
              const float mean = s1 * (1.f / 64.f);
#pragma unroll
              for (int e = 0; e < 8; ++e) ov[e] -= mean; }
          float ss = 0.f;
#pragma unroll
          for (int e = 0; e < 8; ++e) ss += ov[e] * ov[e];
          ss = sum8(ss);
          const float rr = rsqrtf(ss * (1.f / 64.f) + GN_EPS);
          const float gv[8] = {bfl(gC.x), bfh(gC.x), bfl(gC.y), bfh(gC.y), bfl(gC.z), bfh(gC.z), bfl(gC.w), bfh(gC.w)};
          float y[8];
#pragma unroll
          for (int e = 0; e < 8; ++e) y[e] = ov[e] * rr * ngv[e] * gv[e] * __builtin_amdgcn_rcpf(1.f + __builtin_amdgcn_exp2f(-1.4426950408889634f * gv[e]));
          *(v4u*)(ob + (size_t)((i - 1) * 64 + t) * 1024 + 8 * c8) = (v4u){pg8::cvt_pk_bf16(y[0], y[1]), pg8::cvt_pk_bf16(y[2], y[3]), pg8::cvt_pk_bf16(y[4], y[5]), pg8::cvt_pk_bf16(y[6], y[7])}; }
        { const int nl = i + (HG ? 3 : 2); REC_LOAD(nl < NCH ? nl : NCH - 1); gC = *(const v4u*)(pj + (size_t)((i >= 0 ? (i < NCH ? i : NCH - 1) : 0) * 64 + t) * NPROJ + CG + 8 * c8); }
        if (i >= 0 && i < NCH) {
            const int opb = (i & 1) * OPB, stc = ST0 + (i & 1) * 8192, stn = ST0 + ((i + 1) & 1) * 8192;
            if (wid < 4) {
                const int tv = tvO, ti = tiO;
                bf16x8 pf[4];
                f32x16 pt[2] = {{}, {}};
                const bool two = !HG || ti >= 1;
#pragma unroll
                for (int ks = 0; ks < 4; ++ks) { const bf16x8 b = *(const LAS bf16x8*)(lds + opb + Q1C + (2 * ks + hi) * 1024 + (32 * ti + r32) * 16);
                    const bf16x8 a0 = *(const LAS bf16x8*)(lds + opb + K1C + (2 * ks + hi) * 1024 + r32 * 16);
                    pt[0] = __builtin_amdgcn_mfma_f32_32x32x16_bf16(a0, b, pt[0], 0, 0, 0);
                    if (two) { const bf16x8 a1 = *(const LAS bf16x8*)(lds + opb + K1C + (2 * ks + hi) * 1024 + (32 + r32) * 16); pt[1] = __builtin_amdgcn_mfma_f32_32x32x16_bf16(a1, b, pt[1], 0, 0, 0); } }
#pragma unroll
                for (int tj = 0; tj < 2; ++tj) {
                    f32x16 p = pt[tj];
                    if (!HG || tj <= ti) {
                        const int iabs = 32 * ti + r32;
#pragma unroll
                        for (int r = 0; r < 16; ++r) { const int jabs = 32 * tj + (r & 3) + 8 * (r >> 2) + 4 * hi;
                            if (HG) p[r] = (jabs <= iabs) ? p[r] : 0.f; else p[r] *= (tj == 0 ? dm0[r] : dm1[r]); }
                    }
                    pg8::u32x4 w0, w1;
                    w0.x = pg8::cvt_pk_bf16(p[0], p[1]); w0.y = pg8::cvt_pk_bf16(p[2], p[3]); w0.z = pg8::cvt_pk_bf16(p[4], p[5]); w0.w = pg8::cvt_pk_bf16(p[6], p[7]);
                    w1.x = pg8::cvt_pk_bf16(p[8], p[9]); w1.y = pg8::cvt_pk_bf16(p[10], p[11]); w1.z = pg8::cvt_pk_bf16(p[12], p[13]); w1.w = pg8::cvt_pk_bf16(p[14], p[15]);
                    pf[2 * tj] = __builtin_bit_cast(bf16x8, w0); pf[2 * tj + 1] = __builtin_bit_cast(bf16x8, w1);
                }
                f32x16 o = {}, o2 = {};
#pragma unroll
                for (int ks = 0; ks < 4; ++ks) { const bf16x8 a = *(const LAS bf16x8*)(lds + stc + (2 * ks + hi) * 1024 + (32 * tv + r32) * 16), b = *(const LAS bf16x8*)(lds + opb + Q2C + (2 * ks + hi) * 1024 + (32 * ti + r32) * 16);
                    o = __builtin_amdgcn_mfma_f32_32x32x16_bf16(a, b, o, 0, 0, 0); }
#pragma unroll
                for (int s2 = 0; s2 < 4; ++s2) { const s16x4 lo = vtr(lds + opb + VV + tv * 4096 + vrd + s2 * 1024), hh = vtr(lds + opb + VV + tv * 4096 + vrd + s2 * 1024 + 512);
                    const bf16x8 va = (bf16x8){lo[0], lo[1], lo[2], lo[3], hh[0], hh[1], hh[2], hh[3]};
                    o2 = __builtin_amdgcn_mfma_f32_32x32x16_bf16(va, pf[s2], o2, 0, 0, 0); }
#pragma unroll
                for (int r = 0; r < 16; ++r) o[r] += o2[r];
                LAS float* OFp = (LAS float*)(lds + OFO + (i & 1) * OFB) + (32 * ti + r32) * OFP + 32 * tv + 4 * hi;
#pragma unroll
                for (int g = 0; g < 4; ++g) *(LAS f32x4*)(OFp + 8 * g) = (f32x4){o[4 * g], o[4 * g + 1], o[4 * g + 2], o[4 * g + 3]};
            } else {
                const int td = (wid - 4) & 1, tv = (wid - 4) >> 1;
                f32x16 pr = {};
#pragma unroll
                for (int s2 = 0; s2 < 4; ++s2) { const s16x4 lo = vtr(lds + opb + VV + tv * 4096 + vrd + s2 * 1024), hh = vtr(lds + opb + VV + tv * 4096 + vrd + s2 * 1024 + 512);
                    const s16x4 ko = vtr(lds + opb + K2V + td * 4096 + vrd + s2 * 1024), kh = vtr(lds + opb + K2V + td * 4096 + vrd + s2 * 1024 + 512);
                    const bf16x8 va = (bf16x8){lo[0], lo[1], lo[2], lo[3], hh[0], hh[1], hh[2], hh[3]}, kb2 = (bf16x8){ko[0], ko[1], ko[2], ko[3], kh[0], kh[1], kh[2], kh[3]};
                    pr = __builtin_amdgcn_mfma_f32_32x32x16_bf16(va, kb2, pr, 0, 0, 0); }
                const float dec = ((LAS float*)(lds + DECO + (i & 1) * 256))[32 * td + r32];
                const int d = 32 * td + r32;
                LAS bf16* stw = (LAS bf16*)(lds + stn + (d >> 3) * 1024 + (d & 7) * 2);
#pragma unroll
                for (int r = 0; r < 16; ++r) { st[r] = st[r] * dec + pr[r]; const int v = 32 * tv + (r & 3) + 8 * (r >> 2) + 4 * hi; stw[v * 8] = (bf16)f2bf(st[r]); }
            }
        }
        asm volatile("s_waitcnt lgkmcnt(0)" ::: "memory"); __builtin_amdgcn_s_barrier(); asm volatile("" ::: "memory");
    }
    __syncthreads();
#undef REC_LOAD
}
}
__device__ __forceinline__ void recur_phase(Frame& F, int l) {
    int tid = F.tid; OPAQUE_V(tid);
    LAS char* lds = (LAS char*)(F.lds + RING_OFF);
    const bf16* proj = (const bf16*)(F.ws + WS_PROJ); bf16* br = (bf16*)((unsigned char*)F.out); const float* par = (const float*)(F.ws + WS_PAR); const float* rope = (const float*)(F.ws + WS_ROPE);
    for (int u = F.vcu; u < 2 * BATCH * NH; u += F.G) { const int bh = u & 127, b = bh >> 2, h = bh & 3; const size_t row0 = (size_t)b * SEQ;
        if (u < 128) rec::recur_unit<false>(lds, proj + row0 * NPROJ + h * 64, br + row0 * 1024 + 256 + h * 64, h, l, par, rope, tid);
        else rec::recur_unit<true>(lds, proj + row0 * NPROJ + h * 64, br + row0 * 1024 + 512 + h * 64, h, l, par, rope, tid); }
}

__device__ __forceinline__ void naive_attn(Frame& F, int l) {
    int tid_ = F.tid; OPAQUE_V(tid_); const int lane = tid_ & 63, wave_ = __builtin_amdgcn_readfirstlane(tid_ >> 6);
    const int gw = F.vcu * NWAVES + wave_, NGW = F.G * NWAVES;
    const bf16* proj = (const bf16*)(F.ws + WS_PROJ); const bf16* memkv = (const bf16*)(F.ws + WS_MEMKV);
    const float* cc = (const float*)(F.ws + WS_CC); bf16* br = (bf16*)((unsigned char*)F.out);
    constexpr int BHS = BATCH * NH * SEQ;
    for (int it = gw; it < 2 * BHS; it += NGW) {
        const bool is_mem = it >= BHS; const int r = is_mem ? it - BHS : it; const int bh = r / SEQ, s = r % SEQ, b = bh >> 2, h = bh & 3;
        const size_t tok = (size_t)b * SEQ + s;
        const bf16* qp = proj + tok * NPROJ + (is_mem ? 2816 : 0) + h * 64;
        float q[64];
#pragma unroll
        for (int c = 0; c < 8; ++c) { const v4u w = *(const v4u*)(qp + 8 * c); q[8 * c + 0] = bfl(w.x); q[8 * c + 1] = bfh(w.x); q[8 * c + 2] = bfl(w.y); q[8 * c + 3] = bfh(w.y); q[8 * c + 4] = bfl(w.z); q[8 * c + 5] = bfh(w.z); q[8 * c + 6] = bfl(w.w); q[8 * c + 7] = bfh(w.w); }
        const int nkeys = is_mem ? NMEM : s + 1;
        const bf16* kbase = is_mem ? memkv + (size_t)b * NMEM * 1024 + l * 512 + h * 64 : proj + (size_t)b * SEQ * NPROJ + 256 + h * 64;
        const size_t kpitch = is_mem ? 1024 : NPROJ; const int voff = 256;
        const float cq = is_mem ? 0.f : cc[(size_t)bh * SEQ + s];
        float mrun = -1e30f, lrun = 0.f; float o[64];
#pragma unroll
        for (int d = 0; d < 64; ++d) o[d] = 0.f;
        for (int k0 = 0; k0 < nkeys; k0 += 64) { const int kk = k0 + lane;
            if (kk < nkeys) { const bf16* kp = kbase + (size_t)kk * kpitch; float dot = 0.f;
#pragma unroll
                for (int c = 0; c < 8; ++c) { const v4u w = *(const v4u*)(kp + 8 * c);
                    dot += q[8 * c + 0] * bfl(w.x) + q[8 * c + 1] * bfh(w.x) + q[8 * c + 2] * bfl(w.y) + q[8 * c + 3] * bfh(w.y) + q[8 * c + 4] * bfl(w.z) + q[8 * c + 5] * bfh(w.z) + q[8 * c + 6] * bfl(w.w) + q[8 * c + 7] * bfh(w.w); }
                float sv = dot * 0.125f; if (!is_mem) sv += cq - cc[(size_t)bh * SEQ + kk];
                const float mn = fmaxf(mrun, sv), corr = expf(mrun - mn), p = expf(sv - mn); mrun = mn; lrun = lrun * corr + p;
                const bf16* vp = kp + voff;
#pragma unroll
                for (int c = 0; c < 8; ++c) { const v4u w = *(const v4u*)(vp + 8 * c);
                    o[8 * c + 0] = o[8 * c + 0] * corr + p * bfl(w.x); o[8 * c + 1] = o[8 * c + 1] * corr + p * bfh(w.x); o[8 * c + 2] = o[8 * c + 2] * corr + p * bfl(w.y); o[8 * c + 3] = o[8 * c + 3] * corr + p * bfh(w.y);
                    o[8 * c + 4] = o[8 * c + 4] * corr + p * bfl(w.z); o[8 * c + 5] = o[8 * c + 5] * corr + p * bfh(w.z); o[8 * c + 6] = o[8 * c + 6] * corr + p * bfl(w.w); o[8 * c + 7] = o[8 * c + 7] * corr + p * bfh(w.w); } } }
        const float M = wave_max(mrun), sc = expf(mrun - M), L = wave_sum(lrun * sc);
        float res = 0.f;
#pragma unroll
        for (int d = 0; d < 64; ++d) { const float v = wave_sum(o[d] * sc); if (lane == d) res = v; }
        br[tok * 1024 + (is_mem ? 768 : 0) + h * 64 + lane] = (bf16)f2bf(res / L);
    }
}
__device__ __forceinline__ void naive_recur(Frame& F, int l) {
    int tid = F.tid; OPAQUE_V(tid); const int lane = tid & 63, wave = __builtin_amdgcn_readfirstlane(tid >> 6);
    const bf16* proj = (const bf16*)(F.ws + WS_PROJ); bf16* br = (bf16*)((unsigned char*)F.out);
    LAS float* L0 = (LAS float*)(F.lds + RING_OFF);
    if (F.bx < 128) {
        const int bh = F.bx, b = bh >> 2, h = bh & 3;
        LAS float* qr = L0; LAS float* kr = L0 + 4096; LAS float* vv = L0 + 8192; LAS float* sc = L0 + 12288; LAS float* st = L0 + 16384;
        const float* rc = (const float*)(F.ws + WS_ROPE); const float* rs = rc + SEQ * 32;
        const float lg = log1pf(-exp2f(-5.0f - (float)h));
        for (int i = tid; i < 4096; i += 512) st[i] = 0.f;
#pragma unroll 1
        for (int n = 0; n < SEQ / 64; ++n) {
            const size_t row0 = (size_t)b * SEQ + n * 64;
            for (int idx = tid; idx < 2048; idx += 512) { const int t = idx >> 5, c = idx & 31; const bf16* p = proj + (row0 + t) * NPROJ + h * 64;
                const float co = rc[(n * 64 + t) * 32 + c], si = rs[(n * 64 + t) * 32 + c];
                const float q1 = bf1(p[768 + c]), q2 = bf1(p[768 + c + 32]), k1 = bf1(p[1024 + c]), k2 = bf1(p[1024 + c + 32]);
                qr[t * 64 + c] = q1 * co - q2 * si; qr[t * 64 + c + 32] = q1 * si + q2 * co;
                kr[t * 64 + c] = (k1 * co - k2 * si) * 0.125f; kr[t * 64 + c + 32] = (k1 * si + k2 * co) * 0.125f;
                vv[t * 64 + c] = bf1(p[1280 + c]); vv[t * 64 + c + 32] = bf1(p[1280 + c + 32]); }
            __syncthreads();
#pragma unroll 1
            for (int j = 0; j < 8; ++j) { const int idx = tid + 512 * j, i = idx >> 6, jj = idx & 63; float s = 0.f;
#pragma unroll 4
                for (int d = 0; d < 64; ++d) s += qr[i * 64 + d] * kr[jj * 64 + d];
                sc[idx] = s * expf(lg * fabsf((float)(i - jj))); }
            __syncthreads();
            float oreg[8];
#pragma unroll
            for (int j = 0; j < 8; ++j) { const int idx = tid + 512 * j, i = idx >> 6, v = idx & 63; float s = 0.f, s2 = 0.f;
#pragma unroll 4
                for (int jj = 0; jj < 64; ++jj) s += sc[i * 64 + jj] * vv[jj * 64 + v];
#pragma unroll 4
                for (int d = 0; d < 64; ++d) s2 += qr[i * 64 + d] * st[d * 64 + v];
                oreg[j] = s + expf(lg * (float)(i + 1)) * s2; }
            __syncthreads();
#pragma unroll 1
            for (int j = 0; j < 8; ++j) { const int idx = tid + 512 * j, d = idx >> 6, v = idx & 63; float s = 0.f;
#pragma unroll 2
                for (int jj = 0; jj < 64; ++jj) s += kr[jj * 64 + d] * expf(lg * (float)(63 - jj)) * vv[jj * 64 + v];
                st[idx] = expf(lg * 64.0f) * st[idx] + s; }
            for (int j = 0; j < 8; ++j) { const int i = wave + 8 * j;
                const float mean = wave_sum(oreg[j]) * (1.f / 64.f), dv = oreg[j] - mean, var = wave_sum(dv * dv) * (1.f / 64.f);
                const float g = bf1(proj[(row0 + i) * NPROJ + 1536 + h * 64 + lane]);
                br[(row0 + i) * 1024 + 256 + h * 64 + lane] = (bf16)f2bf(dv * rsqrtf(var + GN_EPS) * g / (1.f + expf(-g))); }
            __syncthreads();
        }
    } else {
        const int bh = F.bx - 128, b = bh >> 2, h = bh & 3;
        if (bh >= 128) return;
        LAS float* qf = L0; LAS float* ff = L0 + 4096; LAS float* kf = L0 + 8192; LAS float* iv = L0 + 12288; LAS float* ob = L0 + 16384;
        const int v = tid >> 3, k8 = tid & 7;
        float Sreg[8];
#pragma unroll
        for (int i = 0; i < 8; ++i) Sreg[i] = 0.f;
        const float* lbp = (const float*)(F.ws + WS_PAR) + PAR_LB;
#pragma unroll 1
        for (int n = 0; n < SEQ / 64; ++n) {
            const size_t row0 = (size_t)b * SEQ + n * 64;
            for (int j = 0; j < 8; ++j) { const int idx = tid + 512 * j, t = idx >> 6, c = idx & 63; const bf16* p = proj + (row0 + t) * NPROJ + h * 64 + c;
                float lb = 0.f; if (l == 1) { const float a0 = lbp[h * 64 + c], a1 = lbp[256 + h * 64 + c]; lb = 1.f / (1.f + expf(a0 - a1)); }
                const float zf = bf1(p[1792]); const float kfv = (1.f - lb) / (1.f + expf(zf));
                qf[idx] = bf1(p[2304]); ff[idx] = 1.f - kfv; kf[idx] = kfv; iv[idx] = bf1(p[2048]); }
            __syncthreads();
#pragma unroll 1
            for (int t = 0; t < 64; ++t) { const float ivt = iv[t * 64 + v]; float p = 0.f;
#pragma unroll
                for (int i = 0; i < 8; ++i) { const int k = k8 * 8 + i; Sreg[i] = ff[t * 64 + k] * Sreg[i] + kf[t * 64 + k] * ivt; p += Sreg[i] * qf[t * 64 + k]; }
                p += __shfl_xor(p, 1); p += __shfl_xor(p, 2); p += __shfl_xor(p, 4);
                if (k8 == 0) ob[t * 64 + v] = p; }
            __syncthreads();
            { const int t = tid >> 3, seg = tid & 7; float ov[8]; float ss = 0.f;
#pragma unroll
              for (int i = 0; i < 8; ++i) { ov[i] = ob[t * 64 + seg * 8 + i]; ss += ov[i] * ov[i]; }
              ss = sum8(ss);
              const float rr = rsqrtf(ss * (1.f / 64.f) + GN_EPS);
              const bf16* gp = proj + (row0 + t) * NPROJ + 2560 + h * 64 + seg * 8; const float* ng = (const float*)(F.ws + WS_PAR) + PAR_NG + l * 64 + seg * 8;
              unsigned w[4];
#pragma unroll
              for (int i = 0; i < 4; ++i) { const float g0 = bf1(gp[2 * i]), g1 = bf1(gp[2 * i + 1]);
                  w[i] = pk2(ov[2 * i] * rr * ng[2 * i] * g0 / (1.f + expf(-g0)), ov[2 * i + 1] * rr * ng[2 * i + 1] * g1 / (1.f + expf(-g1))); }
              *(v4u*)(br + (row0 + t) * 1024 + 512 + h * 64 + seg * 8) = (v4u){w[0], w[1], w[2], w[3]}; }
            __syncthreads();
        }
    }
}

__device__ __forceinline__ void ln1_phase(Frame& F, int l, bool commit = true) {
    LAS float* WrT = (LAS float*)(F.lds + RING_OFF);
    LAS int* se1 = (LAS int*)(F.lds + RING_OFF + 65536); LAS int* se2 = se1 + 256; LAS float* sw = (LAS float*)(se2 + 256);
    LAS int* hist = (LAS int*)(F.lds + SM_OFF + 256); LAS int* base = hist + 16;
    int tid = F.tid; OPAQUE_V(tid); const int lane = tid & 63, wave = __builtin_amdgcn_readfirstlane(tid >> 6);
    for (int idx = tid; idx < 16384; idx += 512) { const int d = idx >> 4, e = idx & 15; WrT[e * 1024 + d] = ((const float*)(F.ws + WS_PAR))[PAR_WR + idx]; }
    if (tid < 16) hist[tid] = 0;
    __syncthreads();
    const bf16* xb = (const bf16*)(F.ws + WS_XB); const bf16* yb = (const bf16*)(F.ws + WS_Y); bf16* x1b = (bf16*)(F.ws + WS_X1B);
    const float* lng = (const float*)(F.ws + WS_PAR) + PAR_LNG + (l * 2 + 0) * DM; const float* lnb = (const float*)(F.ws + WS_PAR) + PAR_LNB + (l * 2 + 0) * DM;
    LAS float* gbl = (LAS float*)(F.lds + RING_OFF + 90112);
    for (int idx = tid; idx < 1024; idx += 512) { gbl[idx] = lng[idx]; gbl[1024 + idx] = lnb[idx]; }
    __syncthreads();
    for (int rb = F.bx; rb < T / 256; rb += F.G) {
        LAS float* lgt = (LAS float*)(F.lds + RING_OFF + 65536 + 4096);
        const float* brp = (const float*)(F.ws + WS_PAR) + PAR_BR;
        const int my_e = ((lane >> 4) & 1) * 8 + ((lane >> 3) & 1) * 4 + ((lane >> 2) & 1) * 2 + ((lane >> 1) & 1);
        const float my_b = brp[my_e];
        const int hf = lane >> 5, l5 = lane & 31;
        int rwx[8], rwy[8]; float rsx;
#define LN1_LOAD(ii) do { const size_t r_ = (size_t)rb * 256 + wave * 32 + 2 * (ii) + hf; const GAS int* px_ = (const GAS int*)((const signed char*)(F.ws + WS_X8) + r_ * DM) + l5; const GAS int* py_ = (const GAS int*)((const unsigned char*)(F.ws + WS_Y) + r_ * DM) + l5; \
            rsx = ((const float*)(F.ws + WS_SX))[r_]; _Pragma("unroll") for (int j = 0; j < 8; ++j) { rwx[j] = px_[32 * j]; rwy[j] = py_[32 * j]; } } while (0)
        LN1_LOAD(0);
#pragma unroll 1
        for (int i = 0; i < 16; ++i) {
            const int rl = wave * 32 + 2 * i + hf; const size_t row = (size_t)rb * 256 + rl;
            f32x4 xv[8];
            { f32x4 yv[8];
#pragma unroll
              for (int j = 0; j < 8; ++j) { const int w_ = rwx[j]; xv[j] = (f32x4){(float)((w_ << 24) >> 24), (float)((w_ << 16) >> 24), (float)((w_ << 8) >> 24), (float)(w_ >> 24)} * rsx; const pg8::f32x2 ya_ = __builtin_amdgcn_cvt_pk_f32_fp8(rwy[j], false), yb_ = __builtin_amdgcn_cvt_pk_f32_fp8(rwy[j], true); yv[j] = (f32x4){ya_.x, ya_.y, yb_.x, yb_.y} * 0.03125f; }
              LN1_LOAD(i < 15 ? i + 1 : 15); asm volatile("" ::: "memory");
              float s = 0.f;
#pragma unroll
              for (int j = 0; j < 8; ++j) { xv[j] = xv[j] * ALPHA + yv[j]; s += (xv[j].x + xv[j].y) + (xv[j].z + xv[j].w); }
              s += dpp_f<DPP_X1>(s); s += dpp_f<DPP_X2>(s); s += dpp_f<DPP_HMIR>(s); s += dpp_f<DPP_MIR>(s);
              const float mean = (hf ? rl_f(s, 47) + rl_f(s, 63) : rl_f(s, 15) + rl_f(s, 31)) * (1.f / DM); float s2 = 0.f;
#pragma unroll
              for (int j = 0; j < 8; ++j) { xv[j] = xv[j] - mean; s2 += (xv[j].x * xv[j].x + xv[j].y * xv[j].y) + (xv[j].z * xv[j].z + xv[j].w * xv[j].w); }
              s2 += dpp_f<DPP_X1>(s2); s2 += dpp_f<DPP_X2>(s2); s2 += dpp_f<DPP_HMIR>(s2); s2 += dpp_f<DPP_MIR>(s2);
              const float rstd = 1.f / sqrtf((hf ? rl_f(s2, 47) + rl_f(s2, 63) : rl_f(s2, 15) + rl_f(s2, 31)) * (1.f / DM) + LN_EPS);
              float am = 0.f;
#pragma unroll
              for (int j = 0; j < 8; ++j) { xv[j] = xv[j] * rstd * *(const LAS f32x4*)(gbl + 128 * j + 4 * l5) + *(const LAS f32x4*)(gbl + 1024 + 128 * j + 4 * l5);
                  am = fmaxf(am, fmaxf(fmaxf(fabsf(xv[j].x), fabsf(xv[j].y)), fmaxf(fabsf(xv[j].z), fabsf(xv[j].w)))); }
              GAS unsigned long long* o8 = (GAS unsigned long long*)(x1b + row * DM) + l5;
#pragma unroll
              for (int j = 0; j < 8; ++j) o8[32 * j] = (unsigned long long)pk2(xv[j].x, xv[j].y) | ((unsigned long long)pk2(xv[j].z, xv[j].w) << 32);
              am = fmaxf(am, dpp_f<DPP_X1>(am)); am = fmaxf(am, dpp_f<DPP_X2>(am)); am = fmaxf(am, dpp_f<DPP_HMIR>(am)); am = fmaxf(am, dpp_f<DPP_MIR>(am));
              am = fmaxf(hf ? fmaxf(rl_f(am, 47), rl_f(am, 63)) : fmaxf(rl_f(am, 15), rl_f(am, 31)), 1e-30f);
              const float inv = 127.0f / am;
              GAS unsigned* o4 = (GAS unsigned*)((signed char*)(F.ws + WS_X18) + row * DM) + l5;
#pragma unroll
              for (int j = 0; j < 8; ++j) o4[32 * j] = q8x4(xv[j].x, xv[j].y, xv[j].z, xv[j].w, inv);
              if (l5 == 0) ((float*)(F.ws + WS_S1))[row] = am * (1.0f / 127.0f); }
            float p[16];
#pragma unroll
            for (int e = 0; e < 16; ++e) { pg8::f32x2 a2 = {0.f, 0.f};
#pragma unroll
                for (int j = 0; j < 8; ++j) { const f32x4 w = *(const LAS f32x4*)(WrT + e * 1024 + 128 * j + 4 * l5);
                    a2 = (pg8::f32x2){xv[j].x, xv[j].y} * (pg8::f32x2){w.x, w.y} + a2; a2 = (pg8::f32x2){xv[j].z, xv[j].w} * (pg8::f32x2){w.z, w.w} + a2; }
                p[e] = a2.x + a2.y; asm volatile("" ::: "memory"); }
            { float k8[8], k4[4], k2[2], k1;
#pragma unroll
              for (int e = 0; e < 8; ++e) { float a_ = p[e], b_ = p[e + 8]; asm volatile("s_nop 1\n\tv_permlane16_swap_b32 %0, %1" : "+v"(a_), "+v"(b_)); k8[e] = a_ + b_; }
              { const bool hb = (lane & 8) != 0;
#pragma unroll
                for (int e = 0; e < 4; ++e) { const float keep = hb ? k8[e + 4] : k8[e], send = hb ? k8[e] : k8[e + 4]; k4[e] = keep + dpp_f<0x128>(send); } }
              { const bool hb = (lane & 4) != 0;
#pragma unroll
                for (int e = 0; e < 2; ++e) { const float keep = hb ? k4[e + 2] : k4[e], send = hb ? k4[e] : k4[e + 2]; k2[e] = keep + dpp_f<0x1B>(dpp_f<DPP_HMIR>(send)); } }
              { const bool hb = (lane & 2) != 0; const float keep = hb ? k2[1] : k2[0], send = hb ? k2[0] : k2[1]; k1 = keep + dpp_f<DPP_X2>(send); }
              k1 += dpp_f<DPP_X1>(k1);
              if ((lane & 1) == 0) lgt[rl * 16 + my_e] = k1 + my_b; }
        }
#undef LN1_LOAD
        LDS_WAIT();
        if (lane < 32) { const int rl = wave * 32 + lane; float lg[16];
#pragma unroll
            for (int e4 = 0; e4 < 4; ++e4) { const f32x4 t4 = *(const LAS f32x4*)(lgt + rl * 16 + 4 * e4); lg[4 * e4] = t4.x; lg[4 * e4 + 1] = t4.y; lg[4 * e4 + 2] = t4.z; lg[4 * e4 + 3] = t4.w; }
            float gm[4];
#pragma unroll
            for (int g = 0; g < 4; ++g) gm[g] = fmaxf(fmaxf(lg[4 * g], lg[4 * g + 1]), fmaxf(lg[4 * g + 2], lg[4 * g + 3]));
            int gs = 0; float gb = gm[0];
#pragma unroll
            for (int g = 1; g < 4; ++g) if (gm[g] > gb) { gb = gm[g]; gs = g; }
            float v0 = gs == 0 ? lg[0] : gs == 1 ? lg[4] : gs == 2 ? lg[8] : lg[12], v1 = gs == 0 ? lg[1] : gs == 1 ? lg[5] : gs == 2 ? lg[9] : lg[13];
            float v2 = gs == 0 ? lg[2] : gs == 1 ? lg[6] : gs == 2 ? lg[10] : lg[14], v3 = gs == 0 ? lg[3] : gs == 1 ? lg[7] : gs == 2 ? lg[11] : lg[15];
            int i1 = 0; float m1 = v0; if (v1 > m1) { m1 = v1; i1 = 1; } if (v2 > m1) { m1 = v2; i1 = 2; } if (v3 > m1) { m1 = v3; i1 = 3; }
            int i2 = -1; float m2 = -3.0e38f;
            if (i1 != 0 && v0 > m2) { m2 = v0; i2 = 0; } if (i1 != 1 && v1 > m2) { m2 = v1; i2 = 1; } if (i1 != 2 && v2 > m2) { m2 = v2; i2 = 2; } if (i1 != 3 && v3 > m2) { m2 = v3; i2 = 3; }
            const int e1 = gs * 4 + i1, e2 = gs * 4 + i2;
            const int r1 = __hip_atomic_fetch_add(hist + e1, 1, __ATOMIC_RELAXED, __HIP_MEMORY_SCOPE_WORKGROUP), r2 = __hip_atomic_fetch_add(hist + e2, 1, __ATOMIC_RELAXED, __HIP_MEMORY_SCOPE_WORKGROUP);
            se1[rl] = e1 | (r1 << 8); se2[rl] = e2 | (r2 << 8); sw[rl] = 1.f / (1.f + expf(m2 - m1)); }
        __syncthreads();
        if (tid < 16 && commit) { base[tid] = (int)__hip_atomic_fetch_add((unsigned*)(F.ctl + CW_CNT + (l * 16 + tid) * 64), (unsigned)hist[tid], RLX_AGENT); }
        __syncthreads();
        if (commit) { const int rl = tid >> 1, k = tid & 1; const int v = k ? se2[rl] : se1[rl]; const int e = v & 255, r = v >> 8; const int slot = (rb * 256 + rl) * 2 + k;
          ((int*)(F.ws + WS_LIST))[(size_t)e * LISTCAP + base[e] + r] = slot; ((float*)(F.ws + WS_WT))[slot] = k ? 1.f - sw[rl] : sw[rl]; }
        __syncthreads();
        if (tid < 16) hist[tid] = 0;
        __syncthreads();
    }
}

__device__ __forceinline__ void ln2_phase(Frame& F, int l) {
    LAS float* wff = (LAS float*)(F.lds + RING_OFF + 81920);
    int tid_ = F.tid; OPAQUE_V(tid_); const int lane = tid_ & 63, wave_ = __builtin_amdgcn_readfirstlane(tid_ >> 6); const bool last = (l == NLAYER - 1);
    if (!last) { stage_wff(F, l + 1, wff); }
    __syncthreads();
    const int gw = F.vcu * NWAVES + wave_, NGW = F.G * NWAVES;
    const bf16* x1b = (const bf16*)(F.ws + WS_X1B); const unsigned char* y2 = (const unsigned char*)(F.ws + WS_Y2); bf16* xb = (bf16*)(F.ws + WS_XB);
    const float* lng = (const float*)(F.ws + WS_PAR) + PAR_LNG + (l * 2 + 1) * DM; const float* lnb = (const float*)(F.ws + WS_PAR) + PAR_LNB + (l * 2 + 1) * DM;
    f32x4 gg[4], bb[4];
#pragma unroll
    for (int j = 0; j < 4; ++j) { gg[j] = *(const f32x4*)(lng + 256 * j + 4 * lane); bb[j] = *(const f32x4*)(lnb + 256 * j + 4 * lane); }
    for (int m = gw; m < T; m += NGW) {
        f32x4 xv[4], ya[4], yb[4]; load_row_bf16(x1b + (size_t)m * DM, lane, xv); load_row_fp8(y2 + (size_t)(2 * m) * DM, lane, ya); load_row_fp8(y2 + (size_t)(2 * m + 1) * DM, lane, yb);
        float s = 0.f;
#pragma unroll
        for (int j = 0; j < 4; ++j) { xv[j] = xv[j] * ALPHA + (ya[j] + yb[j]); s += (xv[j].x + xv[j].y) + (xv[j].z + xv[j].w); }
        const float mean = wave_sum(s) * (1.f / DM); float s2 = 0.f;
#pragma unroll
        for (int j = 0; j < 4; ++j) { xv[j] = xv[j] - mean; s2 += (xv[j].x * xv[j].x + xv[j].y * xv[j].y) + (xv[j].z * xv[j].z + xv[j].w * xv[j].w); }
        const float rstd = 1.f / sqrtf(wave_sum(s2) * (1.f / DM) + LN_EPS);
#pragma unroll
        for (int j = 0; j < 4; ++j) xv[j] = xv[j] * rstd * gg[j] + bb[j];
        if (last) { GAS f32x4* o = (GAS f32x4*)(F.out + (size_t)m * DM) + lane;
#pragma unroll
            for (int j = 0; j < 4; ++j) o[64 * j] = xv[j]; }
        else { store_row_i8((signed char*)(F.ws + WS_X8) + (size_t)m * DM, (float*)(F.ws + WS_SX) + m, lane, xv); forget_row(xv, wff, (float*)(F.ws + WS_LF) + (size_t)m * 4, lane); }
    }
}

__device__ __forceinline__ int moe_tables(Frame& F, int l) {
    LAS int* tb = (LAS int*)(F.lds + SM_OFF); LAS int* cn = tb + 32;
    LAS int* gtab = (LAS int*)(F.lds + GT_OFF); LAS float* wtab = (LAS float*)(F.lds + WTB_OFF); LAS float* stab = (LAS float*)(F.lds + STB_OFF);
    if (F.tid < 16) cn[F.tid] = (int)__hip_atomic_load((unsigned*)(F.ctl + CW_CNT + (l * 16 + F.tid) * 64), RLX_AGENT);
    __syncthreads();
    if (F.tid == 0) { int a = 0; for (int e = 0; e < 16; ++e) { tb[e] = a; a += (cn[e] + 255) >> 8; } tb[16] = a; }
    __syncthreads();
    const int ntiles = tb[16];
    const int* list = (const int*)(F.ws + WS_LIST); const float* wt = (const float*)(F.ws + WS_WT);
    for (int i = 0; i < MAXU; ++i) { const long L = (long)i * F.G + F.vcu; if (L >= (long)ntiles * 4) break; const int pm = (int)(L >> 2);
        if (F.tid < 256) { int e = 0;
#pragma unroll
            for (int k = 1; k < 16; ++k) e += (pm >= tb[k]) ? 1 : 0;
            const int p = (pm - tb[e]) * 256 + F.tid; int v = -1; float w = 0.f, sc1 = 0.f;
            if (p < cn[e]) { v = list[(size_t)e * LISTCAP + p]; w = wt[v] * 32.0f; sc1 = ((const float*)(F.ws + WS_S1))[v >> 1]; }
            gtab[i * 256 + F.tid] = v; wtab[i * 256 + F.tid] = w; stab[i * 256 + F.tid] = sc1; } }
    __syncthreads();
    return ntiles;
}

#define STAG_OFF
#ifndef STAG_OFF
#define STAG(t) ((F.vcu & 3) * (t))
#else
#define STAG(t) 0
#endif
#define GRID_BAR() do { XcdBarrier bb_ = bar; asm volatile("" : "+s"(bb_.bar), "+s"(bb_.x)); xcd_barrier(bb_); } while (0)
template <int l> __device__ __forceinline__ void layer_body(const Frame& F0, const XcdBarrier& bar) {
        Frame F = F0; GAS unsigned char* gws_ = (GAS unsigned char*)F0.ws; GAS float* gout_ = (GAS float*)F0.out;
        asm volatile("" : "+s"(gws_), "+s"(gout_), "+s"(F.vcu), "+s"(F.bx), "+s"(F.G), "+v"(F.tid)); F.ws = (unsigned char*)gws_; F.out = (float*)gout_;
        unsigned char* ws; const pg8::bf16_t* x8; const unsigned char* wl;
#define PHASE_PTRS() do { GAS unsigned char* g_ = (GAS unsigned char*)F0.ws; GAS float* o_ = (GAS float*)F0.out; asm volatile("" : "+s"(g_), "+s"(o_)); F.ws = (unsigned char*)g_; F.out = (float*)o_; ws = F.ws; x8 = (const pg8::bf16_t*)(ws + WS_X8); wl = ws + WS_W + (size_t)l * W_LAYER; } while (0)
        PHASE_PTRS();
#ifndef SKIP_CC
        cc_scan(F);
#endif
#ifdef DUP_GA
        { pg8::Gemm g{x8, (const pg8::bf16_t*)(wl + W_IN), DM / 2, DM / 2, DM / 2}; pg8::StaticOrder S; S.init(T, NPROJ, F.G, F.bx);
          pg8::EpiBf16<true> E{(pg8::bf16_t*)(ws + WS_PROJ), NPROJ, (const float*)(ws + WS_BIASP) + l * NPROJ, (const float*)(ws + WS_SX), (const float*)(ws + WS_SWP) + l * NPROJ};
          pg8::gemm_phase<pg8::EpiBf16<true>, pg8::StaticOrder, PG8_ALIGN, false, true>(F.lds + RING_OFF, F.lds + GT_OFF, g, S, E, STAG(600)); }
#endif
#ifndef SKIP_GA
        { pg8::Gemm g{x8, (const pg8::bf16_t*)(wl + W_IN), DM / 2, DM / 2, DM / 2}; pg8::StaticOrder S; S.init(T, NPROJ, F.G, F.bx);
          pg8::EpiBf16<true> E{(pg8::bf16_t*)(ws + WS_PROJ), NPROJ, (const float*)(ws + WS_BIASP) + l * NPROJ, (const float*)(ws + WS_SX), (const float*)(ws + WS_SWP) + l * NPROJ};
          pg8::gemm_phase<pg8::EpiBf16<true>, pg8::StaticOrder, PG8_ALIGN, false, true>(F.lds + RING_OFF, F.lds + GT_OFF, g, S, E, STAG(600)); }
#endif
#ifndef SKIP_GM
        if (l == 0) { pg8::Gemm g{(const pg8::bf16_t*)(ws + WS_MEMB), (const pg8::bf16_t*)(ws + WS_WMEM), DM, DM, DM}; pg8::StaticOrder S; S.init(MEMROWS, 1024, F.G, F.bx);
          pg8::EpiBf16<false> E{(pg8::bf16_t*)(ws + WS_MEMKV), 1024, nullptr, nullptr, nullptr};
          pg8::gemm_phase<pg8::EpiBf16<false>, pg8::StaticOrder, PG8_ALIGN, false>(F.lds + RING_OFF, F.lds + GT_OFF, g, S, E, STAG(500)); }
#endif
        GRID_BAR();
        PHASE_PTRS();
#ifdef NAIVE_RECUR
        naive_recur(F, l);
#else
        recur_phase(F, l);
#ifdef DUP_RECUR
        recur_phase(F, l);
#endif
#endif
#ifdef NAIVE_ATTN
        naive_attn(F, l);
#else
        attn_phase(F, l);
#ifdef DUP_ATTN
        attn_phase(F, l);
#endif
#endif
        GRID_BAR();
        PHASE_PTRS();
#ifdef DUP_GC
        { pg8::Gemm g{(const pg8::bf16_t*)((unsigned char*)F.out), (const pg8::bf16_t*)(wl + W_B), DM, 256, 256}; pg8::StaticOrder S; S.init(T, 4096, F.G, F.bx, 4, 256);
          pg8::EpiU8 E{(unsigned char*)(ws + WS_U), 4096};
          pg8::gemm_phase<pg8::EpiU8, pg8::StaticOrder, PG8_ALIGN, false>(F.lds + RING_OFF, F.lds + GT_OFF, g, S, E, STAG(500)); }
#endif
#ifndef SKIP_GC
        { pg8::Gemm g{(const pg8::bf16_t*)((unsigned char*)F.out), (const pg8::bf16_t*)(wl + W_B), DM, 256, 256}; pg8::StaticOrder S; S.init(T, 4096, F.G, F.bx, 4, 256);
          pg8::EpiU8 E{(unsigned char*)(ws + WS_U), 4096};
          pg8::gemm_phase<pg8::EpiU8, pg8::StaticOrder, PG8_ALIGN, false>(F.lds + RING_OFF, F.lds + GT_OFF, g, S, E, STAG(500)); }
#endif
        GRID_BAR();
        PHASE_PTRS();
#ifdef DUP_GD
        { pg8::Gemm g{x8, (const pg8::bf16_t*)(wl + W_G), DM / 2, DM / 2, DM / 2}; pg8::StaticOrder S; S.init(T, NGATE, F.G, F.bx);
          pg8::EpiGateMix E{(const unsigned char*)(ws + WS_U), (pg8::bf16_t*)((unsigned char*)F.out), (const float*)(ws + WS_BIASG) + l * NGATE, (const float*)(ws + WS_SX), (const float*)(ws + WS_SWG) + l * NGATE};
          pg8::gemm_phase<pg8::EpiGateMix, pg8::StaticOrder, PG8_ALIGN, false, true>(F.lds + RING_OFF, F.lds + GT_OFF, g, S, E, STAG(600)); }
#endif
#ifndef SKIP_GD
        { pg8::Gemm g{x8, (const pg8::bf16_t*)(wl + W_G), DM / 2, DM / 2, DM / 2}; pg8::StaticOrder S; S.init(T, NGATE, F.G, F.bx);
          pg8::EpiGateMix E{(const unsigned char*)(ws + WS_U), (pg8::bf16_t*)((unsigned char*)F.out), (const float*)(ws + WS_BIASG) + l * NGATE, (const float*)(ws + WS_SX), (const float*)(ws + WS_SWG) + l * NGATE};
          pg8::gemm_phase<pg8::EpiGateMix, pg8::StaticOrder, PG8_ALIGN, false, true>(F.lds + RING_OFF, F.lds + GT_OFF, g, S, E, STAG(600)); }
#endif
        GRID_BAR();
        PHASE_PTRS();
#ifdef DUP_GE
        { pg8::Gemm g{(const pg8::bf16_t*)((unsigned char*)F.out), (const pg8::bf16_t*)(wl + W_OUT), DM, DM, DM}; pg8::StaticOrder S; S.init(T, DM, F.G, F.bx);
          pg8::EpiU8 E{(unsigned char*)(ws + WS_Y), DM};
          pg8::gemm_phase<pg8::EpiU8, pg8::StaticOrder, PG8_ALIGN, false>(F.lds + RING_OFF, F.lds + GT_OFF, g, S, E, STAG(500)); }
#endif
#ifndef SKIP_GE
        { pg8::Gemm g{(const pg8::bf16_t*)((unsigned char*)F.out), (const pg8::bf16_t*)(wl + W_OUT), DM, DM, DM}; pg8::StaticOrder S; S.init(T, DM, F.G, F.bx);
          pg8::EpiU8 E{(unsigned char*)(ws + WS_Y), DM};
          pg8::gemm_phase<pg8::EpiU8, pg8::StaticOrder, PG8_ALIGN, false>(F.lds + RING_OFF, F.lds + GT_OFF, g, S, E, STAG(500)); }
#endif
        GRID_BAR();
        PHASE_PTRS();
#ifdef DUP_LN1
        ln1_phase(F, l, false); __syncthreads();
#endif
#ifndef SKIP_LN1
        ln1_phase(F, l);
#endif
        GRID_BAR();
        PHASE_PTRS();
        const int ntiles = moe_tables(F, l);
#ifdef DUP_GG
        { pg8::Gemm g{(const pg8::bf16_t*)(ws + WS_X18), (const pg8::bf16_t*)(wl + W_E1), DM / 2, DM / 2, DM / 2};
          pg8::MoeOrder S{F.G, F.vcu, 4, ntiles, (const LAS int*)(F.lds + SM_OFF), (const LAS int*)(F.lds + GT_OFF), (size_t)1024 * 512, true};
          pg8::EpiMoe1 E{(pg8::bf16_t*)(ws + WS_ACT), (const LAS float*)(F.lds + STB_OFF), (const LAS int*)(F.lds + SM_OFF), (const float*)(ws + WS_SWE) + l * 16 * 1024};
          pg8::gemm_phase<pg8::EpiMoe1, pg8::MoeOrder, PG8_ALIGN, true, true>(F.lds + RING_OFF, F.lds + EV_OFF, g, S, E, STAG(600)); }
#endif
#ifndef SKIP_GG
        { pg8::Gemm g{(const pg8::bf16_t*)(ws + WS_X18), (const pg8::bf16_t*)(wl + W_E1), DM / 2, DM / 2, DM / 2};
          pg8::MoeOrder S{F.G, F.vcu, 4, ntiles, (const LAS int*)(F.lds + SM_OFF), (const LAS int*)(F.lds + GT_OFF), (size_t)1024 * 512, true};
          pg8::EpiMoe1 E{(pg8::bf16_t*)(ws + WS_ACT), (const LAS float*)(F.lds + STB_OFF), (const LAS int*)(F.lds + SM_OFF), (const float*)(ws + WS_SWE) + l * 16 * 1024};
          pg8::gemm_phase<pg8::EpiMoe1, pg8::MoeOrder, PG8_ALIGN, true, true>(F.lds + RING_OFF, F.lds + EV_OFF, g, S, E, STAG(600)); }
#endif
        GRID_BAR();
        PHASE_PTRS();
#ifdef DUP_GH
        { pg8::Gemm g{(const pg8::bf16_t*)(ws + WS_ACT), (const pg8::bf16_t*)(wl + W_E2), DE, DE, DE};
          pg8::MoeOrder S{F.G, F.vcu, 4, ntiles, (const LAS int*)(F.lds + SM_OFF), (const LAS int*)(F.lds + GT_OFF), (size_t)1024 * 512, false};
          pg8::EpiMoe2 E{(unsigned char*)(ws + WS_Y2), (const LAS int*)(F.lds + GT_OFF), (const LAS float*)(F.lds + WTB_OFF)};
          pg8::gemm_phase<pg8::EpiMoe2, pg8::MoeOrder, PG8_ALIGN, false>(F.lds + RING_OFF, F.lds + EV_OFF, g, S, E, STAG(500)); }
#endif
#ifndef SKIP_GH
        { pg8::Gemm g{(const pg8::bf16_t*)(ws + WS_ACT), (const pg8::bf16_t*)(wl + W_E2), DE, DE, DE};
          pg8::MoeOrder S{F.G, F.vcu, 4, ntiles, (const LAS int*)(F.lds + SM_OFF), (const LAS int*)(F.lds + GT_OFF), (size_t)1024 * 512, false};
          pg8::EpiMoe2 E{(unsigned char*)(ws + WS_Y2), (const LAS int*)(F.lds + GT_OFF), (const LAS float*)(F.lds + WTB_OFF)};
          pg8::gemm_phase<pg8::EpiMoe2, pg8::MoeOrder, PG8_ALIGN, false>(F.lds + RING_OFF, F.lds + EV_OFF, g, S, E, STAG(500)); }
#endif
        GRID_BAR();
        PHASE_PTRS();
#ifdef DUP_LN2
        ln2_phase(F, l); __syncthreads();
#endif
#ifndef SKIP_LN2
        ln2_phase(F, l);
#endif
        if (l + 1 < NLAYER) GRID_BAR();
}

__global__ void __launch_bounds__(NWAVES * 64, 2) fwd_kernel(Args args) {
    extern __shared__ __attribute__((aligned(16))) unsigned char lds[];
    Frame F0;
    F0.lds = (LAS unsigned char*)lds;
    F0.MISC = (volatile LAS unsigned*)(F0.lds + MISC_OFF);
    F0.tid = threadIdx.x;
    F0.G = gridDim.x; F0.bx = blockIdx.x; { const int bx = blockIdx.x; F0.vcu = (F0.G % 8 == 0) ? (bx % 8) * (F0.G / 8) + bx / 8 : bx; }
    F0.ws = args.ws; F0.out = args.out; F0.ctl = (gu32*)(args.ws + WS_CTL);
    for (int u = F0.tid; u < (LDS_BYTES - LDSCTL_OFF) / 4; u += NWAVES * 64) ((LAS unsigned*)(F0.lds + LDSCTL_OFF))[u] = 0u;
    __syncthreads();
    XcdBarrier bar = xcd_barrier_post((unsigned*)(F0.ctl + CW_BAR), F0.MISC + 8);

#ifdef DUP_P0
    p0_prologue(F0, args); __syncthreads();
#endif
#ifndef SKIP_P0
    p0_prologue(F0, args);
#endif
    GRID_BAR();

    layer_body<0>(F0, bar);
    layer_body<1>(F0, bar);
}

extern "C" void kernel_launch(void* const* d_in, const int* in_sizes, int n_in, void* d_out, int out_size, void* d_ws, size_t ws_size, hipStream_t stream) {
    static int grid = 0;
    if (grid == 0) {
        if (n_in != 15 || in_sizes[0] != T * DM || out_size != T * DM || ws_size < WS_END) { fprintf(stderr, "kernel_launch: unexpected shapes / workspace (n_in %d, in0 %d, out %d, ws %zu); nothing launched\n", n_in, n_in > 0 ? in_sizes[0] : -1, out_size, ws_size); grid = -1; return; }
        int dev = 0, cus = 0, per_cu = 0;
        if (hipGetDevice(&dev) != hipSuccess || hipDeviceGetAttribute(&cus, hipDeviceAttributeMultiprocessorCount, dev) != hipSuccess) { grid = -1; return; }
        if (hipFuncSetAttribute((const void*)fwd_kernel, hipFuncAttributeMaxDynamicSharedMemorySize, LDS_BYTES) != hipSuccess) { fprintf(stderr, "kernel_launch: hipFuncSetAttribute failed\n"); grid = -1; return; }
        if (hipOccupancyMaxActiveBlocksPerMultiprocessor(&per_cu, (const void*)fwd_kernel, NWAVES * 64, LDS_BYTES) != hipSuccess || per_cu < 1) fprintf(stderr, "kernel_launch: occupancy query reports %d\n", per_cu);
        (void)hipGetLastError();
        grid = cus;
    }
    if (grid < 0) return;
    if (hipMemsetAsync((char*)d_ws + WS_CTL, 0, CTL_ZERO_BYTES, stream) != hipSuccess) return;
    Args a{};
    for (int i = 0; i < 15; ++i) a.in[i] = (const float*)d_in[i];
    a.out = (float*)d_out; a.ws = (unsigned char*)d_ws; a.naive = 0; a.pad = 0;
    hipLaunchKernelGGL(fwd_kernel, dim3(grid), dim3(NWAVES * 64), LDS_BYTES, stream, a);
}
```

```cpp
#include <hip/hip_runtime.h>
#include <cstdio>
#include <cstdint>
#include <type_traits>

namespace pg8 {
#define PG8_LAS __attribute__((address_space(3)))
typedef unsigned short bf16_t;
typedef short bf16x8 __attribute__((ext_vector_type(8)));
typedef float f32x4 __attribute__((ext_vector_type(4)));
typedef float f32x2 __attribute__((ext_vector_type(2)));
typedef unsigned u32x4 __attribute__((ext_vector_type(4)));
typedef unsigned u32x2 __attribute__((ext_vector_type(2)));
typedef int i32x4 __attribute__((ext_vector_type(4)));
__device__ __forceinline__ f32x4 tof(const f32x4& v) { return v; }
__device__ __forceinline__ f32x4 tof(const i32x4& v) { return (f32x4){(float)v[0], (float)v[1], (float)v[2], (float)v[3]}; }
constexpr int BM = 256, BK = 64, HALF = 128, HTB = HALF * BK * 2  , STAGE_BYTES = 8 * HTB, NXCD = 8, WGM = 8;

__host__ __device__ __forceinline__ int lds_byte(int r, int c) { const int st = (r >> 4) * 2 + (c >> 5), rr = r & 15, cc = c & 31, ob = rr * 64 + cc * 2; return st * 1024 + (ob ^ (((ob >> 9) & 1) << 5)); }
__host__ __device__ __forceinline__ void stage_rc(int b, int& R, int& C) { const int st = b / 1024, sb = b % 1024, swz = sb ^ (((sb >> 9) & 1) << 5); R = (st >> 1) * 16 + swz / 64; C = (st & 1) * 32 + (swz % 64) / 2; }
__host__ __device__ __forceinline__ int perm32(int rho) { const int n = rho >> 4, i = rho & 15; return 8 * (i >> 2) + 4 * n + (i & 3); }

#ifdef PG8_NT_STORE
#define PG8_ST16(p, v) __builtin_nontemporal_store((v), (u32x4*)(p))
#else
#define PG8_ST16(p, v) (*(u32x4*)(p) = (v))
#endif
__host__ __device__ __forceinline__ int perm32s(int rho) { const int n = rho >> 4, i = rho & 15, q = i >> 2, sg = ((q & 1) << 1) | (q >> 1); return 8 * sg + 4 * n + (i & 3); }
struct Unit { int pm, pn; };
struct Gemm { const bf16_t* A; const bf16_t* Bt; int lda, ldb, K; };

struct StaticOrder {
    int nM, nN, nwg, G, c, a_div, a_add;
    __device__ void init(int M, int N, int G_, int c_, int a_div_ = 0, int a_add_ = 0) { nM = M / BM; nN = N / BM; nwg = nM * nN; G = G_; c = c_; a_div = a_div_; a_add = a_add_; }
    __device__ bool next(int i, Unit& u) const {
        const long L = (long)i * G + c; if (L >= nwg) return false;
        int wgid = (int)L; { const int q = nwg / NXCD, r = nwg % NXCD, xcd = wgid % NXCD, off = wgid / NXCD; wgid = (xcd < r ? xcd * (q + 1) : r * (q + 1) + (xcd - r) * q) + off; }
        const int nig = WGM * nN, gid = wgid / nig, fm = gid * WGM, gsz = (nM - fm) < WGM ? (nM - fm) : WGM;
        u.pm = fm + ((wgid % nig) % gsz); u.pn = (wgid % nig) / gsz; return true;
    }
    __device__ __forceinline__ const char* a_ptr(const Gemm& g, const Unit& u) const { return (const char*)g.A + ((size_t)u.pm * BM * g.lda + (a_div ? (size_t)((u.pn / a_div) * a_add) : (size_t)0)) * 2; }
    __device__ __forceinline__ const char* b_ptr(const Gemm& g, const Unit& u) const { return (const char*)g.Bt + (size_t)u.pn * BM * g.ldb * 2; }
    __device__ __forceinline__ int grow(int, int) const { return 0; }
};

struct MoeOrder {
    int G, vcu, nN, ntiles; const PG8_LAS int* tb; const PG8_LAS int* gtab; size_t wstride;
    bool gather;
    __device__ __forceinline__ bool next(int i, Unit& u) const { const long L = (long)i * G + vcu; if (L >= (long)ntiles * nN) return false; u.pm = (int)(L / nN); u.pn = (int)(L % nN); return true; }
    __device__ __forceinline__ int expert_of(int pm) const { int e = 0;
#pragma unroll
        for (int k = 1; k < 16; ++k) e += (pm >= tb[k]) ? 1 : 0; return e; }
    __device__ __forceinline__ const char* a_ptr(const Gemm& g, const Unit& u) const { return gather ? (const char*)g.A : (const char*)g.A + (size_t)u.pm * BM * g.lda * 2; }
    __device__ __forceinline__ const char* b_ptr(const Gemm& g, const Unit& u) const { return (const char*)g.Bt + ((size_t)expert_of(u.pm) * wstride + (size_t)u.pn * BM * g.ldb) * 2; }
    __device__ __forceinline__ int grow(int ui, int r) const { const int v = gtab[ui * 256 + r]; return v >= 0 ? (v >> 1) : 0; }
};

__device__ __forceinline__ unsigned cvt_pk_bf16(float lo, float hi) { unsigned r; asm volatile("v_cvt_pk_bf16_f32 %0, %1, %2" : "=v"(r) : "v"(lo), "v"(hi)); return r; }
__device__ __forceinline__ float bf_lo(unsigned w) { return __uint_as_float(w << 16); }
__device__ __forceinline__ float bf_hi(unsigned w) { return __uint_as_float(w & 0xffff0000u); }
__device__ __forceinline__ float sig2(float z) { return __builtin_amdgcn_rcpf(1.0f + __builtin_amdgcn_exp2f(z)); }
__device__ __forceinline__ float sigmoidf_fast(float x) { return __builtin_amdgcn_rcpf(1.0f + __builtin_amdgcn_exp2f(-1.4426950408889634f * x)); }

template <bool SC> struct EpiBf16 { static constexpr bool PSIG = false;
    static constexpr bool PERM = true; static constexpr int NTAB = SC ? 12 : 0, NST = 16;
    bf16_t* O; int ldc; const float* bias; const float* rs; const float* cs;
    __device__ __forceinline__ const float* tab_src(const Unit& u, int ch) const { return ch < 4 ? rs + u.pm * BM + 64 * ch : (ch < 8 ? bias + u.pn * BM + 64 * (ch - 4) : cs + u.pn * BM + 64 * (ch - 8)); }
    template <class AccT>
    __device__ __forceinline__ void operator()(const AccT (&acc)[2][2][4][2], const Unit& u, int ui, int wr, int wc, int fr, int fq, const PG8_LAS float* tab) const {
        const int row0 = u.pm * BM + wr * 64 + fr, col0 = u.pn * BM + wc * 32 + 8 * fq;
        f32x4 bv[2][2], cv[2][2];
#pragma unroll
        for (int bj = 0; bj < 2; ++bj)
#pragma unroll
            for (int n = 0; n < 2; ++n) { bv[bj][n] = SC ? *(const PG8_LAS f32x4*)(tab + 256 + wc * 32 + 8 * fq + bj * HALF + 4 * n) : (f32x4){0.f, 0.f, 0.f, 0.f}; cv[bj][n] = SC ? *(const PG8_LAS f32x4*)(tab + 512 + wc * 32 + 8 * fq + bj * HALF + 4 * n) : (f32x4){1.f, 1.f, 1.f, 1.f}; }
#pragma unroll
        for (int ai = 0; ai < 2; ++ai)
#pragma unroll
            for (int m = 0; m < 4; ++m) { const int rl = wr * 64 + fr + ai * HALF + m * 16; bf16_t* rowp = O + (size_t)(u.pm * BM + rl) * ldc + col0; const float rsc = SC ? tab[rl] : 1.f;
#pragma unroll
                for (int bj = 0; bj < 2; ++bj) { f32x4 v0 = tof(acc[ai][bj][m][0]), v1 = tof(acc[ai][bj][m][1]);
                    if (SC) { v0 = v0 * rsc * cv[bj][0] + bv[bj][0]; v1 = v1 * rsc * cv[bj][1] + bv[bj][1]; }
                    u32x4 w; w.x = cvt_pk_bf16(v0[0], v0[1]); w.y = cvt_pk_bf16(v0[2], v0[3]); w.z = cvt_pk_bf16(v1[0], v1[1]); w.w = cvt_pk_bf16(v1[2], v1[3]);
                    PG8_ST16(rowp + bj * HALF, w); } }
    }
};
__device__ __forceinline__ unsigned pk_fp8x4(float a, float b, float c, float d) { unsigned w; asm volatile("v_cvt_pk_fp8_f32 %0, %1, %2" : "=v"(w) : "v"(a), "v"(b)); asm volatile("v_cvt_pk_fp8_f32 %0, %1, %2 op_sel:[0,0,1]" : "+v"(w) : "v"(c), "v"(d)); return w; }
struct EpiU8 {
    static constexpr bool PERM = true, PSIG = true; static constexpr int NTAB = 0, NST = 8;
    unsigned char* O; int ld;
    __device__ __forceinline__ const float* tab_src(const Unit&, int) const { return nullptr; }
    template <class AccT>
    __device__ __forceinline__ void operator()(const AccT (&acc)[2][2][4][2], const Unit& u, int ui, int wr, int wc, int fr, int fq, const PG8_LAS float* tab) const {
        const int row0 = u.pm * BM + wr * 64 + fr, col0 = u.pn * BM + 128 * (fq >> 1) + wc * 32 + 16 * (fq & 1);
#pragma unroll
        for (int ai = 0; ai < 2; ++ai)
#pragma unroll
            for (int m = 0; m < 4; ++m) { unsigned char* rowp = O + (size_t)(row0 + ai * HALF + m * 16) * ld + col0;
                u32x2 w[2];
#pragma unroll
                for (int bj = 0; bj < 2; ++bj) { const f32x4 v0 = tof(acc[ai][bj][m][0]), v1 = tof(acc[ai][bj][m][1]);
                    w[bj].x = pk_fp8x4(v0[0], v0[1], v0[2], v0[3]); w[bj].y = pk_fp8x4(v1[0], v1[1], v1[2], v1[3]); }
                const auto r0 = __builtin_amdgcn_permlane32_swap(w[0].x, w[1].x, false, false), r1 = __builtin_amdgcn_permlane32_swap(w[0].y, w[1].y, false, false);
                u32x4 o; o.x = r0[0]; o.y = r1[0]; o.z = r0[1]; o.w = r1[1];
                *(u32x4*)rowp = o; }
    }
};
struct EpiGateMix { static constexpr bool PSIG = false;
    static constexpr bool PERM = false; static constexpr int NTAB = 12, NST = 8;
    const unsigned char* U; bf16_t* O; const float* bias; const float* rs; const float* cs;
    __device__ __forceinline__ const float* tab_src(const Unit& u, int ch) const { return ch < 4 ? rs + u.pm * BM + 64 * ch : (ch < 8 ? bias + u.pn * BM + 64 * (ch - 4) : cs + u.pn * BM + 64 * (ch - 8)); }
    template <class AccT>
    __device__ __forceinline__ void operator()(const AccT (&acc)[2][2][4][2], const Unit& u, int ui, int wr, int wc, int fr, int fq, const PG8_LAS float* tab) const {
        const int row0 = u.pm * BM + wr * 64 + fr, d0 = 64 * u.pn + 16 * wc + 4 * fq;
        f32x4 bv[2][2], cv[2][2];
#pragma unroll
        for (int bj = 0; bj < 2; ++bj)
#pragma unroll
            for (int n = 0; n < 2; ++n) { const int vc = 128 * bj + 32 * wc + 16 * n + 4 * fq; bv[bj][n] = *(const PG8_LAS f32x4*)(tab + 256 + vc); cv[bj][n] = *(const PG8_LAS f32x4*)(tab + 512 + vc); }
#pragma unroll
        for (int ai = 0; ai < 2; ++ai)
#pragma unroll
            for (int m = 0; m < 4; ++m) { const int rl = wr * 64 + fr + ai * HALF + m * 16; const size_t row = (size_t)(u.pm * BM + rl); const unsigned char* up = U + row * 4096 + d0; const float rsc = tab[rl];
                f32x4 o = (f32x4){0.f, 0.f, 0.f, 0.f};
#pragma unroll
                for (int bj = 0; bj < 2; ++bj)
#pragma unroll
                    for (int n = 0; n < 2; ++n) { const int w = *(const int*)(up + (2 * bj + n) * 1024);
                        const f32x2 ul = __builtin_amdgcn_cvt_pk_f32_fp8(w, false), uh = __builtin_amdgcn_cvt_pk_f32_fp8(w, true);
                        const f32x4 z = tof(acc[ai][bj][m][n]) * rsc * cv[bj][n] + bv[bj][n];
                        o[0] += sig2(z[0]) * ul.x; o[1] += sig2(z[1]) * ul.y; o[2] += sig2(z[2]) * uh.x; o[3] += sig2(z[3]) * uh.y; }
                u32x2 ow; ow.x = cvt_pk_bf16(o[0] * 0.03125f, o[1] * 0.03125f); ow.y = cvt_pk_bf16(o[2] * 0.03125f, o[3] * 0.03125f);
                *(u32x2*)(O + row * 1024 + d0) = ow; }
    }
};
struct EpiMoe1 { static constexpr bool PSIG = false;
    static constexpr bool PERM = true; static constexpr int NTAB = 4, NST = 8;
    bf16_t* act; const PG8_LAS float* stab; const PG8_LAS int* tb; const float* cs;
    __device__ __forceinline__ const float* tab_src(const Unit& u, int ch) const { int e = 0;
#pragma unroll
        for (int k = 1; k < 16; ++k) e += (u.pm >= tb[k]) ? 1 : 0;
        return cs + e * 1024 + u.pn * BM + 64 * ch; }
    template <class AccT>
    __device__ __forceinline__ void operator()(const AccT (&acc)[2][2][4][2], const Unit& u, int ui, int wr, int wc, int fr, int fq, const PG8_LAS float* tab) const {
        const int row0 = u.pm * BM + wr * 64 + fr, col0 = 128 * u.pn + 32 * wc + 8 * fq;
        f32x4 cg[2], cu[2];
#pragma unroll
        for (int n = 0; n < 2; ++n) { cg[n] = *(const PG8_LAS f32x4*)(tab + 32 * wc + 8 * fq + 4 * n); cu[n] = *(const PG8_LAS f32x4*)(tab + HALF + 32 * wc + 8 * fq + 4 * n); }
#pragma unroll
        for (int ai = 0; ai < 2; ++ai)
#pragma unroll
            for (int m = 0; m < 4; ++m) { const int rl = ai * HALF + wr * 64 + m * 16 + fr; const size_t row = (size_t)(u.pm * BM + rl); const float rsc = stab[ui * 256 + rl];
                float a[8];
#pragma unroll
                for (int n = 0; n < 2; ++n) { const f32x4 g4 = tof(acc[ai][0][m][n]) * rsc * cg[n], u4 = tof(acc[ai][1][m][n]) * rsc * cu[n];
#pragma unroll
                    for (int j = 0; j < 4; ++j) a[4 * n + j] = g4[j] * sigmoidf_fast(g4[j]) * u4[j]; }
                u32x4 w; w.x = cvt_pk_bf16(a[0], a[1]); w.y = cvt_pk_bf16(a[2], a[3]); w.z = cvt_pk_bf16(a[4], a[5]); w.w = cvt_pk_bf16(a[6], a[7]);
                *(u32x4*)(act + row * 512 + col0) = w; }
    }
};
struct EpiMoe2 { static constexpr bool PSIG = false;
    static constexpr bool PERM = true; static constexpr int NTAB = 0, NST = 0;
    __device__ __forceinline__ const float* tab_src(const Unit&, int) const { return nullptr; }
    unsigned char* Y; const PG8_LAS int* gtab; const PG8_LAS float* wtab;
    template <class AccT>
    __device__ __forceinline__ void operator()(const AccT (&acc)[2][2][4][2], const Unit& u, int ui, int wr, int wc, int fr, int fq, const PG8_LAS float* tab) const {
        const int col0 = u.pn * BM + wc * 32 + 8 * fq;
#pragma unroll
        for (int ai = 0; ai < 2; ++ai)
#pragma unroll
            for (int m = 0; m < 4; ++m) { const int rl = ai * HALF + wr * 64 + m * 16 + fr; const int slot = gtab[ui * 256 + rl]; const float wgt = wtab[ui * 256 + rl];
                if (slot >= 0) { unsigned char* rowp = Y + (size_t)slot * 1024 + col0;
#pragma unroll
                    for (int bj = 0; bj < 2; ++bj) { const f32x4 v0 = tof(acc[ai][bj][m][0]) * wgt, v1 = tof(acc[ai][bj][m][1]) * wgt;
                        u32x2 w; w.x = pk_fp8x4(v0[0], v0[1], v0[2], v0[3]); w.y = pk_fp8x4(v1[0], v1[1], v1[2], v1[3]);
                        *(u32x2*)(rowp + bj * HALF) = w; } } }
    }
};

template <class Epi, class Sched, bool ALIGN_EPI, bool GATHER, bool I8 = false>
__device__ __forceinline__ void gemm_phase(PG8_LAS unsigned char* lds, PG8_LAS unsigned char* lds_tab, const Gemm g, const Sched& S, const Epi& E, int stag_ticks = 0) {
    int tid_ = threadIdx.x; asm volatile("" : "+v"(tid_));
    const int tid = tid_, wid = __builtin_amdgcn_readfirstlane(tid >> 6), lane = tid & 63, wr = wid >> 2, wc = wid & 3, fr = lane & 15, fq = lane >> 4;
    const int K = g.K, nt = K / BK;
    unsigned voffA[2], voffB[2]; int RA[2]; unsigned CA2[2];
#pragma unroll
    for (int i = 0; i < 2; ++i) { int R, C; stage_rc(tid * 16 + i * 8192, R, C); const int Rb = Epi::PERM ? ((R & ~31) + (Epi::PSIG ? perm32s(R & 31) : perm32(R & 31))) : R;
        voffA[i] = (unsigned)(R * g.lda + C) * 2u; voffB[i] = (unsigned)(Rb * g.ldb + C) * 2u; RA[i] = R; CA2[i] = (unsigned)C * 2u; }
    const size_t kstep = (size_t)(BK * 2);
    const size_t hstepA = (size_t)HALF * g.lda * 2, hstepB = (size_t)HALF * g.ldb * 2;
    const unsigned ldsw = (unsigned)wid * 1024u;
    const int aoff = lds_byte(wr * 64 + fr, fq * 8), boff = lds_byte(wc * 32 + fr, fq * 8);
    unsigned gvc[2][2], gvn[2][2];
#define PG8_SA(b, h) (((b) * 2 + (h)) * HTB)
#define PG8_SB(b, h) ((4 + (b) * 2 + (h)) * HTB)
#define PG8_STG(bufoff, gbase, voff) do { _Pragma("unroll") for (int _i = 0; _i < 2; ++_i) \
        __builtin_amdgcn_global_load_lds((const unsigned*)((const char*)(gbase) + (voff)[_i]), (PG8_LAS unsigned*)(lds + (bufoff) + ldsw + _i * 8192), 16, 0, 0); } while (0)
#define PG8_STG_B(bufoff, kptr, h) PG8_STG(bufoff, (kptr) + (h) * hstepB, voffB)
#define PG8_STG_A(bufoff, kptr, h, nx) do { if constexpr (GATHER) { unsigned _v[2]; _v[0] = (nx) ? gvn[h][0] : gvc[h][0]; _v[1] = (nx) ? gvn[h][1] : gvc[h][1]; PG8_STG(bufoff, kptr, _v); } \
        else { PG8_STG(bufoff, (kptr) + (h) * hstepA, voffA); } } while (0)
#define PG8_GLOAD(dst, uix) do { _Pragma("unroll") for (int _h = 0; _h < 2; ++_h) _Pragma("unroll") for (int _i = 0; _i < 2; ++_i) \
        dst[_h][_i] = (unsigned)S.grow((uix), _h * HALF + RA[_i]) * (unsigned)(g.lda * 2) + CA2[_i]; } while (0)
#define PG8_LDA(dst, b, h) do { _Pragma("unroll") for (int m = 0; m < 4; ++m) _Pragma("unroll") for (int k = 0; k < 2; ++k) dst[m][k] = *(const PG8_LAS bf16x8*)(lds + PG8_SA(b, h) + aoff + m * 2048 + k * 1024); } while (0)
#define PG8_LDB(dst, b, h) do { _Pragma("unroll") for (int n = 0; n < 2; ++n) _Pragma("unroll") for (int k = 0; k < 2; ++k) dst[n][k] = *(const PG8_LAS bf16x8*)(lds + PG8_SB(b, h) + boff + n * 2048 + k * 1024); } while (0)
#define PG8_MMA(ai, bj, At, Bt) do { __builtin_amdgcn_s_setprio(1); _Pragma("unroll") for (int m = 0; m < 4; ++m) _Pragma("unroll") for (int n = 0; n < 2; ++n) _Pragma("unroll") for (int k = 0; k < 2; ++k) \
        { if constexpr (I8) acc[ai][bj][m][n] = __builtin_amdgcn_mfma_i32_16x16x64_i8(__builtin_bit_cast(i32x4, Bt[n][k]), __builtin_bit_cast(i32x4, At[m][k]), acc[ai][bj][m][n], 0, 0, 0); \
          else acc[ai][bj][m][n] = __builtin_amdgcn_mfma_f32_16x16x32_bf16(Bt[n][k], At[m][k], acc[ai][bj][m][n], 0, 0, 0); } __builtin_amdgcn_s_setprio(0); } while (0)
#define PG8_WAIT_V(n) asm volatile("s_waitcnt vmcnt(" #n ")" ::: "memory")
    constexpr int ND = (Epi::NTAB + 7) / 8, RELAX = 8 + Epi::NST + ND;
#define PG8_TABS(uix, U) do { if constexpr (Epi::NTAB > 0) { _Pragma("unroll") for (int c_ = 0; c_ < ND; ++c_) { const int ch_ = (wid + 8 * c_) % Epi::NTAB; \
        __builtin_amdgcn_global_load_lds((const unsigned*)(E.tab_src(U, ch_) + lane), (PG8_LAS unsigned*)((PG8_LAS float*)lds_tab + ((uix) & 1) * Epi::NTAB * 64 + 64 * ch_), 4, 0, 0); } } } while (0)
#ifdef PG8_RELAX
#define PG8_WAIT_V8R(rx) do { if (rx) asm volatile("s_waitcnt vmcnt(%0)" :: "n"(RELAX) : "memory"); else asm volatile("s_waitcnt vmcnt(8)" ::: "memory"); } while (0)
#else
#define PG8_WAIT_V8R(rx) asm volatile("s_waitcnt vmcnt(8)" ::: "memory")
#endif
#define PG8_WAIT_L(n) asm volatile("s_waitcnt lgkmcnt(" #n ")" ::: "memory")
#define PG8_BAR __builtin_amdgcn_s_barrier()
#define PG8_SCHED __builtin_amdgcn_sched_barrier(0)
    Unit cur, nxt; int ui = 0;
    if (!S.next(0, cur)) return;
    if (stag_ticks > 0) { const unsigned long long t0_ = __builtin_amdgcn_s_memrealtime(); const unsigned long long w_ = (unsigned long long)stag_ticks; while (__builtin_amdgcn_s_memrealtime() - t0_ < w_) __builtin_amdgcn_s_sleep(8); }
    typedef typename std::conditional<I8, i32x4, f32x4>::type AccT;
    AccT acc[2][2][4][2];
#pragma unroll
    for (int a = 0; a < 2; ++a)
#pragma unroll
        for (int b = 0; b < 2; ++b)
#pragma unroll
            for (int m = 0; m < 4; ++m)
#pragma unroll
                for (int n = 0; n < 2; ++n) acc[a][b][m][n] = AccT{};
    bf16x8 At[4][2], B0[2][2], B1[2][2];
    const char* cA = S.a_ptr(g, cur); const char* cB = S.b_ptr(g, cur);
    if constexpr (GATHER) { PG8_GLOAD(gvc, 0); PG8_GLOAD(gvn, 0); }
    PG8_TABS(0, cur);
    PG8_STG_B(PG8_SB(0, 0), cB, 0); PG8_STG_B(PG8_SB(0, 1), cB, 1); PG8_STG_A(PG8_SA(0, 0), cA, 0, false); PG8_STG_A(PG8_SA(0, 1), cA, 1, false);
    if (wr == 1) PG8_BAR;
    PG8_WAIT_V(2); PG8_BAR;
    PG8_STG_B(PG8_SB(1, 0), cB + kstep, 0); PG8_STG_A(PG8_SA(1, 0), cA + kstep, 0, false); PG8_STG_B(PG8_SB(1, 1), cB + kstep, 1);
    PG8_WAIT_V(6); PG8_BAR;
    for (;;) {
        const bool has_next = S.next(ui + 1, nxt);
        const char* nA = has_next ? S.a_ptr(g, nxt) : cA; const char* nB = has_next ? S.b_ptr(g, nxt) : cB;
        if constexpr (GATHER) { if (has_next) { PG8_GLOAD(gvn, ui + 1); } else {
#pragma unroll
            for (int h = 0; h < 2; ++h) { gvn[h][0] = gvc[h][0]; gvn[h][1] = gvc[h][1]; } } }
#pragma nounroll
        for (int t = 0; t < nt; t += 2) {
            const bool last = (t == nt - 2); const bool rx = (t == 0) && (ui > 0) && (RELAX > 8);
            const char* a1 = cA + (size_t)(t + 1) * kstep;
            const char* a2 = last ? nA : cA + (size_t)(t + 2) * kstep; const char* b2 = last ? nB : cB + (size_t)(t + 2) * kstep;
            const char* a3 = a2 + kstep; const char* b3 = b2 + kstep;
            PG8_LDB(B0, 0, 0); PG8_LDB(B1, 0, 1); PG8_SCHED; PG8_LDA(At, 0, 0); PG8_STG_A(PG8_SA(1, 1), a1, 1, false);
            PG8_WAIT_V8R(rx); PG8_WAIT_L(0); PG8_BAR; PG8_MMA(0, 0, At, B0); PG8_MMA(0, 1, At, B1); PG8_BAR; PG8_SCHED;
            PG8_LDA(At, 0, 1); PG8_STG_B(PG8_SB(0, 0), b2, 0); PG8_STG_B(PG8_SB(0, 1), b2, 1); PG8_STG_A(PG8_SA(0, 0), a2, 0, last);
            PG8_WAIT_V8R(rx); PG8_WAIT_L(0); PG8_BAR; PG8_MMA(1, 0, At, B0); PG8_MMA(1, 1, At, B1); PG8_BAR; PG8_SCHED;
            PG8_LDB(B0, 1, 0); PG8_LDB(B1, 1, 1); PG8_SCHED; PG8_LDA(At, 1, 0); PG8_STG_A(PG8_SA(0, 1), a2, 1, last);
            PG8_WAIT_V(8); PG8_WAIT_L(0); PG8_BAR; PG8_MMA(0, 0, At, B0); PG8_MMA(0, 1, At, B1); PG8_BAR; PG8_SCHED;
            PG8_LDA(At, 1, 1); PG8_STG_B(PG8_SB(1, 0), b3, 0); PG8_STG_B(PG8_SB(1, 1), b3, 1); PG8_STG_A(PG8_SA(1, 0), a3, 0, last);
            PG8_WAIT_V(8); PG8_WAIT_L(0); PG8_BAR; PG8_MMA(1, 0, At, B0); PG8_MMA(1, 1, At, B1); PG8_BAR; PG8_SCHED;
        }
        if constexpr (ALIGN_EPI) { if (wr == 0) PG8_BAR; }
        E(acc, cur, ui, wr, wc, fr, fq, (const PG8_LAS float*)lds_tab + (ui & 1) * Epi::NTAB * 64);
        if (!has_next) break;
#pragma unroll
        for (int a = 0; a < 2; ++a)
#pragma unroll
            for (int b = 0; b < 2; ++b)
#pragma unroll
                for (int m = 0; m < 4; ++m)
#pragma unroll
                    for (int n = 0; n < 2; ++n) acc[a][b][m][n] = AccT{};
        cur = nxt; cA = nA; cB = nB; ++ui;
        PG8_TABS(ui, cur);
        if constexpr (GATHER) {
#pragma unroll
            for (int h = 0; h < 2; ++h) { gvc[h][0] = gvn[h][0]; gvc[h][1] = gvn[h][1]; } }
        if constexpr (ALIGN_EPI) { if (wr == 1) PG8_BAR; }
    }
    PG8_WAIT_V(0);
    if constexpr (!ALIGN_EPI) { if (wr == 0) PG8_BAR; }
    PG8_BAR;
#undef PG8_SA
#undef PG8_SB
#undef PG8_STG
#undef PG8_STG_A
#undef PG8_STG_B
#undef PG8_GLOAD
#undef PG8_LDA
#undef PG8_LDB
#undef PG8_MMA
#undef PG8_WAIT_V
#undef PG8_TABS
#undef PG8_WAIT_V8R
#undef PG8_WAIT_L
#undef PG8_BAR
#undef PG8_SCHED
}
}

#ifndef PG8_ALIGN
#define PG8_ALIGN true
#endif
constexpr int NWAVES = 8;
constexpr int BATCH = 32, SEQ = 2048, DM = 1024, NLAYER = 2, NH = 4, HD = 64, NMEM = 256;
constexpr int T = BATCH * SEQ;
constexpr int MEMROWS = BATCH * NMEM;
constexpr int NIN = 7172, NPROJ = 3072, NGATE = 4096, NE = 16, DE = 512;
constexpr int FOX_F_COL = 768, GATE_COL = 3076;
constexpr float ALPHA = 1.4142135623730951f;
constexpr float LN_EPS = 1e-5f, GN_EPS = 1e-6f;
constexpr int LISTCAP = 65536;
constexpr int MAXU = 9;

constexpr size_t MiB = 1u << 20;
constexpr size_t WS_CTL = 0, CTL_ZERO_BYTES = 1 * MiB;
constexpr size_t WS_LF = 2 * MiB;
constexpr size_t WS_CC = 3 * MiB;
constexpr size_t WS_WT = 4 * MiB;
constexpr size_t WS_ROPE = 5 * MiB;
constexpr size_t WS_BIASP = 6 * MiB;
constexpr size_t WS_BIASG = 6 * MiB + 65536;
constexpr size_t WS_PAR = 7 * MiB;
constexpr int PAR_LNG = 0, PAR_LNB = 4096, PAR_WR = 8192, PAR_BR = 24576, PAR_LB = 24592, PAR_NG = 25104, PAR_WFF = 25232;
constexpr size_t WS_LIST = 8 * MiB;
constexpr size_t WS_W = 16 * MiB;
constexpr size_t W_IN = 0, W_G = 3 * MiB, W_B = 7 * MiB, W_OUT = 9 * MiB, W_E1 = 11 * MiB, W_E2 = 27 * MiB, W_LAYER = 43 * MiB;
constexpr size_t WS_WMEM = WS_W + 2 * W_LAYER;
constexpr size_t WS_MEMB = 104 * MiB;
constexpr size_t WS_MEMKV = 120 * MiB;
constexpr size_t WS_XB = 136 * MiB;
constexpr size_t WS_X8 = 264 * MiB;
constexpr size_t WS_X1B = 328 * MiB;
constexpr size_t WS_X18 = 456 * MiB;
constexpr size_t WS_PROJ = 520 * MiB;
constexpr size_t WS_U = 328 * MiB;
constexpr size_t WS_Y = 520 * MiB;
constexpr size_t WS_Y2 = 520 * MiB;
constexpr size_t WS_ACT = 648 * MiB;
constexpr size_t WS_END = 904 * MiB;
static_assert(WS_WMEM + 2 * MiB <= WS_MEMB && WS_U + (size_t)T * 4096 * 2 <= WS_PROJ + (size_t)T * 3072 * 2 && WS_ACT + (size_t)135168 * 512 * 2 <= WS_END && WS_PROJ + (size_t)T * 3072 * 2 <= WS_END, "d_ws map");
constexpr size_t CM_IN = 256 * 1024, CM_E = 320 * 1024;
constexpr size_t WS_SX = 12 * MiB, WS_S1 = 12 * MiB + 512 * 1024;
constexpr size_t WS_SWP = 13 * MiB, WS_SWG = 13 * MiB + 65536, WS_SWE = 13 * MiB + 131072;
constexpr int CW_TMO = 0, CW_CODE = 1, CW_BAR = 4096, CW_CNT = 16384, CW_Q = 20480;

constexpr int RING_OFF = 0, RING_BYTES = 131072;
constexpr int GT_OFF = 131072, WTB_OFF = GT_OFF + MAXU * 1024, STB_OFF = WTB_OFF + MAXU * 1024, SM_OFF = STB_OFF + MAXU * 1024;
constexpr int EV_OFF = SM_OFF + 1024;
constexpr int LDSCTL_OFF = EV_OFF + 2048, MISC_OFF = LDSCTL_OFF + 320;
constexpr int LDS_BYTES = 163840;
static_assert(MISC_OFF + 128 <= LDS_BYTES, "LDS map");

#define GAS __attribute__((address_space(1)))
#define LAS __attribute__((address_space(3)))
typedef unsigned short bf16;
typedef unsigned v4u __attribute__((ext_vector_type(4)));
typedef unsigned v2u __attribute__((ext_vector_type(2)));
typedef float f32x4 __attribute__((ext_vector_type(4)));
typedef GAS unsigned gu32;
#define RLX_AGENT __ATOMIC_RELAXED, __HIP_MEMORY_SCOPE_AGENT
#define LDS_WAIT() asm volatile("s_waitcnt lgkmcnt(0)" ::: "memory")
#define VM_WAIT() asm volatile("s_waitcnt vmcnt(0)" ::: "memory")
__device__ __forceinline__ unsigned f2bf(float f) { unsigned u = __builtin_bit_cast(unsigned, f); return (u + 0x7fffu + ((u >> 16) & 1u)) >> 16; }
__device__ __forceinline__ unsigned pk2(float lo, float hi) { return pg8::cvt_pk_bf16(lo, hi); }
__device__ __forceinline__ float bfl(unsigned w) { return __uint_as_float(w << 16); }
__device__ __forceinline__ float bfh(unsigned w) { return __uint_as_float(w & 0xffff0000u); }
__device__ __forceinline__ float bf1(bf16 h) { return __uint_as_float((unsigned)h << 16); }

#define XB_TMO      128
#define XB_XCNT(j)  (256  + 64 * (j))
#define XB_XSUB(j)  (1280 + 64 * (j))
#define XB_XGEN(j)  (2304 + 64 * (j))
#define XB_TOP      3328
#define XB_TOPGEN   3392
#define XCD_BAR_WORDS 3456
#define XB_SPIN_CAP (1u << 18)
__device__ __forceinline__ unsigned xb_ld(unsigned* p)              { return __hip_atomic_load(p, __ATOMIC_RELAXED, __HIP_MEMORY_SCOPE_AGENT); }
__device__ __forceinline__ unsigned xb_add(unsigned* p, unsigned v) { return __hip_atomic_fetch_add(p, v, __ATOMIC_RELAXED, __HIP_MEMORY_SCOPE_AGENT); }
__device__ __forceinline__ unsigned xb_xcc_id() { return (unsigned)__builtin_amdgcn_s_getreg((3 << 11) | 20) & 0xFu; }
#define XB_SPIN(cond, bar) do { unsigned _sp = 0; while (cond) { __builtin_amdgcn_s_sleep(1); \
    if ((++_sp & 255u) == 0u) { if (xb_ld(&(bar)[XB_TMO])) break; if (_sp > XB_SPIN_CAP) { atomicAdd(&(bar)[XB_TMO], 1u); break; } } } } while (0)
struct XcdBarrier { unsigned* bar; unsigned x; volatile LAS unsigned* st; };
__device__ __forceinline__ XcdBarrier xcd_barrier_post(unsigned* bar, volatile LAS unsigned* st) {
    XcdBarrier b; b.bar = bar; b.x = xb_xcc_id(); b.st = st;
    if (threadIdx.x == 0) (void)xb_add(&bar[XB_XCNT(b.x)], 1u);
    return b;
}
__device__ __forceinline__ void xcd_barrier_complete(unsigned* bar, unsigned x, unsigned& nloc, unsigned& nx) {
    const unsigned G = gridDim.x * gridDim.y * gridDim.z;
    unsigned sum, cnt, mine, sp = 0u;
    for (;;) {
        sum = 0u; cnt = 0u; mine = 0u;
#pragma unroll
        for (unsigned j = 0; j < 16; ++j) { const unsigned c = xb_ld(&bar[XB_XCNT(j)]); sum += c; cnt += (c > 0u) ? 1u : 0u; mine = (j == x) ? c : mine; }
        if (sum == G) break;
        __builtin_amdgcn_s_sleep(1);
        if ((++sp & 255u) == 0u) { if (xb_ld(&bar[XB_TMO])) break; if (sp > XB_SPIN_CAP) { atomicAdd(&bar[XB_TMO], 1u); break; } }
    }
    nloc = mine > 0u ? mine : 1u; nx = cnt > 0u ? cnt : 1u;
}
__device__ __forceinline__ void xcd_barrier(const XcdBarrier& b) {
    asm volatile("s_waitcnt vmcnt(0)" ::: "memory");
    __syncthreads();
    if (threadIdx.x == 0) {
        unsigned* bar = b.bar;
        __builtin_amdgcn_s_waitcnt(0);
        unsigned nloc = b.st[0], nx = b.st[1];
        if (nloc == 0u) { xcd_barrier_complete(bar, b.x, nloc, nx); b.st[0] = nloc; b.st[1] = nx; }
        const unsigned old = xb_add(&bar[XB_XSUB(b.x)], 1u);
        const unsigned gen = old / nloc;
        if (old + 1u == (gen + 1u) * nloc) {
            __builtin_amdgcn_fence(__ATOMIC_RELEASE, "agent");
            asm volatile("s_waitcnt vmcnt(0)" ::: "memory");
            const unsigned og = xb_add(&bar[XB_TOP], 1u);
            const unsigned tg = og / nx;
            if (og + 1u == (tg + 1u) * nx) xb_add(&bar[XB_TOPGEN], 1u);
            else XB_SPIN(xb_ld(&bar[XB_TOPGEN]) == tg, bar);
            __builtin_amdgcn_fence(__ATOMIC_ACQUIRE, "agent");
            xb_add(&bar[XB_XGEN(b.x)], 1u);
            asm volatile("s_waitcnt vmcnt(0)" ::: "memory");
        } else {
            XB_SPIN(xb_ld(&bar[XB_XGEN(b.x)]) == gen, bar);
            __builtin_amdgcn_fence(__ATOMIC_ACQUIRE, "agent");
            asm volatile("s_waitcnt vmcnt(0)" ::: "memory");
        }
    }
    __syncthreads();
}

struct Frame {
    LAS unsigned char* lds;
    volatile LAS unsigned* MISC;
    gu32* ctl;
    int tid, vcu, G, bx;
    float* out; unsigned char* ws;
};
#define OPAQUE_V(x) asm volatile("" : "+v"(x))
enum { I_X = 0, I_MEM, I_WIN, I_BIN, I_WMEMKV, I_LB, I_NORMG, I_WBRANCH, I_WOUT, I_LNG, I_LNB, I_WROUTER, I_BROUTER, I_WEIN, I_WEOUT };

template <int CTRL> __device__ __forceinline__ float dpp_f(float v) { return __builtin_bit_cast(float, __builtin_amdgcn_update_dpp(0, __builtin_bit_cast(int, v), CTRL, 0xF, 0xF, true)); }
constexpr int DPP_X1 = 0xB1, DPP_X2 = 0x4E, DPP_HMIR = 0x141, DPP_MIR = 0x140;
__device__ __forceinline__ float rl_f(float v, int l) { return __builtin_bit_cast(float, __builtin_amdgcn_readlane(__builtin_bit_cast(int, v), l)); }
__device__ __forceinline__ float wave_sum(float v) {
    v += dpp_f<DPP_X1>(v); v += dpp_f<DPP_X2>(v); v += dpp_f<DPP_HMIR>(v); v += dpp_f<DPP_MIR>(v);
    return (rl_f(v, 15) + rl_f(v, 31)) + (rl_f(v, 47) + rl_f(v, 63));
}
__device__ __forceinline__ float wave_max(float v) {
    v = fmaxf(v, dpp_f<DPP_X1>(v)); v = fmaxf(v, dpp_f<DPP_X2>(v)); v = fmaxf(v, dpp_f<DPP_HMIR>(v)); v = fmaxf(v, dpp_f<DPP_MIR>(v));
    return fmaxf(fmaxf(rl_f(v, 15), rl_f(v, 31)), fmaxf(rl_f(v, 47), rl_f(v, 63)));
}
__device__ __forceinline__ float sum8(float v) { v += dpp_f<DPP_X1>(v); v += dpp_f<DPP_X2>(v); v += dpp_f<DPP_HMIR>(v); return v; }
__device__ __forceinline__ float log_sigmoid(float z) { return z >= 0.f ? -log1pf(expf(-z)) : z - log1pf(expf(z)); }

__device__ __forceinline__ int src_col(int mode, int r) {
    if (mode == 1) { const int tile = r >> 8; return r + (tile >= 3 ? 4 : 0); }
    if (mode == 2) { const int nb = 2 * ((r >> 7) & 1) + ((r >> 4) & 1), d = 64 * (r >> 8) + 16 * ((r >> 5) & 3) + (r & 15); return GATE_COL + nb * 1024 + d; }
    if (mode == 3) { return ((r >> 7) & 1) * 512 + 128 * (r >> 8) + (r & 127); }
    return r;
}
__device__ __forceinline__ unsigned q8(float v, float inv) { int q = (int)rintf(v * inv); q = q > 127 ? 127 : (q < -127 ? -127 : q); return (unsigned)q & 255u; }
__device__ __forceinline__ unsigned q8x4(float a, float b, float c, float d, float inv) {
    const int ia = (int)rintf(a * inv), ib = (int)rintf(b * inv), ic = (int)rintf(c * inv), id = (int)rintf(d * inv);
    const unsigned lo = __builtin_bit_cast(unsigned, __builtin_amdgcn_cvt_pk_i16(ia, ib)), hi = __builtin_bit_cast(unsigned, __builtin_amdgcn_cvt_pk_i16(ic, id));
    return __builtin_amdgcn_perm(hi, lo, 0x06040200u);
}
__device__ __forceinline__ void store_row_i8(signed char* orow, float* srow, int lane, const f32x4 (&v)[4]) {
    float am = 0.f;
#pragma unroll
    for (int j = 0; j < 4; ++j) am = fmaxf(am, fmaxf(fmaxf(fabsf(v[j].x), fabsf(v[j].y)), fmaxf(fabsf(v[j].z), fabsf(v[j].w))));
    am = fmaxf(wave_max(am), 1e-30f);
    const float inv = 127.0f / am;
    GAS unsigned* o4 = (GAS unsigned*)orow + lane;
#pragma unroll
    for (int j = 0; j < 4; ++j) o4[64 * j] = q8x4(v[j].x, v[j].y, v[j].z, v[j].w, inv);
    if (lane == 0) *srow = am * (1.0f / 127.0f);
}
__device__ __forceinline__ void p0_transpose_item_q(const float* W, int K, int N, signed char* WT, int mode, const unsigned* cm, LAS float* scr, int item, int ndst32, int lane) {
    const int kb = item / ndst32, nb = item % ndst32, k0 = 64 * kb, n0 = 32 * nb;
    const int sc = src_col(mode, n0 + (lane & 31));
#pragma unroll 8
    for (int i = 0; i < 32; ++i) { const int kk = 2 * i + (lane >> 5); scr[kk * 33 + (lane & 31)] = W[(size_t)(k0 + kk) * N + sc]; }
    LDS_WAIT(); asm volatile("" ::: "memory");
    const int c = lane & 7;
#pragma unroll
    for (int j = 0; j < 4; ++j) { const int n = (lane >> 3) + 8 * j; const LAS float* sp = scr + (8 * c) * 33 + n;
        const float inv = 127.0f / fmaxf(__uint_as_float(cm[src_col(mode, n0 + n)]), 1e-30f);
        v2u o; o.x = q8x4(sp[0 * 33], sp[1 * 33], sp[2 * 33], sp[3 * 33], inv); o.y = q8x4(sp[4 * 33], sp[5 * 33], sp[6 * 33], sp[7 * 33], inv);
        *(GAS v2u*)(WT + (size_t)(n0 + n) * K + k0 + 8 * c) = o; }
    LDS_WAIT(); asm volatile("" ::: "memory");
}
__device__ __forceinline__ void p0_transpose_item(const float* W, int K, int N, bf16* WT, int mode, LAS float* scr, int item, int ndst32, int lane, float mul = 1.0f) {
    const int kb = item / ndst32, nb = item % ndst32, k0 = 64 * kb, n0 = 32 * nb;
    const int sc = src_col(mode, n0 + (lane & 31));
#pragma unroll 8
    for (int i = 0; i < 32; ++i) { const int kk = 2 * i + (lane >> 5); scr[kk * 33 + (lane & 31)] = W[(size_t)(k0 + kk) * N + sc]; }
    LDS_WAIT(); asm volatile("" ::: "memory");
    const int c = lane & 7;
#pragma unroll
    for (int j = 0; j < 4; ++j) { const int n = (lane >> 3) + 8 * j; const LAS float* s = scr + (8 * c) * 33 + n;
        v4u o; o.x = pk2(s[0 * 33] * mul, s[1 * 33] * mul); o.y = pk2(s[2 * 33] * mul, s[3 * 33] * mul); o.z = pk2(s[4 * 33] * mul, s[5 * 33] * mul); o.w = pk2(s[6 * 33] * mul, s[7 * 33] * mul);
        *(GAS v4u*)(WT + (size_t)(n0 + n) * K + k0 + 8 * c) = o; }
    LDS_WAIT(); asm volatile("" ::: "memory");
}
__device__ __forceinline__ void store_row_bf16(bf16* orow, int lane, const f32x4 (&v)[4]) {
    GAS unsigned long long* o8 = (GAS unsigned long long*)orow + lane;
#pragma unroll
    for (int j = 0; j < 4; ++j) o8[64 * j] = (unsigned long long)pk2(v[j].x, v[j].y) | ((unsigned long long)pk2(v[j].z, v[j].w) << 32);
}
__device__ __forceinline__ void load_row_fp8(const unsigned char* irow, int lane, f32x4 (&v)[4]) {
    const GAS int* i4 = (const GAS int*)irow + lane;
#pragma unroll
    for (int j = 0; j < 4; ++j) { const int w = i4[64 * j]; const pg8::f32x2 a = __builtin_amdgcn_cvt_pk_f32_fp8(w, false), b = __builtin_amdgcn_cvt_pk_f32_fp8(w, true); v[j] = (f32x4){a.x, a.y, b.x, b.y} * 0.03125f; }
}
__device__ __forceinline__ void load_row_bf16(const bf16* irow, int lane, f32x4 (&v)[4]) {
    const GAS v2u* i8 = (const GAS v2u*)irow + lane;
#pragma unroll
    for (int j = 0; j < 4; ++j) { const v2u w = i8[64 * j]; v[j] = (f32x4){bfl(w.x), bfh(w.x), bfl(w.y), bfh(w.y)}; }
}
__device__ __forceinline__ void forget_row(const f32x4 (&v)[4], const LAS float* wff, float* lfrow, int lane) {
    float p[4];
#pragma unroll
    for (int h = 0; h < 4; ++h) { pg8::f32x2 s2 = {0.f, 0.f};
#pragma unroll
        for (int j = 0; j < 4; ++j) { const f32x4 w = *(const LAS f32x4*)(wff + h * 1024 + 256 * j + 4 * lane); s2 = (pg8::f32x2){v[j].x, v[j].y} * (pg8::f32x2){w.x, w.y} + s2; s2 = (pg8::f32x2){v[j].z, v[j].w} * (pg8::f32x2){w.z, w.w} + s2; }
        p[h] = wave_sum(s2.x + s2.y) + wff[4096 + h]; }
    if (lane < 4) { const float z = lane == 0 ? p[0] : lane == 1 ? p[1] : lane == 2 ? p[2] : p[3]; lfrow[lane] = log_sigmoid(z); }
}
__device__ __forceinline__ void stage_wff(Frame& F, int l, LAS float* wff) {
    const float* src = (const float*)(F.ws + WS_PAR) + PAR_WFF + l * 4100;
    for (int idx = F.tid; idx < 4100; idx += NWAVES * 64) wff[idx] = src[idx];
}

struct Args { const float* in[15]; float* out; unsigned char* ws; int naive, pad; };
__device__ __forceinline__ void p0_colmax(Frame& F, const Args& A) {
    const int p_lane = F.tid & 63, p_wave = __builtin_amdgcn_readfirstlane(F.tid >> 6);
    const int gw = F.vcu * NWAVES + p_wave, NGW = F.G * NWAVES;
    constexpr int CB_IN = (NIN + 63) / 64, PER_L = (CB_IN + 256) * 8;
    for (int it = gw; it < NLAYER * PER_L; it += NGW) { const int l = it / PER_L, r = it % PER_L, seg = r & 7, cbk = r >> 3;
        const float* W; int N, col; unsigned* cm;
        if (cbk < CB_IN) { W = A.in[I_WIN] + (size_t)l * DM * NIN; N = NIN; col = cbk * 64 + p_lane; cm = (unsigned*)(F.ws + CM_IN) + l * NIN; }
        else { const int e = (cbk - CB_IN) >> 4, cb = (cbk - CB_IN) & 15; W = A.in[I_WEIN] + ((size_t)l * 16 + e) * 1024 * 1024; N = 1024; col = cb * 64 + p_lane; cm = (unsigned*)(F.ws + CM_E) + (l * 16 + e) * 1024; }
        if (col < N) { float m = 0.f; const float* p = W + (size_t)(seg * 128) * N + col;
#pragma unroll 16
            for (int rr = 0; rr < 128; ++rr) m = fmaxf(m, fabsf(p[(size_t)rr * N]));
            __hip_atomic_fetch_max(cm + col, __float_as_uint(m), RLX_AGENT); } }
}
__device__ __forceinline__ void p0_strips(Frame& F, const Args& A) {
    const int tid = F.tid, lane = tid & 63, wave = __builtin_amdgcn_readfirstlane(tid >> 6);
    LAS float* sb = (LAS float*)(F.lds + RING_OFF);
    LAS float* pm = (LAS float*)(F.lds + GT_OFF);
    constexpr int SPL = 96 + 128 + 512, NSTRIP = NLAYER * SPL;
    struct SD { const float* W; int N, mode, r0; signed char* WT; float* sc; float mul; };
    auto desc = [&](int s_) -> SD { SD d; const int l = s_ / SPL, r = s_ % SPL; unsigned char* wl = F.ws + WS_W + (size_t)l * W_LAYER;
        if (r < 96) { d.W = A.in[I_WIN] + (size_t)l * DM * NIN; d.N = NIN; d.mode = 1; d.r0 = 32 * r; d.WT = (signed char*)(wl + W_IN); d.sc = (float*)(F.ws + WS_SWP) + l * NPROJ; d.mul = 1.0f / 127.0f; }
        else if (r < 224) { d.W = A.in[I_WIN] + (size_t)l * DM * NIN; d.N = NIN; d.mode = 2; d.r0 = 32 * (r - 96); d.WT = (signed char*)(wl + W_G); d.sc = (float*)(F.ws + WS_SWG) + l * NGATE; d.mul = -1.4426950408889634f / 127.0f; }
        else { const int rr = r - 224, e = rr >> 5; d.W = A.in[I_WEIN] + ((size_t)l * 16 + e) * 1024 * 1024; d.N = 1024; d.mode = 3; d.r0 = 32 * (rr & 31); d.WT = (signed char*)(wl + W_E1) + (size_t)e * 1024 * 1024; d.sc = (float*)(F.ws + WS_SWE) + (l * 16 + e) * 1024; d.mul = 1.0f / 127.0f; }
        return d; };
    f32x4 raw[16];
    auto issue = [&](const SD& d) {
#pragma unroll
        for (int j = 0; j < 16; ++j) { const int idx = tid + 512 * j, k = idx >> 3, q = idx & 7; raw[j] = *(const GAS f32x4*)(d.W + (size_t)k * d.N + src_col(d.mode, d.r0 + 4 * q)); } };
    int s_ = F.vcu;
    SD cur = desc(s_ < NSTRIP ? s_ : 0); issue(cur);
    for (; s_ < NSTRIP; s_ += F.G) {
#pragma unroll
        for (int j = 0; j < 16; ++j) { const int idx = tid + 512 * j; *(LAS f32x4*)(sb + (idx >> 3) * 32 + 4 * (idx & 7)) = raw[j]; }
        const SD nxt = desc(s_ + F.G < NSTRIP ? s_ + F.G : s_); issue(nxt);
        __syncthreads();
        const int n = lane & 31, kg = wave * 2 + (lane >> 5);
        float v[64]; float m = 0.f;
#pragma unroll
        for (int i = 0; i < 64; ++i) { v[i] = sb[(64 * kg + i) * 32 + n]; m = fmaxf(m, fabsf(v[i])); }
        pm[n * 16 + kg] = m;
        __syncthreads();
        float cm = 0.f;
#pragma unroll
        for (int g = 0; g < 4; ++g) { const f32x4 t4 = *(const LAS f32x4*)(pm + n * 16 + 4 * g); cm = fmaxf(cm, fmaxf(fmaxf(t4.x, t4.y), fmaxf(t4.z, t4.w))); }
        cm = fmaxf(cm, 1e-30f);
        const float inv = 127.0f / cm;
        signed char* orow = cur.WT + (size_t)(cur.r0 + n) * 1024 + 64 * kg;
#pragma unroll
        for (int g = 0; g < 4; ++g) { v4u o; o.x = q8x4(v[16 * g + 0], v[16 * g + 1], v[16 * g + 2], v[16 * g + 3], inv); o.y = q8x4(v[16 * g + 4], v[16 * g + 5], v[16 * g + 6], v[16 * g + 7], inv);
            o.z = q8x4(v[16 * g + 8], v[16 * g + 9], v[16 * g + 10], v[16 * g + 11], inv); o.w = q8x4(v[16 * g + 12], v[16 * g + 13], v[16 * g + 14], v[16 * g + 15], inv); *(GAS v4u*)(orow + 16 * g) = o; }
        if (kg == 0) cur.sc[cur.r0 + n] = cm * cur.mul;
        cur = nxt;
    }
    __syncthreads();
}
template <int K, class Desc>
__device__ __forceinline__ void p0_strips_bf16(Frame& F, int nstrip, const Desc& desc) {
    const int tid = F.tid, lane = tid & 63, wave = __builtin_amdgcn_readfirstlane(tid >> 6);
    LAS float* sb = (LAS float*)(F.lds + RING_OFF);
    constexpr int NL = K / 64, KPT = K / 16;
    struct BD { const float* W; int N, r0; bf16* WT; float mul; };
    f32x4 raw[NL];
    auto issue = [&](const BD& d) {
#pragma unroll
        for (int j = 0; j < NL; ++j) { const int idx = tid + 512 * j, k = idx >> 3, q = idx & 7; raw[j] = *(const GAS f32x4*)(d.W + (size_t)k * d.N + d.r0 + 4 * q); } };
    int s_ = F.vcu;
    BD cur; { const int c_ = s_ < nstrip ? s_ : 0; desc(c_, cur.W, cur.N, cur.r0, cur.WT, cur.mul); } issue(cur);
    for (; s_ < nstrip; s_ += F.G) {
#pragma unroll
        for (int j = 0; j < NL; ++j) { const int idx = tid + 512 * j; *(LAS f32x4*)(sb + (idx >> 3) * 32 + 4 * (idx & 7)) = raw[j]; }
        BD nxt; { const int c_ = s_ + F.G < nstrip ? s_ + F.G : s_; desc(c_, nxt.W, nxt.N, nxt.r0, nxt.WT, nxt.mul); } issue(nxt);
        __syncthreads();
        const int n = lane & 31, kg = wave * 2 + (lane >> 5);
        bf16* orow = cur.WT + (size_t)(cur.r0 + n) * K + KPT * kg;
#pragma unroll
        for (int g = 0; g < KPT / 8; ++g) { float v[8];
#pragma unroll
            for (int i = 0; i < 8; ++i) v[i] = sb[(KPT * kg + 8 * g + i) * 32 + n] * cur.mul;
            v4u o; o.x = pk2(v[0], v[1]); o.y = pk2(v[2], v[3]); o.z = pk2(v[4], v[5]); o.w = pk2(v[6], v[7]); *(GAS v4u*)(orow + 8 * g) = o; }
        __syncthreads();
        cur = nxt;
    }
}
__device__ __forceinline__ void p0_prologue(Frame& F, const Args& A) {
    const int p_lane = F.tid & 63, p_wave = __builtin_amdgcn_readfirstlane(F.tid >> 6);
    LAS float* scr = (LAS float*)(F.lds + RING_OFF + p_wave * 8704);
    LAS float* wff = (LAS float*)(F.lds + RING_OFF + 81920);
    const int gw = F.vcu * NWAVES + p_wave, NGW = F.G * NWAVES;
    p0_strips(F, A);
    p0_strips_bf16<256>(F, NLAYER * 4 * 32, [&](int c, const float*& W, int& N, int& r0, bf16*& WT, float& mul) { const int l = c >> 7, nb = (c >> 5) & 3; W = A.in[I_WBRANCH] + ((size_t)l * 4 + nb) * 256 * 1024; N = 1024; r0 = 32 * (c & 31);
        WT = (bf16*)(F.ws + WS_W + (size_t)l * W_LAYER + W_B) + (size_t)nb * 1024 * 256; mul = 32.0f; });
    p0_strips_bf16<1024>(F, NLAYER * 32 + NLAYER * 16, [&](int c, const float*& W, int& N, int& r0, bf16*& WT, float& mul) {
        if (c < NLAYER * 32) { const int l = c >> 5; W = A.in[I_WOUT] + (size_t)l * 1024 * 1024; N = 1024; r0 = 32 * (c & 31); WT = (bf16*)(F.ws + WS_W + (size_t)l * W_LAYER + W_OUT); mul = 32.0f; }
        else { const int c2 = c - NLAYER * 32, l = c2 >> 4; W = A.in[I_WMEMKV] + (size_t)l * 1024 * 512; N = 512; r0 = 32 * (c2 & 15); WT = (bf16*)(F.ws + WS_WMEM) + (size_t)l * 512 * 1024; mul = 1.0f; } });
    p0_strips_bf16<512>(F, NLAYER * 16 * 32, [&](int c, const float*& W, int& N, int& r0, bf16*& WT, float& mul) { const int l = c >> 9, e = (c >> 5) & 15; W = A.in[I_WEOUT] + ((size_t)l * 16 + e) * 512 * 1024; N = 1024; r0 = 32 * (c & 31);
        WT = (bf16*)(F.ws + WS_W + (size_t)l * W_LAYER + W_E2) + (size_t)e * 1024 * 512; mul = 1.0f; });
    { const float* Win0 = A.in[I_WIN]; const float* bin0 = A.in[I_BIN];
      for (int idx = F.tid; idx < 4096; idx += NWAVES * 64) { const int k = idx >> 2, h = idx & 3; wff[h * 1024 + k] = Win0[(size_t)k * NIN + FOX_F_COL + h]; }
      if (F.tid < 4) wff[4096 + F.tid] = bin0[FOX_F_COL + F.tid]; }
    { const int gt = blockIdx.x * (NWAVES * 64) + F.tid, NGT = F.G * NWAVES * 64;
      float* bp = (float*)(F.ws + WS_BIASP); float* bg = (float*)(F.ws + WS_BIASG);
      for (int i = gt; i < NLAYER * NPROJ; i += NGT) { const int l = i / NPROJ, r = i % NPROJ; bp[i] = A.in[I_BIN][(size_t)l * NIN + src_col(1, r)]; }
      for (int i = gt; i < NLAYER * NGATE; i += NGT) { const int l = i / NGATE, r = i % NGATE; bg[i] = -1.4426950408889634f * A.in[I_BIN][(size_t)l * NIN + src_col(2, r)]; }
      float* rc = (float*)(F.ws + WS_ROPE); float* rs = rc + SEQ * 32;
      for (int i = gt; i < SEQ * 32; i += NGT) { const int pos = i >> 5, f = i & 31; const float inv = powf(10000.0f, -2.0f * (float)f / 64.0f); const float ang = (float)pos * inv; rc[i] = cosf(ang); rs[i] = sinf(ang); }
      float* par = (float*)(F.ws + WS_PAR);
      for (int i = gt; i < 4096; i += NGT) { par[PAR_LNG + i] = A.in[I_LNG][i]; par[PAR_LNB + i] = A.in[I_LNB][i]; }
      for (int i = gt; i < 16384; i += NGT) par[PAR_WR + i] = A.in[I_WROUTER][i];
      for (int i = gt; i < 16; i += NGT) par[PAR_BR + i] = A.in[I_BROUTER][i];
      for (int i = gt; i < 512; i += NGT) par[PAR_LB + i] = A.in[I_LB][i];
      for (int i = gt; i < 128; i += NGT) par[PAR_NG + i] = A.in[I_NORMG][i];
      for (int i = gt; i < NLAYER * 4096; i += NGT) { const int l = i >> 12, k = (i & 4095) >> 2, h = i & 3; par[PAR_WFF + l * 4100 + h * 1024 + k] = A.in[I_WIN][((size_t)l * DM + k) * NIN + FOX_F_COL + h]; }
      for (int i = gt; i < NLAYER * 4; i += NGT) { const int l = i >> 2, h = i & 3; par[PAR_WFF + l * 4100 + 4096 + h] = A.in[I_BIN][(size_t)l * NIN + FOX_F_COL + h]; } }
    __syncthreads();
    { const int hf = p_lane >> 5, l5 = p_lane & 31;
      f32x4 nx[8];
#define P0_LOAD(pp) do { const GAS f32x4* xr_ = (const GAS f32x4*)(A.in[I_X] + (size_t)(2 * (pp) + hf) * DM) + l5; _Pragma("unroll") for (int j = 0; j < 8; ++j) nx[j] = xr_[32 * j]; } while (0)
      P0_LOAD(gw);
      for (int pi = gw; pi < T / 2; pi += NGW) {
        const size_t m = (size_t)2 * pi + hf;
        f32x4 v[8];
#pragma unroll
        for (int j = 0; j < 8; ++j) v[j] = nx[j];
        { const int pn = pi + NGW < T / 2 ? pi + NGW : pi; P0_LOAD(pn); } asm volatile("" ::: "memory");
        float am = 0.f;
#pragma unroll
        for (int j = 0; j < 8; ++j) am = fmaxf(am, fmaxf(fmaxf(fabsf(v[j].x), fabsf(v[j].y)), fmaxf(fabsf(v[j].z), fabsf(v[j].w))));
        am = fmaxf(am, dpp_f<DPP_X1>(am)); am = fmaxf(am, dpp_f<DPP_X2>(am)); am = fmaxf(am, dpp_f<DPP_HMIR>(am)); am = fmaxf(am, dpp_f<DPP_MIR>(am));
        am = fmaxf(hf ? fmaxf(rl_f(am, 47), rl_f(am, 63)) : fmaxf(rl_f(am, 15), rl_f(am, 31)), 1e-30f);
        const float inv = 127.0f / am;
        GAS unsigned* o4 = (GAS unsigned*)((signed char*)(F.ws + WS_X8) + m * DM) + l5;
#pragma unroll
        for (int j = 0; j < 8; ++j) o4[32 * j] = q8x4(v[j].x, v[j].y, v[j].z, v[j].w, inv);
        if (l5 == 0) ((float*)(F.ws + WS_SX))[m] = am * (1.0f / 127.0f);
        float ph[4];
#pragma unroll
        for (int h = 0; h < 4; ++h) { pg8::f32x2 s2 = {0.f, 0.f};
#pragma unroll
            for (int j = 0; j < 8; ++j) { const f32x4 w = *(const LAS f32x4*)(wff + h * 1024 + 128 * j + 4 * l5); s2 = (pg8::f32x2){v[j].x, v[j].y} * (pg8::f32x2){w.x, w.y} + s2; s2 = (pg8::f32x2){v[j].z, v[j].w} * (pg8::f32x2){w.z, w.w} + s2; }
            float t = s2.x + s2.y; t += dpp_f<DPP_X1>(t); t += dpp_f<DPP_X2>(t); t += dpp_f<DPP_HMIR>(t); t += dpp_f<DPP_MIR>(t);
            ph[h] = (hf ? rl_f(t, 47) + rl_f(t, 63) : rl_f(t, 15) + rl_f(t, 31)) + wff[4096 + h]; }
        if (l5 < 4) { const float z = l5 == 0 ? ph[0] : l5 == 1 ? ph[1] : l5 == 2 ? ph[2] : ph[3]; ((float*)(F.ws + WS_LF))[m * 4 + l5] = log_sigmoid(z); }
      }
#undef P0_LOAD
    }
    for (int m = gw; m < MEMROWS; m += NGW) {
        const GAS f32x4* xr = (const GAS f32x4*)(A.in[I_MEM] + (size_t)m * DM) + p_lane;
        f32x4 v[4];
#pragma unroll
        for (int j = 0; j < 4; ++j) v[j] = xr[64 * j];
        store_row_bf16((bf16*)(F.ws + WS_MEMB) + (size_t)m * DM, p_lane, v);
    }
}

__device__ __forceinline__ void cc_scan(Frame& F) {
    int tid_ = F.tid; OPAQUE_V(tid_); const int c_lane = tid_ & 63, c_wave = __builtin_amdgcn_readfirstlane(tid_ >> 6);
    if (F.bx < BATCH * NH && c_wave == 0) {
        const int bh = F.bx, b = bh >> 2, h = bh & 3, s0 = 32 * c_lane;
        const float* lf = (const float*)(F.ws + WS_LF) + ((size_t)b * SEQ + s0) * 4 + h;
        float loc[32]; float run = 0.f;
#pragma unroll
        for (int i = 0; i < 32; ++i) { run += lf[4 * i]; loc[i] = run; }
        float incl = run;
#pragma unroll
        for (int o = 1; o < 64; o <<= 1) { const float t = __shfl_up(incl, o); if (c_lane >= o) incl += t; }
        const float excl = incl - run;
        float* cc = (float*)(F.ws + WS_CC) + (size_t)bh * SEQ + s0;
#pragma unroll
        for (int i = 0; i < 32; ++i) cc[i] = excl + loc[i];
    }
}

namespace att {
typedef float f32x16 __attribute__((ext_vector_type(16)));
typedef short bf16x8 __attribute__((ext_vector_type(8)));
typedef short s16x4 __attribute__((ext_vector_type(4)));
typedef short v4i16_t __attribute__((ext_vector_type(4)));
constexpr int KBUF = 0, VBUF = 16384, KB_OFF = 32768, ATT_LDS = 32768 + 8192;
constexpr float C2 = 0.125f * 1.4426950408889634f;
__device__ __forceinline__ int crow(int r, int hi) { return (r & 3) + 8 * (r >> 2) + 4 * hi; }
__device__ __forceinline__ s16x4 vtr(const LAS char* p) { return __builtin_bit_cast(s16x4, __builtin_amdgcn_ds_read_tr16_b64_v4i16((LAS v4i16_t*)p)); }
template <bool CAUSAL>
__device__ __forceinline__ void attn_unit(LAS char* lds, const bf16* Qp, int qpitch, const bf16* Kp, const bf16* Vp, int kvpitch, int ntiles, int q0, const float* ccp, bf16* Op, int opitch, int tid) {
    const int lane = tid & 63, wid = __builtin_amdgcn_readfirstlane(tid >> 6), r32 = lane & 31, hi = lane >> 5;
    LAS float* kb = (LAS float*)(lds + KB_OFF);
    if (CAUSAL) { for (int k = tid; k < ntiles * 64; k += 512) kb[k] = -1.4426950408889634f * ccp[k]; }
    bf16x8 qr[4];
#pragma unroll
    for (int d0 = 0; d0 < 4; ++d0) qr[d0] = *(const bf16x8*)(Qp + (size_t)(32 * wid + r32) * qpitch + 16 * d0 + 8 * hi);
    const int kvr = tid >> 3, ch = tid & 7;
    const bf16* kg = Kp + (size_t)kvr * kvpitch + ch * 8; const bf16* vg = Vp + (size_t)kvr * kvpitch + ch * 8;
    const int kl = ch * 1024 + kvr * 16, vl = (ch >> 2) * 4096 + kvr * 64 + (ch & 3) * 16;
    v4u kreg = *(const v4u*)kg, vreg = *(const v4u*)vg;
    *(LAS v4u*)(lds + KBUF + kl) = kreg; *(LAS v4u*)(lds + VBUF + vl) = vreg;
    __syncthreads();
    const int qabs = q0 + 32 * wid + r32, qwmax = q0 + 32 * wid + 31;
    float mrun = CAUSAL ? kb[qabs] : 0.f, lrun = 0.f; f32x16 o0 = {}, o1 = {};
    f32x16 cinit;
#pragma unroll
    for (int r = 0; r < 16; ++r) cinit[r] = -mrun * (1.0f / C2);
    const int vrd = (4 * hi + ((lane & 15) >> 2)) * 64 + ((lane >> 4) & 1) * 32 + (lane & 3) * 8;
    for (int t = 0; t < ntiles; ++t) {
        const int buf = (t & 1) * 8192;
        if (t + 1 < ntiles) { kreg = *(const v4u*)(kg + (size_t)(t + 1) * 64 * kvpitch); vreg = *(const v4u*)(vg + (size_t)(t + 1) * 64 * kvpitch); }
        const int kv0 = 64 * t;
        if (!CAUSAL || kv0 <= qwmax) {
            const LAS char* Kb = lds + KBUF + buf; const LAS char* Vb = lds + VBUF + buf;
            const bool band = t >= ntiles - 4;
            f32x16 p0, p1;
            auto scores = [&]() {
                p0 = cinit; p1 = cinit;
#pragma unroll
                for (int d0 = 0; d0 < 4; ++d0) { const bf16x8 a0 = *(const LAS bf16x8*)(Kb + (2 * d0 + hi) * 1024 + r32 * 16), a1 = *(const LAS bf16x8*)(Kb + (2 * d0 + hi) * 1024 + (32 + r32) * 16);
                    p0 = __builtin_amdgcn_mfma_f32_32x32x16_bf16(a0, qr[d0], p0, 0, 0, 0); p1 = __builtin_amdgcn_mfma_f32_32x32x16_bf16(a1, qr[d0], p1, 0, 0, 0); }
#pragma unroll
                for (int g = 0; g < 4; ++g) { f32x4 b0 = {0.f, 0.f, 0.f, 0.f}, b1 = {0.f, 0.f, 0.f, 0.f};
                    if (CAUSAL) { b0 = *(const LAS f32x4*)(kb + kv0 + 8 * g + 4 * hi); b1 = *(const LAS f32x4*)(kb + kv0 + 32 + 8 * g + 4 * hi); }
#pragma unroll
                    for (int j = 0; j < 4; ++j) { const int r = 4 * g + j; float s0 = p0[r] * C2 + b0[j], s1 = p1[r] * C2 + b1[j];
                        if (CAUSAL && band) { const int kv = kv0 + 8 * g + 4 * hi + j; if (kv > qabs) s0 = -INFINITY; if (kv + 32 > qabs) s1 = -INFINITY; }
                        p0[r] = s0; p1[r] = s1; } } };
            scores();
            float rs = 0.f;
#pragma unroll
            for (int r = 0; r < 16; ++r) { p0[r] = __builtin_amdgcn_exp2f(p0[r]); p1[r] = __builtin_amdgcn_exp2f(p1[r]); rs += p0[r] + p1[r]; }
            if (__any(!(rs < 1.0995116e12f))) {
                scores();
                float mx = -1e30f;
#pragma unroll
                for (int r = 0; r < 16; ++r) mx = fmaxf(mx, fmaxf(p0[r], p1[r]));
                mx = fmaxf(mx, __shfl_xor(mx, 32));
                const float dl = mx > 0.f ? mx : 0.f, alpha = __builtin_amdgcn_exp2f(-dl); mrun += dl; lrun *= alpha;
                rs = 0.f;
#pragma unroll
                for (int r = 0; r < 16; ++r) { o0[r] *= alpha; o1[r] *= alpha; cinit[r] = -mrun * (1.0f / C2); p0[r] = __builtin_amdgcn_exp2f(p0[r] - dl); p1[r] = __builtin_amdgcn_exp2f(p1[r] - dl); rs += p0[r] + p1[r]; } }
            lrun += rs;
            bf16x8 pf[4];
#pragma unroll
            for (int s = 0; s < 2; ++s) { pg8::u32x4 w0, w1;
                w0.x = pg8::cvt_pk_bf16(p0[8 * s + 0], p0[8 * s + 1]); w0.y = pg8::cvt_pk_bf16(p0[8 * s + 2], p0[8 * s + 3]); w0.z = pg8::cvt_pk_bf16(p0[8 * s + 4], p0[8 * s + 5]); w0.w = pg8::cvt_pk_bf16(p0[8 * s + 6], p0[8 * s + 7]);
                w1.x = pg8::cvt_pk_bf16(p1[8 * s + 0], p1[8 * s + 1]); w1.y = pg8::cvt_pk_bf16(p1[8 * s + 2], p1[8 * s + 3]); w1.z = pg8::cvt_pk_bf16(p1[8 * s + 4], p1[8 * s + 5]); w1.w = pg8::cvt_pk_bf16(p1[8 * s + 6], p1[8 * s + 7]);
                pf[s] = __builtin_bit_cast(bf16x8, w0); pf[2 + s] = __builtin_bit_cast(bf16x8, w1); }
#pragma unroll
            for (int s = 0; s < 4; ++s) {
                const s16x4 l0 = vtr(Vb + vrd + s * 1024), h0 = vtr(Vb + vrd + s * 1024 + 512), l1 = vtr(Vb + 4096 + vrd + s * 1024), h1 = vtr(Vb + 4096 + vrd + s * 1024 + 512);
                const bf16x8 va = (bf16x8){l0[0], l0[1], l0[2], l0[3], h0[0], h0[1], h0[2], h0[3]}, vb = (bf16x8){l1[0], l1[1], l1[2], l1[3], h1[0], h1[1], h1[2], h1[3]};
                o0 = __builtin_amdgcn_mfma_f32_32x32x16_bf16(va, pf[s], o0, 0, 0, 0); o1 = __builtin_amdgcn_mfma_f32_32x32x16_bf16(vb, pf[s], o1, 0, 0, 0); }
        }
        if (t + 1 < ntiles) { *(LAS v4u*)(lds + KBUF + (buf ^ 8192) + kl) = kreg; *(LAS v4u*)(lds + VBUF + (buf ^ 8192) + vl) = vreg; }
        __syncthreads();
    }
    const float inv = 1.0f / (lrun + __shfl_xor(lrun, 32));
    bf16* orow = Op + (size_t)(32 * wid + r32) * opitch + 4 * hi;
#pragma unroll
    for (int g = 0; g < 4; ++g) { v2u w0, w1;
        w0.x = pg8::cvt_pk_bf16(o0[4 * g] * inv, o0[4 * g + 1] * inv); w0.y = pg8::cvt_pk_bf16(o0[4 * g + 2] * inv, o0[4 * g + 3] * inv);
        w1.x = pg8::cvt_pk_bf16(o1[4 * g] * inv, o1[4 * g + 1] * inv); w1.y = pg8::cvt_pk_bf16(o1[4 * g + 2] * inv, o1[4 * g + 3] * inv);
        *(v2u*)(orow + 8 * g) = w0; *(v2u*)(orow + 32 + 8 * g) = w1; }
}
}
__device__ __forceinline__ void attn_phase(Frame& F, int l) {
    int tid = F.tid; OPAQUE_V(tid);
    LAS char* lds = (LAS char*)(F.lds + RING_OFF);
    const bf16* proj = (const bf16*)(F.ws + WS_PROJ); const bf16* memkv = (const bf16*)(F.ws + WS_MEMKV); const float* cc = (const float*)(F.ws + WS_CC); bf16* br = (bf16*)((unsigned char*)F.out);
    LAS int* qslot = (LAS int*)(F.lds + SM_OFF + 512);
    for (;;) {
        __syncthreads();
        if (tid == 0) *qslot = (int)__hip_atomic_fetch_add((unsigned*)(F.ctl + CW_Q + l * 64), 1u, RLX_AGENT);
        __syncthreads();
        const int it = *qslot;
        if (it >= 768) break;
        if (it < 512) { const int bh = it >> 2, pi = it & 3, b = bh >> 2, h = bh & 3; const size_t row0 = (size_t)b * SEQ;
            for (int k = 0; k < 2; ++k) { const int qb = k ? 7 - pi : pi, q0 = qb * 256;
                att::attn_unit<true>(lds, proj + (row0 + q0) * NPROJ + h * 64, NPROJ, proj + row0 * NPROJ + 256 + h * 64, proj + row0 * NPROJ + 512 + h * 64, NPROJ, q0 / 64 + 4, q0, cc + (size_t)bh * SEQ,
                                     br + (row0 + q0) * 1024 + h * 64, 1024, tid); } }
        else { for (int k = 0; k < 4; ++k) { const int u = (it - 512) * 4 + k; const int bh = u >> 3, qb = u & 7, b = bh >> 2, h = bh & 3, q0 = qb * 256; const size_t row0 = (size_t)b * SEQ;
                const bf16* kp = memkv + (size_t)b * NMEM * 1024 + l * 512 + h * 64;
                att::attn_unit<false>(lds, proj + (row0 + q0) * NPROJ + 2816 + h * 64, NPROJ, kp, kp + 256, 1024, NMEM / 64, q0, nullptr, br + (row0 + q0) * 1024 + 768 + h * 64, 1024, tid); } }
    }
}

namespace rec {
using att::f32x16; using att::bf16x8; using att::s16x4; using att::vtr;
constexpr int OPB = 40960;
constexpr int Q1C = 0, Q2C = 8192, K1C = 16384, K2V = 24576, VV = 32768, ST0 = 81920, OFO = 98304, OFB = 17408, TOTO = 133120, DECO = 137216;
constexpr int OFP = 68;
__device__ __forceinline__ v2u pk4(float a, float b, float c, float d) { v2u w; w.x = pg8::cvt_pk_bf16(a, b); w.y = pg8::cvt_pk_bf16(c, d); return w; }
template <bool HG>
__device__ __forceinline__ void recur_unit(LAS char* lds, const bf16* pj, bf16* ob, int h, int l, const float* par, const float* rope, int tid) {
    const int lane = tid & 63, wid = __builtin_amdgcn_readfirstlane(tid >> 6), r32 = lane & 31, hi = lane >> 5;
    const int t = tid >> 3, c8 = tid & 7;
    constexpr int NCH = SEQ / 64;
    constexpr int CQ = HG ? 2304 : 768, CK = HG ? 1792 : 1024, CV = HG ? 2048 : 1280, CG = HG ? 2560 : 1536;
    const float lg2 = HG ? 0.f : log2f(1.0f - exp2f(-5.0f - (float)h));
    float lbv[8];
#pragma unroll
    for (int e = 0; e < 8; ++e) { lbv[e] = 0.f; if (HG && l == 1) { const float a0 = par[PAR_LB + h * 64 + 8 * c8 + e], a1 = par[PAR_LB + 256 + h * 64 + 8 * c8 + e]; lbv[e] = 1.f / (1.f + expf(a0 - a1)); } }
    float ngv[8];
#pragma unroll
    for (int e = 0; e < 8; ++e) ngv[e] = HG ? par[PAR_NG + l * 64 + 8 * c8 + e] : 1.f;
    for (int i = tid; i < 4096; i += 512) ((LAS unsigned*)(lds + ST0))[i] = 0u;
    if (!HG && tid < 128) ((LAS float*)(lds + DECO))[tid] = exp2f(lg2 * 64.f);
    f32x16 st = {};
    const int tiO = wid & 1, tvO = (wid >> 1) & 1;
    f32x16 dm0 = {}, dm1 = {};
    if (!HG) {
#pragma unroll
        for (int r = 0; r < 16; ++r) { const int dj = 32 * tiO + r32 - ((r & 3) + 8 * (r >> 2) + 4 * hi); dm0[r] = __builtin_amdgcn_exp2f(lg2 * fabsf((float)dj)); dm1[r] = __builtin_amdgcn_exp2f(lg2 * fabsf((float)(dj - 32))); } }
    const float gq = __builtin_amdgcn_exp2f(lg2 * (float)(t + 1)), gk = __builtin_amdgcn_exp2f(lg2 * (float)(63 - t));
    v4u rq, rk, rv; f32x4 rco = {0.f, 0.f, 0.f, 0.f}, rsi = {0.f, 0.f, 0.f, 0.f};
    float runc[8], kfc[8]; v4u qc = {0u, 0u, 0u, 0u}, vc = {0u, 0u, 0u, 0u};
#pragma unroll
    for (int e = 0; e < 8; ++e) { runc[e] = 0.f; kfc[e] = 0.f; }
#define REC_LOAD(n) do { const bf16* rp_ = pj + (size_t)((n) * 64 + t) * NPROJ; \
        if (HG) { rq = *(const v4u*)(rp_ + CQ + 8 * c8); rk = *(const v4u*)(rp_ + CK + 8 * c8); } \
        else { const v2u a_ = *(const v2u*)(rp_ + CQ + 4 * c8), b_ = *(const v2u*)(rp_ + CQ + 32 + 4 * c8), c_ = *(const v2u*)(rp_ + CK + 4 * c8), d_ = *(const v2u*)(rp_ + CK + 32 + 4 * c8); \
               rq = (v4u){a_.x, a_.y, b_.x, b_.y}; rk = (v4u){c_.x, c_.y, d_.x, d_.y}; \
               rco = *(const f32x4*)(rope + ((n) * 64 + t) * 32 + 4 * c8); rsi = *(const f32x4*)(rope + SEQ * 32 + ((n) * 64 + t) * 32 + 4 * c8); } \
        rv = *(const v4u*)(rp_ + CV + 8 * c8); } while (0)
    REC_LOAD(0);
    __syncthreads();
    v4u gC = {0u, 0u, 0u, 0u};
    const int vrd = (4 * hi + ((lane & 15) >> 2)) * 64 + ((lane >> 4) & 1) * 32 + (lane & 3) * 8;
#pragma unroll 1
    for (int i = HG ? -2 : -1; i <= NCH; ++i) {
        if (!HG) {
            if (i + 1 < NCH) { const int ob_ = ((i + 1) & 1) * OPB;
                const float q1[4] = {bfl(rq.x), bfh(rq.x), bfl(rq.y), bfh(rq.y)}, q2[4] = {bfl(rq.z), bfh(rq.z), bfl(rq.w), bfh(rq.w)};
                const float k1[4] = {bfl(rk.x), bfh(rk.x), bfl(rk.y), bfh(rk.y)}, k2[4] = {bfl(rk.z), bfh(rk.z), bfl(rk.w), bfh(rk.w)};
                float qa[4], qb[4], ka[4], kb[4];
#pragma unroll
                for (int e = 0; e < 4; ++e) { qa[e] = q1[e] * rco[e] - q2[e] * rsi[e]; qb[e] = q1[e] * rsi[e] + q2[e] * rco[e]; ka[e] = (k1[e] * rco[e] - k2[e] * rsi[e]) * 0.125f; kb[e] = (k1[e] * rsi[e] + k2[e] * rco[e]) * 0.125f; }
                const int ca = ob_ + (c8 >> 1) * 1024 + t * 16 + 8 * (c8 & 1), cb = ca + 4096;
                *(LAS v2u*)(lds + Q1C + ca) = pk4(qa[0], qa[1], qa[2], qa[3]); *(LAS v2u*)(lds + Q1C + cb) = pk4(qb[0], qb[1], qb[2], qb[3]);
                *(LAS v2u*)(lds + Q2C + ca) = pk4(qa[0] * gq, qa[1] * gq, qa[2] * gq, qa[3] * gq); *(LAS v2u*)(lds + Q2C + cb) = pk4(qb[0] * gq, qb[1] * gq, qb[2] * gq, qb[3] * gq);
                *(LAS v2u*)(lds + K1C + ca) = pk4(ka[0], ka[1], ka[2], ka[3]); *(LAS v2u*)(lds + K1C + cb) = pk4(kb[0], kb[1], kb[2], kb[3]);
                const int va = ob_ + t * 64 + 8 * c8;
                *(LAS v2u*)(lds + K2V + va) = pk4(ka[0] * gk, ka[1] * gk, ka[2] * gk, ka[3] * gk); *(LAS v2u*)(lds + K2V + 4096 + va) = pk4(kb[0] * gk, kb[1] * gk, kb[2] * gk, kb[3] * gk);
                *(LAS v4u*)(lds + VV + ob_ + (c8 >> 2) * 4096 + t * 64 + (c8 & 3) * 16) = rv; }
        } else {
            if (i + 1 >= 0 && i + 1 < NCH) { const int ob_ = ((i + 1) & 1) * OPB;
                const LAS float* TOT = (const LAS float*)(lds + TOTO + ((i + 1) & 1) * 2048);
                float bb[8], bm[8], bl[8];
#pragma unroll
                for (int e = 0; e < 8; ++e) { bb[e] = runc[e]; bm[e] = 0.f; bl[e] = 0.f; }
#pragma unroll
                for (int w2 = 0; w2 < 8; ++w2) { const f32x4 t0 = *(const LAS f32x4*)(TOT + w2 * 64 + 8 * c8), t1 = *(const LAS f32x4*)(TOT + w2 * 64 + 8 * c8 + 4);
                    const float tt[8] = {t0[0], t0[1], t0[2], t0[3], t1[0], t1[1], t1[2], t1[3]};
#pragma unroll
                    for (int e = 0; e < 8; ++e) { if (w2 < wid) bb[e] += tt[e]; if (w2 < 4) bm[e] += tt[e]; bl[e] += tt[e]; } }
                const float qv[8] = {bfl(qc.x), bfh(qc.x), bfl(qc.y), bfh(qc.y), bfl(qc.z), bfh(qc.z), bfl(qc.w), bfh(qc.w)};
                float A1[8], A2[8], B1[8], B2[8];
#pragma unroll
                for (int e = 0; e < 8; ++e) { A1[e] = qv[e] * __builtin_amdgcn_exp2f(fminf(bb[e] - bm[e], 115.f)); A2[e] = qv[e] * __builtin_amdgcn_exp2f(bb[e]); B1[e] = kfc[e] * __builtin_amdgcn_exp2f(fminf(bm[e] - bb[e], 115.f)); B2[e] = kfc[e] * __builtin_amdgcn_exp2f(bl[e] - bb[e]); }
                const int ca = ob_ + c8 * 1024 + t * 16, va = ob_ + (c8 >> 2) * 4096 + t * 64 + (c8 & 3) * 16;
#define PK8(x) (v4u){pg8::cvt_pk_bf16(x[0], x[1]), pg8::cvt_pk_bf16(x[2], x[3]), pg8::cvt_pk_bf16(x[4], x[5]), pg8::cvt_pk_bf16(x[6], x[7])}
                *(LAS v4u*)(lds + Q1C + ca) = PK8(A1); *(LAS v4u*)(lds + Q2C + ca) = PK8(A2); *(LAS v4u*)(lds + K1C + ca) = PK8(B1); *(LAS v4u*)(lds + K2V + va) = PK8(B2);
#undef PK8
                *(LAS v4u*)(lds + VV + va) = vc;
                if (t == 0) {
#pragma unroll
                    for (int e = 0; e < 8; ++e) ((LAS float*)(lds + DECO + ((i + 1) & 1) * 256))[8 * c8 + e] = __builtin_amdgcn_exp2f(bl[e]); }
            }
            if (i + 2 < NCH) {
                const float zf[8] = {bfl(rk.x), bfh(rk.x), bfl(rk.y), bfh(rk.y), bfl(rk.z), bfh(rk.z), bfl(rk.w), bfh(rk.w)};
#pragma unroll
                for (int e = 0; e < 8; ++e) { const float ez = __builtin_amdgcn_exp2f(-1.4426950408889634f * zf[e]); const float r1 = __builtin_amdgcn_rcpf(1.f + ez); const float f = lbv[e] + (1.f - lbv[e]) * r1; runc[e] = __builtin_amdgcn_logf(f); kfc[e] = (1.f - lbv[e]) * (ez * r1); }
#pragma unroll
                for (int st_ = 8; st_ < 64; st_ <<= 1) {
#pragma unroll
                    for (int e = 0; e < 8; ++e) { const float v_ = __shfl_up(runc[e], st_); if (lane >= st_) runc[e] += v_; } }
                LAS float* TOTw = (LAS float*)(lds + TOTO + ((i + 2) & 1) * 2048);
                if ((lane >> 3) == 7) { *(LAS f32x4*)(TOTw + wid * 64 + 8 * c8) = (f32x4){runc[0], runc[1], runc[2], runc[3]}; *(LAS f32x4*)(TOTw + wid * 64 + 8 * c8 + 4) = (f32x4){runc[4], runc[5], runc[6], runc[7]}; }
                qc = rq; vc = rv; }
        }
        if (i >= 1) { const LAS float* OFr = (const LAS float*)(lds + OFO + ((i - 1) & 1) * OFB) + t * OFP + 8 * c8;
          const f32x4 x0 = *(const LAS f32x4*)OFr, x1 = *(const LAS f32x4*)(OFr + 4);
          float ov[8] = {x0[0], x0[1], x0[2], x0[3], x1[0], x1[1], x1[2], x1[3]};
          float s1 = 0.f;
          if (!HG) {
#pragma unroll
              for (int e = 0; e < 8; ++e) s1 += ov[e];
              s1 = sum8(s1);
              const float mean = s1 * (1.f / 64.f);
#pragma unroll
              for (int e = 0; e < 8; ++e) ov[e] -= mean; }
          float ss = 0.f;
#pragma unroll
          for (int e = 0; e < 8; ++e) ss += ov[e] * ov[e];
          ss = sum8(ss);
          const float rr = rsqrtf(ss * (1.f / 64.f) + GN_EPS);
          const float gv[8] = {bfl(gC.x), bfh(gC.x), bfl(gC.y), bfh(gC.y), bfl(gC.z), bfh(gC.z), bfl(gC.w), bfh(gC.w)};
          float y[8];
#pragma unroll
          for (int e = 0; e < 8; ++e) y[e] = ov[e] * rr * ngv[e] * gv[e] * __builtin_amdgcn_rcpf(1.f + __builtin_amdgcn_exp2f(-1.4426950408889634f * gv[e]));
          *(v4u*)(ob + (size_t)((i - 1) * 64 + t) * 1024 + 8 * c8) = (v4u){pg8::cvt_pk_bf16(y[0], y[1]), pg8::cvt_pk_bf16(y[2], y[3]), pg8::cvt_pk_bf16(y[4], y[5]), pg8::cvt_pk_bf16(y[6], y[7])}; }
        { const int nl = i + (HG ? 3 : 2); REC_LOAD(nl < NCH ? nl : NCH - 1); gC = *(const v4u*)(pj + (size_t)((i >= 0 ? (i < NCH ? i : NCH - 1) : 0) * 64 + t) * NPROJ + CG + 8 * c8); }
        if (i >= 0 && i < NCH) {
            const int opb = (i & 1) * OPB, stc = ST0 + (i & 1) * 8192, stn = ST0 + ((i + 1) & 1) * 8192;
            if (wid < 4) {
                const int tv = tvO, ti = tiO;
                bf16x8 pf[4];
                f32x16 pt[2] = {{}, {}};
                const bool two = !HG || ti >= 1;
#pragma unroll
                for (int ks = 0; ks < 4; ++ks) { const bf16x8 b = *(const LAS bf16x8*)(lds + opb + Q1C + (2 * ks + hi) * 1024 + (32 * ti + r32) * 16);
                    const bf16x8 a0 = *(const LAS bf16x8*)(lds + opb + K1C + (2 * ks + hi) * 1024 + r32 * 16);
                    pt[0] = __builtin_amdgcn_mfma_f32_32x32x16_bf16(a0, b, pt[0], 0, 0, 0);
                    if (two) { const bf16x8 a1 = *(const LAS bf16x8*)(lds + opb + K1C + (2 * ks + hi) * 1024 + (32 + r32) * 16); pt[1] = __builtin_amdgcn_mfma_f32_32x32x16_bf16(a1, b, pt[1], 0, 0, 0); } }
#pragma unroll
                for (int tj = 0; tj < 2; ++tj) {
                    f32x16 p = pt[tj];
                    if (!HG || tj <= ti) {
                        const int iabs = 32 * ti + r32;
#pragma unroll
                        for (int r = 0; r < 16; ++r) { const int jabs = 32 * tj + (r & 3) + 8 * (r >> 2) + 4 * hi;
                            if (HG) p[r] = (jabs <= iabs) ? p[r] : 0.f; else p[r] *= (tj == 0 ? dm0[r] : dm1[r]); }
                    }
                    pg8::u32x4 w0, w1;
                    w0.x = pg8::cvt_pk_bf16(p[0], p[1]); w0.y = pg8::cvt_pk_bf16(p[2], p[3]); w0.z = pg8::cvt_pk_bf16(p[4], p[5]); w0.w = pg8::cvt_pk_bf16(p[6], p[7]);
                    w1.x = pg8::cvt_pk_bf16(p[8], p[9]); w1.y = pg8::cvt_pk_bf16(p[10], p[11]); w1.z = pg8::cvt_pk_bf16(p[12], p[13]); w1.w = pg8::cvt_pk_bf16(p[14], p[15]);
                    pf[2 * tj] = __builtin_bit_cast(bf16x8, w0); pf[2 * tj + 1] = __builtin_bit_cast(bf16x8, w1);
                }
                f32x16 o = {}, o2 = {};
#pragma unroll
                for (int ks = 0; ks < 4; ++ks) { const bf16x8 a = *(const LAS bf16x8*)(lds + stc + (2 * ks + hi) * 1024 + (32 * tv + r32) * 16), b = *(const LAS bf16x8*)(lds + opb + Q2C + (2 * ks + hi) * 1024 + (32 * ti + r32) * 16);
                    o = __builtin_amdgcn_mfma_f32_32x32x16_bf16(a, b, o, 0, 0, 0); }
#pragma unroll
                for (int s2 = 0; s2 < 4; ++s2) { const s16x4 lo = vtr(lds + opb + VV + tv * 4096 + vrd + s2 * 1024), hh = vtr(lds + opb + VV + tv * 4096 + vrd + s2 * 1024 + 512);
                    const bf16x8 va = (bf16x8){lo[0], lo[1], lo[2], lo[3], hh[0], hh[1], hh[2], hh[3]};
                    o2 = __builtin_amdgcn_mfma_f32_32x32x16_bf16(va, pf[s2], o2, 0, 0, 0); }
#pragma unroll
                for (int r = 0; r < 16; ++r) o[r] += o2[r];
                LAS float* OFp = (LAS float*)(lds + OFO + (i & 1) * OFB) + (32 * ti + r32) * OFP + 32 * tv + 4 * hi;
#pragma unroll
                for (int g = 0; g < 4; ++g) *(LAS f32x4*)(OFp + 8 * g) = (f32x4){o[4 * g], o[4 * g + 1], o[4 * g + 2], o[4 * g + 3]};
            } else {
                const int td = (wid - 4) & 1, tv = (wid - 4) >> 1;
                f32x16 pr = {};
#pragma unroll
                for (int s2 = 0; s2 < 4; ++s2) { const s16x4 lo = vtr(lds + opb + VV + tv * 4096 + vrd + s2 * 1024), hh = vtr(lds + opb + VV + tv * 4096 + vrd + s2 * 1024 + 512);
                    const s16x4 ko = vtr(lds + opb + K2V + td * 4096 + vrd + s2 * 1024), kh = vtr(lds + opb + K2V + td * 4096 + vrd + s2 * 1024 + 512);
                    const bf16x8 va = (bf16x8){lo[0], lo[1], lo[2], lo[3], hh[0], hh[1], hh[2], hh[3]}, kb2 = (bf16x8){ko[0], ko[1], ko[2], ko[3], kh[0], kh[1], kh[2], kh[3]};
                    pr = __builtin_amdgcn_mfma_f32_32x32x16_bf16(va, kb2, pr, 0, 0, 0); }
                const float dec = ((LAS float*)(lds + DECO + (i & 1) * 256))[32 * td + r32];
                const int d = 32 * td + r32;
                LAS bf16* stw = (LAS bf16*)(lds + stn + (d >> 3) * 1024 + (d & 7) * 2);
#pragma unroll
                for (int r = 0; r < 16; ++r) { st[r] = st[r] * dec + pr[r]; const int v = 32 * tv + (r & 3) + 8 * (r >> 2) + 4 * hi; stw[v * 8] = (bf16)f2bf(st[r]); }
            }
        }
        asm volatile("s_waitcnt lgkmcnt(0)" ::: "memory"); __builtin_amdgcn_s_barrier(); asm volatile("" ::: "memory");
    }
    __syncthreads();
#undef REC_LOAD
}
}
__device__ __forceinline__ void recur_phase(Frame& F, int l) {
    int tid = F.tid; OPAQUE_V(tid);
    LAS char* lds = (LAS char*)(F.lds + RING_OFF);
    const bf16* proj = (const bf16*)(F.ws + WS_PROJ); bf16* br = (bf16*)((unsigned char*)F.out); const float* par = (const float*)(F.ws + WS_PAR); const float* rope = (const float*)(F.ws + WS_ROPE);
    for (int u = F.vcu; u < 2 * BATCH * NH; u += F.G) { const int bh = u & 127, b = bh >> 2, h = bh & 3; const size_t row0 = (size_t)b * SEQ;
        if (u < 128) rec::recur_unit<false>(lds, proj + row0 * NPROJ + h * 64, br + row0 * 1024 + 256 + h * 64, h, l, par, rope, tid);
        else rec::recur_unit<true>(lds, proj + row0 * NPROJ + h * 64, br + row0 * 1024 + 512 + h * 64, h, l, par, rope, tid); }
}

__device__ __forceinline__ void naive_attn(Frame& F, int l) {
    int tid_ = F.tid; OPAQUE_V(tid_); const int lane = tid_ & 63, wave_ = __builtin_amdgcn_readfirstlane(tid_ >> 6);
    const int gw = F.vcu * NWAVES + wave_, NGW = F.G * NWAVES;
    const bf16* proj = (const bf16*)(F.ws + WS_PROJ); const bf16* memkv = (const bf16*)(F.ws + WS_MEMKV);
    const float* cc = (const float*)(F.ws + WS_CC); bf16* br = (bf16*)((unsigned char*)F.out);
    constexpr int BHS = BATCH * NH * SEQ;
    for (int it = gw; it < 2 * BHS; it += NGW) {
        const bool is_mem = it >= BHS; const int r = is_mem ? it - BHS : it; const int bh = r / SEQ, s = r % SEQ, b = bh >> 2, h = bh & 3;
        const size_t tok = (size_t)b * SEQ + s;
        const bf16* qp = proj + tok * NPROJ + (is_mem ? 2816 : 0) + h * 64;
        float q[64];
#pragma unroll
        for (int c = 0; c < 8; ++c) { const v4u w = *(const v4u*)(qp + 8 * c); q[8 * c + 0] = bfl(w.x); q[8 * c + 1] = bfh(w.x); q[8 * c + 2] = bfl(w.y); q[8 * c + 3] = bfh(w.y); q[8 * c + 4] = bfl(w.z); q[8 * c + 5] = bfh(w.z); q[8 * c + 6] = bfl(w.w); q[8 * c + 7] = bfh(w.w); }
        const int nkeys = is_mem ? NMEM : s + 1;
        const bf16* kbase = is_mem ? memkv + (size_t)b * NMEM * 1024 + l * 512 + h * 64 : proj + (size_t)b * SEQ * NPROJ + 256 + h * 64;
        const size_t kpitch = is_mem ? 1024 : NPROJ; const int voff = 256;
        const float cq = is_mem ? 0.f : cc[(size_t)bh * SEQ + s];
        float mrun = -1e30f, lrun = 0.f; float o[64];
#pragma unroll
        for (int d = 0; d < 64; ++d) o[d] = 0.f;
        for (int k0 = 0; k0 < nkeys; k0 += 64) { const int kk = k0 + lane;
            if (kk < nkeys) { const bf16* kp = kbase + (size_t)kk * kpitch; float dot = 0.f;
#pragma unroll
                for (int c = 0; c < 8; ++c) { const v4u w = *(const v4u*)(kp + 8 * c);
                    dot += q[8 * c + 0] * bfl(w.x) + q[8 * c + 1] * bfh(w.x) + q[8 * c + 2] * bfl(w.y) + q[8 * c + 3] * bfh(w.y) + q[8 * c + 4] * bfl(w.z) + q[8 * c + 5] * bfh(w.z) + q[8 * c + 6] * bfl(w.w) + q[8 * c + 7] * bfh(w.w); }
                float sv = dot * 0.125f; if (!is_mem) sv += cq - cc[(size_t)bh * SEQ + kk];
                const float mn = fmaxf(mrun, sv), corr = expf(mrun - mn), p = expf(sv - mn); mrun = mn; lrun = lrun * corr + p;
                const bf16* vp = kp + voff;
#pragma unroll
                for (int c = 0; c < 8; ++c) { const v4u w = *(const v4u*)(vp + 8 * c);
                    o[8 * c + 0] = o[8 * c + 0] * corr + p * bfl(w.x); o[8 * c + 1] = o[8 * c + 1] * corr + p * bfh(w.x); o[8 * c + 2] = o[8 * c + 2] * corr + p * bfl(w.y); o[8 * c + 3] = o[8 * c + 3] * corr + p * bfh(w.y);
                    o[8 * c + 4] = o[8 * c + 4] * corr + p * bfl(w.z); o[8 * c + 5] = o[8 * c + 5] * corr + p * bfh(w.z); o[8 * c + 6] = o[8 * c + 6] * corr + p * bfl(w.w); o[8 * c + 7] = o[8 * c + 7] * corr + p * bfh(w.w); } } }
        const float M = wave_max(mrun), sc = expf(mrun - M), L = wave_sum(lrun * sc);
        float res = 0.f;
#pragma unroll
        for (int d = 0; d < 64; ++d) { const float v = wave_sum(o[d] * sc); if (lane == d) res = v; }
        br[tok * 1024 + (is_mem ? 768 : 0) + h * 64 + lane] = (bf16)f2bf(res / L);
    }
}
__device__ __forceinline__ void naive_recur(Frame& F, int l) {
    int tid = F.tid; OPAQUE_V(tid); const int lane = tid & 63, wave = __builtin_amdgcn_readfirstlane(tid >> 6);
    const bf16* proj = (const bf16*)(F.ws + WS_PROJ); bf16* br = (bf16*)((unsigned char*)F.out);
    LAS float* L0 = (LAS float*)(F.lds + RING_OFF);
    if (F.bx < 128) {
        const int bh = F.bx, b = bh >> 2, h = bh & 3;
        LAS float* qr = L0; LAS float* kr = L0 + 4096; LAS float* vv = L0 + 8192; LAS float* sc = L0 + 12288; LAS float* st = L0 + 16384;
        const float* rc = (const float*)(F.ws + WS_ROPE); const float* rs = rc + SEQ * 32;
        const float lg = log1pf(-exp2f(-5.0f - (float)h));
        for (int i = tid; i < 4096; i += 512) st[i] = 0.f;
#pragma unroll 1
        for (int n = 0; n < SEQ / 64; ++n) {
            const size_t row0 = (size_t)b * SEQ + n * 64;
            for (int idx = tid; idx < 2048; idx += 512) { const int t = idx >> 5, c = idx & 31; const bf16* p = proj + (row0 + t) * NPROJ + h * 64;
                const float co = rc[(n * 64 + t) * 32 + c], si = rs[(n * 64 + t) * 32 + c];
                const float q1 = bf1(p[768 + c]), q2 = bf1(p[768 + c + 32]), k1 = bf1(p[1024 + c]), k2 = bf1(p[1024 + c + 32]);
                qr[t * 64 + c] = q1 * co - q2 * si; qr[t * 64 + c + 32] = q1 * si + q2 * co;
                kr[t * 64 + c] = (k1 * co - k2 * si) * 0.125f; kr[t * 64 + c + 32] = (k1 * si + k2 * co) * 0.125f;
                vv[t * 64 + c] = bf1(p[1280 + c]); vv[t * 64 + c + 32] = bf1(p[1280 + c + 32]); }
            __syncthreads();
#pragma unroll 1
            for (int j = 0; j < 8; ++j) { const int idx = tid + 512 * j, i = idx >> 6, jj = idx & 63; float s = 0.f;
#pragma unroll 4
                for (int d = 0; d < 64; ++d) s += qr[i * 64 + d] * kr[jj * 64 + d];
                sc[idx] = s * expf(lg * fabsf((float)(i - jj))); }
            __syncthreads();
            float oreg[8];
#pragma unroll
            for (int j = 0; j < 8; ++j) { const int idx = tid + 512 * j, i = idx >> 6, v = idx & 63; float s = 0.f, s2 = 0.f;
#pragma unroll 4
                for (int jj = 0; jj < 64; ++jj) s += sc[i * 64 + jj] * vv[jj * 64 + v];
#pragma unroll 4
                for (int d = 0; d < 64; ++d) s2 += qr[i * 64 + d] * st[d * 64 + v];
                oreg[j] = s + expf(lg * (float)(i + 1)) * s2; }
            __syncthreads();
#pragma unroll 1
            for (int j = 0; j < 8; ++j) { const int idx = tid + 512 * j, d = idx >> 6, v = idx & 63; float s = 0.f;
#pragma unroll 2
                for (int jj = 0; jj < 64; ++jj) s += kr[jj * 64 + d] * expf(lg * (float)(63 - jj)) * vv[jj * 64 + v];
                st[idx] = expf(lg * 64.0f) * st[idx] + s; }
            for (int j = 0; j < 8; ++j) { const int i = wave + 8 * j;
                const float mean = wave_sum(oreg[j]) * (1.f / 64.f), dv = oreg[j] - mean, var = wave_sum(dv * dv) * (1.f / 64.f);
                const float g = bf1(proj[(row0 + i) * NPROJ + 1536 + h * 64 + lane]);
                br[(row0 + i) * 1024 + 256 + h * 64 + lane] = (bf16)f2bf(dv * rsqrtf(var + GN_EPS) * g / (1.f + expf(-g))); }
            __syncthreads();
        }
    } else {
        const int bh = F.bx - 128, b = bh >> 2, h = bh & 3;
        if (bh >= 128) return;
        LAS float* qf = L0; LAS float* ff = L0 + 4096; LAS float* kf = L0 + 8192; LAS float* iv = L0 + 12288; LAS float* ob = L0 + 16384;
        const int v = tid >> 3, k8 = tid & 7;
        float Sreg[8];
#pragma unroll
        for (int i = 0; i < 8; ++i) Sreg[i] = 0.f;
        const float* lbp = (const float*)(F.ws + WS_PAR) + PAR_LB;
#pragma unroll 1
        for (int n = 0; n < SEQ / 64; ++n) {
            const size_t row0 = (size_t)b * SEQ + n * 64;
            for (int j = 0; j < 8; ++j) { const int idx = tid + 512 * j, t = idx >> 6, c = idx & 63; const bf16* p = proj + (row0 + t) * NPROJ + h * 64 + c;
                float lb = 0.f; if (l == 1) { const float a0 = lbp[h * 64 + c], a1 = lbp[256 + h * 64 + c]; lb = 1.f / (1.f + expf(a0 - a1)); }
                const float zf = bf1(p[1792]); const float kfv = (1.f - lb) / (1.f + expf(zf));
                qf[idx] = bf1(p[2304]); ff[idx] = 1.f - kfv; kf[idx] = kfv; iv[idx] = bf1(p[2048]); }
            __syncthreads();
#pragma unroll 1
            for (int t = 0; t < 64; ++t) { const float ivt = iv[t * 64 + v]; float p = 0.f;
#pragma unroll
                for (int i = 0; i < 8; ++i) { const int k = k8 * 8 + i; Sreg[i] = ff[t * 64 + k] * Sreg[i] + kf[t * 64 + k] * ivt; p += Sreg[i] * qf[t * 64 + k]; }
                p += __shfl_xor(p, 1); p += __shfl_xor(p, 2); p += __shfl_xor(p, 4);
                if (k8 == 0) ob[t * 64 + v] = p; }
            __syncthreads();
            { const int t = tid >> 3, seg = tid & 7; float ov[8]; float ss = 0.f;
#pragma unroll
              for (int i = 0; i < 8; ++i) { ov[i] = ob[t * 64 + seg * 8 + i]; ss += ov[i] * ov[i]; }
              ss = sum8(ss);
              const float rr = rsqrtf(ss * (1.f / 64.f) + GN_EPS);
              const bf16* gp = proj + (row0 + t) * NPROJ + 2560 + h * 64 + seg * 8; const float* ng = (const float*)(F.ws + WS_PAR) + PAR_NG + l * 64 + seg * 8;
              unsigned w[4];
#pragma unroll
              for (int i = 0; i < 4; ++i) { const float g0 = bf1(gp[2 * i]), g1 = bf1(gp[2 * i + 1]);
                  w[i] = pk2(ov[2 * i] * rr * ng[2 * i] * g0 / (1.f + expf(-g0)), ov[2 * i + 1] * rr * ng[2 * i + 1] * g1 / (1.f + expf(-g1))); }
              *(v4u*)(br + (row0 + t) * 1024 + 512 + h * 64 + seg * 8) = (v4u){w[0], w[1], w[2], w[3]}; }
            __syncthreads();
        }
    }
}

__device__ __forceinline__ void ln1_phase(Frame& F, int l, bool commit = true) {
    LAS float* WrT = (LAS float*)(F.lds + RING_OFF);
    LAS int* se1 = (LAS int*)(F.lds + RING_OFF + 65536); LAS int* se2 = se1 + 256; LAS float* sw = (LAS float*)(se2 + 256);
    LAS int* hist = (LAS int*)(F.lds + SM_OFF + 256); LAS int* base = hist + 16;
    int tid = F.tid; OPAQUE_V(tid); const int lane = tid & 63, wave = __builtin_amdgcn_readfirstlane(tid >> 6);
    for (int idx = tid; idx < 16384; idx += 512) { const int d = idx >> 4, e = idx & 15; WrT[e * 1024 + d] = ((const float*)(F.ws + WS_PAR))[PAR_WR + idx]; }
    if (tid < 16) hist[tid] = 0;
    __syncthreads();
    const bf16* xb = (const bf16*)(F.ws + WS_XB); const bf16* yb = (const bf16*)(F.ws + WS_Y); bf16* x1b = (bf16*)(F.ws + WS_X1B);
    const float* lng = (const float*)(F.ws + WS_PAR) + PAR_LNG + (l * 2 + 0) * DM; const float* lnb = (const float*)(F.ws + WS_PAR) + PAR_LNB + (l * 2 + 0) * DM;
    LAS float* gbl = (LAS float*)(F.lds + RING_OFF + 90112);
    for (int idx = tid; idx < 1024; idx += 512) { gbl[idx] = lng[idx]; gbl[1024 + idx] = lnb[idx]; }
    __syncthreads();
    for (int rb = F.bx; rb < T / 256; rb += F.G) {
        LAS float* lgt = (LAS float*)(F.lds + RING_OFF + 65536 + 4096);
        const float* brp = (const float*)(F.ws + WS_PAR) + PAR_BR;
        const int my_e = ((lane >> 4) & 1) * 8 + ((lane >> 3) & 1) * 4 + ((lane >> 2) & 1) * 2 + ((lane >> 1) & 1);
        const float my_b = brp[my_e];
        const int hf = lane >> 5, l5 = lane & 31;
        int rwx[8], rwy[8]; float rsx;
#define LN1_LOAD(ii) do { const size_t r_ = (size_t)rb * 256 + wave * 32 + 2 * (ii) + hf; const GAS int* px_ = (const GAS int*)((const signed char*)(F.ws + WS_X8) + r_ * DM) + l5; const GAS int* py_ = (const GAS int*)((const unsigned char*)(F.ws + WS_Y) + r_ * DM) + l5; \
            rsx = ((const float*)(F.ws + WS_SX))[r_]; _Pragma("unroll") for (int j = 0; j < 8; ++j) { rwx[j] = px_[32 * j]; rwy[j] = py_[32 * j]; } } while (0)
        LN1_LOAD(0);
#pragma unroll 1
        for (int i = 0; i < 16; ++i) {
            const int rl = wave * 32 + 2 * i + hf; const size_t row = (size_t)rb * 256 + rl;
            f32x4 xv[8];
            { f32x4 yv[8];
#pragma unroll
              for (int j = 0; j < 8; ++j) { const int w_ = rwx[j]; xv[j] = (f32x4){(float)((w_ << 24) >> 24), (float)((w_ << 16) >> 24), (float)((w_ << 8) >> 24), (float)(w_ >> 24)} * rsx; const pg8::f32x2 ya_ = __builtin_amdgcn_cvt_pk_f32_fp8(rwy[j], false), yb_ = __builtin_amdgcn_cvt_pk_f32_fp8(rwy[j], true); yv[j] = (f32x4){ya_.x, ya_.y, yb_.x, yb_.y} * 0.03125f; }
              LN1_LOAD(i < 15 ? i + 1 : 15); asm volatile("" ::: "memory");
              float s = 0.f;
#pragma unroll
              for (int j = 0; j < 8; ++j) { xv[j] = xv[j] * ALPHA + yv[j]; s += (xv[j].x + xv[j].y) + (xv[j].z + xv[j].w); }
              s += dpp_f<DPP_X1>(s); s += dpp_f<DPP_X2>(s); s += dpp_f<DPP_HMIR>(s); s += dpp_f<DPP_MIR>(s);
              const float mean = (hf ? rl_f(s, 47) + rl_f(s, 63) : rl_f(s, 15) + rl_f(s, 31)) * (1.f / DM); float s2 = 0.f;
#pragma unroll
              for (int j = 0; j < 8; ++j) { xv[j] = xv[j] - mean; s2 += (xv[j].x * xv[j].x + xv[j].y * xv[j].y) + (xv[j].z * xv[j].z + xv[j].w * xv[j].w); }
              s2 += dpp_f<DPP_X1>(s2); s2 += dpp_f<DPP_X2>(s2); s2 += dpp_f<DPP_HMIR>(s2); s2 += dpp_f<DPP_MIR>(s2);
              const float rstd = 1.f / sqrtf((hf ? rl_f(s2, 47) + rl_f(s2, 63) : rl_f(s2, 15) + rl_f(s2, 31)) * (1.f / DM) + LN_EPS);
              float am = 0.f;
#pragma unroll
              for (int j = 0; j < 8; ++j) { xv[j] = xv[j] * rstd * *(const LAS f32x4*)(gbl + 128 * j + 4 * l5) + *(const LAS f32x4*)(gbl + 1024 + 128 * j + 4 * l5);
                  am = fmaxf(am, fmaxf(fmaxf(fabsf(xv[j].x), fabsf(xv[j].y)), fmaxf(fabsf(xv[j].z), fabsf(xv[j].w)))); }
              GAS unsigned long long* o8 = (GAS unsigned long long*)(x1b + row * DM) + l5;
#pragma unroll
              for (int j = 0; j < 8; ++j) o8[32 * j] = (unsigned long long)pk2(xv[j].x, xv[j].y) | ((unsigned long long)pk2(xv[j].z, xv[j].w) << 32);
              am = fmaxf(am, dpp_f<DPP_X1>(am)); am = fmaxf(am, dpp_f<DPP_X2>(am)); am = fmaxf(am, dpp_f<DPP_HMIR>(am)); am = fmaxf(am, dpp_f<DPP_MIR>(am));
              am = fmaxf(hf ? fmaxf(rl_f(am, 47), rl_f(am, 63)) : fmaxf(rl_f(am, 15), rl_f(am, 31)), 1e-30f);
              const float inv = 127.0f / am;
              GAS unsigned* o4 = (GAS unsigned*)((signed char*)(F.ws + WS_X18) + row * DM) + l5;
#pragma unroll
              for (int j = 0; j < 8; ++j) o4[32 * j] = q8x4(xv[j].x, xv[j].y, xv[j].z, xv[j].w, inv);
              if (l5 == 0) ((float*)(F.ws + WS_S1))[row] = am * (1.0f / 127.0f); }
            float p[16];
#pragma unroll
            for (int e = 0; e < 16; ++e) { pg8::f32x2 a2 = {0.f, 0.f};
#pragma unroll
                for (int j = 0; j < 8; ++j) { const f32x4 w = *(const LAS f32x4*)(WrT + e * 1024 + 128 * j + 4 * l5);
                    a2 = (pg8::f32x2){xv[j].x, xv[j].y} * (pg8::f32x2){w.x, w.y} + a2; a2 = (pg8::f32x2){xv[j].z, xv[j].w} * (pg8::f32x2){w.z, w.w} + a2; }
                p[e] = a2.x + a2.y; asm volatile("" ::: "memory"); }
            { float k8[8], k4[4], k2[2], k1;
#pragma unroll
              for (int e = 0; e < 8; ++e) { float a_ = p[e], b_ = p[e + 8]; asm volatile("s_nop 1\n\tv_permlane16_swap_b32 %0, %1" : "+v"(a_), "+v"(b_)); k8[e] = a_ + b_; }
              { const bool hb = (lane & 8) != 0;
#pragma unroll
                for (int e = 0; e < 4; ++e) { const float keep = hb ? k8[e + 4] : k8[e], send = hb ? k8[e] : k8[e + 4]; k4[e] = keep + dpp_f<0x128>(send); } }
              { const bool hb = (lane & 4) != 0;
#pragma unroll
                for (int e = 0; e < 2; ++e) { const float keep = hb ? k4[e + 2] : k4[e], send = hb ? k4[e] : k4[e + 2]; k2[e] = keep + dpp_f<0x1B>(dpp_f<DPP_HMIR>(send)); } }
              { const bool hb = (lane & 2) != 0; const float keep = hb ? k2[1] : k2[0], send = hb ? k2[0] : k2[1]; k1 = keep + dpp_f<DPP_X2>(send); }
              k1 += dpp_f<DPP_X1>(k1);
              if ((lane & 1) == 0) lgt[rl * 16 + my_e] = k1 + my_b; }
        }
#undef LN1_LOAD
        LDS_WAIT();
        if (lane < 32) { const int rl = wave * 32 + lane; float lg[16];
#pragma unroll
            for (int e4 = 0; e4 < 4; ++e4) { const f32x4 t4 = *(const LAS f32x4*)(lgt + rl * 16 + 4 * e4); lg[4 * e4] = t4.x; lg[4 * e4 + 1] = t4.y; lg[4 * e4 + 2] = t4.z; lg[4 * e4 + 3] = t4.w; }
            float gm[4];
#pragma unroll
            for (int g = 0; g < 4; ++g) gm[g] = fmaxf(fmaxf(lg[4 * g], lg[4 * g + 1]), fmaxf(lg[4 * g + 2], lg[4 * g + 3]));
            int gs = 0; float gb = gm[0];
#pragma unroll
            for (int g = 1; g < 4; ++g) if (gm[g] > gb) { gb = gm[g]; gs = g; }
            float v0 = gs == 0 ? lg[0] : gs == 1 ? lg[4] : gs == 2 ? lg[8] : lg[12], v1 = gs == 0 ? lg[1] : gs == 1 ? lg[5] : gs == 2 ? lg[9] : lg[13];
            float v2 = gs == 0 ? lg[2] : gs == 1 ? lg[6] : gs == 2 ? lg[10] : lg[14], v3 = gs == 0 ? lg[3] : gs == 1 ? lg[7] : gs == 2 ? lg[11] : lg[15];
            int i1 = 0; float m1 = v0; if (v1 > m1) { m1 = v1; i1 = 1; } if (v2 > m1) { m1 = v2; i1 = 2; } if (v3 > m1) { m1 = v3; i1 = 3; }
            int i2 = -1; float m2 = -3.0e38f;
            if (i1 != 0 && v0 > m2) { m2 = v0; i2 = 0; } if (i1 != 1 && v1 > m2) { m2 = v1; i2 = 1; } if (i1 != 2 && v2 > m2) { m2 = v2; i2 = 2; } if (i1 != 3 && v3 > m2) { m2 = v3; i2 = 3; }
            const int e1 = gs * 4 + i1, e2 = gs * 4 + i2;
            const int r1 = __hip_atomic_fetch_add(hist + e1, 1, __ATOMIC_RELAXED, __HIP_MEMORY_SCOPE_WORKGROUP), r2 = __hip_atomic_fetch_add(hist + e2, 1, __ATOMIC_RELAXED, __HIP_MEMORY_SCOPE_WORKGROUP);
            se1[rl] = e1 | (r1 << 8); se2[rl] = e2 | (r2 << 8); sw[rl] = 1.f / (1.f + expf(m2 - m1)); }
        __syncthreads();
        if (tid < 16 && commit) { base[tid] = (int)__hip_atomic_fetch_add((unsigned*)(F.ctl + CW_CNT + (l * 16 + tid) * 64), (unsigned)hist[tid], RLX_AGENT); }
        __syncthreads();
        if (commit) { const int rl = tid >> 1, k = tid & 1; const int v = k ? se2[rl] : se1[rl]; const int e = v & 255, r = v >> 8; const int slot = (rb * 256 + rl) * 2 + k;
          ((int*)(F.ws + WS_LIST))[(size_t)e * LISTCAP + base[e] + r] = slot; ((float*)(F.ws + WS_WT))[slot] = k ? 1.f - sw[rl] : sw[rl]; }
        __syncthreads();
        if (tid < 16) hist[tid] = 0;
        __syncthreads();
    }
}

__device__ __forceinline__ void ln2_phase(Frame& F, int l) {
    LAS float* wff = (LAS float*)(F.lds + RING_OFF + 81920);
    int tid_ = F.tid; OPAQUE_V(tid_); const int lane = tid_ & 63, wave_ = __builtin_amdgcn_readfirstlane(tid_ >> 6); const bool last = (l == NLAYER - 1);
    if (!last) { stage_wff(F, l + 1, wff); }
    __syncthreads();
    const int gw = F.vcu * NWAVES + wave_, NGW = F.G * NWAVES;
    const bf16* x1b = (const bf16*)(F.ws + WS_X1B); const unsigned char* y2 = (const unsigned char*)(F.ws + WS_Y2); bf16* xb = (bf16*)(F.ws + WS_XB);
    const float* lng = (const float*)(F.ws + WS_PAR) + PAR_LNG + (l * 2 + 1) * DM; const float* lnb = (const float*)(F.ws + WS_PAR) + PAR_LNB + (l * 2 + 1) * DM;
    f32x4 gg[4], bb[4];
#pragma unroll
    for (int j = 0; j < 4; ++j) { gg[j] = *(const f32x4*)(lng + 256 * j + 4 * lane); bb[j] = *(const f32x4*)(lnb + 256 * j + 4 * lane); }
    for (int m = gw; m < T; m += NGW) {
        f32x4 xv[4], ya[4], yb[4]; load_row_bf16(x1b + (size_t)m * DM, lane, xv); load_row_fp8(y2 + (size_t)(2 * m) * DM, lane, ya); load_row_fp8(y2 + (size_t)(2 * m + 1) * DM, lane, yb);
        float s = 0.f;
#pragma unroll
        for (int j = 0; j < 4; ++j) { xv[j] = xv[j] * ALPHA + (ya[j] + yb[j]); s += (xv[j].x + xv[j].y) + (xv[j].z + xv[j].w); }
        const float mean = wave_sum(s) * (1.f / DM); float s2 = 0.f;
#pragma unroll
        for (int j = 0; j < 4; ++j) { xv[j] = xv[j] - mean; s2 += (xv[j].x * xv[j].x + xv[j].y * xv[j].y) + (xv[j].z * xv[j].z + xv[j].w * xv[j].w); }
        const float rstd = 1.f / sqrtf(wave_sum(s2) * (1.f / DM) + LN_EPS);
#pragma unroll
        for (int j = 0; j < 4; ++j) xv[j] = xv[j] * rstd * gg[j] + bb[j];
        if (last) { GAS f32x4* o = (GAS f32x4*)(F.out + (size_t)m * DM) + lane;
#pragma unroll
            for (int j = 0; j < 4; ++j) o[64 * j] = xv[j]; }
        else { store_row_i8((signed char*)(F.ws + WS_X8) + (size_t)m * DM, (float*)(F.ws + WS_SX) + m, lane, xv); forget_row(xv, wff, (float*)(F.ws + WS_LF) + (size_t)m * 4, lane); }
    }
}

__device__ __forceinline__ int moe_tables(Frame& F, int l) {
    LAS int* tb = (LAS int*)(F.lds + SM_OFF); LAS int* cn = tb + 32;
    LAS int* gtab = (LAS int*)(F.lds + GT_OFF); LAS float* wtab = (LAS float*)(F.lds + WTB_OFF); LAS float* stab = (LAS float*)(F.lds + STB_OFF);
    if (F.tid < 16) cn[F.tid] = (int)__hip_atomic_load((unsigned*)(F.ctl + CW_CNT + (l * 16 + F.tid) * 64), RLX_AGENT);
    __syncthreads();
    if (F.tid == 0) { int a = 0; for (int e = 0; e < 16; ++e) { tb[e] = a; a += (cn[e] + 255) >> 8; } tb[16] = a; }
    __syncthreads();
    const int ntiles = tb[16];
    const int* list = (const int*)(F.ws + WS_LIST); const float* wt = (const float*)(F.ws + WS_WT);
    for (int i = 0; i < MAXU; ++i) { const long L = (long)i * F.G + F.vcu; if (L >= (long)ntiles * 4) break; const int pm = (int)(L >> 2);
        if (F.tid < 256) { int e = 0;
#pragma unroll
            for (int k = 1; k < 16; ++k) e += (pm >= tb[k]) ? 1 : 0;
            const int p = (pm - tb[e]) * 256 + F.tid; int v = -1; float w = 0.f, sc1 = 0.f;
            if (p < cn[e]) { v = list[(size_t)e * LISTCAP + p]; w = wt[v] * 32.0f; sc1 = ((const float*)(F.ws + WS_S1))[v >> 1]; }
            gtab[i * 256 + F.tid] = v; wtab[i * 256 + F.tid] = w; stab[i * 256 + F.tid] = sc1; } }
    __syncthreads();
    return ntiles;
}

#define STAG_OFF
#ifndef STAG_OFF
#define STAG(t) ((F.vcu & 3) * (t))
#else
#define STAG(t) 0
#endif
#define GRID_BAR() do { XcdBarrier bb_ = bar; asm volatile("" : "+s"(bb_.bar), "+s"(bb_.x)); xcd_barrier(bb_); } while (0)
template <int l> __device__ __forceinline__ void layer_body(const Frame& F0, const XcdBarrier& bar) {
        Frame F = F0; GAS unsigned char* gws_ = (GAS unsigned char*)F0.ws; GAS float* gout_ = (GAS float*)F0.out;
        asm volatile("" : "+s"(gws_), "+s"(gout_), "+s"(F.vcu), "+s"(F.bx), "+s"(F.G), "+v"(F.tid)); F.ws = (unsigned char*)gws_; F.out = (float*)gout_;
        unsigned char* ws; const pg8::bf16_t* x8; const unsigned char* wl;
#define PHASE_PTRS() do { GAS unsigned char* g_ = (GAS unsigned char*)F0.ws; GAS float* o_ = (GAS float*)F0.out; asm volatile("" : "+s"(g_), "+s"(o_)); F.ws = (unsigned char*)g_; F.out = (float*)o_; ws = F.ws; x8 = (const pg8::bf16_t*)(ws + WS_X8); wl = ws + WS_W + (size_t)l * W_LAYER; } while (0)
        PHASE_PTRS();
#ifndef SKIP_CC
        cc_scan(F);
#endif
#ifdef DUP_GA
        { pg8::Gemm g{x8, (const pg8::bf16_t*)(wl + W_IN), DM / 2, DM / 2, DM / 2}; pg8::StaticOrder S; S.init(T, NPROJ, F.G, F.bx);
          pg8::EpiBf16<true> E{(pg8::bf16_t*)(ws + WS_PROJ), NPROJ, (const float*)(ws + WS_BIASP) + l * NPROJ, (const float*)(ws + WS_SX), (const float*)(ws + WS_SWP) + l * NPROJ};
          pg8::gemm_phase<pg8::EpiBf16<true>, pg8::StaticOrder, PG8_ALIGN, false, true>(F.lds + RING_OFF, F.lds + GT_OFF, g, S, E, STAG(600)); }
#endif
#ifndef SKIP_GA
        { pg8::Gemm g{x8, (const pg8::bf16_t*)(wl + W_IN), DM / 2, DM / 2, DM / 2}; pg8::StaticOrder S; S.init(T, NPROJ, F.G, F.bx);
          pg8::EpiBf16<true> E{(pg8::bf16_t*)(ws + WS_PROJ), NPROJ, (const float*)(ws + WS_BIASP) + l * NPROJ, (const float*)(ws + WS_SX), (const float*)(ws + WS_SWP) + l * NPROJ};
          pg8::gemm_phase<pg8::EpiBf16<true>, pg8::StaticOrder, PG8_ALIGN, false, true>(F.lds + RING_OFF, F.lds + GT_OFF, g, S, E, STAG(600)); }
#endif
#ifndef SKIP_GM
        if (l == 0) { pg8::Gemm g{(const pg8::bf16_t*)(ws + WS_MEMB), (const pg8::bf16_t*)(ws + WS_WMEM), DM, DM, DM}; pg8::StaticOrder S; S.init(MEMROWS, 1024, F.G, F.bx);
          pg8::EpiBf16<false> E{(pg8::bf16_t*)(ws + WS_MEMKV), 1024, nullptr, nullptr, nullptr};
          pg8::gemm_phase<pg8::EpiBf16<false>, pg8::StaticOrder, PG8_ALIGN, false>(F.lds + RING_OFF, F.lds + GT_OFF, g, S, E, STAG(500)); }
#endif
        GRID_BAR();
        PHASE_PTRS();
#ifdef NAIVE_RECUR
        naive_recur(F, l);
#else
        recur_phase(F, l);
#ifdef DUP_RECUR
        recur_phase(F, l);
#endif
#endif
#ifdef NAIVE_ATTN
        naive_attn(F, l);
#else
        attn_phase(F, l);
#ifdef DUP_ATTN
        attn_phase(F, l);
#endif
#endif
        GRID_BAR();
        PHASE_PTRS();
#ifdef DUP_GC
        { pg8::Gemm g{(const pg8::bf16_t*)((unsigned char*)F.out), (const pg8::bf16_t*)(wl + W_B), DM, 256, 256}; pg8::StaticOrder S; S.init(T, 4096, F.G, F.bx, 4, 256);
          pg8::EpiU8 E{(unsigned char*)(ws + WS_U), 4096};
          pg8::gemm_phase<pg8::EpiU8, pg8::StaticOrder, PG8_ALIGN, false>(F.lds + RING_OFF, F.lds + GT_OFF, g, S, E, STAG(500)); }
#endif
#ifndef SKIP_GC
        { pg8::Gemm g{(const pg8::bf16_t*)((unsigned char*)F.out), (const pg8::bf16_t*)(wl + W_B), DM, 256, 256}; pg8::StaticOrder S; S.init(T, 4096, F.G, F.bx, 4, 256);
          pg8::EpiU8 E{(unsigned char*)(ws + WS_U), 4096};
          pg8::gemm_phase<pg8::EpiU8, pg8::StaticOrder, PG8_ALIGN, false>(F.lds + RING_OFF, F.lds + GT_OFF, g, S, E, STAG(500)); }
#endif
        GRID_BAR();
        PHASE_PTRS();
#ifdef DUP_GD
        { pg8::Gemm g{x8, (const pg8::bf16_t*)(wl + W_G), DM / 2, DM / 2, DM / 2}; pg8::StaticOrder S; S.init(T, NGATE, F.G, F.bx);
          pg8::EpiGateMix E{(const unsigned char*)(ws + WS_U), (pg8::bf16_t*)((unsigned char*)F.out), (const float*)(ws + WS_BIASG) + l * NGATE, (const float*)(ws + WS_SX), (const float*)(ws + WS_SWG) + l * NGATE};
          pg8::gemm_phase<pg8::EpiGateMix, pg8::StaticOrder, PG8_ALIGN, false, true>(F.lds + RING_OFF, F.lds + GT_OFF, g, S, E, STAG(600)); }
#endif
#ifndef SKIP_GD
        { pg8::Gemm g{x8, (const pg8::bf16_t*)(wl + W_G), DM / 2, DM / 2, DM / 2}; pg8::StaticOrder S; S.init(T, NGATE, F.G, F.bx);
          pg8::EpiGateMix E{(const unsigned char*)(ws + WS_U), (pg8::bf16_t*)((unsigned char*)F.out), (const float*)(ws + WS_BIASG) + l * NGATE, (const float*)(ws + WS_SX), (const float*)(ws + WS_SWG) + l * NGATE};
          pg8::gemm_phase<pg8::EpiGateMix, pg8::StaticOrder, PG8_ALIGN, false, true>(F.lds + RING_OFF, F.lds + GT_OFF, g, S, E, STAG(600)); }
#endif
        GRID_BAR();
        PHASE_PTRS();
#ifdef DUP_GE
        { pg8::Gemm g{(const pg8::bf16_t*)((unsigned char*)F.out), (const pg8::bf16_t*)(wl + W_OUT), DM, DM, DM}; pg8::StaticOrder S; S.init(T, DM, F.G, F.bx);
          pg8::EpiU8 E{(unsigned char*)(ws + WS_Y), DM};
          pg8::gemm_phase<pg8::EpiU8, pg8::StaticOrder, PG8_ALIGN, false>(F.lds + RING_OFF, F.lds + GT_OFF, g, S, E, STAG(500)); }
#endif
#ifndef SKIP_GE
        { pg8::Gemm g{(const pg8::bf16_t*)((unsigned char*)F.out), (const pg8::bf16_t*)(wl + W_OUT), DM, DM, DM}; pg8::StaticOrder S; S.init(T, DM, F.G, F.bx);
          pg8::EpiU8 E{(unsigned char*)(ws + WS_Y), DM};
          pg8::gemm_phase<pg8::EpiU8, pg8::StaticOrder, PG8_ALIGN, false>(F.lds + RING_OFF, F.lds + GT_OFF, g, S, E, STAG(500)); }
#endif
        GRID_BAR();
        PHASE_PTRS();
#ifdef DUP_LN1
        ln1_phase(F, l, false); __syncthreads();
#endif
#ifndef SKIP_LN1
        ln1_phase(F, l);
#endif
        GRID_BAR();
        PHASE_PTRS();
        const int ntiles = moe_tables(F, l);
#ifdef DUP_GG
        { pg8::Gemm g{(const pg8::bf16_t*)(ws + WS_X18), (const pg8::bf16_t*)(wl + W_E1), DM / 2, DM / 2, DM / 2};
          pg8::MoeOrder S{F.G, F.vcu, 4, ntiles, (const LAS int*)(F.lds + SM_OFF), (const LAS int*)(F.lds + GT_OFF), (size_t)1024 * 512, true};
          pg8::EpiMoe1 E{(pg8::bf16_t*)(ws + WS_ACT), (const LAS float*)(F.lds + STB_OFF), (const LAS int*)(F.lds + SM_OFF), (const float*)(ws + WS_SWE) + l * 16 * 1024};
          pg8::gemm_phase<pg8::EpiMoe1, pg8::MoeOrder, PG8_ALIGN, true, true>(F.lds + RING_OFF, F.lds + EV_OFF, g, S, E, STAG(600)); }
#endif
#ifndef SKIP_GG
        { pg8::Gemm g{(const pg8::bf16_t*)(ws + WS_X18), (const pg8::bf16_t*)(wl + W_E1), DM / 2, DM / 2, DM / 2};
          pg8::MoeOrder S{F.G, F.vcu, 4, ntiles, (const LAS int*)(F.lds + SM_OFF), (const LAS int*)(F.lds + GT_OFF), (size_t)1024 * 512, true};
          pg8::EpiMoe1 E{(pg8::bf16_t*)(ws + WS_ACT), (const LAS float*)(F.lds + STB_OFF), (const LAS int*)(F.lds + SM_OFF), (const float*)(ws + WS_SWE) + l * 16 * 1024};
          pg8::gemm_phase<pg8::EpiMoe1, pg8::MoeOrder, PG8_ALIGN, true, true>(F.lds + RING_OFF, F.lds + EV_OFF, g, S, E, STAG(600)); }
#endif
        GRID_BAR();
        PHASE_PTRS();
#ifdef DUP_GH
        { pg8::Gemm g{(const pg8::bf16_t*)(ws + WS_ACT), (const pg8::bf16_t*)(wl + W_E2), DE, DE, DE};
          pg8::MoeOrder S{F.G, F.vcu, 4, ntiles, (const LAS int*)(F.lds + SM_OFF), (const LAS int*)(F.lds + GT_OFF), (size_t)1024 * 512, false};
          pg8::EpiMoe2 E{(unsigned char*)(ws + WS_Y2), (const LAS int*)(F.lds + GT_OFF), (const LAS float*)(F.lds + WTB_OFF)};
          pg8::gemm_phase<pg8::EpiMoe2, pg8::MoeOrder, PG8_ALIGN, false>(F.lds + RING_OFF, F.lds + EV_OFF, g, S, E, STAG(500)); }
#endif
#ifndef SKIP_GH
        { pg8::Gemm g{(const pg8::bf16_t*)(ws + WS_ACT), (const pg8::bf16_t*)(wl + W_E2), DE, DE, DE};
          pg8::MoeOrder S{F.G, F.vcu, 4, ntiles, (const LAS int*)(F.lds + SM_OFF), (const LAS int*)(F.lds + GT_OFF), (size_t)1024 * 512, false};
          pg8::EpiMoe2 E{(unsigned char*)(ws + WS_Y2), (const LAS int*)(F.lds + GT_OFF), (const LAS float*)(F.lds + WTB_OFF)};
          pg8::gemm_phase<pg8::EpiMoe2, pg8::MoeOrder, PG8_ALIGN, false>(F.lds + RING_OFF, F.lds + EV_OFF, g, S, E, STAG(500)); }
#endif
        GRID_BAR();
        PHASE_PTRS();
#ifdef DUP_LN2
        ln2_phase(F, l); __syncthreads();
#endif
#ifndef SKIP_LN2
        ln2_phase(F, l);
#endif
        if (l + 1 < NLAYER) GRID_BAR();
}

__global__ void __launch_bounds__(NWAVES * 64, 2) fwd_kernel(Args args) {
    extern __shared__ __attribute__((aligned(16))) unsigned char lds[];
    Frame F0;
    F0.lds = (LAS unsigned char*)lds;
    F0.MISC = (volatile LAS unsigned*)(F0.lds + MISC_OFF);
    F0.tid = threadIdx.x;
    F0.G = gridDim.x; F0.bx = blockIdx.x; { const int bx = blockIdx.x; F0.vcu = (F0.G % 8 == 0) ? (bx % 8) * (F0.G / 8) + bx / 8 : bx; }
    F0.ws = args.ws; F0.out = args.out; F0.ctl = (gu32*)(args.ws + WS_CTL);
    for (int u = F0.tid; u < (LDS_BYTES - LDSCTL_OFF) / 4; u += NWAVES * 64) ((LAS unsigned*)(F0.lds + LDSCTL_OFF))[u] = 0u;
    __syncthreads();
    XcdBarrier bar = xcd_barrier_post((unsigned*)(F0.ctl + CW_BAR), F0.MISC + 8);

#ifdef DUP_P0
    p0_prologue(F0, args); __syncthreads();
#endif
#ifndef SKIP_P0
    p0_prologue(F0, args);
#endif
    GRID_BAR();

    layer_body<0>(F0, bar);
    layer_body<1>(F0, bar);
}

extern "C" void kernel_launch(void* const* d_in, const int* in_sizes, int n_in, void* d_out, int out_size, void* d_ws, size_t ws_size, hipStream_t stream) {
    static int grid = 0;
    if (grid == 0) {
        if (n_in != 15 || in_sizes[0] != T * DM || out_size != T * DM || ws_size < WS_END) { fprintf(stderr, "kernel_launch: unexpected shapes / workspace (n_in %d, in0 %d, out %d, ws %zu); nothing launched\n", n_in, n_in > 0 ? in_sizes[0] : -1, out_size, ws_size); grid = -1; return; }
        int dev = 0, cus = 0, per_cu = 0;
        if (hipGetDevice(&dev) != hipSuccess || hipDeviceGetAttribute(&cus, hipDeviceAttributeMultiprocessorCount, dev) != hipSuccess) { grid = -1; return; }
        if (hipFuncSetAttribute((const void*)fwd_kernel, hipFuncAttributeMaxDynamicSharedMemorySize, LDS_BYTES) != hipSuccess) { fprintf(stderr, "kernel_launch: hipFuncSetAttribute failed\n"); grid = -1; return; }
        if (hipOccupancyMaxActiveBlocksPerMultiprocessor(&per_cu, (const void*)fwd_kernel, NWAVES * 64, LDS_BYTES) != hipSuccess || per_cu < 1) fprintf(stderr, "kernel_launch: occupancy query reports %d\n", per_cu);
        (void)hipGetLastError();
        grid = cus;
    }
    if (grid < 0) return;
    if (hipMemsetAsync((char*)d_ws + WS_CTL, 0, CTL_ZERO_BYTES, stream) != hipSuccess) return;
    Args a{};
    for (int i = 0; i < 15; ++i) a.in[i] = (const float*)d_in[i];
    a.out = (float*)d_out; a.ws = (unsigned char*)d_ws; a.naive = 0; a.pad = 0;
    hipLaunchKernelGGL(fwd_kernel, dim3(grid), dim3(NWAVES * 64), LDS_BYTES, stream, a);
}
```

```cpp
#include <hip/hip_runtime.h>
#include <cstdio>
#include <cstdint>
#include <type_traits>

namespace pg8 {
#define PG8_LAS __attribute__((address_space(3)))
typedef unsigned short bf16_t;
typedef short bf16x8 __attribute__((ext_vector_type(8)));
typedef float f32x4 __attribute__((ext_vector_type(4)));
typedef float f32x2 __attribute__((ext_vector_type(2)));
typedef unsigned u32x4 __attribute__((ext_vector_type(4)));
typedef unsigned u32x2 __attribute__((ext_vector_type(2)));
typedef int i32x4 __attribute__((ext_vector_type(4)));
__device__ __forceinline__ f32x4 tof(const f32x4& v) { return v; }
__device__ __forceinline__ f32x4 tof(const i32x4& v) { return (f32x4){(float)v[0], (float)v[1], (float)v[2], (float)v[3]}; }
constexpr int BM = 256, BK = 64, HALF = 128, HTB = HALF * BK * 2  , STAGE_BYTES = 8 * HTB, NXCD = 8, WGM = 8;

__host__ __device__ __forceinline__ int lds_byte(int r, int c) { const int st = (r >> 4) * 2 + (c >> 5), rr = r & 15, cc = c & 31, ob = rr * 64 + cc * 2; return st * 1024 + (ob ^ (((ob >> 9) & 1) << 5)); }
__host__ __device__ __forceinline__ void stage_rc(int b, int& R, int& C) { const int st = b / 1024, sb = b % 1024, swz = sb ^ (((sb >> 9) & 1) << 5); R = (st >> 1) * 16 + swz / 64; C = (st & 1) * 32 + (swz % 64) / 2; }
__host__ __device__ __forceinline__ int perm32(int rho) { const int n = rho >> 4, i = rho & 15; return 8 * (i >> 2) + 4 * n + (i & 3); }

#ifdef PG8_NT_STORE
#define PG8_ST16(p, v) __builtin_nontemporal_store((v), (u32x4*)(p))
#else
#define PG8_ST16(p, v) (*(u32x4*)(p) = (v))
#endif
__host__ __device__ __forceinline__ int perm32s(int rho) { const int n = rho >> 4, i = rho & 15, q = i >> 2, sg = ((q & 1) << 1) | (q >> 1); return 8 * sg + 4 * n + (i & 3); }
struct Unit { int pm, pn; };
struct Gemm { const bf16_t* A; const bf16_t* Bt; int lda, ldb, K; };

struct StaticOrder {
    int nM, nN, nwg, G, c, a_div, a_add;
    __device__ void init(int M, int N, int G_, int c_, int a_div_ = 0, int a_add_ = 0) { nM = M / BM; nN = N / BM; nwg = nM * nN; G = G_; c = c_; a_div = a_div_; a_add = a_add_; }
    __device__ bool next(int i, Unit& u) const {
        const long L = (long)i * G + c; if (L >= nwg) return false;
        int wgid = (int)L; { const int q = nwg / NXCD, r = nwg % NXCD, xcd = wgid % NXCD, off = wgid / NXCD; wgid = (xcd < r ? xcd * (q + 1) : r * (q + 1) + (xcd - r) * q) + off; }
        const int nig = WGM * nN, gid = wgid / nig, fm = gid * WGM, gsz = (nM - fm) < WGM ? (nM - fm) : WGM;
        u.pm = fm + ((wgid % nig) % gsz); u.pn = (wgid % nig) / gsz; return true;
    }
    __device__ __forceinline__ const char* a_ptr(const Gemm& g, const Unit& u) const { return (const char*)g.A + ((size_t)u.pm * BM * g.lda + (a_div ? (size_t)((u.pn / a_div) * a_add) : (size_t)0)) * 2; }
    __device__ __forceinline__ const char* b_ptr(const Gemm& g, const Unit& u) const { return (const char*)g.Bt + (size_t)u.pn * BM * g.ldb * 2; }
    __device__ __forceinline__ int grow(int, int) const { return 0; }
};

template <int NN> struct RowOrder : StaticOrder {
    __device__ __forceinline__ bool next(int i, Unit& u) const { const int rb = i / NN; u.pm = c + rb * G; u.pn = i % NN; return u.pm < nM; }
};

struct MoeOrder {
    int G, vcu, nN, ntiles; const PG8_LAS int* tb; const PG8_LAS int* gtab; size_t wstride;
    bool gather;
    __device__ __forceinline__ bool next(int i, Unit& u) const { const long L = (long)i * G + vcu; if (L >= (long)ntiles * nN) return false; u.pm = (int)(L / nN); u.pn = (int)(L % nN); return true; }
    __device__ __forceinline__ int expert_of(int pm) const { int e = 0;
#pragma unroll
        for (int k = 1; k < 16; ++k) e += (pm >= tb[k]) ? 1 : 0; return e; }
    __device__ __forceinline__ const char* a_ptr(const Gemm& g, const Unit& u) const { return gather ? (const char*)g.A : (const char*)g.A + (size_t)u.pm * BM * g.lda * 2; }
    __device__ __forceinline__ const char* b_ptr(const Gemm& g, const Unit& u) const { return (const char*)g.Bt + ((size_t)expert_of(u.pm) * wstride + (size_t)u.pn * BM * g.ldb) * 2; }
    __device__ __forceinline__ int grow(int ui, int r) const { const int v = gtab[ui * 256 + r]; return v >= 0 ? (v >> 1) : 0; }
};

__device__ __forceinline__ unsigned cvt_pk_bf16(float lo, float hi) { unsigned r; asm volatile("v_cvt_pk_bf16_f32 %0, %1, %2" : "=v"(r) : "v"(lo), "v"(hi)); return r; }
__device__ __forceinline__ float bf_lo(unsigned w) { return __uint_as_float(w << 16); }
__device__ __forceinline__ float bf_hi(unsigned w) { return __uint_as_float(w & 0xffff0000u); }
__device__ __forceinline__ float sig2(float z) { return __builtin_amdgcn_rcpf(1.0f + __builtin_amdgcn_exp2f(z)); }
__device__ __forceinline__ float sigmoidf_fast(float x) { return __builtin_amdgcn_rcpf(1.0f + __builtin_amdgcn_exp2f(-1.4426950408889634f * x)); }

template <bool SC> struct EpiBf16 { static constexpr bool PSIG = false;
    static constexpr bool PERM = true; static constexpr int NTAB = SC ? 12 : 0, NST = 16;
    bf16_t* O; int ldc; const float* bias; const float* rs; const float* cs;
    __device__ __forceinline__ const float* tab_src(const Unit& u, int ch) const { return ch < 4 ? rs + u.pm * BM + 64 * ch : (ch < 8 ? bias + u.pn * BM + 64 * (ch - 4) : cs + u.pn * BM + 64 * (ch - 8)); }
    template <class AccT>
    __device__ __forceinline__ void operator()(const AccT (&acc)[2][2][4][2], const Unit& u, int ui, int wr, int wc, int fr, int fq, const PG8_LAS float* tab) const {
        const int row0 = u.pm * BM + wr * 64 + fr, col0 = u.pn * BM + wc * 32 + 8 * fq;
        f32x4 bv[2][2], cv[2][2];
#pragma unroll
        for (int bj = 0; bj < 2; ++bj)
#pragma unroll
            for (int n = 0; n < 2; ++n) { bv[bj][n] = SC ? *(const PG8_LAS f32x4*)(tab + 256 + wc * 32 + 8 * fq + bj * HALF + 4 * n) : (f32x4){0.f, 0.f, 0.f, 0.f}; cv[bj][n] = SC ? *(const PG8_LAS f32x4*)(tab + 512 + wc * 32 + 8 * fq + bj * HALF + 4 * n) : (f32x4){1.f, 1.f, 1.f, 1.f}; }
#pragma unroll
        for (int ai = 0; ai < 2; ++ai)
#pragma unroll
            for (int m = 0; m < 4; ++m) { const int rl = wr * 64 + fr + ai * HALF + m * 16; bf16_t* rowp = O + (size_t)(u.pm * BM + rl) * ldc + col0; const float rsc = SC ? tab[rl] : 1.f;
#pragma unroll
                for (int bj = 0; bj < 2; ++bj) { f32x4 v0 = tof(acc[ai][bj][m][0]), v1 = tof(acc[ai][bj][m][1]);
                    if (SC) { v0 = v0 * rsc * cv[bj][0] + bv[bj][0]; v1 = v1 * rsc * cv[bj][1] + bv[bj][1]; }
                    u32x4 w; w.x = cvt_pk_bf16(v0[0], v0[1]); w.y = cvt_pk_bf16(v0[2], v0[3]); w.z = cvt_pk_bf16(v1[0], v1[1]); w.w = cvt_pk_bf16(v1[2], v1[3]);
                    PG8_ST16(rowp + bj * HALF, w); } }
    }
};
__device__ __forceinline__ unsigned pk_fp8x4(float a, float b, float c, float d) { unsigned w; a = __builtin_amdgcn_fmed3f(a, -448.0f, 448.0f); b = __builtin_amdgcn_fmed3f(b, -448.0f, 448.0f); c = __builtin_amdgcn_fmed3f(c, -448.0f, 448.0f); d = __builtin_amdgcn_fmed3f(d, -448.0f, 448.0f);
    asm volatile("v_cvt_pk_fp8_f32 %0, %1, %2" : "=v"(w) : "v"(a), "v"(b)); asm volatile("v_cvt_pk_fp8_f32 %0, %1, %2 op_sel:[0,0,1]" : "+v"(w) : "v"(c), "v"(d)); return w; }
struct EpiU8 {
    static constexpr bool PERM = true, PSIG = true; static constexpr int NTAB = 0, NST = 8;
    unsigned char* O; int ld; float mul; bool blk = false;
    __device__ __forceinline__ const float* tab_src(const Unit&, int) const { return nullptr; }
    template <class AccT>
    __device__ __forceinline__ void operator()(const AccT (&acc)[2][2][4][2], const Unit& u, int ui, int wr, int wc, int fr, int fq, const PG8_LAS float* tab) const {
        const int row0 = u.pm * BM + wr * 64 + fr, col0 = u.pn * BM + 128 * (fq >> 1) + wc * 32 + 16 * (fq & 1);
#pragma unroll
        for (int ai = 0; ai < 2; ++ai)
#pragma unroll
            for (int m = 0; m < 4; ++m) { const int row_ = row0 + ai * HALF + m * 16; unsigned char* rowp = blk ? O + (size_t)(row_ >> 4) * 65536 + (size_t)(col0 >> 4) * 256 + (row_ & 15) * 16 : O + (size_t)row_ * ld + col0;
                u32x2 w[2];
#pragma unroll
                for (int bj = 0; bj < 2; ++bj) { const f32x4 v0 = tof(acc[ai][bj][m][0]) * mul, v1 = tof(acc[ai][bj][m][1]) * mul;
                    w[bj].x = pk_fp8x4(v0[0], v0[1], v0[2], v0[3]); w[bj].y = pk_fp8x4(v1[0], v1[1], v1[2], v1[3]); }
                const auto r0 = __builtin_amdgcn_permlane32_swap(w[0].x, w[1].x, false, false), r1 = __builtin_amdgcn_permlane32_swap(w[0].y, w[1].y, false, false);
                u32x4 o; o.x = r0[0]; o.y = r1[0]; o.z = r0[1]; o.w = r1[1];
                *(u32x4*)rowp = o; }
    }
};
__device__ __forceinline__ size_t pjoff(int row, int col) { return (size_t)(row >> 4) * (16 * 3072) + (size_t)(col >> 6) * 1024 + (size_t)((row & 15) * 64 + (col & 63)); }
struct EpiF8SC {
    static constexpr bool PERM = true, PSIG = true; static constexpr int NTAB = 12, NST = 8;
    unsigned char* O; int ld; const float* bias; const float* rs; const float* cs;
    __device__ __forceinline__ const float* tab_src(const Unit& u, int ch) const { return ch < 4 ? rs + u.pm * BM + 64 * ch : (ch < 8 ? bias + u.pn * BM + 64 * (ch - 4) : cs + u.pn * BM + 64 * (ch - 8)); }
    template <class AccT>
    __device__ __forceinline__ void operator()(const AccT (&acc)[2][2][4][2], const Unit& u, int ui, int wr, int wc, int fr, int fq, const PG8_LAS float* tab) const {
        const int sfq = ((fq & 1) << 1) | (fq >> 1);
        const int col0 = u.pn * BM + wc * 64 + 16 * fq;
        f32x4 bv[2][2], cv[2][2];
#pragma unroll
        for (int bj = 0; bj < 2; ++bj)
#pragma unroll
            for (int n = 0; n < 2; ++n) { bv[bj][n] = *(const PG8_LAS f32x4*)(tab + 256 + wc * 32 + 8 * sfq + bj * HALF + 4 * n) * 16.0f; cv[bj][n] = *(const PG8_LAS f32x4*)(tab + 512 + wc * 32 + 8 * sfq + bj * HALF + 4 * n) * 16.0f; }
#pragma unroll
        for (int ai = 0; ai < 2; ++ai)
#pragma unroll
            for (int m = 0; m < 4; ++m) { const int rl = wr * 64 + fr + ai * HALF + m * 16; unsigned char* rowp = O + pjoff(u.pm * BM + rl, col0); const float rsc = tab[rl];
                u32x2 w[2];
#pragma unroll
                for (int bj = 0; bj < 2; ++bj) { const f32x4 v0 = tof(acc[ai][bj][m][0]) * rsc * cv[bj][0] + bv[bj][0], v1 = tof(acc[ai][bj][m][1]) * rsc * cv[bj][1] + bv[bj][1];
                    w[bj].x = pk_fp8x4(v0[0], v0[1], v0[2], v0[3]); w[bj].y = pk_fp8x4(v1[0], v1[1], v1[2], v1[3]); }
                const auto r0 = __builtin_amdgcn_permlane32_swap(w[0].x, w[1].x, false, false), r1 = __builtin_amdgcn_permlane32_swap(w[0].y, w[1].y, false, false);
                u32x4 o; o.x = r0[0]; o.y = r1[0]; o.z = r0[1]; o.w = r1[1];
                *(u32x4*)rowp = o; }
    }
};
struct EpiGateMix { static constexpr bool PSIG = false;
    static constexpr bool PERM = false; static constexpr int NTAB = 12, NST = 8;
    const unsigned char* U; unsigned char* O; const float* bias; const float* rs; const float* cs;
    __device__ __forceinline__ const float* tab_src(const Unit& u, int ch) const { return ch < 4 ? rs + u.pm * BM + 64 * ch : (ch < 8 ? bias + u.pn * BM + 64 * (ch - 4) : cs + u.pn * BM + 64 * (ch - 8)); }
    template <class AccT>
    __device__ __forceinline__ void operator()(const AccT (&acc)[2][2][4][2], const Unit& u, int ui, int wr, int wc, int fr, int fq, const PG8_LAS float* tab) const {
        const int row0 = u.pm * BM + wr * 64 + fr, d0 = 64 * u.pn + 16 * wc + 4 * fq;
        f32x4 bv[2][2], cv[2][2];
#pragma unroll
        for (int bj = 0; bj < 2; ++bj)
#pragma unroll
            for (int n = 0; n < 2; ++n) { const int vc = 128 * bj + 32 * wc + 16 * n + 4 * fq; bv[bj][n] = *(const PG8_LAS f32x4*)(tab + 256 + vc); cv[bj][n] = *(const PG8_LAS f32x4*)(tab + 512 + vc); }
#pragma unroll
        for (int ai = 0; ai < 2; ++ai)
#pragma unroll
            for (int m = 0; m < 4; ++m) { const int rl = wr * 64 + fr + ai * HALF + m * 16; const size_t row = (size_t)(u.pm * BM + rl); const unsigned char* up = U + (row >> 4) * 65536 + (size_t)(d0 >> 4) * 256 + (row & 15) * 16 + (d0 & 15); const float rsc = tab[rl];
                f32x4 o = (f32x4){0.f, 0.f, 0.f, 0.f};
#pragma unroll
                for (int bj = 0; bj < 2; ++bj)
#pragma unroll
                    for (int n = 0; n < 2; ++n) { const int w = *(const int*)(up + (2 * bj + n) * 16384);
                        const f32x2 ul = __builtin_amdgcn_cvt_pk_f32_fp8(w, false), uh = __builtin_amdgcn_cvt_pk_f32_fp8(w, true);
                        const f32x4 z = tof(acc[ai][bj][m][n]) * rsc * cv[bj][n] + bv[bj][n];
                        o[0] = __builtin_fmaf(sig2(z[0]), ul.x, o[0]); o[1] = __builtin_fmaf(sig2(z[1]), ul.y, o[1]); o[2] = __builtin_fmaf(sig2(z[2]), uh.x, o[2]); o[3] = __builtin_fmaf(sig2(z[3]), uh.y, o[3]); }
                *(unsigned*)(O + row * 1024 + d0) = pk_fp8x4(o[0] * 0.5f, o[1] * 0.5f, o[2] * 0.5f, o[3] * 0.5f); }
    }
};
struct EpiMoe1 { static constexpr bool PSIG = false;
    static constexpr bool PERM = true; static constexpr int NTAB = 4, NST = 8;
    unsigned char* act; const PG8_LAS float* stab; const PG8_LAS int* tb; const float* cs;
    __device__ __forceinline__ const float* tab_src(const Unit& u, int ch) const { int e = 0;
#pragma unroll
        for (int k = 1; k < 16; ++k) e += (u.pm >= tb[k]) ? 1 : 0;
        return cs + e * 1024 + u.pn * BM + 64 * ch; }
    template <class AccT>
    __device__ __forceinline__ void operator()(const AccT (&acc)[2][2][4][2], const Unit& u, int ui, int wr, int wc, int fr, int fq, const PG8_LAS float* tab) const {
        const int row0 = u.pm * BM + wr * 64 + fr, col0 = 128 * u.pn + 32 * wc + 8 * fq;
        f32x4 cg[2], cu[2];
#pragma unroll
        for (int n = 0; n < 2; ++n) { cg[n] = *(const PG8_LAS f32x4*)(tab + 32 * wc + 8 * fq + 4 * n); cu[n] = *(const PG8_LAS f32x4*)(tab + HALF + 32 * wc + 8 * fq + 4 * n); }
#pragma unroll
        for (int ai = 0; ai < 2; ++ai)
#pragma unroll
            for (int m = 0; m < 4; ++m) { const int rl = ai * HALF + wr * 64 + m * 16 + fr; const size_t row = (size_t)(u.pm * BM + rl); const float rsc = stab[ui * 256 + rl];
                float a[8];
#pragma unroll
                for (int n = 0; n < 2; ++n) { const f32x4 g4 = tof(acc[ai][0][m][n]) * rsc * cg[n], u4 = tof(acc[ai][1][m][n]) * rsc * cu[n];
#pragma unroll
                    for (int j = 0; j < 4; ++j) a[4 * n + j] = g4[j] * sigmoidf_fast(g4[j]) * u4[j]; }
                u32x2 w; w.x = pk_fp8x4(a[0] * 8.0f, a[1] * 8.0f, a[2] * 8.0f, a[3] * 8.0f); w.y = pk_fp8x4(a[4] * 8.0f, a[5] * 8.0f, a[6] * 8.0f, a[7] * 8.0f);
                *(u32x2*)(act + row * 512 + col0) = w; }
    }
};
struct EpiMoe2 { static constexpr bool PSIG = false;
    static constexpr bool PERM = true; static constexpr int NTAB = 0, NST = 0;
    __device__ __forceinline__ const float* tab_src(const Unit&, int) const { return nullptr; }
    unsigned char* Y; const PG8_LAS int* gtab; const PG8_LAS float* wtab;
    template <class AccT>
    __device__ __forceinline__ void operator()(const AccT (&acc)[2][2][4][2], const Unit& u, int ui, int wr, int wc, int fr, int fq, const PG8_LAS float* tab) const {
        const int col0 = u.pn * BM + wc * 32 + 8 * fq;
#pragma unroll
        for (int ai = 0; ai < 2; ++ai)
#pragma unroll
            for (int m = 0; m < 4; ++m) { const int rl = ai * HALF + wr * 64 + m * 16 + fr; const int slot = gtab[ui * 256 + rl]; const float wgt = wtab[ui * 256 + rl];
                if (slot >= 0) { unsigned char* rowp = Y + (size_t)slot * 1024 + col0;
#pragma unroll
                    for (int bj = 0; bj < 2; ++bj) { const f32x4 v0 = tof(acc[ai][bj][m][0]) * wgt, v1 = tof(acc[ai][bj][m][1]) * wgt;
                        u32x2 w; w.x = pk_fp8x4(v0[0], v0[1], v0[2], v0[3]); w.y = pk_fp8x4(v1[0], v1[1], v1[2], v1[3]);
                        *(u32x2*)(rowp + bj * HALF) = w; } } }
    }
};

template <class Epi, class Sched, bool ALIGN_EPI, bool GATHER, bool I8 = false, bool F8 = false>
__device__ __forceinline__ void gemm_phase(PG8_LAS unsigned char* lds, PG8_LAS unsigned char* lds_tab, const Gemm g, const Sched& S, const Epi& E, int stag_ticks = 0) {
    int tid_ = threadIdx.x; asm volatile("" : "+v"(tid_));
    const int tid = tid_, wid = __builtin_amdgcn_readfirstlane(tid >> 6), lane = tid & 63, wr = wid >> 2, wc = wid & 3, fr = lane & 15, fq = lane >> 4;
    const int K = g.K, nt = K / BK;
    unsigned voffA[2], voffB[2]; int RA[2]; unsigned CA2[2];
#pragma unroll
    for (int i = 0; i < 2; ++i) { int R, C; stage_rc(tid * 16 + i * 8192, R, C); const int Rb = Epi::PERM ? ((R & ~31) + (Epi::PSIG ? perm32s(R & 31) : perm32(R & 31))) : R;
        voffA[i] = (unsigned)(R * g.lda + C) * 2u; voffB[i] = (unsigned)(Rb * g.ldb + C) * 2u; RA[i] = R; CA2[i] = (unsigned)C * 2u; }
    const size_t kstep = (size_t)(BK * 2);
    const size_t hstepA = (size_t)HALF * g.lda * 2, hstepB = (size_t)HALF * g.ldb * 2;
    const unsigned ldsw = (unsigned)wid * 1024u;
    const int aoff = lds_byte(wr * 64 + fr, fq * 8), boff = lds_byte(wc * 32 + fr, fq * 8);
    unsigned gvc[2][2], gvn[2][2];
#define PG8_SA(b, h) (((b) * 2 + (h)) * HTB)
#define PG8_SB(b, h) ((4 + (b) * 2 + (h)) * HTB)
#define PG8_STG(bufoff, gbase, voff) do { _Pragma("unroll") for (int _i = 0; _i < 2; ++_i) \
        __builtin_amdgcn_global_load_lds((const unsigned*)((const char*)(gbase) + (voff)[_i]), (PG8_LAS unsigned*)(lds + (bufoff) + ldsw + _i * 8192), 16, 0, 0); } while (0)
#define PG8_STG_B(bufoff, kptr, h) PG8_STG(bufoff, (kptr) + (h) * hstepB, voffB)
#define PG8_STG_A(bufoff, kptr, h, nx) do { if constexpr (GATHER) { unsigned _v[2]; _v[0] = (nx) ? gvn[h][0] : gvc[h][0]; _v[1] = (nx) ? gvn[h][1] : gvc[h][1]; PG8_STG(bufoff, kptr, _v); } \
        else { PG8_STG(bufoff, (kptr) + (h) * hstepA, voffA); } } while (0)
#define PG8_GLOAD(dst, uix) do { _Pragma("unroll") for (int _h = 0; _h < 2; ++_h) _Pragma("unroll") for (int _i = 0; _i < 2; ++_i) \
        dst[_h][_i] = (unsigned)S.grow((uix), _h * HALF + RA[_i]) * (unsigned)(g.lda * 2) + CA2[_i]; } while (0)
#define PG8_LDA(dst, b, h) do { _Pragma("unroll") for (int m = 0; m < 4; ++m) _Pragma("unroll") for (int k = 0; k < 2; ++k) dst[m][k] = *(const PG8_LAS bf16x8*)(lds + PG8_SA(b, h) + aoff + m * 2048 + k * 1024); } while (0)
#define PG8_LDB(dst, b, h) do { _Pragma("unroll") for (int n = 0; n < 2; ++n) _Pragma("unroll") for (int k = 0; k < 2; ++k) dst[n][k] = *(const PG8_LAS bf16x8*)(lds + PG8_SB(b, h) + boff + n * 2048 + k * 1024); } while (0)
#define PG8_MMA(ai, bj, At, Bt) do { __builtin_amdgcn_s_setprio(1); _Pragma("unroll") for (int m = 0; m < 4; ++m) _Pragma("unroll") for (int n = 0; n < 2; ++n) _Pragma("unroll") for (int k = 0; k < 2; ++k) \
        { if constexpr (F8) { typedef long l2_t __attribute__((ext_vector_type(2))); const l2_t b2_ = __builtin_bit_cast(l2_t, Bt[n][k]), a2_ = __builtin_bit_cast(l2_t, At[m][k]);     \
              acc[ai][bj][m][n] = __builtin_amdgcn_mfma_f32_16x16x32_fp8_fp8(b2_[0], a2_[0], acc[ai][bj][m][n], 0, 0, 0); acc[ai][bj][m][n] = __builtin_amdgcn_mfma_f32_16x16x32_fp8_fp8(b2_[1], a2_[1], acc[ai][bj][m][n], 0, 0, 0); } \
          else if constexpr (I8) acc[ai][bj][m][n] = __builtin_amdgcn_mfma_i32_16x16x64_i8(__builtin_bit_cast(i32x4, Bt[n][k]), __builtin_bit_cast(i32x4, At[m][k]), acc[ai][bj][m][n], 0, 0, 0); \
          else acc[ai][bj][m][n] = __builtin_amdgcn_mfma_f32_16x16x32_bf16(Bt[n][k], At[m][k], acc[ai][bj][m][n], 0, 0, 0); } __builtin_amdgcn_s_setprio(0); } while (0)
#define PG8_WAIT_V(n) asm volatile("s_waitcnt vmcnt(" #n ")" ::: "memory")
    constexpr int ND = (Epi::NTAB + 7) / 8, RELAX = 8 + Epi::NST + ND;
#define PG8_TABS(uix, U) do { if constexpr (Epi::NTAB > 0) { _Pragma("unroll") for (int c_ = 0; c_ < ND; ++c_) { const int ch_ = (wid + 8 * c_) % Epi::NTAB; \
        __builtin_amdgcn_global_load_lds((const unsigned*)(E.tab_src(U, ch_) + lane), (PG8_LAS unsigned*)((PG8_LAS float*)lds_tab + ((uix) & 1) * Epi::NTAB * 64 + 64 * ch_), 4, 0, 0); } } } while (0)
#ifdef PG8_RELAX
#define PG8_WAIT_V8R(rx) do { if (rx) asm volatile("s_waitcnt vmcnt(%0)" :: "n"(RELAX) : "memory"); else asm volatile("s_waitcnt vmcnt(8)" ::: "memory"); } while (0)
#else
#define PG8_WAIT_V8R(rx) asm volatile("s_waitcnt vmcnt(8)" ::: "memory")
#endif
#define PG8_WAIT_L(n) asm volatile("s_waitcnt lgkmcnt(" #n ")" ::: "memory")
#define PG8_BAR __builtin_amdgcn_s_barrier()
#define PG8_SCHED __builtin_amdgcn_sched_barrier(0)
    Unit cur, nxt; int ui = 0;
    if (!S.next(0, cur)) return;
    if (stag_ticks > 0) { const unsigned long long t0_ = __builtin_amdgcn_s_memrealtime(); const unsigned long long w_ = (unsigned long long)stag_ticks; while (__builtin_amdgcn_s_memrealtime() - t0_ < w_) __builtin_amdgcn_s_sleep(8); }
    typedef typename std::conditional<I8, i32x4, f32x4>::type AccT;
    AccT acc[2][2][4][2];
#pragma unroll
    for (int a = 0; a < 2; ++a)
#pragma unroll
        for (int b = 0; b < 2; ++b)
#pragma unroll
            for (int m = 0; m < 4; ++m)
#pragma unroll
                for (int n = 0; n < 2; ++n) acc[a][b][m][n] = AccT{};
    bf16x8 At[4][2], B0[2][2], B1[2][2];
    const char* cA = S.a_ptr(g, cur); const char* cB = S.b_ptr(g, cur);
    if constexpr (GATHER) { PG8_GLOAD(gvc, 0); PG8_GLOAD(gvn, 0); }
    PG8_TABS(0, cur);
    PG8_STG_B(PG8_SB(0, 0), cB, 0); PG8_STG_B(PG8_SB(0, 1), cB, 1); PG8_STG_A(PG8_SA(0, 0), cA, 0, false); PG8_STG_A(PG8_SA(0, 1), cA, 1, false);
    if (wr == 1) PG8_BAR;
    PG8_WAIT_V(2); PG8_BAR;
    PG8_STG_B(PG8_SB(1, 0), cB + kstep, 0); PG8_STG_A(PG8_SA(1, 0), cA + kstep, 0, false); PG8_STG_B(PG8_SB(1, 1), cB + kstep, 1);
    PG8_WAIT_V(6); PG8_BAR;
    for (;;) {
        const bool has_next = S.next(ui + 1, nxt);
        const char* nA = has_next ? S.a_ptr(g, nxt) : cA; const char* nB = has_next ? S.b_ptr(g, nxt) : cB;
        if constexpr (GATHER) { if (has_next) { PG8_GLOAD(gvn, ui + 1); } else {
#pragma unroll
            for (int h = 0; h < 2; ++h) { gvn[h][0] = gvc[h][0]; gvn[h][1] = gvc[h][1]; } } }
#pragma nounroll
        for (int t = 0; t < nt; t += 2) {
            const bool last = (t == nt - 2); const bool rx = (t == 0) && (ui > 0) && (RELAX > 8);
            const char* a1 = cA + (size_t)(t + 1) * kstep;
            const char* a2 = last ? nA : cA + (size_t)(t + 2) * kstep; const char* b2 = last ? nB : cB + (size_t)(t + 2) * kstep;
            const char* a3 = a2 + kstep; const char* b3 = b2 + kstep;
            PG8_LDB(B0, 0, 0); PG8_LDB(B1, 0, 1); PG8_SCHED; PG8_LDA(At, 0, 0); PG8_STG_A(PG8_SA(1, 1), a1, 1, false);
            PG8_WAIT_V8R(rx); PG8_WAIT_L(0); PG8_BAR; PG8_MMA(0, 0, At, B0); PG8_MMA(0, 1, At, B1); PG8_BAR; PG8_SCHED;
            PG8_LDA(At, 0, 1); PG8_STG_B(PG8_SB(0, 0), b2, 0); PG8_STG_B(PG8_SB(0, 1), b2, 1); PG8_STG_A(PG8_SA(0, 0), a2, 0, last);
            PG8_WAIT_V8R(rx); PG8_WAIT_L(0); PG8_BAR; PG8_MMA(1, 0, At, B0); PG8_MMA(1, 1, At, B1); PG8_BAR; PG8_SCHED;
            PG8_LDB(B0, 1, 0); PG8_LDB(B1, 1, 1); PG8_SCHED; PG8_LDA(At, 1, 0); PG8_STG_A(PG8_SA(0, 1), a2, 1, last);
            PG8_WAIT_V(8); PG8_WAIT_L(0); PG8_BAR; PG8_MMA(0, 0, At, B0); PG8_MMA(0, 1, At, B1); PG8_BAR; PG8_SCHED;
            PG8_LDA(At, 1, 1); PG8_STG_B(PG8_SB(1, 0), b3, 0); PG8_STG_B(PG8_SB(1, 1), b3, 1); PG8_STG_A(PG8_SA(1, 0), a3, 0, last);
            PG8_WAIT_V(8); PG8_WAIT_L(0); PG8_BAR; PG8_MMA(1, 0, At, B0); PG8_MMA(1, 1, At, B1); PG8_BAR; PG8_SCHED;
        }
        if constexpr (ALIGN_EPI) { if (wr == 0) PG8_BAR; }
        E(acc, cur, ui, wr, wc, fr, fq, (const PG8_LAS float*)lds_tab + (ui & 1) * Epi::NTAB * 64);
        if (!has_next) break;
#pragma unroll
        for (int a = 0; a < 2; ++a)
#pragma unroll
            for (int b = 0; b < 2; ++b)
#pragma unroll
                for (int m = 0; m < 4; ++m)
#pragma unroll
                    for (int n = 0; n < 2; ++n) acc[a][b][m][n] = AccT{};
        cur = nxt; cA = nA; cB = nB; ++ui;
        PG8_TABS(ui, cur);
        if constexpr (GATHER) {
#pragma unroll
            for (int h = 0; h < 2; ++h) { gvc[h][0] = gvn[h][0]; gvc[h][1] = gvn[h][1]; } }
        if constexpr (ALIGN_EPI) { if (wr == 1) PG8_BAR; }
    }
    PG8_WAIT_V(0);
    if constexpr (!ALIGN_EPI) { if (wr == 0) PG8_BAR; }
    PG8_BAR;
#undef PG8_SA
#undef PG8_SB
#undef PG8_STG
#undef PG8_STG_A
#undef PG8_STG_B
#undef PG8_GLOAD
#undef PG8_LDA
#undef PG8_LDB
#undef PG8_MMA
#undef PG8_WAIT_V
#undef PG8_TABS
#undef PG8_WAIT_V8R
#undef PG8_WAIT_L
#undef PG8_BAR
#undef PG8_SCHED
}
}

#ifndef PG8_ALIGN
#define PG8_ALIGN true
#endif
constexpr int NWAVES = 8;
constexpr int BATCH = 32, SEQ = 2048, DM = 1024, NLAYER = 2, NH = 4, HD = 64, NMEM = 256;
constexpr int T = BATCH * SEQ;
constexpr int MEMROWS = BATCH * NMEM;
constexpr int NIN = 7172, NPROJ = 3072, NGATE = 4096, NE = 16, DE = 512;
constexpr int FOX_F_COL = 768, GATE_COL = 3076;
constexpr float ALPHA = 1.4142135623730951f;
constexpr float LN_EPS = 1e-5f, GN_EPS = 1e-6f;
constexpr int LISTCAP = 65536;
constexpr int MAXU = 9;

constexpr size_t MiB = 1u << 20;
constexpr size_t WS_CTL = 0, CTL_ZERO_BYTES = 1 * MiB;
constexpr size_t WS_LF = 2 * MiB;
constexpr size_t WS_CC = 3 * MiB;
constexpr size_t WS_WT = 4 * MiB;
constexpr size_t WS_ROPE = 5 * MiB;
constexpr size_t WS_BIASP = 6 * MiB;
constexpr size_t WS_BIASG = 6 * MiB + 65536;
constexpr size_t WS_PAR = 7 * MiB;
constexpr int PAR_LNG = 0, PAR_LNB = 4096, PAR_WR = 8192, PAR_BR = 24576, PAR_LB = 24592, PAR_NG = 25104, PAR_WFF = 25232;
constexpr size_t WS_LIST = 8 * MiB;
constexpr size_t WS_W = 16 * MiB;
constexpr size_t W_IN = 0, W_G = 3 * MiB, W_B = 7 * MiB, W_OUT = 9 * MiB, W_E1 = 11 * MiB, W_E2 = 27 * MiB, W_LAYER = 43 * MiB;
constexpr size_t WS_WMEM = WS_W + 2 * W_LAYER;
constexpr size_t WS_MEMB = 104 * MiB;
constexpr size_t WS_MEMKV = 120 * MiB;
constexpr size_t WS_XB = 136 * MiB;
constexpr size_t WS_X8 = 264 * MiB;
constexpr size_t WS_X1B = 328 * MiB;
constexpr size_t WS_X18 = 456 * MiB;
constexpr size_t WS_PROJ = 520 * MiB;
constexpr size_t WS_U = 648 * MiB;
constexpr size_t WS_Y = 520 * MiB;
constexpr size_t WS_Y2 = 520 * MiB;
constexpr size_t WS_ACT = 648 * MiB;
constexpr size_t WS_END = 904 * MiB;
static_assert(WS_WMEM + 2 * MiB <= WS_MEMB && WS_U + (size_t)T * 4096 <= WS_END && WS_ACT + (size_t)135168 * 512 * 2 <= WS_END && WS_PROJ + (size_t)T * 3072 * 2 <= WS_END, "d_ws map");
constexpr size_t CM_IN = 256 * 1024, CM_E = 320 * 1024;
constexpr size_t WS_SX = 12 * MiB, WS_S1 = 12 * MiB + 512 * 1024;
constexpr size_t WS_SWP = 13 * MiB, WS_SWG = 13 * MiB + 65536, WS_SWE = 13 * MiB + 131072;
constexpr int CW_TMO = 0, CW_CODE = 1, CW_BAR = 4096, CW_CNT = 16384, CW_Q = 20480;

constexpr int RING_OFF = 0, RING_BYTES = 131072;
constexpr int GT_OFF = 131072, WTB_OFF = GT_OFF + MAXU * 1024, STB_OFF = WTB_OFF + MAXU * 1024, SM_OFF = STB_OFF + MAXU * 1024;
constexpr int EV_OFF = SM_OFF + 1024;
constexpr int LDSCTL_OFF = EV_OFF + 2048, MISC_OFF = LDSCTL_OFF + 320;
constexpr int LDS_BYTES = 163840;
static_assert(MISC_OFF + 128 <= LDS_BYTES, "LDS map");

#define GAS __attribute__((address_space(1)))
#define LAS __attribute__((address_space(3)))
typedef unsigned short bf16;
typedef unsigned v4u __attribute__((ext_vector_type(4)));
typedef unsigned v2u __attribute__((ext_vector_type(2)));
typedef float f32x4 __attribute__((ext_vector_type(4)));
typedef GAS unsigned gu32;
#define RLX_AGENT __ATOMIC_RELAXED, __HIP_MEMORY_SCOPE_AGENT
#define LDS_WAIT() asm volatile("s_waitcnt lgkmcnt(0)" ::: "memory")
#define VM_WAIT() asm volatile("s_waitcnt vmcnt(0)" ::: "memory")
__device__ __forceinline__ unsigned f2bf(float f) { unsigned u = __builtin_bit_cast(unsigned, f); return (u + 0x7fffu + ((u >> 16) & 1u)) >> 16; }
__device__ __forceinline__ unsigned pk2(float lo, float hi) { return pg8::cvt_pk_bf16(lo, hi); }
__device__ __forceinline__ float bfl(unsigned w) { return __uint_as_float(w << 16); }
__device__ __forceinline__ float bfh(unsigned w) { return __uint_as_float(w & 0xffff0000u); }
constexpr float PSCALE = 16.0f, BRSCALE = 8.0f;
template <bool DESCALE> __device__ __forceinline__ v4u f8x8_bf16(v2u w) {
    pg8::f32x2 a = __builtin_amdgcn_cvt_pk_f32_fp8((int)w.x, false), b = __builtin_amdgcn_cvt_pk_f32_fp8((int)w.x, true), c = __builtin_amdgcn_cvt_pk_f32_fp8((int)w.y, false), d = __builtin_amdgcn_cvt_pk_f32_fp8((int)w.y, true);
    if (DESCALE) { a = a * (1.0f / PSCALE); b = b * (1.0f / PSCALE); c = c * (1.0f / PSCALE); d = d * (1.0f / PSCALE); }
    return (v4u){pg8::cvt_pk_bf16(a.x, a.y), pg8::cvt_pk_bf16(b.x, b.y), pg8::cvt_pk_bf16(c.x, c.y), pg8::cvt_pk_bf16(d.x, d.y)};
}
__device__ __forceinline__ float bf1(bf16 h) { return __uint_as_float((unsigned)h << 16); }

#define XB_TMO      128
#define XB_XCNT(j)  (256  + 64 * (j))
#define XB_XSUB(j)  (1280 + 64 * (j))
#define XB_XGEN(j)  (2304 + 64 * (j))
#define XB_TOP      3328
#define XB_TOPGEN   3392
#define XCD_BAR_WORDS 3456
#define XB_SPIN_CAP (1u << 18)
__device__ __forceinline__ unsigned xb_ld(unsigned* p)              { return __hip_atomic_load(p, __ATOMIC_RELAXED, __HIP_MEMORY_SCOPE_AGENT); }
__device__ __forceinline__ unsigned xb_add(unsigned* p, unsigned v) { return __hip_atomic_fetch_add(p, v, __ATOMIC_RELAXED, __HIP_MEMORY_SCOPE_AGENT); }
__device__ __forceinline__ unsigned xb_xcc_id() { return (unsigned)__builtin_amdgcn_s_getreg((3 << 11) | 20) & 0xFu; }
#define XB_SPIN(cond, bar) do { unsigned _sp = 0; while (cond) { __builtin_amdgcn_s_sleep(1); \
    if ((++_sp & 255u) == 0u) { if (xb_ld(&(bar)[XB_TMO])) break; if (_sp > XB_SPIN_CAP) { atomicAdd(&(bar)[XB_TMO], 1u); break; } } } } while (0)
struct XcdBarrier { unsigned* bar; unsigned x; volatile LAS unsigned* st; };
__device__ __forceinline__ XcdBarrier xcd_barrier_post(unsigned* bar, volatile LAS unsigned* st) {
    XcdBarrier b; b.bar = bar; b.x = xb_xcc_id(); b.st = st;
    if (threadIdx.x == 0) (void)xb_add(&bar[XB_XCNT(b.x)], 1u);
    return b;
}
__device__ __forceinline__ void xcd_barrier_complete(unsigned* bar, unsigned x, unsigned& nloc, unsigned& nx) {
    const unsigned G = gridDim.x * gridDim.y * gridDim.z;
    unsigned sum, cnt, mine, sp = 0u;
    for (;;) {
        sum = 0u; cnt = 0u; mine = 0u;
#pragma unroll
        for (unsigned j = 0; j < 16; ++j) { const unsigned c = xb_ld(&bar[XB_XCNT(j)]); sum += c; cnt += (c > 0u) ? 1u : 0u; mine = (j == x) ? c : mine; }
        if (sum == G) break;
        __builtin_amdgcn_s_sleep(1);
        if ((++sp & 255u) == 0u) { if (xb_ld(&bar[XB_TMO])) break; if (sp > XB_SPIN_CAP) { atomicAdd(&bar[XB_TMO], 1u); break; } }
    }
    nloc = mine > 0u ? mine : 1u; nx = cnt > 0u ? cnt : 1u;
}
__device__ __forceinline__ void xcd_barrier(const XcdBarrier& b) {
    asm volatile("s_waitcnt vmcnt(0)" ::: "memory");
    __syncthreads();
    if (threadIdx.x == 0) {
        unsigned* bar = b.bar;
        __builtin_amdgcn_s_waitcnt(0);
        unsigned nloc = b.st[0], nx = b.st[1];
        if (nloc == 0u) { xcd_barrier_complete(bar, b.x, nloc, nx); b.st[0] = nloc; b.st[1] = nx; }
        const unsigned old = xb_add(&bar[XB_XSUB(b.x)], 1u);
        const unsigned gen = old / nloc;
        if (old + 1u == (gen + 1u) * nloc) {
            __builtin_amdgcn_fence(__ATOMIC_RELEASE, "agent");
            asm volatile("s_waitcnt vmcnt(0)" ::: "memory");
            const unsigned og = xb_add(&bar[XB_TOP], 1u);
            const unsigned tg = og / nx;
            if (og + 1u == (tg + 1u) * nx) xb_add(&bar[XB_TOPGEN], 1u);
            else XB_SPIN(xb_ld(&bar[XB_TOPGEN]) == tg, bar);
            __builtin_amdgcn_fence(__ATOMIC_ACQUIRE, "agent");
            xb_add(&bar[XB_XGEN(b.x)], 1u);
            asm volatile("s_waitcnt vmcnt(0)" ::: "memory");
        } else {
            XB_SPIN(xb_ld(&bar[XB_XGEN(b.x)]) == gen, bar);
            __builtin_amdgcn_fence(__ATOMIC_ACQUIRE, "agent");
            asm volatile("s_waitcnt vmcnt(0)" ::: "memory");
        }
    }
    __syncthreads();
}

struct Frame {
    LAS unsigned char* lds;
    volatile LAS unsigned* MISC;
    gu32* ctl;
    int tid, vcu, G, bx;
    float* out; unsigned char* ws;
};
#define OPAQUE_V(x) asm volatile("" : "+v"(x))
enum { I_X = 0, I_MEM, I_WIN, I_BIN, I_WMEMKV, I_LB, I_NORMG, I_WBRANCH, I_WOUT, I_LNG, I_LNB, I_WROUTER, I_BROUTER, I_WEIN, I_WEOUT };

template <int CTRL> __device__ __forceinline__ float dpp_f(float v) { return __builtin_bit_cast(float, __builtin_amdgcn_update_dpp(0, __builtin_bit_cast(int, v), CTRL, 0xF, 0xF, true)); }
constexpr int DPP_X1 = 0xB1, DPP_X2 = 0x4E, DPP_HMIR = 0x141, DPP_MIR = 0x140;
__device__ __forceinline__ float rl_f(float v, int l) { return __builtin_bit_cast(float, __builtin_amdgcn_readlane(__builtin_bit_cast(int, v), l)); }
__device__ __forceinline__ float wave_sum(float v) {
    v += dpp_f<DPP_X1>(v); v += dpp_f<DPP_X2>(v); v += dpp_f<DPP_HMIR>(v); v += dpp_f<DPP_MIR>(v);
    return (rl_f(v, 15) + rl_f(v, 31)) + (rl_f(v, 47) + rl_f(v, 63));
}
__device__ __forceinline__ float wave_max(float v) {
    v = fmaxf(v, dpp_f<DPP_X1>(v)); v = fmaxf(v, dpp_f<DPP_X2>(v)); v = fmaxf(v, dpp_f<DPP_HMIR>(v)); v = fmaxf(v, dpp_f<DPP_MIR>(v));
    return fmaxf(fmaxf(rl_f(v, 15), rl_f(v, 31)), fmaxf(rl_f(v, 47), rl_f(v, 63)));
}
__device__ __forceinline__ float sum8(float v) { v += dpp_f<DPP_X1>(v); v += dpp_f<DPP_X2>(v); v += dpp_f<DPP_HMIR>(v); return v; }
__device__ __forceinline__ float log_sigmoid(float z) { return z >= 0.f ? -log1pf(expf(-z)) : z - log1pf(expf(z)); }

__device__ __forceinline__ int src_col(int mode, int r) {
    if (mode == 1) { const int c = (r & ~255) + 64 * ((r >> 5) & 3) + 32 * ((r >> 7) & 1) + (r & 31); return c + ((r >> 8) >= 3 ? 4 : 0); }
    if (mode == 2) { const int nb = 2 * ((r >> 7) & 1) + ((r >> 4) & 1), d = 64 * (r >> 8) + 16 * ((r >> 5) & 3) + (r & 15); return GATE_COL + nb * 1024 + d; }
    if (mode == 3) { return ((r >> 7) & 1) * 512 + 128 * (r >> 8) + (r & 127); }
    return r;
}
__device__ __forceinline__ unsigned q8(float v, float inv) { int q = (int)rintf(v * inv); q = q > 127 ? 127 : (q < -127 ? -127 : q); return (unsigned)q & 255u; }
__device__ __forceinline__ unsigned q8x4(float a, float b, float c, float d, float inv) {
    const int ia = (int)rintf(a * inv), ib = (int)rintf(b * inv), ic = (int)rintf(c * inv), id = (int)rintf(d * inv);
    const unsigned lo = __builtin_bit_cast(unsigned, __builtin_amdgcn_cvt_pk_i16(ia, ib)), hi = __builtin_bit_cast(unsigned, __builtin_amdgcn_cvt_pk_i16(ic, id));
    return __builtin_amdgcn_perm(hi, lo, 0x06040200u);
}
__device__ __forceinline__ void store_row_i8(signed char* orow, float* srow, int lane, const f32x4 (&v)[4]) {
    float am = 0.f;
#pragma unroll
    for (int j = 0; j < 4; ++j) am = fmaxf(am, fmaxf(fmaxf(fabsf(v[j].x), fabsf(v[j].y)), fmaxf(fabsf(v[j].z), fabsf(v[j].w))));
    am = fmaxf(wave_max(am), 1e-30f);
    const float inv = 127.0f / am;
    GAS unsigned* o4 = (GAS unsigned*)orow + lane;
#pragma unroll
    for (int j = 0; j < 4; ++j) o4[64 * j] = q8x4(v[j].x, v[j].y, v[j].z, v[j].w, inv);
    if (lane == 0) *srow = am * (1.0f / 127.0f);
}
__device__ __forceinline__ void p0_transpose_item_q(const float* W, int K, int N, signed char* WT, int mode, const unsigned* cm, LAS float* scr, int item, int ndst32, int lane) {
    const int kb = item / ndst32, nb = item % ndst32, k0 = 64 * kb, n0 = 32 * nb;
    const int sc = src_col(mode, n0 + (lane & 31));
#pragma unroll 8
    for (int i = 0; i < 32; ++i) { const int kk = 2 * i + (lane >> 5); scr[kk * 33 + (lane & 31)] = W[(size_t)(k0 + kk) * N + sc]; }
    LDS_WAIT(); asm volatile("" ::: "memory");
    const int c = lane & 7;
#pragma unroll
    for (int j = 0; j < 4; ++j) { const int n = (lane >> 3) + 8 * j; const LAS float* sp = scr + (8 * c) * 33 + n;
        const float inv = 127.0f / fmaxf(__uint_as_float(cm[src_col(mode, n0 + n)]), 1e-30f);
        v2u o; o.x = q8x4(sp[0 * 33], sp[1 * 33], sp[2 * 33], sp[3 * 33], inv); o.y = q8x4(sp[4 * 33], sp[5 * 33], sp[6 * 33], sp[7 * 33], inv);
        *(GAS v2u*)(WT + (size_t)(n0 + n) * K + k0 + 8 * c) = o; }
    LDS_WAIT(); asm volatile("" ::: "memory");
}
__device__ __forceinline__ void p0_transpose_item(const float* W, int K, int N, bf16* WT, int mode, LAS float* scr, int item, int ndst32, int lane, float mul = 1.0f) {
    const int kb = item / ndst32, nb = item % ndst32, k0 = 64 * kb, n0 = 32 * nb;
    const int sc = src_col(mode, n0 + (lane & 31));
#pragma unroll 8
    for (int i = 0; i < 32; ++i) { const int kk = 2 * i + (lane >> 5); scr[kk * 33 + (lane & 31)] = W[(size_t)(k0 + kk) * N + sc]; }
    LDS_WAIT(); asm volatile("" ::: "memory");
    const int c = lane & 7;
#pragma unroll
    for (int j = 0; j < 4; ++j) { const int n = (lane >> 3) + 8 * j; const LAS float* s = scr + (8 * c) * 33 + n;
        v4u o; o.x = pk2(s[0 * 33] * mul, s[1 * 33] * mul); o.y = pk2(s[2 * 33] * mul, s[3 * 33] * mul); o.z = pk2(s[4 * 33] * mul, s[5 * 33] * mul); o.w = pk2(s[6 * 33] * mul, s[7 * 33] * mul);
        *(GAS v4u*)(WT + (size_t)(n0 + n) * K + k0 + 8 * c) = o; }
    LDS_WAIT(); asm volatile("" ::: "memory");
}
__device__ __forceinline__ void store_row_bf16(bf16* orow, int lane, const f32x4 (&v)[4]) {
    GAS unsigned long long* o8 = (GAS unsigned long long*)orow + lane;
#pragma unroll
    for (int j = 0; j < 4; ++j) o8[64 * j] = (unsigned long long)pk2(v[j].x, v[j].y) | ((unsigned long long)pk2(v[j].z, v[j].w) << 32);
}
__device__ __forceinline__ void load_row_fp8(const unsigned char* irow, int lane, f32x4 (&v)[4]) {
    const GAS int* i4 = (const GAS int*)irow + lane;
#pragma unroll
    for (int j = 0; j < 4; ++j) { const int w = i4[64 * j]; const pg8::f32x2 a = __builtin_amdgcn_cvt_pk_f32_fp8(w, false), b = __builtin_amdgcn_cvt_pk_f32_fp8(w, true); v[j] = (f32x4){a.x, a.y, b.x, b.y} * 0.03125f; }
}
__device__ __forceinline__ void load_row_bf16(const bf16* irow, int lane, f32x4 (&v)[4]) {
    const GAS v2u* i8 = (const GAS v2u*)irow + lane;
#pragma unroll
    for (int j = 0; j < 4; ++j) { const v2u w = i8[64 * j]; v[j] = (f32x4){bfl(w.x), bfh(w.x), bfl(w.y), bfh(w.y)}; }
}
__device__ __forceinline__ void forget_row(const f32x4 (&v)[4], const LAS float* wff, float* lfrow, int lane) {
    float p[4];
#pragma unroll
    for (int h = 0; h < 4; ++h) { pg8::f32x2 s2 = {0.f, 0.f};
#pragma unroll
        for (int j = 0; j < 4; ++j) { const f32x4 w = *(const LAS f32x4*)(wff + h * 1024 + 256 * j + 4 * lane); s2 = (pg8::f32x2){v[j].x, v[j].y} * (pg8::f32x2){w.x, w.y} + s2; s2 = (pg8::f32x2){v[j].z, v[j].w} * (pg8::f32x2){w.z, w.w} + s2; }
        p[h] = wave_sum(s2.x + s2.y) + wff[4096 + h]; }
    if (lane < 4) { const float z = lane == 0 ? p[0] : lane == 1 ? p[1] : lane == 2 ? p[2] : p[3]; lfrow[lane] = log_sigmoid(z); }
}
__device__ __forceinline__ void stage_wff(Frame& F, int l, LAS float* wff) {
    const float* src = (const float*)(F.ws + WS_PAR) + PAR_WFF + l * 4100;
    for (int idx = F.tid; idx < 4100; idx += NWAVES * 64) wff[idx] = src[idx];
}

struct Args { const float* in[15]; float* out; unsigned char* ws; int naive, pad; };
__device__ __forceinline__ void p0_colmax(Frame& F, const Args& A) {
    const int p_lane = F.tid & 63, p_wave = __builtin_amdgcn_readfirstlane(F.tid >> 6);
    const int gw = F.vcu * NWAVES + p_wave, NGW = F.G * NWAVES;
    constexpr int CB_IN = (NIN + 63) / 64, PER_L = (CB_IN + 256) * 8;
    for (int it = gw; it < NLAYER * PER_L; it += NGW) { const int l = it / PER_L, r = it % PER_L, seg = r & 7, cbk = r >> 3;
        const float* W; int N, col; unsigned* cm;
        if (cbk < CB_IN) { W = A.in[I_WIN] + (size_t)l * DM * NIN; N = NIN; col = cbk * 64 + p_lane; cm = (unsigned*)(F.ws + CM_IN) + l * NIN; }
        else { const int e = (cbk - CB_IN) >> 4, cb = (cbk - CB_IN) & 15; W = A.in[I_WEIN] + ((size_t)l * 16 + e) * 1024 * 1024; N = 1024; col = cb * 64 + p_lane; cm = (unsigned*)(F.ws + CM_E) + (l * 16 + e) * 1024; }
        if (col < N) { float m = 0.f; const float* p = W + (size_t)(seg * 128) * N + col;
#pragma unroll 16
            for (int rr = 0; rr < 128; ++rr) m = fmaxf(m, fabsf(p[(size_t)rr * N]));
            __hip_atomic_fetch_max(cm + col, __float_as_uint(m), RLX_AGENT); } }
}
__device__ __forceinline__ void p0_strips(Frame& F, const Args& A) {
    const int tid = F.tid, lane = tid & 63, wave = __builtin_amdgcn_readfirstlane(tid >> 6);
    LAS float* sb = (LAS float*)(F.lds + RING_OFF);
    LAS float* pm = (LAS float*)(F.lds + GT_OFF);
    constexpr int SPL = 96 + 128 + 512, NSTRIP = NLAYER * SPL;
    struct SD { const float* W; int N, mode, r0; signed char* WT; float* sc; float mul; };
    auto desc = [&](int s_) -> SD { SD d; const int l = s_ / SPL, r = s_ % SPL; unsigned char* wl = F.ws + WS_W + (size_t)l * W_LAYER;
        if (r < 96) { d.W = A.in[I_WIN] + (size_t)l * DM * NIN; d.N = NIN; d.mode = 1; d.r0 = 32 * r; d.WT = (signed char*)(wl + W_IN); d.sc = (float*)(F.ws + WS_SWP) + l * NPROJ; d.mul = 1.0f / 127.0f; }
        else if (r < 224) { d.W = A.in[I_WIN] + (size_t)l * DM * NIN; d.N = NIN; d.mode = 2; d.r0 = 32 * (r - 96); d.WT = (signed char*)(wl + W_G); d.sc = (float*)(F.ws + WS_SWG) + l * NGATE; d.mul = -1.4426950408889634f / 127.0f; }
        else { const int rr = r - 224, e = rr >> 5; d.W = A.in[I_WEIN] + ((size_t)l * 16 + e) * 1024 * 1024; d.N = 1024; d.mode = 3; d.r0 = 32 * (rr & 31); d.WT = (signed char*)(wl + W_E1) + (size_t)e * 1024 * 1024; d.sc = (float*)(F.ws + WS_SWE) + (l * 16 + e) * 1024; d.mul = 1.0f / 127.0f; }
        return d; };
    f32x4 raw[16];
    auto issue = [&](const SD& d) {
#pragma unroll
        for (int j = 0; j < 16; ++j) { const int idx = tid + 512 * j, k = idx >> 3, q = idx & 7; raw[j] = *(const GAS f32x4*)(d.W + (size_t)k * d.N + src_col(d.mode, d.r0 + 4 * q)); } };
    int s_ = F.vcu;
    SD cur = desc(s_ < NSTRIP ? s_ : 0); issue(cur);
    for (; s_ < NSTRIP; s_ += F.G) {
#pragma unroll
        for (int j = 0; j < 16; ++j) { const int idx = tid + 512 * j; *(LAS f32x4*)(sb + (idx >> 3) * 32 + 4 * (idx & 7)) = raw[j]; }
        const SD nxt = desc(s_ + F.G < NSTRIP ? s_ + F.G : s_); issue(nxt);
        __syncthreads();
        const int n = lane & 31, kg = wave * 2 + (lane >> 5);
        float v[64]; float m = 0.f;
#pragma unroll
        for (int i = 0; i < 64; ++i) { v[i] = sb[(64 * kg + i) * 32 + n]; m = fmaxf(m, fabsf(v[i])); }
        pm[n * 16 + kg] = m;
        __syncthreads();
        float cm = 0.f;
#pragma unroll
        for (int g = 0; g < 4; ++g) { const f32x4 t4 = *(const LAS f32x4*)(pm + n * 16 + 4 * g); cm = fmaxf(cm, fmaxf(fmaxf(t4.x, t4.y), fmaxf(t4.z, t4.w))); }
        cm = fmaxf(cm, 1e-30f);
        const float inv = 127.0f / cm;
        signed char* orow = cur.WT + (size_t)(cur.r0 + n) * 1024 + 64 * kg;
#pragma unroll
        for (int g = 0; g < 4; ++g) { v4u o; o.x = q8x4(v[16 * g + 0], v[16 * g + 1], v[16 * g + 2], v[16 * g + 3], inv); o.y = q8x4(v[16 * g + 4], v[16 * g + 5], v[16 * g + 6], v[16 * g + 7], inv);
            o.z = q8x4(v[16 * g + 8], v[16 * g + 9], v[16 * g + 10], v[16 * g + 11], inv); o.w = q8x4(v[16 * g + 12], v[16 * g + 13], v[16 * g + 14], v[16 * g + 15], inv); *(GAS v4u*)(orow + 16 * g) = o; }
        if (kg == 0) cur.sc[cur.r0 + n] = cm * cur.mul;
        cur = nxt;
    }
    __syncthreads();
}
template <int K, bool OUT8 = false, class Desc>
__device__ __forceinline__ void p0_strips_bf16(Frame& F, int nstrip, const Desc& desc) {
    const int tid = F.tid, lane = tid & 63, wave = __builtin_amdgcn_readfirstlane(tid >> 6);
    LAS float* sb = (LAS float*)(F.lds + RING_OFF);
    constexpr int NL = K / 64, KPT = K / 16;
    struct BD { const float* W; int N, r0; bf16* WT; float mul; };
    f32x4 raw[NL];
    auto issue = [&](const BD& d) {
#pragma unroll
        for (int j = 0; j < NL; ++j) { const int idx = tid + 512 * j, k = idx >> 3, q = idx & 7; raw[j] = *(const GAS f32x4*)(d.W + (size_t)k * d.N + d.r0 + 4 * q); } };
    int s_ = F.vcu;
    BD cur; { const int c_ = s_ < nstrip ? s_ : 0; desc(c_, cur.W, cur.N, cur.r0, cur.WT, cur.mul); } issue(cur);
    for (; s_ < nstrip; s_ += F.G) {
#pragma unroll
        for (int j = 0; j < NL; ++j) { const int idx = tid + 512 * j; *(LAS f32x4*)(sb + (idx >> 3) * 32 + 4 * (idx & 7)) = raw[j]; }
        BD nxt; { const int c_ = s_ + F.G < nstrip ? s_ + F.G : s_; desc(c_, nxt.W, nxt.N, nxt.r0, nxt.WT, nxt.mul); } issue(nxt);
        __syncthreads();
        const int n = lane & 31, kg = wave * 2 + (lane >> 5);
        bf16* orow = cur.WT + (size_t)(cur.r0 + n) * K + KPT * kg;
        unsigned char* orow8 = (unsigned char*)cur.WT + (size_t)(cur.r0 + n) * K + KPT * kg;
#pragma unroll
        for (int g = 0; g < KPT / 8; ++g) { float v[8];
#pragma unroll
            for (int i = 0; i < 8; ++i) v[i] = sb[(KPT * kg + 8 * g + i) * 32 + n] * cur.mul;
            if (OUT8) { v2u o; o.x = pg8::pk_fp8x4(v[0], v[1], v[2], v[3]); o.y = pg8::pk_fp8x4(v[4], v[5], v[6], v[7]); *(GAS v2u*)(orow8 + 8 * g) = o; }
            else { v4u o; o.x = pk2(v[0], v[1]); o.y = pk2(v[2], v[3]); o.z = pk2(v[4], v[5]); o.w = pk2(v[6], v[7]); *(GAS v4u*)(orow + 8 * g) = o; } }
        __syncthreads();
        cur = nxt;
    }
}
__device__ __forceinline__ void p0_prologue(Frame& F, const Args& A) {
    const int p_lane = F.tid & 63, p_wave = __builtin_amdgcn_readfirstlane(F.tid >> 6);
    LAS float* scr = (LAS float*)(F.lds + RING_OFF + p_wave * 8704);
    LAS float* wff = (LAS float*)(F.lds + RING_OFF + 81920);
    const int gw = F.vcu * NWAVES + p_wave, NGW = F.G * NWAVES;
    p0_strips(F, A);
    p0_strips_bf16<256, true>(F, NLAYER * 4 * 32, [&](int c, const float*& W, int& N, int& r0, bf16*& WT, float& mul) { const int l = c >> 7, nb = (c >> 5) & 3; W = A.in[I_WBRANCH] + ((size_t)l * 4 + nb) * 256 * 1024; N = 1024; r0 = 32 * (c & 31);
        WT = (bf16*)(F.ws + WS_W + (size_t)l * W_LAYER + W_B + (size_t)nb * 1024 * 256); mul = 32.0f; });
    p0_strips_bf16<1024, true>(F, NLAYER * 32, [&](int c, const float*& W, int& N, int& r0, bf16*& WT, float& mul) {
        const int l = c >> 5; W = A.in[I_WOUT] + (size_t)l * 1024 * 1024; N = 1024; r0 = 32 * (c & 31); WT = (bf16*)(F.ws + WS_W + (size_t)l * W_LAYER + W_OUT); mul = 32.0f; });
    p0_strips_bf16<1024>(F, NLAYER * 16, [&](int c, const float*& W, int& N, int& r0, bf16*& WT, float& mul) {
        const int l = c >> 4; W = A.in[I_WMEMKV] + (size_t)l * 1024 * 512; N = 512; r0 = 32 * (c & 15); WT = (bf16*)(F.ws + WS_WMEM) + (size_t)l * 512 * 1024; mul = 1.0f; });
    p0_strips_bf16<512, true>(F, NLAYER * 16 * 32, [&](int c, const float*& W, int& N, int& r0, bf16*& WT, float& mul) { const int l = c >> 9, e = (c >> 5) & 15; W = A.in[I_WEOUT] + ((size_t)l * 16 + e) * 512 * 1024; N = 1024; r0 = 32 * (c & 31);
        WT = (bf16*)(F.ws + WS_W + (size_t)l * W_LAYER + W_E2 + (size_t)e * 1024 * 512); mul = 64.0f; });
    { const float* Win0 = A.in[I_WIN]; const float* bin0 = A.in[I_BIN];
      for (int idx = F.tid; idx < 4096; idx += NWAVES * 64) { const int k = idx >> 2, h = idx & 3; wff[h * 1024 + k] = Win0[(size_t)k * NIN + FOX_F_COL + h]; }
      if (F.tid < 4) wff[4096 + F.tid] = bin0[FOX_F_COL + F.tid]; }
    { const int gt = blockIdx.x * (NWAVES * 64) + F.tid, NGT = F.G * NWAVES * 64;
      float* bp = (float*)(F.ws + WS_BIASP); float* bg = (float*)(F.ws + WS_BIASG);
      for (int i = gt; i < NLAYER * NPROJ; i += NGT) { const int l = i / NPROJ, r = i % NPROJ; bp[i] = A.in[I_BIN][(size_t)l * NIN + src_col(1, r)]; }
      for (int i = gt; i < NLAYER * NGATE; i += NGT) { const int l = i / NGATE, r = i % NGATE; bg[i] = -1.4426950408889634f * A.in[I_BIN][(size_t)l * NIN + src_col(2, r)]; }
      float* rc = (float*)(F.ws + WS_ROPE); float* rs = rc + SEQ * 32;
      for (int i = gt; i < SEQ * 32; i += NGT) { const int pos = i >> 5, f = i & 31; const float inv = powf(10000.0f, -2.0f * (float)f / 64.0f); const float ang = (float)pos * inv; rc[i] = cosf(ang); rs[i] = sinf(ang); }
      float* par = (float*)(F.ws + WS_PAR);
      for (int i = gt; i < 4096; i += NGT) { par[PAR_LNG + i] = A.in[I_LNG][i]; par[PAR_LNB + i] = A.in[I_LNB][i]; }
      for (int i = gt; i < 16384; i += NGT) par[PAR_WR + i] = A.in[I_WROUTER][i];
      for (int i = gt; i < 16; i += NGT) par[PAR_BR + i] = A.in[I_BROUTER][i];
      for (int i = gt; i < 512; i += NGT) par[PAR_LB + i] = A.in[I_LB][i];
      for (int i = gt; i < 128; i += NGT) par[PAR_NG + i] = A.in[I_NORMG][i];
      for (int i = gt; i < NLAYER * 4096; i += NGT) { const int l = i >> 12, k = (i & 4095) >> 2, h = i & 3; par[PAR_WFF + l * 4100 + h * 1024 + k] = A.in[I_WIN][((size_t)l * DM + k) * NIN + FOX_F_COL + h]; }
      for (int i = gt; i < NLAYER * 4; i += NGT) { const int l = i >> 2, h = i & 3; par[PAR_WFF + l * 4100 + 4096 + h] = A.in[I_BIN][(size_t)l * NIN + FOX_F_COL + h]; } }
    __syncthreads();
    { const int hf = p_lane >> 5, l5 = p_lane & 31;
      f32x4 nx[8];
#define P0_LOAD(pp) do { const GAS f32x4* xr_ = (const GAS f32x4*)(A.in[I_X] + (size_t)(2 * (pp) + hf) * DM) + l5; _Pragma("unroll") for (int j = 0; j < 8; ++j) nx[j] = xr_[32 * j]; } while (0)
      P0_LOAD(gw);
      for (int pi = gw; pi < T / 2; pi += NGW) {
        const size_t m = (size_t)2 * pi + hf;
        f32x4 v[8];
#pragma unroll
        for (int j = 0; j < 8; ++j) v[j] = nx[j];
        { const int pn = pi + NGW < T / 2 ? pi + NGW : pi; P0_LOAD(pn); } asm volatile("" ::: "memory");
        float am = 0.f;
#pragma unroll
        for (int j = 0; j < 8; ++j) am = fmaxf(am, fmaxf(fmaxf(fabsf(v[j].x), fabsf(v[j].y)), fmaxf(fabsf(v[j].z), fabsf(v[j].w))));
        am = fmaxf(am, dpp_f<DPP_X1>(am)); am = fmaxf(am, dpp_f<DPP_X2>(am)); am = fmaxf(am, dpp_f<DPP_HMIR>(am)); am = fmaxf(am, dpp_f<DPP_MIR>(am));
        am = fmaxf(hf ? fmaxf(rl_f(am, 47), rl_f(am, 63)) : fmaxf(rl_f(am, 15), rl_f(am, 31)), 1e-30f);
        const float inv = 127.0f / am;
        GAS unsigned* o4 = (GAS unsigned*)((signed char*)(F.ws + WS_X8) + m * DM) + l5;
#pragma unroll
        for (int j = 0; j < 8; ++j) o4[32 * j] = q8x4(v[j].x, v[j].y, v[j].z, v[j].w, inv);
        if (l5 == 0) ((float*)(F.ws + WS_SX))[m] = am * (1.0f / 127.0f);
        float ph[4];
#pragma unroll
        for (int h = 0; h < 4; ++h) { pg8::f32x2 s2 = {0.f, 0.f};
#pragma unroll
            for (int j = 0; j < 8; ++j) { const f32x4 w = *(const LAS f32x4*)(wff + h * 1024 + 128 * j + 4 * l5); s2 = (pg8::f32x2){v[j].x, v[j].y} * (pg8::f32x2){w.x, w.y} + s2; s2 = (pg8::f32x2){v[j].z, v[j].w} * (pg8::f32x2){w.z, w.w} + s2; }
            float t = s2.x + s2.y; t += dpp_f<DPP_X1>(t); t += dpp_f<DPP_X2>(t); t += dpp_f<DPP_HMIR>(t); t += dpp_f<DPP_MIR>(t);
            ph[h] = (hf ? rl_f(t, 47) + rl_f(t, 63) : rl_f(t, 15) + rl_f(t, 31)) + wff[4096 + h]; }
        if (l5 < 4) { const float z = l5 == 0 ? ph[0] : l5 == 1 ? ph[1] : l5 == 2 ? ph[2] : ph[3]; ((float*)(F.ws + WS_LF))[m * 4 + l5] = log_sigmoid(z); }
      }
#undef P0_LOAD
    }
    for (int m = gw; m < MEMROWS; m += NGW) {
        const GAS f32x4* xr = (const GAS f32x4*)(A.in[I_MEM] + (size_t)m * DM) + p_lane;
        f32x4 v[4];
#pragma unroll
        for (int j = 0; j < 4; ++j) v[j] = xr[64 * j];
        store_row_bf16((bf16*)(F.ws + WS_MEMB) + (size_t)m * DM, p_lane, v);
    }
}

__device__ __forceinline__ void cc_scan(Frame& F) {
    int tid_ = F.tid; OPAQUE_V(tid_); const int c_lane = tid_ & 63, c_wave = __builtin_amdgcn_readfirstlane(tid_ >> 6);
    if (F.bx < BATCH * NH && c_wave == 0) {
        const int bh = F.bx, b = bh >> 2, h = bh & 3, s0 = 32 * c_lane;
        const float* lf = (const float*)(F.ws + WS_LF) + ((size_t)b * SEQ + s0) * 4 + h;
        float loc[32]; float run = 0.f;
#pragma unroll
        for (int i = 0; i < 32; ++i) { run += lf[4 * i]; loc[i] = run; }
        float incl = run;
#pragma unroll
        for (int o = 1; o < 64; o <<= 1) { const float t = __shfl_up(incl, o); if (c_lane >= o) incl += t; }
        const float excl = incl - run;
        float* cc = (float*)(F.ws + WS_CC) + (size_t)bh * SEQ + s0;
#pragma unroll
        for (int i = 0; i < 32; ++i) cc[i] = excl + loc[i];
    }
}

namespace att {
typedef float f32x16 __attribute__((ext_vector_type(16)));
typedef short bf16x8 __attribute__((ext_vector_type(8)));
typedef short s16x4 __attribute__((ext_vector_type(4)));
typedef short v4i16_t __attribute__((ext_vector_type(4)));
constexpr int KBUF = 0, VBUF = 16384, KB_OFF = 32768, ATT_LDS = 32768 + 8192;
constexpr float C2 = 0.125f * 1.4426950408889634f;
__device__ __forceinline__ int crow(int r, int hi) { return (r & 3) + 8 * (r >> 2) + 4 * hi; }
__device__ __forceinline__ s16x4 vtr(const LAS char* p) { return __builtin_bit_cast(s16x4, __builtin_amdgcn_ds_read_tr16_b64_v4i16((LAS v4i16_t*)p)); }
template <bool CAUSAL>
__device__ __forceinline__ void attn_unit(LAS char* lds, const unsigned char* pj, int qrow, int qcol, int krow, int kcol, int vcol, const void* Kp_, const void* Vp_, int kvpitch, int ntiles, int q0, const float* ccp, unsigned char* Op, int opitch, int tid) {
    constexpr float C2 = att::C2 / (CAUSAL ? PSCALE * PSCALE : PSCALE);
    const int lane = tid & 63, wid = __builtin_amdgcn_readfirstlane(tid >> 6), r32 = lane & 31, hi = lane >> 5;
    LAS float* kb = (LAS float*)(lds + KB_OFF);
    if (CAUSAL) { for (int k = tid; k < ntiles * 64; k += 512) kb[k] = -1.4426950408889634f * ccp[k]; }
    bf16x8 qr[4];
    long q8[4];
#pragma unroll
    for (int d0 = 0; d0 < 4; ++d0) { const v2u qw = *(const v2u*)(pj + pg8::pjoff(qrow + 32 * wid + r32, qcol + 16 * d0 + 8 * hi)); q8[d0] = __builtin_bit_cast(long, qw); qr[d0] = __builtin_bit_cast(bf16x8, f8x8_bf16<false>(qw)); }
    const int kvr = tid >> 3, ch = tid & 7;
    const size_t kvoff = (size_t)kvr * kvpitch + ch * 8;
    const unsigned char* kg8 = pj + pg8::pjoff(krow + kvr, kcol + ch * 8); const unsigned char* vg8 = pj + pg8::pjoff(krow + kvr, vcol + ch * 8);
    const bf16* kg = (const bf16*)Kp_ + kvoff; const bf16* vg = (const bf16*)Vp_ + kvoff;
    const int kl = ch * 1024 + kvr * 16, vl = (ch >> 2) * 4096 + kvr * 64 + (ch & 3) * 16;
    v4u kreg = {0u, 0u, 0u, 0u}, vreg = kreg; v2u kreg8 = {0u, 0u}, vreg8 = kreg8;
#define ATT_LDKV(tt) do { if (CAUSAL) { kreg8 = *(const v2u*)(kg8 + (size_t)(tt) * (4 * 16 * 3072)); vreg8 = *(const v2u*)(vg8 + (size_t)(tt) * (4 * 16 * 3072)); } \
                          else { kreg = *(const v4u*)(kg + (size_t)(tt) * 64 * kvpitch); vreg = *(const v4u*)(vg + (size_t)(tt) * 64 * kvpitch); } } while (0)
#define ATT_STKV(boff) do { if (CAUSAL) { vreg = f8x8_bf16<false>(vreg8); *(LAS v2u*)(lds + KBUF + (boff) + (kl >> 1)) = kreg8; }     \
                            else *(LAS v4u*)(lds + KBUF + (boff) + kl) = kreg; \
                            *(LAS v4u*)(lds + VBUF + (boff) + vl) = vreg; } while (0)
    ATT_LDKV(0); ATT_STKV(0);
    __syncthreads();
    const int qabs = q0 + 32 * wid + r32, qwmax = q0 + 32 * wid + 31;
    float mrun = CAUSAL ? kb[qabs] : 0.f, lrun = 0.f; f32x16 o0 = {}, o1 = {};
    f32x16 cinit;
#pragma unroll
    for (int r = 0; r < 16; ++r) cinit[r] = -mrun * (1.0f / C2);
    const int vrd = (4 * hi + ((lane & 15) >> 2)) * 64 + ((lane >> 4) & 1) * 32 + (lane & 3) * 8;
    for (int t = 0; t < ntiles; ++t) {
        const int buf = (t & 1) * 8192;
        if (t + 1 < ntiles) ATT_LDKV(t + 1);
        const int kv0 = 64 * t;
        if (!CAUSAL || kv0 <= qwmax) {
            const LAS char* Kb = lds + KBUF + buf; const LAS char* Vb = lds + VBUF + buf;
            const bool band = t >= ntiles - 4;
            f32x16 p0, p1;
            auto scores = [&]() {
                p0 = cinit; p1 = cinit;
#pragma unroll
                for (int d0 = 0; d0 < 4; ++d0) {
                    if (CAUSAL) { const long a0 = *(const LAS long*)(Kb + (2 * d0 + hi) * 512 + r32 * 8), a1 = *(const LAS long*)(Kb + (2 * d0 + hi) * 512 + (32 + r32) * 8);
                        p0 = __builtin_amdgcn_mfma_f32_32x32x16_fp8_fp8(a0, q8[d0], p0, 0, 0, 0); p1 = __builtin_amdgcn_mfma_f32_32x32x16_fp8_fp8(a1, q8[d0], p1, 0, 0, 0); }
                    else { const bf16x8 a0 = *(const LAS bf16x8*)(Kb + (2 * d0 + hi) * 1024 + r32 * 16), a1 = *(const LAS bf16x8*)(Kb + (2 * d0 + hi) * 1024 + (32 + r32) * 16);
                        p0 = __builtin_amdgcn_mfma_f32_32x32x16_bf16(a0, qr[d0], p0, 0, 0, 0); p1 = __builtin_amdgcn_mfma_f32_32x32x16_bf16(a1, qr[d0], p1, 0, 0, 0); } }
#pragma unroll
                for (int g = 0; g < 4; ++g) { f32x4 b0 = {0.f, 0.f, 0.f, 0.f}, b1 = {0.f, 0.f, 0.f, 0.f};
                    if (CAUSAL) { b0 = *(const LAS f32x4*)(kb + kv0 + 8 * g + 4 * hi); b1 = *(const LAS f32x4*)(kb + kv0 + 32 + 8 * g + 4 * hi); }
#pragma unroll
                    for (int j = 0; j < 4; ++j) { const int r = 4 * g + j; float s0 = p0[r] * C2 + b0[j], s1 = p1[r] * C2 + b1[j];
                        if (CAUSAL && band) { const int kv = kv0 + 8 * g + 4 * hi + j; if (kv > qabs) s0 = -INFINITY; if (kv + 32 > qabs) s1 = -INFINITY; }
                        p0[r] = s0; p1[r] = s1; } } };
            scores();
            float rs = 0.f;
#pragma unroll
            for (int r = 0; r < 16; ++r) { p0[r] = __builtin_amdgcn_exp2f(p0[r]); p1[r] = __builtin_amdgcn_exp2f(p1[r]); rs += p0[r] + p1[r]; }
            if (__any(!(rs < 1.0995116e12f))) {
                scores();
                float mx = -1e30f;
#pragma unroll
                for (int r = 0; r < 16; ++r) mx = fmaxf(mx, fmaxf(p0[r], p1[r]));
                mx = fmaxf(mx, __shfl_xor(mx, 32));
                const float dl = mx > 0.f ? mx : 0.f, alpha = __builtin_amdgcn_exp2f(-dl); mrun += dl; lrun *= alpha;
                rs = 0.f;
#pragma unroll
                for (int r = 0; r < 16; ++r) { o0[r] *= alpha; o1[r] *= alpha; cinit[r] = -mrun * (1.0f / C2); p0[r] = __builtin_amdgcn_exp2f(p0[r] - dl); p1[r] = __builtin_amdgcn_exp2f(p1[r] - dl); rs += p0[r] + p1[r]; } }
            lrun += rs;
            bf16x8 pf[4];
#pragma unroll
            for (int s = 0; s < 2; ++s) { pg8::u32x4 w0, w1;
                w0.x = pg8::cvt_pk_bf16(p0[8 * s + 0], p0[8 * s + 1]); w0.y = pg8::cvt_pk_bf16(p0[8 * s + 2], p0[8 * s + 3]); w0.z = pg8::cvt_pk_bf16(p0[8 * s + 4], p0[8 * s + 5]); w0.w = pg8::cvt_pk_bf16(p0[8 * s + 6], p0[8 * s + 7]);
                w1.x = pg8::cvt_pk_bf16(p1[8 * s + 0], p1[8 * s + 1]); w1.y = pg8::cvt_pk_bf16(p1[8 * s + 2], p1[8 * s + 3]); w1.z = pg8::cvt_pk_bf16(p1[8 * s + 4], p1[8 * s + 5]); w1.w = pg8::cvt_pk_bf16(p1[8 * s + 6], p1[8 * s + 7]);
                pf[s] = __builtin_bit_cast(bf16x8, w0); pf[2 + s] = __builtin_bit_cast(bf16x8, w1); }
#pragma unroll
            for (int s = 0; s < 4; ++s) {
                const s16x4 l0 = vtr(Vb + vrd + s * 1024), h0 = vtr(Vb + vrd + s * 1024 + 512), l1 = vtr(Vb + 4096 + vrd + s * 1024), h1 = vtr(Vb + 4096 + vrd + s * 1024 + 512);
                const bf16x8 va = (bf16x8){l0[0], l0[1], l0[2], l0[3], h0[0], h0[1], h0[2], h0[3]}, vb = (bf16x8){l1[0], l1[1], l1[2], l1[3], h1[0], h1[1], h1[2], h1[3]};
                o0 = __builtin_amdgcn_mfma_f32_32x32x16_bf16(va, pf[s], o0, 0, 0, 0); o1 = __builtin_amdgcn_mfma_f32_32x32x16_bf16(vb, pf[s], o1, 0, 0, 0); }
        }
        if (t + 1 < ntiles) ATT_STKV(buf ^ 8192);
        __syncthreads();
    }
#undef ATT_LDKV
#undef ATT_STKV
    const float inv = (CAUSAL ? BRSCALE / PSCALE : BRSCALE) / (lrun + __shfl_xor(lrun, 32));
    unsigned char* orow = Op + (size_t)(32 * wid + r32) * opitch + 4 * hi;
#pragma unroll
    for (int g = 0; g < 4; ++g) { *(unsigned*)(orow + 8 * g) = pg8::pk_fp8x4(o0[4 * g] * inv, o0[4 * g + 1] * inv, o0[4 * g + 2] * inv, o0[4 * g + 3] * inv);
        *(unsigned*)(orow + 32 + 8 * g) = pg8::pk_fp8x4(o1[4 * g] * inv, o1[4 * g + 1] * inv, o1[4 * g + 2] * inv, o1[4 * g + 3] * inv); }
}
}
__device__ __forceinline__ void attn_phase(Frame& F, int l) {
    int tid = F.tid; OPAQUE_V(tid);
    LAS char* lds = (LAS char*)(F.lds + RING_OFF);
    const unsigned char* proj = (const unsigned char*)(F.ws + WS_PROJ); const bf16* memkv = (const bf16*)(F.ws + WS_MEMKV); const float* cc = (const float*)(F.ws + WS_CC); unsigned char* br = (unsigned char*)F.out;
    LAS int* qslot = (LAS int*)(F.lds + SM_OFF + 512);
    for (;;) {
        __syncthreads();
        if (tid == 0) *qslot = (int)__hip_atomic_fetch_add((unsigned*)(F.ctl + CW_Q + l * 64), 1u, RLX_AGENT);
        __syncthreads();
        const int it = *qslot;
        if (it >= 768) break;
        if (it < 512) { const int bh = it >> 2, pi = it & 3, b = bh >> 2, h = bh & 3; const size_t row0 = (size_t)b * SEQ;
            for (int k = 0; k < 2; ++k) { const int qb = k ? 7 - pi : pi, q0 = qb * 256;
                att::attn_unit<true>(lds, proj, (int)row0 + q0, h * 64, (int)row0, 256 + h * 64, 512 + h * 64, nullptr, nullptr, 0, q0 / 64 + 4, q0, cc + (size_t)bh * SEQ,
                                     br + (row0 + q0) * 1024 + h * 64, 1024, tid); } }
        else { for (int k = 0; k < 4; ++k) { const int u = (it - 512) * 4 + k; const int bh = u >> 3, qb = u & 7, b = bh >> 2, h = bh & 3, q0 = qb * 256; const size_t row0 = (size_t)b * SEQ;
                const bf16* kp = memkv + (size_t)b * NMEM * 1024 + l * 512 + h * 64;
                att::attn_unit<false>(lds, proj, (int)row0 + q0, 2816 + h * 64, 0, 0, 0, kp, kp + 256, 1024, NMEM / 64, q0, nullptr, br + (row0 + q0) * 1024 + 768 + h * 64, 1024, tid); } }
    }
}

namespace rec {
using att::f32x16; using att::bf16x8; using att::s16x4; using att::vtr;
constexpr int OPB = 40960;
constexpr int Q1C = 0, Q2C = 8192, K1C = 16384, K2V = 24576, VV = 32768, ST0 = 81920, OFO = 98304, OFB = 17408, TOTO = 133120, DECO = 137216;
constexpr int OFP = 68;
__device__ __forceinline__ v2u pk4(float a, float b, float c, float d) { v2u w; w.x = pg8::cvt_pk_bf16(a, b); w.y = pg8::cvt_pk_bf16(c, d); return w; }
template <bool HG>
__device__ __forceinline__ void recur_unit(LAS char* lds, const unsigned char* pj, int prow0, int pcol, unsigned char* ob, int h, int l, const float* par, const float* rope, int tid) {
    const int lane = tid & 63, wid = __builtin_amdgcn_readfirstlane(tid >> 6), r32 = lane & 31, hi = lane >> 5;
    const int t = tid >> 3, c8 = tid & 7;
    constexpr int NCH = SEQ / 64;
    constexpr int CQ = HG ? 2304 : 768, CK = HG ? 1792 : 1024, CV = HG ? 2048 : 1280, CG = HG ? 2560 : 1536;
    const float lg2 = HG ? 0.f : log2f(1.0f - exp2f(-5.0f - (float)h));
    float lbv[8];
#pragma unroll
    for (int e = 0; e < 8; ++e) { lbv[e] = 0.f; if (HG && l == 1) { const float a0 = par[PAR_LB + h * 64 + 8 * c8 + e], a1 = par[PAR_LB + 256 + h * 64 + 8 * c8 + e]; lbv[e] = 1.f / (1.f + expf(a0 - a1)); } }
    float ngv[8];
#pragma unroll
    for (int e = 0; e < 8; ++e) ngv[e] = HG ? par[PAR_NG + l * 64 + 8 * c8 + e] : 1.f;
    for (int i = tid; i < 4096; i += 512) ((LAS unsigned*)(lds + ST0))[i] = 0u;
    if (!HG && tid < 128) ((LAS float*)(lds + DECO))[tid] = exp2f(lg2 * 64.f);
    f32x16 st = {};
    const int tiO = wid & 1, tvO = (wid >> 1) & 1;
    f32x16 dm0 = {}, dm1 = {};
    if (!HG) {
#pragma unroll
        for (int r = 0; r < 16; ++r) { const int dj = 32 * tiO + r32 - ((r & 3) + 8 * (r >> 2) + 4 * hi); dm0[r] = __builtin_amdgcn_exp2f(lg2 * fabsf((float)dj)); dm1[r] = __builtin_amdgcn_exp2f(lg2 * fabsf((float)(dj - 32))); } }
    const float gq = __builtin_amdgcn_exp2f(lg2 * (float)(t + 1)), gk = __builtin_amdgcn_exp2f(lg2 * (float)(63 - t));
    v2u rq8, rk8, rv8; f32x4 rco = {0.f, 0.f, 0.f, 0.f}, rsi = {0.f, 0.f, 0.f, 0.f};
    float runc[8], kfc[8]; v2u qc8 = {0u, 0u}, vc8 = {0u, 0u};
#pragma unroll
    for (int e = 0; e < 8; ++e) { runc[e] = 0.f; kfc[e] = 0.f; }
#define REC_CP(c_) ((size_t)((pcol + (c_)) >> 6) * 1024 + (size_t)((pcol + (c_)) & 63))
#define REC_LOAD(n) do { const unsigned char* rp0_ = pj + pg8::pjoff(prow0 + (n) * 64 + t, 0); \
        if (HG) { rq8 = *(const v2u*)(rp0_ + REC_CP(CQ + 8 * c8)); rk8 = *(const v2u*)(rp0_ + REC_CP(CK + 8 * c8)); } \
        else { rq8.x = *(const unsigned*)(rp0_ + REC_CP(CQ + 4 * c8)); rq8.y = *(const unsigned*)(rp0_ + REC_CP(CQ + 32 + 4 * c8)); rk8.x = *(const unsigned*)(rp0_ + REC_CP(CK + 4 * c8)); rk8.y = *(const unsigned*)(rp0_ + REC_CP(CK + 32 + 4 * c8)); \
               rco = *(const f32x4*)(rope + ((n) * 64 + t) * 32 + 4 * c8); rsi = *(const f32x4*)(rope + SEQ * 32 + ((n) * 64 + t) * 32 + 4 * c8); } \
        rv8 = *(const v2u*)(rp0_ + REC_CP(CV + 8 * c8)); } while (0)
    REC_LOAD(0);
    __syncthreads();
    v2u gC8 = {0u, 0u};
    const int vrd = (4 * hi + ((lane & 15) >> 2)) * 64 + ((lane >> 4) & 1) * 32 + (lane & 3) * 8;
#pragma unroll 1
    for (int i = HG ? -2 : -1; i <= NCH; ++i) {
        if (!HG) {
            if (i + 1 < NCH) { const int ob_ = ((i + 1) & 1) * OPB;
                const v4u rq = f8x8_bf16<true>(rq8), rk = f8x8_bf16<true>(rk8), rv = f8x8_bf16<true>(rv8);
                const float q1[4] = {bfl(rq.x), bfh(rq.x), bfl(rq.y), bfh(rq.y)}, q2[4] = {bfl(rq.z), bfh(rq.z), bfl(rq.w), bfh(rq.w)};
                const float k1[4] = {bfl(rk.x), bfh(rk.x), bfl(rk.y), bfh(rk.y)}, k2[4] = {bfl(rk.z), bfh(rk.z), bfl(rk.w), bfh(rk.w)};
                float qa[4], qb[4], ka[4], kb[4];
#pragma unroll
                for (int e = 0; e < 4; ++e) { qa[e] = q1[e] * rco[e] - q2[e] * rsi[e]; qb[e] = q1[e] * rsi[e] + q2[e] * rco[e]; ka[e] = (k1[e] * rco[e] - k2[e] * rsi[e]) * 0.125f; kb[e] = (k1[e] * rsi[e] + k2[e] * rco[e]) * 0.125f; }
                const int ca = ob_ + (c8 >> 1) * 1024 + t * 16 + 8 * (c8 & 1), cb = ca + 4096;
                *(LAS v2u*)(lds + Q1C + ca) = pk4(qa[0], qa[1], qa[2], qa[3]); *(LAS v2u*)(lds + Q1C + cb) = pk4(qb[0], qb[1], qb[2], qb[3]);
                *(LAS v2u*)(lds + Q2C + ca) = pk4(qa[0] * gq, qa[1] * gq, qa[2] * gq, qa[3] * gq); *(LAS v2u*)(lds + Q2C + cb) = pk4(qb[0] * gq, qb[1] * gq, qb[2] * gq, qb[3] * gq);
                *(LAS v2u*)(lds + K1C + ca) = pk4(ka[0], ka[1], ka[2], ka[3]); *(LAS v2u*)(lds + K1C + cb) = pk4(kb[0], kb[1], kb[2], kb[3]);
                const int va = ob_ + t * 64 + 8 * c8;
                *(LAS v2u*)(lds + K2V + va) = pk4(ka[0] * gk, ka[1] * gk, ka[2] * gk, ka[3] * gk); *(LAS v2u*)(lds + K2V + 4096 + va) = pk4(kb[0] * gk, kb[1] * gk, kb[2] * gk, kb[3] * gk);
                *(LAS v4u*)(lds + VV + ob_ + (c8 >> 2) * 4096 + t * 64 + (c8 & 3) * 16) = rv; }
        } else {
            if (i + 1 >= 0 && i + 1 < NCH) { const int ob_ = ((i + 1) & 1) * OPB;
                const LAS float* TOT = (const LAS float*)(lds + TOTO + ((i + 1) & 1) * 2048);
                float bb[8], bm[8], bl[8];
#pragma unroll
                for (int e = 0; e < 8; ++e) { bb[e] = runc[e]; bm[e] = 0.f; bl[e] = 0.f; }
#pragma unroll
                for (int w2 = 0; w2 < 8; ++w2) { const f32x4 t0 = *(const LAS f32x4*)(TOT + w2 * 64 + 8 * c8), t1 = *(const LAS f32x4*)(TOT + w2 * 64 + 8 * c8 + 4);
                    const float tt[8] = {t0[0], t0[1], t0[2], t0[3], t1[0], t1[1], t1[2], t1[3]};
#pragma unroll
                    for (int e = 0; e < 8; ++e) { if (w2 < wid) bb[e] += tt[e]; if (w2 < 4) bm[e] += tt[e]; bl[e] += tt[e]; } }
                const v4u qc = f8x8_bf16<true>(qc8), vc = f8x8_bf16<true>(vc8);
                const float qv[8] = {bfl(qc.x), bfh(qc.x), bfl(qc.y), bfh(qc.y), bfl(qc.z), bfh(qc.z), bfl(qc.w), bfh(qc.w)};
                float A1[8], A2[8], B1[8], B2[8];
#pragma unroll
                for (int e = 0; e < 8; ++e) { A1[e] = qv[e] * __builtin_amdgcn_exp2f(fminf(bb[e] - bm[e], 115.f)); A2[e] = qv[e] * __builtin_amdgcn_exp2f(bb[e]); B1[e] = kfc[e] * __builtin_amdgcn_exp2f(fminf(bm[e] - bb[e], 115.f)); B2[e] = kfc[e] * __builtin_amdgcn_exp2f(bl[e] - bb[e]); }
                const int ca = ob_ + c8 * 1024 + t * 16, va = ob_ + (c8 >> 2) * 4096 + t * 64 + (c8 & 3) * 16;
#define PK8(x) (v4u){pg8::cvt_pk_bf16(x[0], x[1]), pg8::cvt_pk_bf16(x[2], x[3]), pg8::cvt_pk_bf16(x[4], x[5]), pg8::cvt_pk_bf16(x[6], x[7])}
                *(LAS v4u*)(lds + Q1C + ca) = PK8(A1); *(LAS v4u*)(lds + Q2C + ca) = PK8(A2); *(LAS v4u*)(lds + K1C + ca) = PK8(B1); *(LAS v4u*)(lds + K2V + va) = PK8(B2);
#undef PK8
                *(LAS v4u*)(lds + VV + va) = vc;
                if (t == 0) {
#pragma unroll
                    for (int e = 0; e < 8; ++e) ((LAS float*)(lds + DECO + ((i + 1) & 1) * 256))[8 * c8 + e] = __builtin_amdgcn_exp2f(bl[e]); }
            }
            if (i + 2 < NCH) {
                const v4u rk = f8x8_bf16<true>(rk8);
                const float zf[8] = {bfl(rk.x), bfh(rk.x), bfl(rk.y), bfh(rk.y), bfl(rk.z), bfh(rk.z), bfl(rk.w), bfh(rk.w)};
#pragma unroll
                for (int e = 0; e < 8; ++e) { const float ez = __builtin_amdgcn_exp2f(-1.4426950408889634f * zf[e]); const float r1 = __builtin_amdgcn_rcpf(1.f + ez); const float f = lbv[e] + (1.f - lbv[e]) * r1; runc[e] = __builtin_amdgcn_logf(f); kfc[e] = (1.f - lbv[e]) * (ez * r1); }
#pragma unroll
                for (int st_ = 8; st_ < 64; st_ <<= 1) {
#pragma unroll
                    for (int e = 0; e < 8; ++e) { const float v_ = __shfl_up(runc[e], st_); if (lane >= st_) runc[e] += v_; } }
                LAS float* TOTw = (LAS float*)(lds + TOTO + ((i + 2) & 1) * 2048);
                if ((lane >> 3) == 7) { *(LAS f32x4*)(TOTw + wid * 64 + 8 * c8) = (f32x4){runc[0], runc[1], runc[2], runc[3]}; *(LAS f32x4*)(TOTw + wid * 64 + 8 * c8 + 4) = (f32x4){runc[4], runc[5], runc[6], runc[7]}; }
                qc8 = rq8; vc8 = rv8; }
        }
        if (i >= 1) { const LAS float* OFr = (const LAS float*)(lds + OFO + ((i - 1) & 1) * OFB) + t * OFP + 8 * c8;
          const f32x4 x0 = *(const LAS f32x4*)OFr, x1 = *(const LAS f32x4*)(OFr + 4);
          float ov[8] = {x0[0], x0[1], x0[2], x0[3], x1[0], x1[1], x1[2], x1[3]};
          float s1 = 0.f;
          if (!HG) {
#pragma unroll
              for (int e = 0; e < 8; ++e) s1 += ov[e];
              s1 = sum8(s1);
              const float mean = s1 * (1.f / 64.f);
#pragma unroll
              for (int e = 0; e < 8; ++e) ov[e] -= mean; }
          float ss = 0.f;
#pragma unroll
          for (int e = 0; e < 8; ++e) ss += ov[e] * ov[e];
          ss = sum8(ss);
          const float rr = rsqrtf(ss * (1.f / 64.f) + GN_EPS);
          const v4u gC = f8x8_bf16<true>(gC8);
          const float gv[8] = {bfl(gC.x), bfh(gC.x), bfl(gC.y), bfh(gC.y), bfl(gC.z), bfh(gC.z), bfl(gC.w), bfh(gC.w)};
          float y[8];
#pragma unroll
          for (int e = 0; e < 8; ++e) y[e] = ov[e] * rr * ngv[e] * gv[e] * __builtin_amdgcn_rcpf(1.f + __builtin_amdgcn_exp2f(-1.4426950408889634f * gv[e]));
          { v2u w_; w_.x = pg8::pk_fp8x4(y[0] * BRSCALE, y[1] * BRSCALE, y[2] * BRSCALE, y[3] * BRSCALE); w_.y = pg8::pk_fp8x4(y[4] * BRSCALE, y[5] * BRSCALE, y[6] * BRSCALE, y[7] * BRSCALE); *(v2u*)(ob + (size_t)((i - 1) * 64 + t) * 1024 + 8 * c8) = w_; } }
        { const int nl = i + (HG ? 3 : 2); REC_LOAD(nl < NCH ? nl : NCH - 1); gC8 = *(const v2u*)(pj + pg8::pjoff(prow0 + (i >= 0 ? (i < NCH ? i : NCH - 1) : 0) * 64 + t, 0) + REC_CP(CG + 8 * c8)); }
        if (i >= 0 && i < NCH) {
            const int opb = (i & 1) * OPB, stc = ST0 + (i & 1) * 8192, stn = ST0 + ((i + 1) & 1) * 8192;
            if (wid < 4) {
                const int tv = tvO, ti = tiO;
                bf16x8 pf[4];
                f32x16 pt[2] = {{}, {}};
                const bool two = !HG || ti >= 1;
#pragma unroll
                for (int ks = 0; ks < 4; ++ks) { const bf16x8 b = *(const LAS bf16x8*)(lds + opb + Q1C + (2 * ks + hi) * 1024 + (32 * ti + r32) * 16);
                    const bf16x8 a0 = *(const LAS bf16x8*)(lds + opb + K1C + (2 * ks + hi) * 1024 + r32 * 16);
                    pt[0] = __builtin_amdgcn_mfma_f32_32x32x16_bf16(a0, b, pt[0], 0, 0, 0);
                    if (two) { const bf16x8 a1 = *(const LAS bf16x8*)(lds + opb + K1C + (2 * ks + hi) * 1024 + (32 + r32) * 16); pt[1] = __builtin_amdgcn_mfma_f32_32x32x16_bf16(a1, b, pt[1], 0, 0, 0); } }
#pragma unroll
                for (int tj = 0; tj < 2; ++tj) {
                    f32x16 p = pt[tj];
                    if (!HG || tj <= ti) {
                        const int iabs = 32 * ti + r32;
#pragma unroll
                        for (int r = 0; r < 16; ++r) { const int jabs = 32 * tj + (r & 3) + 8 * (r >> 2) + 4 * hi;
                            if (HG) p[r] = (jabs <= iabs) ? p[r] : 0.f; else p[r] *= (tj == 0 ? dm0[r] : dm1[r]); }
                    }
                    pg8::u32x4 w0, w1;
                    w0.x = pg8::cvt_pk_bf16(p[0], p[1]); w0.y = pg8::cvt_pk_bf16(p[2], p[3]); w0.z = pg8::cvt_pk_bf16(p[4], p[5]); w0.w = pg8::cvt_pk_bf16(p[6], p[7]);
                    w1.x = pg8::cvt_pk_bf16(p[8], p[9]); w1.y = pg8::cvt_pk_bf16(p[10], p[11]); w1.z = pg8::cvt_pk_bf16(p[12], p[13]); w1.w = pg8::cvt_pk_bf16(p[14], p[15]);
                    pf[2 * tj] = __builtin_bit_cast(bf16x8, w0); pf[2 * tj + 1] = __builtin_bit_cast(bf16x8, w1);
                }
                f32x16 o = {}, o2 = {};
#pragma unroll
                for (int ks = 0; ks < 4; ++ks) { const bf16x8 a = *(const LAS bf16x8*)(lds + stc + (2 * ks + hi) * 1024 + (32 * tv + r32) * 16), b = *(const LAS bf16x8*)(lds + opb + Q2C + (2 * ks + hi) * 1024 + (32 * ti + r32) * 16);
                    o = __builtin_amdgcn_mfma_f32_32x32x16_bf16(a, b, o, 0, 0, 0); }
#pragma unroll
                for (int s2 = 0; s2 < 4; ++s2) { const s16x4 lo = vtr(lds + opb + VV + tv * 4096 + vrd + s2 * 1024), hh = vtr(lds + opb + VV + tv * 4096 + vrd + s2 * 1024 + 512);
                    const bf16x8 va = (bf16x8){lo[0], lo[1], lo[2], lo[3], hh[0], hh[1], hh[2], hh[3]};
                    o2 = __builtin_amdgcn_mfma_f32_32x32x16_bf16(va, pf[s2], o2, 0, 0, 0); }
#pragma unroll
                for (int r = 0; r < 16; ++r) o[r] += o2[r];
                LAS float* OFp = (LAS float*)(lds + OFO + (i & 1) * OFB) + (32 * ti + r32) * OFP + 32 * tv + 4 * hi;
#pragma unroll
                for (int g = 0; g < 4; ++g) *(LAS f32x4*)(OFp + 8 * g) = (f32x4){o[4 * g], o[4 * g + 1], o[4 * g + 2], o[4 * g + 3]};
            } else {
                const int td = (wid - 4) & 1, tv = (wid - 4) >> 1;
                f32x16 pr = {};
#pragma unroll
                for (int s2 = 0; s2 < 4; ++s2) { const s16x4 lo = vtr(lds + opb + VV + tv * 4096 + vrd + s2 * 1024), hh = vtr(lds + opb + VV + tv * 4096 + vrd + s2 * 1024 + 512);
                    const s16x4 ko = vtr(lds + opb + K2V + td * 4096 + vrd + s2 * 1024), kh = vtr(lds + opb + K2V + td * 4096 + vrd + s2 * 1024 + 512);
                    const bf16x8 va = (bf16x8){lo[0], lo[1], lo[2], lo[3], hh[0], hh[1], hh[2], hh[3]}, kb2 = (bf16x8){ko[0], ko[1], ko[2], ko[3], kh[0], kh[1], kh[2], kh[3]};
                    pr = __builtin_amdgcn_mfma_f32_32x32x16_bf16(va, kb2, pr, 0, 0, 0); }
                const float dec = ((LAS float*)(lds + DECO + (i & 1) * 256))[32 * td + r32];
                const int d = 32 * td + r32;
                LAS bf16* stw = (LAS bf16*)(lds + stn + (d >> 3) * 1024 + (d & 7) * 2);
#pragma unroll
                for (int r = 0; r < 16; ++r) { st[r] = st[r] * dec + pr[r]; const int v = 32 * tv + (r & 3) + 8 * (r >> 2) + 4 * hi; stw[v * 8] = (bf16)f2bf(st[r]); }
            }
        }
        asm volatile("s_waitcnt lgkmcnt(0)" ::: "memory"); __builtin_amdgcn_s_barrier(); asm volatile("" ::: "memory");
    }
    __syncthreads();
#undef REC_LOAD
#undef REC_CP
}
}
__device__ __forceinline__ void recur_phase(Frame& F, int l) {
    int tid = F.tid; OPAQUE_V(tid);
    LAS char* lds = (LAS char*)(F.lds + RING_OFF);
    const unsigned char* proj = (const unsigned char*)(F.ws + WS_PROJ); unsigned char* br = (unsigned char*)F.out; const float* par = (const float*)(F.ws + WS_PAR); const float* rope = (const float*)(F.ws + WS_ROPE);
    for (int u = F.vcu; u < 2 * BATCH * NH; u += F.G) { const int bh = u & 127, b = bh >> 2, h = bh & 3; const size_t row0 = (size_t)b * SEQ;
        if (u < 128) rec::recur_unit<false>(lds, proj, (int)row0, h * 64, br + row0 * 1024 + 256 + h * 64, h, l, par, rope, tid);
        else rec::recur_unit<true>(lds, proj, (int)row0, h * 64, br + row0 * 1024 + 512 + h * 64, h, l, par, rope, tid); }
}

__device__ __forceinline__ void naive_attn(Frame& F, int l) {
    int tid_ = F.tid; OPAQUE_V(tid_); const int lane = tid_ & 63, wave_ = __builtin_amdgcn_readfirstlane(tid_ >> 6);
    const int gw = F.vcu * NWAVES + wave_, NGW = F.G * NWAVES;
    const bf16* proj = (const bf16*)(F.ws + WS_PROJ); const bf16* memkv = (const bf16*)(F.ws + WS_MEMKV);
    const float* cc = (const float*)(F.ws + WS_CC); bf16* br = (bf16*)((unsigned char*)F.out);
    constexpr int BHS = BATCH * NH * SEQ;
    for (int it = gw; it < 2 * BHS; it += NGW) {
        const bool is_mem = it >= BHS; const int r = is_mem ? it - BHS : it; const int bh = r / SEQ, s = r % SEQ, b = bh >> 2, h = bh & 3;
        const size_t tok = (size_t)b * SEQ + s;
        const bf16* qp = proj + tok * NPROJ + (is_mem ? 2816 : 0) + h * 64;
        float q[64];
#pragma unroll
        for (int c = 0; c < 8; ++c) { const v4u w = *(const v4u*)(qp + 8 * c); q[8 * c + 0] = bfl(w.x); q[8 * c + 1] = bfh(w.x); q[8 * c + 2] = bfl(w.y); q[8 * c + 3] = bfh(w.y); q[8 * c + 4] = bfl(w.z); q[8 * c + 5] = bfh(w.z); q[8 * c + 6] = bfl(w.w); q[8 * c + 7] = bfh(w.w); }
        const int nkeys = is_mem ? NMEM : s + 1;
        const bf16* kbase = is_mem ? memkv + (size_t)b * NMEM * 1024 + l * 512 + h * 64 : proj + (size_t)b * SEQ * NPROJ + 256 + h * 64;
        const size_t kpitch = is_mem ? 1024 : NPROJ; const int voff = 256;
        const float cq = is_mem ? 0.f : cc[(size_t)bh * SEQ + s];
        float mrun = -1e30f, lrun = 0.f; float o[64];
#pragma unroll
        for (int d = 0; d < 64; ++d) o[d] = 0.f;
        for (int k0 = 0; k0 < nkeys; k0 += 64) { const int kk = k0 + lane;
            if (kk < nkeys) { const bf16* kp = kbase + (size_t)kk * kpitch; float dot = 0.f;
#pragma unroll
                for (int c = 0; c < 8; ++c) { const v4u w = *(const v4u*)(kp + 8 * c);
                    dot += q[8 * c + 0] * bfl(w.x) + q[8 * c + 1] * bfh(w.x) + q[8 * c + 2] * bfl(w.y) + q[8 * c + 3] * bfh(w.y) + q[8 * c + 4] * bfl(w.z) + q[8 * c + 5] * bfh(w.z) + q[8 * c + 6] * bfl(w.w) + q[8 * c + 7] * bfh(w.w); }
                float sv = dot * 0.125f; if (!is_mem) sv += cq - cc[(size_t)bh * SEQ + kk];
                const float mn = fmaxf(mrun, sv), corr = expf(mrun - mn), p = expf(sv - mn); mrun = mn; lrun = lrun * corr + p;
                const bf16* vp = kp + voff;
#pragma unroll
                for (int c = 0; c < 8; ++c) { const v4u w = *(const v4u*)(vp + 8 * c);
                    o[8 * c + 0] = o[8 * c + 0] * corr + p * bfl(w.x); o[8 * c + 1] = o[8 * c + 1] * corr + p * bfh(w.x); o[8 * c + 2] = o[8 * c + 2] * corr + p * bfl(w.y); o[8 * c + 3] = o[8 * c + 3] * corr + p * bfh(w.y);
                    o[8 * c + 4] = o[8 * c + 4] * corr + p * bfl(w.z); o[8 * c + 5] = o[8 * c + 5] * corr + p * bfh(w.z); o[8 * c + 6] = o[8 * c + 6] * corr + p * bfl(w.w); o[8 * c + 7] = o[8 * c + 7] * corr + p * bfh(w.w); } } }
        const float M = wave_max(mrun), sc = expf(mrun - M), L = wave_sum(lrun * sc);
        float res = 0.f;
#pragma unroll
        for (int d = 0; d < 64; ++d) { const float v = wave_sum(o[d] * sc); if (lane == d) res = v; }
        br[tok * 1024 + (is_mem ? 768 : 0) + h * 64 + lane] = (bf16)f2bf(res / L);
    }
}
__device__ __forceinline__ void naive_recur(Frame& F, int l) {
    int tid = F.tid; OPAQUE_V(tid); const int lane = tid & 63, wave = __builtin_amdgcn_readfirstlane(tid >> 6);
    const bf16* proj = (const bf16*)(F.ws + WS_PROJ); bf16* br = (bf16*)((unsigned char*)F.out);
    LAS float* L0 = (LAS float*)(F.lds + RING_OFF);
    if (F.bx < 128) {
        const int bh = F.bx, b = bh >> 2, h = bh & 3;
        LAS float* qr = L0; LAS float* kr = L0 + 4096; LAS float* vv = L0 + 8192; LAS float* sc = L0 + 12288; LAS float* st = L0 + 16384;
        const float* rc = (const float*)(F.ws + WS_ROPE); const float* rs = rc + SEQ * 32;
        const float lg = log1pf(-exp2f(-5.0f - (float)h));
        for (int i = tid; i < 4096; i += 512) st[i] = 0.f;
#pragma unroll 1
        for (int n = 0; n < SEQ / 64; ++n) {
            const size_t row0 = (size_t)b * SEQ + n * 64;
            for (int idx = tid; idx < 2048; idx += 512) { const int t = idx >> 5, c = idx & 31; const bf16* p = proj + (row0 + t) * NPROJ + h * 64;
                const float co = rc[(n * 64 + t) * 32 + c], si = rs[(n * 64 + t) * 32 + c];
                const float q1 = bf1(p[768 + c]), q2 = bf1(p[768 + c + 32]), k1 = bf1(p[1024 + c]), k2 = bf1(p[1024 + c + 32]);
                qr[t * 64 + c] = q1 * co - q2 * si; qr[t * 64 + c + 32] = q1 * si + q2 * co;
                kr[t * 64 + c] = (k1 * co - k2 * si) * 0.125f; kr[t * 64 + c + 32] = (k1 * si + k2 * co) * 0.125f;
                vv[t * 64 + c] = bf1(p[1280 + c]); vv[t * 64 + c + 32] = bf1(p[1280 + c + 32]); }
            __syncthreads();
#pragma unroll 1
            for (int j = 0; j < 8; ++j) { const int idx = tid + 512 * j, i = idx >> 6, jj = idx & 63; float s = 0.f;
#pragma unroll 4
                for (int d = 0; d < 64; ++d) s += qr[i * 64 + d] * kr[jj * 64 + d];
                sc[idx] = s * expf(lg * fabsf((float)(i - jj))); }
            __syncthreads();
            float oreg[8];
#pragma unroll
            for (int j = 0; j < 8; ++j) { const int idx = tid + 512 * j, i = idx >> 6, v = idx & 63; float s = 0.f, s2 = 0.f;
#pragma unroll 4
                for (int jj = 0; jj < 64; ++jj) s += sc[i * 64 + jj] * vv[jj * 64 + v];
#pragma unroll 4
                for (int d = 0; d < 64; ++d) s2 += qr[i * 64 + d] * st[d * 64 + v];
                oreg[j] = s + expf(lg * (float)(i + 1)) * s2; }
            __syncthreads();
#pragma unroll 1
            for (int j = 0; j < 8; ++j) { const int idx = tid + 512 * j, d = idx >> 6, v = idx & 63; float s = 0.f;
#pragma unroll 2
                for (int jj = 0; jj < 64; ++jj) s += kr[jj * 64 + d] * expf(lg * (float)(63 - jj)) * vv[jj * 64 + v];
                st[idx] = expf(lg * 64.0f) * st[idx] + s; }
            for (int j = 0; j < 8; ++j) { const int i = wave + 8 * j;
                const float mean = wave_sum(oreg[j]) * (1.f / 64.f), dv = oreg[j] - mean, var = wave_sum(dv * dv) * (1.f / 64.f);
                const float g = bf1(proj[(row0 + i) * NPROJ + 1536 + h * 64 + lane]);
                br[(row0 + i) * 1024 + 256 + h * 64 + lane] = (bf16)f2bf(dv * rsqrtf(var + GN_EPS) * g / (1.f + expf(-g))); }
            __syncthreads();
        }
    } else {
        const int bh = F.bx - 128, b = bh >> 2, h = bh & 3;
        if (bh >= 128) return;
        LAS float* qf = L0; LAS float* ff = L0 + 4096; LAS float* kf = L0 + 8192; LAS float* iv = L0 + 12288; LAS float* ob = L0 + 16384;
        const int v = tid >> 3, k8 = tid & 7;
        float Sreg[8];
#pragma unroll
        for (int i = 0; i < 8; ++i) Sreg[i] = 0.f;
        const float* lbp = (const float*)(F.ws + WS_PAR) + PAR_LB;
#pragma unroll 1
        for (int n = 0; n < SEQ / 64; ++n) {
            const size_t row0 = (size_t)b * SEQ + n * 64;
            for (int j = 0; j < 8; ++j) { const int idx = tid + 512 * j, t = idx >> 6, c = idx & 63; const bf16* p = proj + (row0 + t) * NPROJ + h * 64 + c;
                float lb = 0.f; if (l == 1) { const float a0 = lbp[h * 64 + c], a1 = lbp[256 + h * 64 + c]; lb = 1.f / (1.f + expf(a0 - a1)); }
                const float zf = bf1(p[1792]); const float kfv = (1.f - lb) / (1.f + expf(zf));
                qf[idx] = bf1(p[2304]); ff[idx] = 1.f - kfv; kf[idx] = kfv; iv[idx] = bf1(p[2048]); }
            __syncthreads();
#pragma unroll 1
            for (int t = 0; t < 64; ++t) { const float ivt = iv[t * 64 + v]; float p = 0.f;
#pragma unroll
                for (int i = 0; i < 8; ++i) { const int k = k8 * 8 + i; Sreg[i] = ff[t * 64 + k] * Sreg[i] + kf[t * 64 + k] * ivt; p += Sreg[i] * qf[t * 64 + k]; }
                p += __shfl_xor(p, 1); p += __shfl_xor(p, 2); p += __shfl_xor(p, 4);
                if (k8 == 0) ob[t * 64 + v] = p; }
            __syncthreads();
            { const int t = tid >> 3, seg = tid & 7; float ov[8]; float ss = 0.f;
#pragma unroll
              for (int i = 0; i < 8; ++i) { ov[i] = ob[t * 64 + seg * 8 + i]; ss += ov[i] * ov[i]; }
              ss = sum8(ss);
              const float rr = rsqrtf(ss * (1.f / 64.f) + GN_EPS);
              const bf16* gp = proj + (row0 + t) * NPROJ + 2560 + h * 64 + seg * 8; const float* ng = (const float*)(F.ws + WS_PAR) + PAR_NG + l * 64 + seg * 8;
              unsigned w[4];
#pragma unroll
              for (int i = 0; i < 4; ++i) { const float g0 = bf1(gp[2 * i]), g1 = bf1(gp[2 * i + 1]);
                  w[i] = pk2(ov[2 * i] * rr * ng[2 * i] * g0 / (1.f + expf(-g0)), ov[2 * i + 1] * rr * ng[2 * i + 1] * g1 / (1.f + expf(-g1))); }
              *(v4u*)(br + (row0 + t) * 1024 + 512 + h * 64 + seg * 8) = (v4u){w[0], w[1], w[2], w[3]}; }
            __syncthreads();
        }
    }
}

__device__ __forceinline__ void ln1_phase(Frame& F, int l, bool commit = true) {
    LAS float* WrT = (LAS float*)(F.lds + RING_OFF);
    LAS int* se1 = (LAS int*)(F.lds + RING_OFF + 65536); LAS int* se2 = se1 + 256; LAS float* sw = (LAS float*)(se2 + 256);
    LAS int* hist = (LAS int*)(F.lds + SM_OFF + 256); LAS int* base = hist + 16;
    int tid = F.tid; OPAQUE_V(tid); const int lane = tid & 63, wave = __builtin_amdgcn_readfirstlane(tid >> 6);
    for (int idx = tid; idx < 16384; idx += 512) { const int d = idx >> 4, e = idx & 15; WrT[e * 1024 + d] = ((const float*)(F.ws + WS_PAR))[PAR_WR + idx]; }
    if (tid < 16) hist[tid] = 0;
    __syncthreads();
    const bf16* xb = (const bf16*)(F.ws + WS_XB); const bf16* yb = (const bf16*)(F.ws + WS_Y); bf16* x1b = (bf16*)(F.ws + WS_X1B);
    const float* lng = (const float*)(F.ws + WS_PAR) + PAR_LNG + (l * 2 + 0) * DM; const float* lnb = (const float*)(F.ws + WS_PAR) + PAR_LNB + (l * 2 + 0) * DM;
    LAS float* gbl = (LAS float*)(F.lds + RING_OFF + 90112);
    for (int idx = tid; idx < 1024; idx += 512) { gbl[idx] = lng[idx]; gbl[1024 + idx] = lnb[idx]; }
    __syncthreads();
    for (int rb = F.bx; rb < T / 256; rb += F.G) {
        LAS float* lgt = (LAS float*)(F.lds + RING_OFF + 65536 + 4096);
        const float* brp = (const float*)(F.ws + WS_PAR) + PAR_BR;
        const int my_e = ((lane >> 4) & 1) * 8 + ((lane >> 3) & 1) * 4 + ((lane >> 2) & 1) * 2 + ((lane >> 1) & 1);
        const float my_b = brp[my_e];
        const int hf = lane >> 5, l5 = lane & 31;
        int rwx[8], rwy[8]; float rsx;
#define LN1_LOAD(ii) do { const size_t r_ = (size_t)rb * 256 + wave * 32 + 2 * (ii) + hf; const GAS int* px_ = (const GAS int*)((const signed char*)(F.ws + WS_X8) + r_ * DM) + l5; const GAS int* py_ = (const GAS int*)((const unsigned char*)(F.ws + WS_Y) + r_ * DM) + l5; \
            rsx = ((const float*)(F.ws + WS_SX))[r_]; _Pragma("unroll") for (int j = 0; j < 8; ++j) { rwx[j] = px_[32 * j]; rwy[j] = py_[32 * j]; } } while (0)
        LN1_LOAD(0);
#pragma unroll 1
        for (int i = 0; i < 16; ++i) {
            const int rl = wave * 32 + 2 * i + hf; const size_t row = (size_t)rb * 256 + rl;
            f32x4 xv[8];
            { f32x4 yv[8];
#pragma unroll
              for (int j = 0; j < 8; ++j) { const int w_ = rwx[j]; xv[j] = (f32x4){(float)((w_ << 24) >> 24), (float)((w_ << 16) >> 24), (float)((w_ << 8) >> 24), (float)(w_ >> 24)} * rsx; const pg8::f32x2 ya_ = __builtin_amdgcn_cvt_pk_f32_fp8(rwy[j], false), yb_ = __builtin_amdgcn_cvt_pk_f32_fp8(rwy[j], true); yv[j] = (f32x4){ya_.x, ya_.y, yb_.x, yb_.y} * 0.03125f; }
              LN1_LOAD(i < 15 ? i + 1 : 15); asm volatile("" ::: "memory");
              float s = 0.f;
#pragma unroll
              for (int j = 0; j < 8; ++j) { xv[j] = xv[j] * ALPHA + yv[j]; s += (xv[j].x + xv[j].y) + (xv[j].z + xv[j].w); }
              s += dpp_f<DPP_X1>(s); s += dpp_f<DPP_X2>(s); s += dpp_f<DPP_HMIR>(s); s += dpp_f<DPP_MIR>(s);
              const float mean = (hf ? rl_f(s, 47) + rl_f(s, 63) : rl_f(s, 15) + rl_f(s, 31)) * (1.f / DM); float s2 = 0.f;
#pragma unroll
              for (int j = 0; j < 8; ++j) { xv[j] = xv[j] - mean; s2 += (xv[j].x * xv[j].x + xv[j].y * xv[j].y) + (xv[j].z * xv[j].z + xv[j].w * xv[j].w); }
              s2 += dpp_f<DPP_X1>(s2); s2 += dpp_f<DPP_X2>(s2); s2 += dpp_f<DPP_HMIR>(s2); s2 += dpp_f<DPP_MIR>(s2);
              const float rstd = 1.f / sqrtf((hf ? rl_f(s2, 47) + rl_f(s2, 63) : rl_f(s2, 15) + rl_f(s2, 31)) * (1.f / DM) + LN_EPS);
              float am = 0.f;
#pragma unroll
              for (int j = 0; j < 8; ++j) { xv[j] = xv[j] * rstd * *(const LAS f32x4*)(gbl + 128 * j + 4 * l5) + *(const LAS f32x4*)(gbl + 1024 + 128 * j + 4 * l5);
                  am = fmaxf(am, fmaxf(fmaxf(fabsf(xv[j].x), fabsf(xv[j].y)), fmaxf(fabsf(xv[j].z), fabsf(xv[j].w)))); }
              am = fmaxf(am, dpp_f<DPP_X1>(am)); am = fmaxf(am, dpp_f<DPP_X2>(am)); am = fmaxf(am, dpp_f<DPP_HMIR>(am)); am = fmaxf(am, dpp_f<DPP_MIR>(am));
              am = fmaxf(hf ? fmaxf(rl_f(am, 47), rl_f(am, 63)) : fmaxf(rl_f(am, 15), rl_f(am, 31)), 1e-30f);
              const float inv = 127.0f / am;
              GAS unsigned* o4 = (GAS unsigned*)((signed char*)(F.ws + WS_X18) + row * DM) + l5;
#pragma unroll
              for (int j = 0; j < 8; ++j) o4[32 * j] = q8x4(xv[j].x, xv[j].y, xv[j].z, xv[j].w, inv);
              if (l5 == 0) ((float*)(F.ws + WS_S1))[row] = am * (1.0f / 127.0f); }
            float p[16];
#pragma unroll
            for (int e = 0; e < 16; ++e) { pg8::f32x2 a2 = {0.f, 0.f};
#pragma unroll
                for (int j = 0; j < 8; ++j) { const f32x4 w = *(const LAS f32x4*)(WrT + e * 1024 + 128 * j + 4 * l5);
                    a2 = (pg8::f32x2){xv[j].x, xv[j].y} * (pg8::f32x2){w.x, w.y} + a2; a2 = (pg8::f32x2){xv[j].z, xv[j].w} * (pg8::f32x2){w.z, w.w} + a2; }
                p[e] = a2.x + a2.y; asm volatile("" ::: "memory"); }
            { float k8[8], k4[4], k2[2], k1;
#pragma unroll
              for (int e = 0; e < 8; ++e) { float a_ = p[e], b_ = p[e + 8]; asm volatile("s_nop 1\n\tv_permlane16_swap_b32 %0, %1" : "+v"(a_), "+v"(b_)); k8[e] = a_ + b_; }
              { const bool hb = (lane & 8) != 0;
#pragma unroll
                for (int e = 0; e < 4; ++e) { const float keep = hb ? k8[e + 4] : k8[e], send = hb ? k8[e] : k8[e + 4]; k4[e] = keep + dpp_f<0x128>(send); } }
              { const bool hb = (lane & 4) != 0;
#pragma unroll
                for (int e = 0; e < 2; ++e) { const float keep = hb ? k4[e + 2] : k4[e], send = hb ? k4[e] : k4[e + 2]; k2[e] = keep + dpp_f<0x1B>(dpp_f<DPP_HMIR>(send)); } }
              { const bool hb = (lane & 2) != 0; const float keep = hb ? k2[1] : k2[0], send = hb ? k2[0] : k2[1]; k1 = keep + dpp_f<DPP_X2>(send); }
              k1 += dpp_f<DPP_X1>(k1);
              if ((lane & 1) == 0) lgt[rl * 16 + my_e] = k1 + my_b; }
        }
#undef LN1_LOAD
        LDS_WAIT();
        if (lane < 32) { const int rl = wave * 32 + lane; float lg[16];
#pragma unroll
            for (int e4 = 0; e4 < 4; ++e4) { const f32x4 t4 = *(const LAS f32x4*)(lgt + rl * 16 + 4 * e4); lg[4 * e4] = t4.x; lg[4 * e4 + 1] = t4.y; lg[4 * e4 + 2] = t4.z; lg[4 * e4 + 3] = t4.w; }
            float gm[4];
#pragma unroll
            for (int g = 0; g < 4; ++g) gm[g] = fmaxf(fmaxf(lg[4 * g], lg[4 * g + 1]), fmaxf(lg[4 * g + 2], lg[4 * g + 3]));
            int gs = 0; float gb = gm[0];
#pragma unroll
            for (int g = 1; g < 4; ++g) if (gm[g] > gb) { gb = gm[g]; gs = g; }
            float v0 = gs == 0 ? lg[0] : gs == 1 ? lg[4] : gs == 2 ? lg[8] : lg[12], v1 = gs == 0 ? lg[1] : gs == 1 ? lg[5] : gs == 2 ? lg[9] : lg[13];
            float v2 = gs == 0 ? lg[2] : gs == 1 ? lg[6] : gs == 2 ? lg[10] : lg[14], v3 = gs == 0 ? lg[3] : gs == 1 ? lg[7] : gs == 2 ? lg[11] : lg[15];
            int i1 = 0; float m1 = v0; if (v1 > m1) { m1 = v1; i1 = 1; } if (v2 > m1) { m1 = v2; i1 = 2; } if (v3 > m1) { m1 = v3; i1 = 3; }
            int i2 = -1; float m2 = -3.0e38f;
            if (i1 != 0 && v0 > m2) { m2 = v0; i2 = 0; } if (i1 != 1 && v1 > m2) { m2 = v1; i2 = 1; } if (i1 != 2 && v2 > m2) { m2 = v2; i2 = 2; } if (i1 != 3 && v3 > m2) { m2 = v3; i2 = 3; }
            if (i2 < 0) i2 = (i1 == 0) ? 1 : 0;
            const int e1 = gs * 4 + i1, e2 = gs * 4 + i2;
            const int r1 = __hip_atomic_fetch_add(hist + e1, 1, __ATOMIC_RELAXED, __HIP_MEMORY_SCOPE_WORKGROUP), r2 = __hip_atomic_fetch_add(hist + e2, 1, __ATOMIC_RELAXED, __HIP_MEMORY_SCOPE_WORKGROUP);
            se1[rl] = e1 | (r1 << 8); se2[rl] = e2 | (r2 << 8); sw[rl] = 1.f / (1.f + expf(m2 - m1)); }
        __syncthreads();
        if (tid < 16 && commit) { base[tid] = (int)__hip_atomic_fetch_add((unsigned*)(F.ctl + CW_CNT + (l * 16 + tid) * 64), (unsigned)hist[tid], RLX_AGENT); }
        __syncthreads();
        if (commit) { const int rl = tid >> 1, k = tid & 1; const int v = k ? se2[rl] : se1[rl]; const int e = v & 255, r = v >> 8; const int slot = (rb * 256 + rl) * 2 + k;
          ((int*)(F.ws + WS_LIST))[(size_t)e * LISTCAP + base[e] + r] = slot; ((float*)(F.ws + WS_WT))[slot] = k ? 1.f - sw[rl] : sw[rl]; }
        __syncthreads();
        if (tid < 16) hist[tid] = 0;
        __syncthreads();
    }
}

__device__ __forceinline__ void ln2_phase(Frame& F, int l) {
    LAS float* wff = (LAS float*)(F.lds + RING_OFF + 81920);
    int tid_ = F.tid; OPAQUE_V(tid_); const int lane = tid_ & 63, wave_ = __builtin_amdgcn_readfirstlane(tid_ >> 6); const bool last = (l == NLAYER - 1);
    if (!last) { stage_wff(F, l + 1, wff); }
    __syncthreads();
    const int gw = F.vcu * NWAVES + wave_, NGW = F.G * NWAVES;
    const bf16* x1b = (const bf16*)(F.ws + WS_X1B); const unsigned char* y2 = (const unsigned char*)(F.ws + WS_Y2); bf16* xb = (bf16*)(F.ws + WS_XB);
    const float* lng = (const float*)(F.ws + WS_PAR) + PAR_LNG + (l * 2 + 1) * DM; const float* lnb = (const float*)(F.ws + WS_PAR) + PAR_LNB + (l * 2 + 1) * DM;
    f32x4 gg[4], bb[4];
#pragma unroll
    for (int j = 0; j < 4; ++j) { gg[j] = *(const f32x4*)(lng + 256 * j + 4 * lane); bb[j] = *(const f32x4*)(lnb + 256 * j + 4 * lane); }
#define LN2_RAW(m_, rx_, ra_, rb_, sc_) do { const GAS int* p8_ = (const GAS int*)((const signed char*)(F.ws + WS_X18) + (size_t)(m_) * DM) + lane; const GAS int* pa_ = (const GAS int*)(y2 + (size_t)(2 * (m_)) * DM) + lane; const GAS int* pb_ = (const GAS int*)(y2 + (size_t)(2 * (m_) + 1) * DM) + lane; \
        sc_ = ((const float*)(F.ws + WS_S1))[m_]; _Pragma("unroll") for (int j = 0; j < 4; ++j) { rx_[j] = p8_[64 * j]; ra_[j] = pa_[64 * j]; rb_[j] = pb_[64 * j]; } } while (0)
    auto row = [&](int m, const int (&rx)[4], const int (&ra)[4], const int (&rb)[4], float s1_) {
        f32x4 xv[4];
        float s = 0.f;
#pragma unroll
        for (int j = 0; j < 4; ++j) { const int w_ = rx[j]; xv[j] = (f32x4){(float)((w_ << 24) >> 24), (float)((w_ << 16) >> 24), (float)((w_ << 8) >> 24), (float)(w_ >> 24)} * s1_;
            const pg8::f32x2 a0 = __builtin_amdgcn_cvt_pk_f32_fp8(ra[j], false), a1 = __builtin_amdgcn_cvt_pk_f32_fp8(ra[j], true), b0 = __builtin_amdgcn_cvt_pk_f32_fp8(rb[j], false), b1 = __builtin_amdgcn_cvt_pk_f32_fp8(rb[j], true);
            const f32x4 ya = (f32x4){a0.x, a0.y, a1.x, a1.y} * 0.03125f, yb = (f32x4){b0.x, b0.y, b1.x, b1.y} * 0.03125f;
            xv[j] = xv[j] * ALPHA + (ya + yb); s += (xv[j].x + xv[j].y) + (xv[j].z + xv[j].w); }
        const float mean = wave_sum(s) * (1.f / DM); float s2 = 0.f;
#pragma unroll
        for (int j = 0; j < 4; ++j) { xv[j] = xv[j] - mean; s2 += (xv[j].x * xv[j].x + xv[j].y * xv[j].y) + (xv[j].z * xv[j].z + xv[j].w * xv[j].w); }
        const float rstd = 1.f / sqrtf(wave_sum(s2) * (1.f / DM) + LN_EPS);
#pragma unroll
        for (int j = 0; j < 4; ++j) xv[j] = xv[j] * rstd * gg[j] + bb[j];
        if (last) { GAS f32x4* o = (GAS f32x4*)(F.out + (size_t)m * DM) + lane;
#pragma unroll
            for (int j = 0; j < 4; ++j) o[64 * j] = xv[j]; }
        else { store_row_i8((signed char*)(F.ws + WS_X8) + (size_t)m * DM, (float*)(F.ws + WS_SX) + m, lane, xv); forget_row(xv, wff, (float*)(F.ws + WS_LF) + (size_t)m * 4, lane); }
    };
    constexpr int NR = 4;
    for (int m = gw; m < T; m += NR * NGW) {
        int rx[NR][4], ra[NR][4], rb[NR][4]; float sc[NR];
#pragma unroll
        for (int q = 0; q < NR; ++q) { const int mq = (m + q * NGW < T) ? m + q * NGW : m; LN2_RAW(mq, rx[q], ra[q], rb[q], sc[q]); }
        asm volatile("" ::: "memory");
#pragma unroll
        for (int q = 0; q < NR; ++q) if (m + q * NGW < T) row(m + q * NGW, rx[q], ra[q], rb[q], sc[q]);
    }
#undef LN2_RAW
}

__device__ __forceinline__ int moe_tables(Frame& F, int l) {
    LAS int* tb = (LAS int*)(F.lds + SM_OFF); LAS int* cn = tb + 32;
    LAS int* gtab = (LAS int*)(F.lds + GT_OFF); LAS float* wtab = (LAS float*)(F.lds + WTB_OFF); LAS float* stab = (LAS float*)(F.lds + STB_OFF);
    if (F.tid < 16) cn[F.tid] = (int)__hip_atomic_load((unsigned*)(F.ctl + CW_CNT + (l * 16 + F.tid) * 64), RLX_AGENT);
    __syncthreads();
    if (F.tid == 0) { int a = 0; for (int e = 0; e < 16; ++e) { tb[e] = a; a += (cn[e] + 255) >> 8; } tb[16] = a; }
    __syncthreads();
    const int ntiles = tb[16];
    const int* list = (const int*)(F.ws + WS_LIST); const float* wt = (const float*)(F.ws + WS_WT);
    constexpr int NK = (MAXU * 256 + 511) / 512;
    int vv[NK]; bool un[NK], has[NK]; float ww[NK], ss[NK];
#pragma unroll
    for (int k = 0; k < NK; ++k) { const int idx = F.tid + 512 * k, iu = idx >> 8, t = idx & 255; const long L = (long)iu * F.G + F.vcu; un[k] = iu < MAXU && L < (long)ntiles * 4; const int pm = un[k] ? (int)(L >> 2) : 0;
        int e = 0;
#pragma unroll
        for (int kk = 1; kk < 16; ++kk) e += (pm >= tb[kk]) ? 1 : 0;
        const int p = (pm - tb[e]) * 256 + t; has[k] = un[k] && p < cn[e];
        vv[k] = list[(size_t)e * LISTCAP + (has[k] ? p : 0)]; }
#pragma unroll
    for (int k = 0; k < NK; ++k) { const int v = has[k] ? vv[k] : 0; ww[k] = wt[v]; ss[k] = ((const float*)(F.ws + WS_S1))[v >> 1]; }
#pragma unroll
    for (int k = 0; k < NK; ++k) if (un[k]) { const int idx = F.tid + 512 * k; gtab[idx] = has[k] ? vv[k] : -1; wtab[idx] = has[k] ? ww[k] * (32.0f / (8.0f * 64.0f)) : 0.f; stab[idx] = has[k] ? ss[k] : 0.f; }
    __syncthreads();
    return ntiles;
}

#define STAG_OFF
#ifndef STAG_OFF
#define STAG(t) ((F.vcu & 3) * (t))
#else
#define STAG(t) 0
#endif
#define BLOCK_SEAM() do { __builtin_amdgcn_fence(__ATOMIC_RELEASE, "workgroup"); __syncthreads(); __builtin_amdgcn_fence(__ATOMIC_ACQUIRE, "workgroup"); } while (0)
#define GRID_BAR() do { XcdBarrier bb_ = bar; asm volatile("" : "+s"(bb_.bar), "+s"(bb_.x)); xcd_barrier(bb_); } while (0)
template <int l> __device__ __forceinline__ void layer_body(const Frame& F0, const XcdBarrier& bar) {
        Frame F = F0; GAS unsigned char* gws_ = (GAS unsigned char*)F0.ws; GAS float* gout_ = (GAS float*)F0.out;
        asm volatile("" : "+s"(gws_), "+s"(gout_), "+s"(F.vcu), "+s"(F.bx), "+s"(F.G), "+v"(F.tid)); F.ws = (unsigned char*)gws_; F.out = (float*)gout_;
        unsigned char* ws; const pg8::bf16_t* x8; const unsigned char* wl;
#define PHASE_PTRS() do { GAS unsigned char* g_ = (GAS unsigned char*)F0.ws; GAS float* o_ = (GAS float*)F0.out; asm volatile("" : "+s"(g_), "+s"(o_)); F.ws = (unsigned char*)g_; F.out = (float*)o_; ws = F.ws; x8 = (const pg8::bf16_t*)(ws + WS_X8); wl = ws + WS_W + (size_t)l * W_LAYER; } while (0)
        PHASE_PTRS();
#ifndef SKIP_CC
        cc_scan(F);
#endif
#ifdef DUP_GA
        { pg8::Gemm g{x8, (const pg8::bf16_t*)(wl + W_IN), DM / 2, DM / 2, DM / 2}; pg8::StaticOrder S; S.init(T, NPROJ, F.G, F.bx);
          pg8::EpiF8SC E{(unsigned char*)(ws + WS_PROJ), NPROJ, (const float*)(ws + WS_BIASP) + l * NPROJ, (const float*)(ws + WS_SX), (const float*)(ws + WS_SWP) + l * NPROJ};
          pg8::gemm_phase<pg8::EpiF8SC, pg8::StaticOrder, PG8_ALIGN, false, true>(F.lds + RING_OFF, F.lds + GT_OFF, g, S, E, STAG(600)); }
#endif
#ifndef SKIP_GA
        { pg8::Gemm g{x8, (const pg8::bf16_t*)(wl + W_IN), DM / 2, DM / 2, DM / 2}; pg8::StaticOrder S; S.init(T, NPROJ, F.G, F.bx);
          pg8::EpiF8SC E{(unsigned char*)(ws + WS_PROJ), NPROJ, (const float*)(ws + WS_BIASP) + l * NPROJ, (const float*)(ws + WS_SX), (const float*)(ws + WS_SWP) + l * NPROJ};
          pg8::gemm_phase<pg8::EpiF8SC, pg8::StaticOrder, PG8_ALIGN, false, true>(F.lds + RING_OFF, F.lds + GT_OFF, g, S, E, STAG(600)); }
#endif
#ifndef SKIP_GM
        if (l == 0) { pg8::Gemm g{(const pg8::bf16_t*)(ws + WS_MEMB), (const pg8::bf16_t*)(ws + WS_WMEM), DM, DM, DM}; pg8::StaticOrder S; S.init(MEMROWS, 1024, F.G, F.bx);
          pg8::EpiBf16<false> E{(pg8::bf16_t*)(ws + WS_MEMKV), 1024, nullptr, nullptr, nullptr};
          pg8::gemm_phase<pg8::EpiBf16<false>, pg8::StaticOrder, PG8_ALIGN, false>(F.lds + RING_OFF, F.lds + GT_OFF, g, S, E, STAG(500)); }
#endif
        GRID_BAR();
        PHASE_PTRS();
#ifdef NAIVE_RECUR
        naive_recur(F, l);
#else
        recur_phase(F, l);
#ifdef DUP_RECUR
        recur_phase(F, l);
#endif
#endif
#ifdef NAIVE_ATTN
        naive_attn(F, l);
#else
        attn_phase(F, l);
#ifdef DUP_ATTN
        attn_phase(F, l);
#endif
#endif
        GRID_BAR();
        PHASE_PTRS();
#ifdef DUP_GC
        { pg8::Gemm g{(const pg8::bf16_t*)((unsigned char*)F.out), (const pg8::bf16_t*)(wl + W_B), DM / 2, 128, 128}; pg8::StaticOrder S; S.init(T, 4096, F.G, F.bx, 4, 128);
          pg8::EpiU8 E{(unsigned char*)(ws + WS_U), 4096, 1.0f / BRSCALE, true};
          pg8::gemm_phase<pg8::EpiU8, pg8::StaticOrder, PG8_ALIGN, false, false, true>(F.lds + RING_OFF, F.lds + GT_OFF, g, S, E, STAG(500)); }
#endif
#ifndef SKIP_GC
        { pg8::Gemm g{(const pg8::bf16_t*)((unsigned char*)F.out), (const pg8::bf16_t*)(wl + W_B), DM / 2, 128, 128}; pg8::StaticOrder S; S.init(T, 4096, F.G, F.bx, 4, 128);
          pg8::EpiU8 E{(unsigned char*)(ws + WS_U), 4096, 1.0f / BRSCALE, true};
          pg8::gemm_phase<pg8::EpiU8, pg8::StaticOrder, PG8_ALIGN, false, false, true>(F.lds + RING_OFF, F.lds + GT_OFF, g, S, E, STAG(500)); }
#endif
        GRID_BAR();
        PHASE_PTRS();
#ifdef DUP_GD
        { pg8::Gemm g{x8, (const pg8::bf16_t*)(wl + W_G), DM / 2, DM / 2, DM / 2}; pg8::StaticOrder S; S.init(T, NGATE, F.G, F.bx);
          pg8::EpiGateMix E{(const unsigned char*)(ws + WS_U), (unsigned char*)F.out, (const float*)(ws + WS_BIASG) + l * NGATE, (const float*)(ws + WS_SX), (const float*)(ws + WS_SWG) + l * NGATE};
          pg8::gemm_phase<pg8::EpiGateMix, pg8::StaticOrder, PG8_ALIGN, false, true>(F.lds + RING_OFF, F.lds + GT_OFF, g, S, E, STAG(600)); }
#endif
#ifndef SKIP_GD
        { pg8::Gemm g{x8, (const pg8::bf16_t*)(wl + W_G), DM / 2, DM / 2, DM / 2}; pg8::StaticOrder S; S.init(T, NGATE, F.G, F.bx);
          pg8::EpiGateMix E{(const unsigned char*)(ws + WS_U), (unsigned char*)F.out, (const float*)(ws + WS_BIASG) + l * NGATE, (const float*)(ws + WS_SX), (const float*)(ws + WS_SWG) + l * NGATE};
          pg8::gemm_phase<pg8::EpiGateMix, pg8::StaticOrder, PG8_ALIGN, false, true>(F.lds + RING_OFF, F.lds + GT_OFF, g, S, E, STAG(600)); }
#endif
        GRID_BAR();
        PHASE_PTRS();
#ifdef DUP_GE
        { pg8::Gemm g{(const pg8::bf16_t*)((unsigned char*)F.out), (const pg8::bf16_t*)(wl + W_OUT), DM / 2, DM / 2, DM / 2}; pg8::StaticOrder S; S.init(T, DM, F.G, F.bx);
          pg8::EpiU8 E{(unsigned char*)(ws + WS_Y), DM, 1.0f / 16.0f};
          pg8::gemm_phase<pg8::EpiU8, pg8::StaticOrder, PG8_ALIGN, false, false, true>(F.lds + RING_OFF, F.lds + GT_OFF, g, S, E, STAG(500)); }
#endif
#ifndef SKIP_GE
        { pg8::Gemm g{(const pg8::bf16_t*)((unsigned char*)F.out), (const pg8::bf16_t*)(wl + W_OUT), DM / 2, DM / 2, DM / 2}; pg8::RowOrder<4> S; S.init(T, DM, F.G, F.bx);
          pg8::EpiU8 E{(unsigned char*)(ws + WS_Y), DM, 1.0f / 16.0f};
          pg8::gemm_phase<pg8::EpiU8, pg8::RowOrder<4>, PG8_ALIGN, false, false, true>(F.lds + RING_OFF, F.lds + GT_OFF, g, S, E, STAG(500)); }
#endif
        BLOCK_SEAM();
        PHASE_PTRS();
#ifdef DUP_LN1
        ln1_phase(F, l, false); __syncthreads();
#endif
#ifndef SKIP_LN1
        ln1_phase(F, l);
#endif
        GRID_BAR();
        PHASE_PTRS();
        const int ntiles = moe_tables(F, l);
#ifdef DUP_GG
        { pg8::Gemm g{(const pg8::bf16_t*)(ws + WS_X18), (const pg8::bf16_t*)(wl + W_E1), DM / 2, DM / 2, DM / 2};
          pg8::MoeOrder S{F.G, F.vcu, 4, ntiles, (const LAS int*)(F.lds + SM_OFF), (const LAS int*)(F.lds + GT_OFF), (size_t)1024 * 512, true};
          pg8::EpiMoe1 E{(unsigned char*)(ws + WS_ACT), (const LAS float*)(F.lds + STB_OFF), (const LAS int*)(F.lds + SM_OFF), (const float*)(ws + WS_SWE) + l * 16 * 1024};
          pg8::gemm_phase<pg8::EpiMoe1, pg8::MoeOrder, PG8_ALIGN, true, true>(F.lds + RING_OFF, F.lds + EV_OFF, g, S, E, STAG(600)); }
#endif
#ifndef SKIP_GG
        { pg8::Gemm g{(const pg8::bf16_t*)(ws + WS_X18), (const pg8::bf16_t*)(wl + W_E1), DM / 2, DM / 2, DM / 2};
          pg8::MoeOrder S{F.G, F.vcu, 4, ntiles, (const LAS int*)(F.lds + SM_OFF), (const LAS int*)(F.lds + GT_OFF), (size_t)1024 * 512, true};
          pg8::EpiMoe1 E{(unsigned char*)(ws + WS_ACT), (const LAS float*)(F.lds + STB_OFF), (const LAS int*)(F.lds + SM_OFF), (const float*)(ws + WS_SWE) + l * 16 * 1024};
          pg8::gemm_phase<pg8::EpiMoe1, pg8::MoeOrder, PG8_ALIGN, true, true>(F.lds + RING_OFF, F.lds + EV_OFF, g, S, E, STAG(600)); }
#endif
        GRID_BAR();
        PHASE_PTRS();
#ifdef DUP_GH
        { pg8::Gemm g{(const pg8::bf16_t*)(ws + WS_ACT), (const pg8::bf16_t*)(wl + W_E2), DE / 2, DE / 2, DE / 2};
          pg8::MoeOrder S{F.G, F.vcu, 4, ntiles, (const LAS int*)(F.lds + SM_OFF), (const LAS int*)(F.lds + GT_OFF), (size_t)1024 * 256, false};
          pg8::EpiMoe2 E{(unsigned char*)(ws + WS_Y2), (const LAS int*)(F.lds + GT_OFF), (const LAS float*)(F.lds + WTB_OFF)};
          pg8::gemm_phase<pg8::EpiMoe2, pg8::MoeOrder, PG8_ALIGN, false, false, true>(F.lds + RING_OFF, F.lds + EV_OFF, g, S, E, STAG(500)); }
#endif
#ifndef SKIP_GH
        { pg8::Gemm g{(const pg8::bf16_t*)(ws + WS_ACT), (const pg8::bf16_t*)(wl + W_E2), DE / 2, DE / 2, DE / 2};
          pg8::MoeOrder S{F.G, F.vcu, 4, ntiles, (const LAS int*)(F.lds + SM_OFF), (const LAS int*)(F.lds + GT_OFF), (size_t)1024 * 256, false};
          pg8::EpiMoe2 E{(unsigned char*)(ws + WS_Y2), (const LAS int*)(F.lds + GT_OFF), (const LAS float*)(F.lds + WTB_OFF)};
          pg8::gemm_phase<pg8::EpiMoe2, pg8::MoeOrder, PG8_ALIGN, false, false, true>(F.lds + RING_OFF, F.lds + EV_OFF, g, S, E, STAG(500)); }
#endif
        GRID_BAR();
        PHASE_PTRS();
#ifdef DUP_LN2
        ln2_phase(F, l); __syncthreads();
#endif
#ifndef SKIP_LN2
        ln2_phase(F, l);
#endif
        if (l + 1 < NLAYER) GRID_BAR();
}

__global__ void __launch_bounds__(NWAVES * 64, 2) fwd_kernel(Args args) {
    extern __shared__ __attribute__((aligned(16))) unsigned char lds[];
    Frame F0;
    F0.lds = (LAS unsigned char*)lds;
    F0.MISC = (volatile LAS unsigned*)(F0.lds + MISC_OFF);
    F0.tid = threadIdx.x;
    F0.G = gridDim.x; F0.bx = blockIdx.x; { const int bx = blockIdx.x; F0.vcu = (F0.G % 8 == 0) ? (bx % 8) * (F0.G / 8) + bx / 8 : bx; }
    F0.ws = args.ws; F0.out = args.out; F0.ctl = (gu32*)(args.ws + WS_CTL);
    for (int u = F0.tid; u < (LDS_BYTES - LDSCTL_OFF) / 4; u += NWAVES * 64) ((LAS unsigned*)(F0.lds + LDSCTL_OFF))[u] = 0u;
    __syncthreads();
    XcdBarrier bar = xcd_barrier_post((unsigned*)(F0.ctl + CW_BAR), F0.MISC + 8);

#ifdef DUP_P0
    p0_prologue(F0, args); __syncthreads();
#endif
#ifndef SKIP_P0
    p0_prologue(F0, args);
#endif
    GRID_BAR();

    layer_body<0>(F0, bar);
    layer_body<1>(F0, bar);
}

extern "C" void kernel_launch(void* const* d_in, const int* in_sizes, int n_in, void* d_out, int out_size, void* d_ws, size_t ws_size, hipStream_t stream) {
    static int grid = 0;
    if (grid == 0) {
        if (n_in != 15 || in_sizes[0] != T * DM || out_size != T * DM || ws_size < WS_END) { fprintf(stderr, "kernel_launch: unexpected shapes / workspace (n_in %d, in0 %d, out %d, ws %zu); nothing launched\n", n_in, n_in > 0 ? in_sizes[0] : -1, out_size, ws_size); grid = -1; return; }
        int dev = 0, cus = 0, per_cu = 0;
        if (hipGetDevice(&dev) != hipSuccess || hipDeviceGetAttribute(&cus, hipDeviceAttributeMultiprocessorCount, dev) != hipSuccess) { grid = -1; return; }
        if (hipFuncSetAttribute((const void*)fwd_kernel, hipFuncAttributeMaxDynamicSharedMemorySize, LDS_BYTES) != hipSuccess) { fprintf(stderr, "kernel_launch: hipFuncSetAttribute failed\n"); grid = -1; return; }
        if (hipOccupancyMaxActiveBlocksPerMultiprocessor(&per_cu, (const void*)fwd_kernel, NWAVES * 64, LDS_BYTES) != hipSuccess || per_cu < 1) fprintf(stderr, "kernel_launch: occupancy query reports %d\n", per_cu);
        (void)hipGetLastError();
        grid = cus;
    }
    if (grid < 0) return;
    if (hipMemsetAsync((char*)d_ws + WS_CTL, 0, CTL_ZERO_BYTES, stream) != hipSuccess) return;
    Args a{};
    for (int i = 0; i < 15; ++i) a.in[i] = (const float*)d_in[i];
    a.out = (float*)d_out; a.ws = (unsigned char*)d_ws; a.naive = 0; a.pad = 0;
    hipLaunchKernelGGL(fwd_kernel, dim3(grid), dim3(NWAVES * 64), LDS_BYTES, stream, a);
}
```
